# Optimizing an MI355X kernel written in HIP

```python
import jax, jax.numpy as jnp
from jax import lax
import numpy as np

D_MODEL = 1024
BATCH = 2
SEQ = 8192
DEPTH = 4

N_MEM = 256
EPS = 1e-6
N_BRANCH = 4
BRANCH_W = D_MODEL // 2
GM_W = BRANCH_W
GM_GROUPS = 4
GM_CHUNK = 128
LRU_W = BRANCH_W
LRU_BLOCKS = 8
LRU_CONV = 4
LRU_C = 8.0
HEAD_DIM = 64
SWA_HEADS = BRANCH_W // HEAD_DIM
SWA_KV = 2
WINDOW = 128
ROPE_THETA = 500000.0
ROT_DIM = HEAD_DIM // 4
XA_HEADS = 4
XA_DIM = BRANCH_W // XA_HEADS
D_FF = 4 * D_MODEL

IN_SIZES = [2 * GM_W, 2 * LRU_W, SWA_HEADS * HEAD_DIM, SWA_KV * HEAD_DIM, SWA_KV * HEAD_DIM,
            XA_HEADS * XA_DIM, N_BRANCH * D_MODEL]
D_IN = sum(IN_SIZES)
IN_SPLITS = [int(v) for v in np.cumsum(IN_SIZES)[:-1]]

kernel_name = "griffin_hybrid_gmlp_rglru_swa_xattn"


def rmsnorm(x, g):
    xf = x.astype(jnp.float32)
    y = xf * lax.rsqrt(jnp.mean(xf * xf, axis=-1, keepdims=True) + EPS)
    return (y * g.astype(jnp.float32)).astype(x.dtype)


def rope_tables(seq):
    pos = jnp.arange(seq, dtype=jnp.float32)
    inv = ROPE_THETA ** (-jnp.arange(0, ROT_DIM, 2, dtype=jnp.float32) / ROT_DIM)
    ang = pos[:, None] * inv[None, :]
    return jnp.cos(ang), jnp.sin(ang)


def partial_rope(x, cos, sin):
    xf = x.astype(jnp.float32)
    half = ROT_DIM // 2
    x1, x2, xp = xf[..., :half], xf[..., half:ROT_DIM], xf[..., ROT_DIM:]
    c = cos[None, :, None, :]
    s = sin[None, :, None, :]
    out = jnp.concatenate([x1 * c - x2 * s, x2 * c + x1 * s, xp], axis=-1)
    return out.astype(x.dtype)


def gmlp_branch(z, v_gain, ws, bs):
    B, S, _ = z.shape
    z = jax.nn.gelu(z)
    u, v = jnp.split(z, 2, axis=-1)
    v = rmsnorm(v, v_gain)
    nc = S // GM_CHUNK
    v = v.reshape(B, nc, GM_CHUNK, GM_GROUPS, GM_W // GM_GROUPS)
    causal = jnp.tril(jnp.ones((GM_CHUNK, GM_CHUNK), dtype=bool))
    w = jnp.where(causal[None], ws, jnp.zeros_like(ws))
    s = jnp.einsum('gts,bnsgc->bntgc', w, v) + bs.T[:, :, None]
    return u * s.reshape(B, S, GM_W)


def rglru_branch(z, conv_w, conv_b, wr, br, wi, bi, lam):
    B, S, _ = z.shape
    xb, gb = jnp.split(z, 2, axis=-1)
    xp = jnp.pad(xb, ((0, 0), (LRU_CONV - 1, 0), (0, 0)))
    xc = conv_b + xp[:, 0:S] * conv_w[0]
    for k in range(1, LRU_CONV):
        xc = xc + xp[:, k:k + S] * conv_w[k]
    xh = xc.reshape(B, S, LRU_BLOCKS, LRU_W // LRU_BLOCKS)
    r_gate = jax.nn.sigmoid(jnp.einsum('bshi,hij->bshj', xh, wr).reshape(B, S, LRU_W) + br)
    i_gate = jax.nn.sigmoid(jnp.einsum('bshi,hij->bshj', xh, wi).reshape(B, S, LRU_W) + bi)
    log_a = -LRU_C * r_gate.astype(jnp.float32) * jax.nn.softplus(-lam.astype(jnp.float32))
    a = jnp.exp(log_a)
    mult = jnp.sqrt(-jnp.expm1(2.0 * log_a))
    b_in = xc.astype(jnp.float32) * i_gate.astype(jnp.float32) * mult

    def combine(lhs, rhs):
        a1, b1 = lhs
        a2, b2 = rhs
        return a1 * a2, a2 * b1 + b2

    _, h = lax.associative_scan(combine, (a, b_in), axis=1)
    return jax.nn.gelu(gb) * h.astype(gb.dtype)


def swa_branch(q, k, v, q_gain, k_gain, sinks, cos, sin):
    B, S, _ = q.shape
    G = SWA_HEADS // SWA_KV
    nb = S // WINDOW
    q = partial_rope(rmsnorm(q.reshape(B, S, SWA_HEADS, HEAD_DIM), q_gain), cos, sin)
    k = partial_rope(rmsnorm(k.reshape(B, S, SWA_KV, HEAD_DIM), k_gain), cos, sin)
    v = v.reshape(B, S, SWA_KV, HEAD_DIM)
    qb = q.reshape(B, nb, WINDOW, SWA_KV, G, HEAD_DIM)
    kb = k.reshape(B, nb, WINDOW, SWA_KV, HEAD_DIM)
    vb = v.reshape(B, nb, WINDOW, SWA_KV, HEAD_DIM)
    pad = ((0, 0), (1, 0), (0, 0), (0, 0), (0, 0))
    kk = jnp.concatenate([jnp.pad(kb, pad)[:, :-1], kb], axis=2)
    vv = jnp.concatenate([jnp.pad(vb, pad)[:, :-1], vb], axis=2)
    scores = jnp.einsum('bnikgd,bnjkd->bnkgij', qb, kk).astype(jnp.float32) * (HEAD_DIM ** -0.5)
    qi = jnp.arange(WINDOW)[:, None]
    kj = jnp.arange(2 * WINDOW)[None, :]
    diff = qi + WINDOW - kj
    band = (diff >= 0) & (diff < WINDOW)
    first_ok = (jnp.arange(nb)[:, None, None] > 0) | (kj[None] >= WINDOW)
    valid = band[None] & first_ok
    scores = jnp.where(valid[None, :, None, None], scores, -jnp.inf)
    sink = sinks.astype(jnp.float32).reshape(SWA_KV, G)[None, None, :, :, None, None]
    m = jnp.maximum(jnp.max(scores, axis=-1, keepdims=True), sink)
    p = jnp.exp(scores - m)
    p = p / (jnp.sum(p, axis=-1, keepdims=True) + jnp.exp(sink - m))
    o = jnp.einsum('bnkgij,bnjkd->bnikgd', p.astype(vv.dtype), vv)
    return o.reshape(B, S, SWA_HEADS * HEAD_DIM)


def cross_branch(q, mem_n, w_kv, q_gain, k_gain):
    B, S, _ = q.shape
    M = mem_n.shape[1]
    q = rmsnorm(q.reshape(B, S, XA_HEADS, XA_DIM), q_gain)
    k, v = jnp.split(mem_n @ w_kv, 2, axis=-1)
    k = rmsnorm(k.reshape(B, M, XA_HEADS, XA_DIM), k_gain)
    v = v.reshape(B, M, XA_HEADS, XA_DIM)
    s = jnp.einsum('bshd,bmhd->bhsm', q, k).astype(jnp.float32) * (XA_DIM ** -0.5)
    p = jax.nn.softmax(s, axis=-1)
    o = jnp.einsum('bhsm,bmhd->bshd', p.astype(v.dtype), v)
    return o.reshape(B, S, XA_HEADS * XA_DIM)


def setup_inputs(seed: int = 0) -> dict:
    key = jax.random.key(seed)
    ks = jax.random.split(key, 32)
    f32 = jnp.float32
    nrm = lambda k, shape, scale: jax.random.normal(k, shape, f32) * scale
    gain = lambda k, shape: 1.0 + 0.01 * jax.random.normal(k, shape, f32)
    L = DEPTH
    a_c = jax.random.uniform(ks[12], (L, LRU_W), f32, 0.9, 0.999)
    a0 = a_c ** (1.0 / LRU_C)
    lam = jnp.log(a0) - jnp.log1p(-a0)
    return {
        "x": nrm(ks[0], (BATCH, SEQ, D_MODEL), 1.0),
        "mem": nrm(ks[1], (BATCH, N_MEM, D_MODEL), 1.0),
        "norm_mix": gain(ks[2], (L, D_MODEL)),
        "norm_mem": gain(ks[3], (L, D_MODEL)),
        "norm_mlp": gain(ks[4], (L, D_MODEL)),
        "w_in": nrm(ks[5], (L, D_MODEL, D_IN), D_MODEL ** -0.5),
        "b_gate": nrm(ks[6], (L, N_BRANCH, D_MODEL), 0.01),
        "gm_v_gain": gain(ks[7], (L, GM_W)),
        "gm_ws": nrm(ks[8], (L, GM_GROUPS, GM_CHUNK, GM_CHUNK), GM_CHUNK ** -0.5),
        "gm_bs": gain(ks[9], (L, GM_GROUPS, GM_CHUNK)),
        "lru_conv_w": nrm(ks[10], (L, LRU_CONV, LRU_W), LRU_CONV ** -0.5),
        "lru_conv_b": nrm(ks[11], (L, LRU_W), 0.01),
        "lru_wr": nrm(ks[13], (L, LRU_BLOCKS, LRU_W // LRU_BLOCKS, LRU_W // LRU_BLOCKS), (LRU_W // LRU_BLOCKS) ** -0.5),
        "lru_br": nrm(ks[14], (L, LRU_W), 0.01),
        "lru_wi": nrm(ks[15], (L, LRU_BLOCKS, LRU_W // LRU_BLOCKS, LRU_W // LRU_BLOCKS), (LRU_W // LRU_BLOCKS) ** -0.5),
        "lru_bi": nrm(ks[16], (L, LRU_W), 0.01),
        "lru_lambda": lam,
        "swa_q_gain": gain(ks[17], (L, HEAD_DIM)),
        "swa_k_gain": gain(ks[18], (L, HEAD_DIM)),
        "swa_sinks": nrm(ks[19], (L, SWA_HEADS), 0.5),
        "w_mem_kv": nrm(ks[20], (L, D_MODEL, 2 * XA_HEADS * XA_DIM), D_MODEL ** -0.5),
        "xa_q_gain": gain(ks[21], (L, XA_DIM)),
        "xa_k_gain": gain(ks[22], (L, XA_DIM)),
        "w_branch": nrm(ks[23], (L, N_BRANCH, BRANCH_W, D_MODEL), BRANCH_W ** -0.5),
        "w_out": nrm(ks[24], (L, D_MODEL, D_MODEL), D_MODEL ** -0.5),
        "w_ff1": nrm(ks[25], (L, D_MODEL, D_FF), D_MODEL ** -0.5),
        "w_ff2": nrm(ks[26], (L, D_FF, D_MODEL), D_FF ** -0.5),
    }


def reference(x, mem, norm_mix, norm_mem, norm_mlp, w_in, b_gate, gm_v_gain, gm_ws, gm_bs,
              lru_conv_w, lru_conv_b, lru_wr, lru_br, lru_wi, lru_bi, lru_lambda,
              swa_q_gain, swa_k_gain, swa_sinks, w_mem_kv, xa_q_gain, xa_k_gain,
              w_branch, w_out, w_ff1, w_ff2):
    B, S, D = x.shape
    cos, sin = rope_tables(S)
    for l in range(DEPTH):
        h = rmsnorm(x, norm_mix[l])
        z = h @ w_in[l]
        z_gm, z_lru, q_s, k_s, v_s, q_x, z_gate = jnp.split(z, IN_SPLITS, axis=-1)
        mem_n = rmsnorm(mem, norm_mem[l])
        o_gm = gmlp_branch(z_gm, gm_v_gain[l], gm_ws[l], gm_bs[l])
        o_lru = rglru_branch(z_lru, lru_conv_w[l], lru_conv_b[l], lru_wr[l], lru_br[l],
                             lru_wi[l], lru_bi[l], lru_lambda[l])
        o_swa = swa_branch(q_s, k_s, v_s, swa_q_gain[l], swa_k_gain[l], swa_sinks[l], cos, sin)
        o_xa = cross_branch(q_x, mem_n, w_mem_kv[l], xa_q_gain[l], xa_k_gain[l])
        o = jnp.stack([o_gm, o_lru, o_swa, o_xa], axis=2)
        p = jnp.einsum('bsnc,ncd->bsnd', o, w_branch[l])
        g = jax.nn.sigmoid(z_gate.reshape(B, S, N_BRANCH, D) + b_gate[l])
        x = x + jnp.sum(g * p, axis=2) @ w_out[l]
        h = rmsnorm(x, norm_mlp[l])
        x = x + jnp.square(jax.nn.relu(h @ w_ff1[l])) @ w_ff2[l]
    return x
```

```cpp
#include <hip/hip_runtime.h>
#include <hip/hip_cooperative_groups.h>
#include <cstdio>
#include <cstdint>
namespace cg = cooperative_groups;

#define LAS __attribute__((address_space(3)))
#define GAS __attribute__((address_space(1)))
typedef unsigned short bf16_t;
typedef short bf16x8 __attribute__((ext_vector_type(8)));
typedef float f32x4 __attribute__((ext_vector_type(4)));
typedef unsigned u32x4 __attribute__((ext_vector_type(4)));
typedef unsigned u32x2 __attribute__((ext_vector_type(2)));

constexpr int M = 16384, D = 1024, DIN = 7424, NZA = 3328, NZG = 4096, FF = 4096, DEPTH = 4, NO = 2048;
constexpr float EPS = 1e-6f;
constexpr size_t MiB = 1u << 20;
constexpr size_t WS_CTL = 0, CTL_ZERO_BYTES = 64 * 1024;
constexpr size_t WS_WIN = 2 * MiB, WS_WBR = 17 * MiB, WS_WOUT = 21 * MiB, WS_WFF1 = 23 * MiB, WS_WFF2 = 31 * MiB, WS_WKV = 39 * MiB;
constexpr size_t WS_MEMN = 47 * MiB, WS_MEMKV = 48 * MiB, WS_SSQ = 52 * MiB, WS_CARRY = 53 * MiB, WS_XB = 54 * MiB;
constexpr size_t WS_ZA = 86 * MiB, WS_S = 86 * MiB, WS_MB = 150 * MiB, WS_ZG = 190 * MiB, WS_O = 318 * MiB, WS_LY = 382 * MiB, WS_LP = 414 * MiB, WS_END = 446 * MiB;
static_assert(WS_ZA + (size_t)M * NZA * 2 <= WS_ZG && WS_MB + (size_t)M * D * 2 <= WS_ZG && WS_WIN + (size_t)DIN * D * 2 <= WS_WBR, "ws map");

constexpr int LDS_BYTES = 147456, MISC_OFF = LDS_BYTES - 256;

__device__ __forceinline__ float bf2f(bf16_t h) { return __uint_as_float((unsigned)h << 16); }
__device__ __forceinline__ unsigned f2bf(float f) { unsigned u = __float_as_uint(f); return (u + 0x7fffu + ((u >> 16) & 1u)) >> 16; }
__device__ __forceinline__ unsigned pk2(float lo, float hi) { return f2bf(lo) | (f2bf(hi) << 16); }
__device__ __forceinline__ unsigned cvt_pk_bf16(float lo, float hi) { unsigned r; asm volatile("v_cvt_pk_bf16_f32 %0, %1, %2" : "=v"(r) : "v"(lo), "v"(hi)); return r; }
#define UNPACK8(VV, f, o) do { (f)[(o) + 0] = __uint_as_float((VV)[0] << 16); (f)[(o) + 1] = __uint_as_float((VV)[0] & 0xffff0000u); (f)[(o) + 2] = __uint_as_float((VV)[1] << 16); (f)[(o) + 3] = __uint_as_float((VV)[1] & 0xffff0000u); \
    (f)[(o) + 4] = __uint_as_float((VV)[2] << 16); (f)[(o) + 5] = __uint_as_float((VV)[2] & 0xffff0000u); (f)[(o) + 6] = __uint_as_float((VV)[3] << 16); (f)[(o) + 7] = __uint_as_float((VV)[3] & 0xffff0000u); } while (0)
#define PACK8(f, o) ((u32x4){pk2((f)[(o) + 0], (f)[(o) + 1]), pk2((f)[(o) + 2], (f)[(o) + 3]), pk2((f)[(o) + 4], (f)[(o) + 5]), pk2((f)[(o) + 6], (f)[(o) + 7])})
__device__ __forceinline__ float gelu_t(float x) { const float u = 0.7978845608028654f * (x + 0.044715f * x * x * x); return x / (1.f + __expf(-2.f * u)); }
__device__ __forceinline__ float sigmoid_f(float x) { return 1.f / (1.f + __expf(-x)); }
__device__ __forceinline__ float row_rstd(const float* ssq, int row) {
    const f32x4* p = (const f32x4*)(ssq + (size_t)row * 16);
    const f32x4 a = p[0], b = p[1], c = p[2], d = p[3];
    const float s = (((a.x + a.y) + (a.z + a.w)) + ((b.x + b.y) + (b.z + b.w))) + (((c.x + c.y) + (c.z + c.w)) + ((d.x + d.y) + (d.z + d.w)));
    return rsqrtf(s * (1.f / 1024.f) + EPS);
}
#define LDS_WAIT() asm volatile("s_waitcnt lgkmcnt(0)" ::: "memory")
__device__ __forceinline__ int opaque_tid() { int t = threadIdx.x; asm volatile("" : "+v"(t)); return t; }

namespace pg8 {
constexpr int BM = 256, BK = 64, HALF = 128, HTB = HALF * BK * 2, STAGE_BYTES = 8 * HTB, NXCD = 8, WGM = 8;
__host__ __device__ __forceinline__ int lds_byte(int r, int c) { const int st = (r >> 4) * 2 + (c >> 5), rr = r & 15, cc = c & 31, ob = rr * 64 + cc * 2; return st * 1024 + (ob ^ (((ob >> 9) & 1) << 5)); }
__host__ __device__ __forceinline__ void stage_rc(int b, int& R, int& C) { const int st = b / 1024, sb = b % 1024, swz = sb ^ (((sb >> 9) & 1) << 5); R = (st >> 1) * 16 + swz / 64; C = (st & 1) * 32 + (swz % 64) / 2; }
__host__ __device__ __forceinline__ int perm32(int rho) { const int n = rho >> 4, i = rho & 15; return 8 * (i >> 2) + 4 * n + (i & 3); }

struct Unit { int pm, pn, b; };
struct Gemm { const bf16_t* A; const bf16_t* Bt; };

struct SchedStd {
    int nM, nN, nwg, G, c; size_t as, bs;
    __device__ void init(int M_, int N_, int G_, int c_, int lda, int ldb) { nM = M_ / BM; nN = N_ / BM; nwg = nM * nN; G = G_; c = c_; as = (size_t)BM * lda * 2; bs = (size_t)BM * ldb * 2; }
    __device__ bool tile(long L, Unit& u) const {
        if (L >= nwg) return false;
        int wgid = (int)L; { const int q = nwg / NXCD, r = nwg % NXCD, xcd = wgid % NXCD, off = wgid / NXCD; wgid = (xcd < r ? xcd * (q + 1) : r * (q + 1) + (xcd - r) * q) + off; }
        const int nig = WGM * nN, gid = wgid / nig, fm = gid * WGM, gsz = (nM - fm) < WGM ? (nM - fm) : WGM;
        u.pm = fm + ((wgid % nig) % gsz); u.pn = (wgid % nig) / gsz; u.b = 0; return true;
    }
    __device__ bool next(int i, Unit& u) const { return tile((long)i * G + c, u); }
    __device__ size_t aoff(const Unit& u) const { return (size_t)u.pm * as; }
    __device__ size_t boff(const Unit& u) const { return (size_t)u.pn * bs; }
};
struct SchedMerge {
    SchedStd t;
    __device__ bool next(int i, Unit& u) const { if (!t.tile((long)(i >> 2) * t.G + t.c, u)) return false; u.b = i & 3; return true; }
    __device__ size_t aoff(const Unit& u) const { return (size_t)u.pm * t.as + (size_t)u.b * 1024; }
    __device__ size_t boff(const Unit& u) const { return (size_t)u.pn * t.bs + (size_t)u.b * 1024; }
};
struct SchedKV {
    int c;
    __device__ bool next(int i, Unit& u) const { if (i > 0 || c >= 32) return false; u.b = c >> 3; u.pm = (c & 7) >> 2; u.pn = c & 3; return true; }
    __device__ size_t aoff(const Unit& u) const { return (size_t)u.pm * 256 * 1024 * 2; }
    __device__ size_t boff(const Unit& u) const { return ((size_t)u.b * 1024 + (size_t)u.pn * 256) * 1024 * 2; }
};

struct EpiZ {
    static constexpr bool PERM = true;
    bf16_t* za; bf16_t* zg; const float* ssq; const float* bgate;
    __device__ __forceinline__ void operator()(const f32x4 (&acc)[2][2][4][2], const Unit& u, int wr, int wc, int fr, int fq) const {
        const int row0 = u.pm * BM + wr * 64 + fr, pn = u.pn;
        bf16_t* base; int ldc, colt, mode;
        if (pn < 13) { base = za; ldc = NZA; colt = pn * 256; mode = (pn < 4 || pn == 6 || pn == 7) ? 1 : 0; }
        else { base = zg; ldc = NZG; colt = (pn - 13) * 256; mode = 2; }
        const int col0 = colt + wc * 32 + 8 * fq;
        f32x4 bv[2][2];
#pragma unroll
        for (int bj = 0; bj < 2; ++bj)
#pragma unroll
            for (int n = 0; n < 2; ++n) bv[bj][n] = (mode == 2) ? *(const f32x4*)(bgate + col0 + bj * HALF + 4 * n) : (f32x4){0.f, 0.f, 0.f, 0.f};
#pragma unroll
        for (int ai = 0; ai < 2; ++ai)
#pragma unroll
            for (int m = 0; m < 4; ++m) {
                const int row = row0 + ai * HALF + m * 16; const float rs = row_rstd(ssq, row);
                bf16_t* rowp = base + (size_t)row * ldc + col0;
#pragma unroll
                for (int bj = 0; bj < 2; ++bj) {
                    f32x4 v0 = acc[ai][bj][m][0] * rs, v1 = acc[ai][bj][m][1] * rs;
                    if (mode == 1) {
#pragma unroll
                        for (int e = 0; e < 4; ++e) { v0[e] = gelu_t(v0[e]); v1[e] = gelu_t(v1[e]); }
                    } else if (mode == 2) {
                        v0 = v0 + bv[bj][0]; v1 = v1 + bv[bj][1];
#pragma unroll
                        for (int e = 0; e < 4; ++e) { v0[e] = sigmoid_f(v0[e]); v1[e] = sigmoid_f(v1[e]); }
                    }
                    u32x4 w; w.x = cvt_pk_bf16(v0[0], v0[1]); w.y = cvt_pk_bf16(v0[2], v0[3]); w.z = cvt_pk_bf16(v1[0], v1[1]); w.w = cvt_pk_bf16(v1[2], v1[3]);
                    *(u32x4*)(rowp + bj * HALF) = w;
                }
                asm volatile("" ::: "memory");
            }
    }
};
struct EpiFF1 {
    static constexpr bool PERM = true;
    bf16_t* f; const float* ssq;
    __device__ __forceinline__ void operator()(const f32x4 (&acc)[2][2][4][2], const Unit& u, int wr, int wc, int fr, int fq) const {
        const int row0 = u.pm * BM + wr * 64 + fr, col0 = u.pn * BM + wc * 32 + 8 * fq;
#pragma unroll
        for (int ai = 0; ai < 2; ++ai)
#pragma unroll
            for (int m = 0; m < 4; ++m) {
                const int row = row0 + ai * HALF + m * 16; const float rs = row_rstd(ssq, row);
                bf16_t* rowp = f + (size_t)row * FF + col0;
#pragma unroll
                for (int bj = 0; bj < 2; ++bj) {
                    f32x4 v0 = acc[ai][bj][m][0] * rs, v1 = acc[ai][bj][m][1] * rs;
#pragma unroll
                    for (int e = 0; e < 4; ++e) { const float a = fmaxf(v0[e], 0.f), b = fmaxf(v1[e], 0.f); v0[e] = a * a; v1[e] = b * b; }
                    u32x4 w; w.x = cvt_pk_bf16(v0[0], v0[1]); w.y = cvt_pk_bf16(v0[2], v0[3]); w.z = cvt_pk_bf16(v1[0], v1[1]); w.w = cvt_pk_bf16(v1[2], v1[3]);
                    *(u32x4*)(rowp + bj * HALF) = w;
                }
                asm volatile("" ::: "memory");
            }
    }
};
struct EpiRes {
    static constexpr bool PERM = true;
    float* x; bf16_t* xb; float* ssq;
    __device__ __forceinline__ void operator()(const f32x4 (&acc)[2][2][4][2], const Unit& u, int wr, int wc, int fr, int fq) const {
        const int row0 = u.pm * BM + wr * 64 + fr, col0 = u.pn * BM + wc * 32 + 8 * fq;
#pragma unroll
        for (int ai = 0; ai < 2; ++ai)
#pragma unroll
            for (int m = 0; m < 4; ++m) {
                const int row = row0 + ai * HALF + m * 16; float ss = 0.f;
#pragma unroll
                for (int bj = 0; bj < 2; ++bj) {
                    float* xp = x + (size_t)row * D + col0 + bj * HALF;
                    const f32x4 v0 = *(const f32x4*)xp + acc[ai][bj][m][0], v1 = *(const f32x4*)(xp + 4) + acc[ai][bj][m][1];
                    *(f32x4*)xp = v0; *(f32x4*)(xp + 4) = v1;
                    ss += (v0[0] * v0[0] + v0[1] * v0[1]) + (v0[2] * v0[2] + v0[3] * v0[3]) + (v1[0] * v1[0] + v1[1] * v1[1]) + (v1[2] * v1[2] + v1[3] * v1[3]);
                    u32x4 w; w.x = cvt_pk_bf16(v0[0], v0[1]); w.y = cvt_pk_bf16(v0[2], v0[3]); w.z = cvt_pk_bf16(v1[0], v1[1]); w.w = cvt_pk_bf16(v1[2], v1[3]);
                    *(u32x4*)(xb + (size_t)row * D + col0 + bj * HALF) = w;
                }
                ss += __shfl_xor(ss, 16); ss += __shfl_xor(ss, 32);
                if (fq == 0) ssq[(size_t)row * 16 + u.pn * 4 + wc] = ss;
                asm volatile("" ::: "memory");
            }
    }
};
struct EpiMerge {
    static constexpr bool PERM = true;
    const bf16_t* zg; float* S; bf16_t* mb;
    __device__ __forceinline__ void operator()(const f32x4 (&acc)[2][2][4][2], const Unit& u, int wr, int wc, int fr, int fq) const {
        const int row0 = u.pm * BM + wr * 64 + fr, col0 = u.pn * BM + wc * 32 + 8 * fq, b = u.b;
#pragma unroll
        for (int ai = 0; ai < 2; ++ai)
#pragma unroll
            for (int m = 0; m < 4; ++m) {
                const int row = row0 + ai * HALF + m * 16;
#pragma unroll
                for (int bj = 0; bj < 2; ++bj) {
                    const int col = col0 + bj * HALF;
                    const u32x4 gw = *(const u32x4*)(zg + (size_t)row * NZG + b * 1024 + col);
                    float g[8]; UNPACK8(gw, g, 0);
                    f32x4 v0 = acc[ai][bj][m][0], v1 = acc[ai][bj][m][1];
#pragma unroll
                    for (int e = 0; e < 4; ++e) { v0[e] *= g[e]; v1[e] *= g[4 + e]; }
                    float* sp = S + (size_t)row * D + col;
                    if (b > 0) { v0 = v0 + *(const f32x4*)sp; v1 = v1 + *(const f32x4*)(sp + 4); }
                    if (b < 3) { *(f32x4*)sp = v0; *(f32x4*)(sp + 4) = v1; }
                    else { u32x4 w; w.x = cvt_pk_bf16(v0[0], v0[1]); w.y = cvt_pk_bf16(v0[2], v0[3]); w.z = cvt_pk_bf16(v1[0], v1[1]); w.w = cvt_pk_bf16(v1[2], v1[3]);
                        *(u32x4*)(mb + (size_t)row * D + col) = w; }
                }
                asm volatile("" ::: "memory");
            }
    }
};
struct EpiKV {
    static constexpr bool PERM = true;
    bf16_t* out;
    __device__ __forceinline__ void operator()(const f32x4 (&acc)[2][2][4][2], const Unit& u, int wr, int wc, int fr, int fq) const {
        const int row0 = u.pm * BM + wr * 64 + fr, col0 = u.pn * BM + wc * 32 + 8 * fq;
        bf16_t* base = out + (size_t)u.b * 512 * 1024;
#pragma unroll
        for (int ai = 0; ai < 2; ++ai)
#pragma unroll
            for (int m = 0; m < 4; ++m) {
                const int row = row0 + ai * HALF + m * 16;
#pragma unroll
                for (int bj = 0; bj < 2; ++bj) {
                    const f32x4 v0 = acc[ai][bj][m][0], v1 = acc[ai][bj][m][1];
                    u32x4 w; w.x = cvt_pk_bf16(v0[0], v0[1]); w.y = cvt_pk_bf16(v0[2], v0[3]); w.z = cvt_pk_bf16(v1[0], v1[1]); w.w = cvt_pk_bf16(v1[2], v1[3]);
                    *(u32x4*)(base + (size_t)row * 1024 + col0 + bj * HALF) = w;
                }
            }
    }
};

template <class Epi, class Sched, bool ALIGN_EPI, int LDA, int LDB, int KK>
__device__ __forceinline__ void gemm_phase(LAS unsigned char* lds, const Gemm g, const Sched& S, const Epi& E) {
    const int tid = opaque_tid(), wid = __builtin_amdgcn_readfirstlane(tid >> 6), lane = tid & 63, wr = wid >> 2, wc = wid & 3, fr = lane & 15, fq = lane >> 4;
    constexpr int nt = KK / BK;
    unsigned voffA[2], voffB[2];
#pragma unroll
    for (int i = 0; i < 2; ++i) { int R, C; stage_rc(tid * 16 + i * 8192, R, C); const int Rb = Epi::PERM ? ((R & ~31) + perm32(R & 31)) : R;
        voffA[i] = (unsigned)(R * LDA + C) * 2u; voffB[i] = (unsigned)(Rb * LDB + C) * 2u; }
    constexpr size_t kstep = (size_t)(BK * 2);
    constexpr size_t hstepA = (size_t)HALF * LDA * 2, hstepB = (size_t)HALF * LDB * 2;
    const unsigned ldsw = (unsigned)wid * 1024u;
    const int aoff = lds_byte(wr * 64 + fr, fq * 8), boff = lds_byte(wc * 32 + fr, fq * 8);
#define PG8_SA(b, h) (((b) * 2 + (h)) * HTB)
#define PG8_SB(b, h) ((4 + (b) * 2 + (h)) * HTB)
#define PG8_STAGE(bufoff, gbase, voff) do { _Pragma("unroll") for (int _i = 0; _i < 2; ++_i) \
        __builtin_amdgcn_global_load_lds((const unsigned*)((const char*)(gbase) + (voff)[_i]), (LAS unsigned*)(lds + (bufoff) + ldsw + _i * 8192), 16, 0, 0); } while (0)
#define PG8_LDA(dst, b, h) do { _Pragma("unroll") for (int m = 0; m < 4; ++m) _Pragma("unroll") for (int k = 0; k < 2; ++k) dst[m][k] = *(const LAS bf16x8*)(lds + PG8_SA(b, h) + aoff + m * 2048 + k * 1024); } while (0)
#define PG8_LDB(dst, b, h) do { _Pragma("unroll") for (int n = 0; n < 2; ++n) _Pragma("unroll") for (int k = 0; k < 2; ++k) dst[n][k] = *(const LAS bf16x8*)(lds + PG8_SB(b, h) + boff + n * 2048 + k * 1024); } while (0)
#define PG8_MMA(ai, bj, At, Bt) do { __builtin_amdgcn_s_setprio(1); _Pragma("unroll") for (int m = 0; m < 4; ++m) _Pragma("unroll") for (int n = 0; n < 2; ++n) _Pragma("unroll") for (int k = 0; k < 2; ++k) \
        acc[ai][bj][m][n] = __builtin_amdgcn_mfma_f32_16x16x32_bf16(Bt[n][k], At[m][k], acc[ai][bj][m][n], 0, 0, 0); __builtin_amdgcn_s_setprio(0); } while (0)
#define PG8_WAIT_V(n) asm volatile("s_waitcnt vmcnt(" #n ")" ::: "memory")
#define PG8_WAIT_L(n) asm volatile("s_waitcnt lgkmcnt(" #n ")" ::: "memory")
#define PG8_BAR __builtin_amdgcn_s_barrier()
#define PG8_SCHED __builtin_amdgcn_sched_barrier(0)
    Unit cur, nxt; int ui = 0;
    if (!S.next(0, cur)) return;
    f32x4 acc[2][2][4][2];
#pragma unroll
    for (int a = 0; a < 2; ++a)
#pragma unroll
        for (int b = 0; b < 2; ++b)
#pragma unroll
            for (int m = 0; m < 4; ++m)
#pragma unroll
                for (int n = 0; n < 2; ++n) acc[a][b][m][n] = (f32x4){0.f, 0.f, 0.f, 0.f};
    bf16x8 At[4][2], B0[2][2], B1[2][2];
    const char* gA = (const char*)g.A; const char* gB = (const char*)g.Bt;
    asm volatile("" : "+s"(gA), "+s"(gB));
    const char* cA = gA + S.aoff(cur); const char* cB = gB + S.boff(cur);
    PG8_STAGE(PG8_SB(0, 0), cB, voffB); PG8_STAGE(PG8_SB(0, 1), cB + hstepB, voffB); PG8_STAGE(PG8_SA(0, 0), cA, voffA); PG8_STAGE(PG8_SA(0, 1), cA + hstepA, voffA);
    if (wr == 1) PG8_BAR;
    PG8_WAIT_V(2); PG8_BAR;
    PG8_STAGE(PG8_SB(1, 0), cB + kstep, voffB); PG8_STAGE(PG8_SA(1, 0), cA + kstep, voffA); PG8_STAGE(PG8_SB(1, 1), cB + hstepB + kstep, voffB);
    PG8_WAIT_V(6); PG8_BAR;
    for (;;) {
        const bool has_next = S.next(ui + 1, nxt);
        const char* nA = has_next ? gA + S.aoff(nxt) : cA; const char* nB = has_next ? gB + S.boff(nxt) : cB;
        for (int t = 0; t < nt; t += 2) {
            const bool last = (t == nt - 2);
            const char* a1 = cA + (size_t)(t + 1) * kstep;
            const char* a2 = last ? nA : cA + (size_t)(t + 2) * kstep; const char* b2 = last ? nB : cB + (size_t)(t + 2) * kstep;
            const char* a3 = a2 + kstep; const char* b3 = b2 + kstep;
            PG8_LDB(B0, 0, 0); PG8_LDB(B1, 0, 1); PG8_SCHED; PG8_LDA(At, 0, 0); PG8_STAGE(PG8_SA(1, 1), a1 + hstepA, voffA);
            PG8_WAIT_V(8); PG8_WAIT_L(0); PG8_BAR; PG8_MMA(0, 0, At, B0); PG8_MMA(0, 1, At, B1); PG8_BAR; PG8_SCHED;
            PG8_LDA(At, 0, 1); PG8_STAGE(PG8_SB(0, 0), b2, voffB); PG8_STAGE(PG8_SB(0, 1), b2 + hstepB, voffB); PG8_STAGE(PG8_SA(0, 0), a2, voffA);
            PG8_WAIT_V(8); PG8_WAIT_L(0); PG8_BAR; PG8_MMA(1, 0, At, B0); PG8_MMA(1, 1, At, B1); PG8_BAR; PG8_SCHED;
            PG8_LDB(B0, 1, 0); PG8_LDB(B1, 1, 1); PG8_SCHED; PG8_LDA(At, 1, 0); PG8_STAGE(PG8_SA(0, 1), a2 + hstepA, voffA);
            PG8_WAIT_V(8); PG8_WAIT_L(0); PG8_BAR; PG8_MMA(0, 0, At, B0); PG8_MMA(0, 1, At, B1); PG8_BAR; PG8_SCHED;
            PG8_LDA(At, 1, 1); PG8_STAGE(PG8_SB(1, 0), b3, voffB); PG8_STAGE(PG8_SB(1, 1), b3 + hstepB, voffB); PG8_STAGE(PG8_SA(1, 0), a3, voffA);
            PG8_WAIT_V(8); PG8_WAIT_L(0); PG8_BAR; PG8_MMA(1, 0, At, B0); PG8_MMA(1, 1, At, B1); PG8_BAR; PG8_SCHED;
        }
        if constexpr (ALIGN_EPI) { if (wr == 0) PG8_BAR; }
        E(acc, cur, wr, wc, fr, fq);
        if (!has_next) break;
#pragma unroll
        for (int a = 0; a < 2; ++a)
#pragma unroll
            for (int b = 0; b < 2; ++b)
#pragma unroll
                for (int m = 0; m < 4; ++m)
#pragma unroll
                    for (int n = 0; n < 2; ++n) acc[a][b][m][n] = (f32x4){0.f, 0.f, 0.f, 0.f};
        cur = nxt; cA = nA; cB = nB; ++ui;
        if constexpr (ALIGN_EPI) { if (wr == 1) PG8_BAR; }
    }
    PG8_WAIT_V(0);
    if constexpr (!ALIGN_EPI) { if (wr == 0) PG8_BAR; }
    PG8_BAR;
#undef PG8_SA
#undef PG8_SB
#undef PG8_STAGE
#undef PG8_LDA
#undef PG8_LDB
#undef PG8_MMA
#undef PG8_WAIT_V
#undef PG8_WAIT_L
#undef PG8_BAR
#undef PG8_SCHED
}
}

#define XB_TMO      128
#define XB_XCNT(j)  (256  + 64 * (j))
#define XB_XSUB(j)  (1280 + 64 * (j))
#define XB_XGEN(j)  (2304 + 64 * (j))
#define XB_TOP      3328
#define XB_TOPGEN   3392
#define XCD_BAR_WORDS 3456
#define XB_SPIN_CAP (1u << 23)
__device__ __forceinline__ unsigned xb_ld(unsigned* p)              { return __hip_atomic_load(p, __ATOMIC_RELAXED, __HIP_MEMORY_SCOPE_AGENT); }
__device__ __forceinline__ unsigned xb_add(unsigned* p, unsigned v) { return __hip_atomic_fetch_add(p, v, __ATOMIC_RELAXED, __HIP_MEMORY_SCOPE_AGENT); }
__device__ __forceinline__ unsigned xb_xcc_id() { return (unsigned)__builtin_amdgcn_s_getreg((3 << 11) | 20) & 0xFu; }
#define XB_SPIN(cond, bar) do { unsigned _sp = 0; while (cond) { __builtin_amdgcn_s_sleep(1); \
    if ((++_sp & 255u) == 0u) { if (xb_ld(&(bar)[XB_TMO])) break; if (_sp > XB_SPIN_CAP) { atomicAdd(&(bar)[XB_TMO], 1u); break; } } } } while (0)
struct XcdBarrier { unsigned* bar; unsigned x; volatile LAS unsigned* st; };
__device__ __forceinline__ XcdBarrier xcd_barrier_post(unsigned* bar, volatile LAS unsigned* st) {
    XcdBarrier b; b.bar = bar; b.x = xb_xcc_id(); b.st = st;
    if (threadIdx.x == 0) (void)xb_add(&bar[XB_XCNT(b.x)], 1u);
    return b;
}
__device__ __forceinline__ void xcd_barrier_complete(unsigned* bar, unsigned x, unsigned& nloc, unsigned& nx) {
    const unsigned G = gridDim.x * gridDim.y * gridDim.z;
    unsigned sum, cnt, mine, sp = 0u;
    for (;;) {
        sum = 0u; cnt = 0u; mine = 0u;
#pragma unroll
        for (unsigned j = 0; j < 16; ++j) { const unsigned c = xb_ld(&bar[XB_XCNT(j)]); sum += c; cnt += (c > 0u) ? 1u : 0u; mine = (j == x) ? c : mine; }
        if (sum == G) break;
        __builtin_amdgcn_s_sleep(1);
        if ((++sp & 255u) == 0u) { if (xb_ld(&bar[XB_TMO])) break; if (sp > XB_SPIN_CAP) { atomicAdd(&bar[XB_TMO], 1u); break; } }
    }
    nloc = mine > 0u ? mine : 1u; nx = cnt > 0u ? cnt : 1u;
}
__device__ __forceinline__ void xcd_barrier(const XcdBarrier& b) {
    asm volatile("s_waitcnt vmcnt(0)" ::: "memory");
    __syncthreads();
    if (threadIdx.x == 0) {
        unsigned* bar = b.bar;
        __builtin_amdgcn_s_waitcnt(0);
        unsigned nloc = b.st[0], nx = b.st[1];
        if (nloc == 0u) { xcd_barrier_complete(bar, b.x, nloc, nx); b.st[0] = nloc; b.st[1] = nx; }
        const unsigned old = xb_add(&bar[XB_XSUB(b.x)], 1u);
        const unsigned gen = old / nloc;
        if (old + 1u == (gen + 1u) * nloc) {
            __builtin_amdgcn_fence(__ATOMIC_RELEASE, "agent");
            asm volatile("s_waitcnt vmcnt(0)" ::: "memory");
            const unsigned og = xb_add(&bar[XB_TOP], 1u);
            const unsigned tg = og / nx;
            if (og + 1u == (tg + 1u) * nx) xb_add(&bar[XB_TOPGEN], 1u);
            else XB_SPIN(xb_ld(&bar[XB_TOPGEN]) == tg, bar);
            __builtin_amdgcn_fence(__ATOMIC_ACQUIRE, "agent");
            xb_add(&bar[XB_XGEN(b.x)], 1u);
            asm volatile("s_waitcnt vmcnt(0)" ::: "memory");
        } else {
            XB_SPIN(xb_ld(&bar[XB_XGEN(b.x)]) == gen, bar);
            __builtin_amdgcn_fence(__ATOMIC_ACQUIRE, "agent");
            asm volatile("s_waitcnt vmcnt(0)" ::: "memory");
        }
    }
    __syncthreads();
}

struct Args { const float* in[27]; float* out; unsigned char* ws; };
enum { I_X = 0, I_MEM, I_NMIX, I_NMEM, I_NMLP, I_WIN, I_BGATE, I_GMVG, I_GMWS, I_GMBS, I_CONVW, I_CONVB, I_WR, I_BR, I_WI, I_BI, I_LAM, I_SQG, I_SKG, I_SINK, I_WKV, I_XQG, I_XKG, I_WBR, I_WOUT, I_WFF1, I_WFF2 };
struct Ctx {
    const float* const* in; float* x;
    bf16_t *wt_in, *wt_br, *wt_out, *wt_ff1, *wt_ff2, *wt_kv, *memn, *memkv, *xb, *za, *zg, *mb, *o;
    float *ssq, *carryA, *carryH, *S, *ly, *lp;
};

__device__ __forceinline__ void transpose_item(const float* W, int N, bf16_t* WT, int ldk, int koff, const float* gain, LAS float* scr, int item, int lane) {
    const int nblk = N / 32, kb = item / nblk, nb = item % nblk, k0 = 64 * kb, n0 = 32 * nb;
#pragma unroll 8
    for (int i = 0; i < 32; ++i) { const int kk = 2 * i + (lane >> 5); float v = W[(size_t)(k0 + kk) * N + n0 + (lane & 31)]; if (gain) v *= gain[k0 + kk]; scr[kk * 33 + (lane & 31)] = v; }
    LDS_WAIT(); asm volatile("" ::: "memory");
    const int c = lane & 7;
#pragma unroll
    for (int j = 0; j < 4; ++j) { const int n = (lane >> 3) + 8 * j; const LAS float* s = scr + (8 * c) * 33 + n;
        u32x4 o; o.x = pk2(s[0 * 33], s[1 * 33]); o.y = pk2(s[2 * 33], s[3 * 33]); o.z = pk2(s[4 * 33], s[5 * 33]); o.w = pk2(s[6 * 33], s[7 * 33]);
        *(u32x4*)(WT + (size_t)(n0 + n) * ldk + koff + k0 + 8 * c) = o; }
    LDS_WAIT(); asm volatile("" ::: "memory");
}
__device__ __forceinline__ float wave_sum(float v) {
#pragma unroll
    for (int o = 1; o < 64; o <<= 1) v += __shfl_xor(v, o);
    return v;
}
__device__ __forceinline__ void conv_w(const Ctx& C, int which, int l, int item, LAS float* scr, int lane) {
    if (which == 0) transpose_item(C.in[I_WIN] + (size_t)l * D * DIN, DIN, C.wt_in, D, 0, C.in[I_NMIX] + l * D, scr, item, lane);
    else if (which == 1) { const int b = item >> 8; transpose_item(C.in[I_WBR] + (size_t)(l * 4 + b) * 512 * D, D, C.wt_br, 2048, b * 512, nullptr, scr, item & 255, lane); }
    else if (which == 2) transpose_item(C.in[I_WOUT] + (size_t)l * D * D, D, C.wt_out, D, 0, nullptr, scr, item, lane);
    else if (which == 3) transpose_item(C.in[I_WFF1] + (size_t)l * D * FF, FF, C.wt_ff1, D, 0, C.in[I_NMLP] + l * D, scr, item, lane);
    else if (which == 4) transpose_item(C.in[I_WFF2] + (size_t)l * FF * D, D, C.wt_ff2, FF, 0, nullptr, scr, item, lane);
    else transpose_item(C.in[I_WKV] + (size_t)l * D * D, D, C.wt_kv + (size_t)l * D * D, D, 0, C.in[I_NMEM] + l * D, scr, item, lane);
}
constexpr int IT_WIN = 16 * 232, IT_WBR = 1024, IT_WOUT = 512, IT_WFF1 = 2048, IT_WFF2 = 2048, IT_WKV = 512;

#define ROPE_INV(i) ((i) == 0 ? 1.0f : (i) == 1 ? 0.19392274474868576f : (i) == 2 ? 0.03760603093086393f : (i) == 3 ? 0.007292664737217109f : (i) == 4 ? 0.001414213562373095f : (i) == 5 ? 0.0002742481756762073f : (i) == 6 ? 5.318295896944988e-05f : 1.031338537721246e-05f)
#define ROPE16(f, pos) do { _Pragma("unroll") for (int _i = 0; _i < 8; ++_i) { float _s, _c; sincosf((pos) * ROPE_INV(_i), &_s, &_c); const float _x1 = (f)[_i], _x2 = (f)[_i + 8]; (f)[_i] = _x1 * _c - _x2 * _s; (f)[_i + 8] = _x2 * _c + _x1 * _s; } } while (0)

__device__ __forceinline__ void swa_item(LAS unsigned char* lds, const Ctx& C, int l, int tile, int h) {
    const int tid = opaque_tid();
    LAS bf16_t* Ks = (LAS bf16_t*)lds;
    LAS bf16_t* Vs = Ks + 256 * 72;
    const int kvh = h >> 2, nb = tile & 63, row0 = tile * 128;
    {
        const int key = tid >> 1, half = tid & 1;
        const bool ok = (nb > 0) || (key >= 128);
        const size_t grow = (size_t)(ok ? row0 - 128 + key : row0);
        const u32x4* kp = (const u32x4*)(C.za + grow * NZA + 2560 + kvh * 64 + half * 32);
        const u32x4* vp = (const u32x4*)(C.za + grow * NZA + 2688 + kvh * 64 + half * 32);
        float kf[32]; float ss = 0.f;
#pragma unroll
        for (int i = 0; i < 4; ++i) { const u32x4 w = kp[i]; UNPACK8(w, kf, 8 * i); }
#pragma unroll
        for (int i = 0; i < 32; ++i) ss += kf[i] * kf[i];
        ss += __shfl_xor(ss, 1);
        const float rs = rsqrtf(ss * (1.f / 64.f) + EPS);
        const float* kg = C.in[I_SKG] + l * 64 + half * 32;
#pragma unroll
        for (int i = 0; i < 32; ++i) kf[i] *= rs * kg[i];
        if (half == 0) { const float pos = (float)(nb * 128 - 128 + key); ROPE16(kf, pos); }
#pragma unroll
        for (int i = 0; i < 4; ++i) { *(LAS u32x4*)(Ks + key * 72 + half * 32 + 8 * i) = PACK8(kf, 8 * i); *(LAS u32x4*)(Vs + key * 72 + half * 32 + 8 * i) = vp[i]; }
    }
    const int q = tid >> 2, sub = tid & 3;
    float qf[16];
    {
        const u32x4* qp = (const u32x4*)(C.za + (size_t)(row0 + q) * NZA + 2048 + h * 64 + sub * 16);
        const u32x4 w0 = qp[0], w1 = qp[1]; UNPACK8(w0, qf, 0); UNPACK8(w1, qf, 8);
        float ss = 0.f;
#pragma unroll
        for (int i = 0; i < 16; ++i) ss += qf[i] * qf[i];
        ss += __shfl_xor(ss, 1); ss += __shfl_xor(ss, 2);
        const float rs = rsqrtf(ss * (1.f / 64.f) + EPS);
        const float* qg = C.in[I_SQG] + l * 64 + sub * 16;
#pragma unroll
        for (int i = 0; i < 16; ++i) qf[i] *= rs * qg[i];
        if (sub == 0) { const float pos = (float)(nb * 128 + q); ROPE16(qf, pos); }
#pragma unroll
        for (int i = 0; i < 16; ++i) qf[i] *= 0.125f;
    }
    __syncthreads();
    const float sink = C.in[I_SINK][l * 8 + h];
    float mx = sink;
    for (int j = 0; j < 128; ++j) {
        const int kj = q + 1 + j; const bool valid = (nb > 0) || (kj >= 128);
        const LAS u32x4* kr = (const LAS u32x4*)(Ks + kj * 72 + sub * 16);
        float kf[16]; const u32x4 w0 = kr[0], w1 = kr[1]; UNPACK8(w0, kf, 0); UNPACK8(w1, kf, 8);
        float s = 0.f;
#pragma unroll
        for (int i = 0; i < 16; ++i) s += qf[i] * kf[i];
        s += __shfl_xor(s, 1); s += __shfl_xor(s, 2);
        if (valid) mx = fmaxf(mx, s);
    }
    float lsum = __expf(sink - mx); float o[16];
#pragma unroll
    for (int i = 0; i < 16; ++i) o[i] = 0.f;
    for (int j = 0; j < 128; ++j) {
        const int kj = q + 1 + j; const bool valid = (nb > 0) || (kj >= 128);
        const LAS u32x4* kr = (const LAS u32x4*)(Ks + kj * 72 + sub * 16);
        float kf[16]; { const u32x4 w0 = kr[0], w1 = kr[1]; UNPACK8(w0, kf, 0); UNPACK8(w1, kf, 8); }
        float s = 0.f;
#pragma unroll
        for (int i = 0; i < 16; ++i) s += qf[i] * kf[i];
        s += __shfl_xor(s, 1); s += __shfl_xor(s, 2);
        const float p = valid ? __expf(s - mx) : 0.f;
        lsum += p;
        const LAS u32x4* vr = (const LAS u32x4*)(Vs + kj * 72 + sub * 16);
        float vf[16]; { const u32x4 w0 = vr[0], w1 = vr[1]; UNPACK8(w0, vf, 0); UNPACK8(w1, vf, 8); }
#pragma unroll
        for (int i = 0; i < 16; ++i) o[i] += p * vf[i];
    }
    const float inv = 1.f / lsum;
#pragma unroll
    for (int i = 0; i < 16; ++i) o[i] *= inv;
    u32x4* op = (u32x4*)(C.o + (size_t)(row0 + q) * NO + 1024 + h * 64 + sub * 16);
    op[0] = PACK8(o, 0); op[1] = PACK8(o, 8);
    __syncthreads();
}

__device__ __forceinline__ void xa_item(LAS unsigned char* lds, const Ctx& C, int l, int tile, int h) {
    const int tid = opaque_tid();
    LAS bf16_t* Ks = (LAS bf16_t*)lds;
    LAS bf16_t* Vs = Ks + 256 * 136;
    const int b = tile >> 6, row0 = tile * 128;
    {
        const int key = tid >> 1, half = tid & 1;
        const bf16_t* src = C.memkv + ((size_t)(l * 512 + b * 256 + key)) * 1024 + h * 128 + half * 64;
        const u32x4* kp = (const u32x4*)src; const u32x4* vp = (const u32x4*)(src + 512);
        float kf[64]; float ss = 0.f;
#pragma unroll
        for (int i = 0; i < 8; ++i) { const u32x4 w = kp[i]; UNPACK8(w, kf, 8 * i); }
#pragma unroll
        for (int i = 0; i < 64; ++i) ss += kf[i] * kf[i];
        ss += __shfl_xor(ss, 1);
        const float rs = rsqrtf(ss * (1.f / 128.f) + EPS);
        const float* kg = C.in[I_XKG] + l * 128 + half * 64;
#pragma unroll
        for (int i = 0; i < 64; ++i) kf[i] *= rs * kg[i];
#pragma unroll
        for (int i = 0; i < 8; ++i) { *(LAS u32x4*)(Ks + key * 136 + half * 64 + 8 * i) = PACK8(kf, 8 * i); *(LAS u32x4*)(Vs + key * 136 + half * 64 + 8 * i) = vp[i]; }
    }
    const int q = tid >> 2, sub = tid & 3;
    float qf[32];
    {
        const u32x4* qp = (const u32x4*)(C.za + (size_t)(row0 + q) * NZA + 2816 + h * 128 + sub * 32);
#pragma unroll
        for (int i = 0; i < 4; ++i) { const u32x4 w = qp[i]; UNPACK8(w, qf, 8 * i); }
        float ss = 0.f;
#pragma unroll
        for (int i = 0; i < 32; ++i) ss += qf[i] * qf[i];
        ss += __shfl_xor(ss, 1); ss += __shfl_xor(ss, 2);
        const float rs = rsqrtf(ss * (1.f / 128.f) + EPS) * 0.08838834764831845f;
        const float* qg = C.in[I_XQG] + l * 128 + sub * 32;
#pragma unroll
        for (int i = 0; i < 32; ++i) qf[i] *= rs * qg[i];
    }
    __syncthreads();
    float mx = -3.0e38f;
    for (int key = 0; key < 256; ++key) {
        const LAS u32x4* kr = (const LAS u32x4*)(Ks + key * 136 + sub * 32);
        float s = 0.f;
#pragma unroll
        for (int c = 0; c < 4; ++c) { float kf[8]; const u32x4 w = kr[c]; UNPACK8(w, kf, 0);
#pragma unroll
            for (int i = 0; i < 8; ++i) s += qf[8 * c + i] * kf[i]; }
        s += __shfl_xor(s, 1); s += __shfl_xor(s, 2);
        mx = fmaxf(mx, s);
    }
    float lsum = 0.f; float o[32];
#pragma unroll
    for (int i = 0; i < 32; ++i) o[i] = 0.f;
    for (int key = 0; key < 256; ++key) {
        const LAS u32x4* kr = (const LAS u32x4*)(Ks + key * 136 + sub * 32);
        float s = 0.f;
#pragma unroll
        for (int c = 0; c < 4; ++c) { float kf[8]; const u32x4 w = kr[c]; UNPACK8(w, kf, 0);
#pragma unroll
            for (int i = 0; i < 8; ++i) s += qf[8 * c + i] * kf[i]; }
        s += __shfl_xor(s, 1); s += __shfl_xor(s, 2);
        const float p = __expf(s - mx);
        lsum += p;
        const LAS u32x4* vr = (const LAS u32x4*)(Vs + key * 136 + sub * 32);
#pragma unroll
        for (int c = 0; c < 4; ++c) { float vf[8]; const u32x4 w = vr[c]; UNPACK8(w, vf, 0);
#pragma unroll
            for (int i = 0; i < 8; ++i) o[8 * c + i] += p * vf[i]; }
    }
    const float inv = 1.f / lsum;
#pragma unroll
    for (int i = 0; i < 32; ++i) o[i] *= inv;
    u32x4* op = (u32x4*)(C.o + (size_t)(row0 + q) * NO + 1536 + h * 128 + sub * 32);
#pragma unroll
    for (int c = 0; c < 4; ++c) op[c] = PACK8(o, 8 * c);
    __syncthreads();
}

__device__ __forceinline__ void gm_item(LAS unsigned char* lds, const Ctx& C, int l, int tile, int g) {
    const int tid = opaque_tid();
    LAS float* vn = (LAS float*)lds;
    LAS float* Wl = vn + 128 * 128;
    LAS float* rsv = Wl + 128 * 128;
    const int row0 = tile * 128;
    {
        const int tok = tid >> 2, sub = tid & 3;
        const u32x4* vp = (const u32x4*)(C.za + (size_t)(row0 + tok) * NZA + 512 + sub * 128);
        float ss = 0.f;
#pragma unroll
        for (int i = 0; i < 16; ++i) { float f[8]; const u32x4 w = vp[i]; UNPACK8(w, f, 0);
#pragma unroll
            for (int e = 0; e < 8; ++e) ss += f[e] * f[e]; }
        ss += __shfl_xor(ss, 1); ss += __shfl_xor(ss, 2);
        if (sub == 0) rsv[tok] = rsqrtf(ss * (1.f / 512.f) + EPS);
        const f32x4* wp = (const f32x4*)(C.in[I_GMWS] + (size_t)(l * 4 + g) * 128 * 128);
#pragma unroll
        for (int i = 0; i < 8; ++i) *(LAS f32x4*)(Wl + (i * 512 + tid) * 4) = wp[i * 512 + tid];
    }
    __syncthreads();
    {
        const int s = tid >> 2, c0 = (tid & 3) * 32;
        const u32x4* vp = (const u32x4*)(C.za + (size_t)(row0 + s) * NZA + 512 + g * 128 + c0);
        const float rs = rsv[s]; const float* vg = C.in[I_GMVG] + l * 512 + g * 128 + c0;
#pragma unroll
        for (int i = 0; i < 4; ++i) { float f[8]; const u32x4 w = vp[i]; UNPACK8(w, f, 0);
#pragma unroll
            for (int e = 0; e < 8; ++e) f[e] *= rs * vg[8 * i + e];
            *(LAS f32x4*)(vn + s * 128 + c0 + 8 * i) = (f32x4){f[0], f[1], f[2], f[3]}; *(LAS f32x4*)(vn + s * 128 + c0 + 8 * i + 4) = (f32x4){f[4], f[5], f[6], f[7]}; }
    }
    __syncthreads();
    {
        const int c = tid & 127, tq = tid >> 7;
        const float* bs = C.in[I_GMBS] + (size_t)(l * 4 + g) * 128;
        for (int k = 0; k < 32; ++k) {
            const int t = tq * 32 + k; float acc = 0.f;
            for (int s = 0; s <= t; ++s) acc += Wl[t * 128 + s] * vn[s * 128 + c];
            const float sval = acc + bs[t];
            const float u = bf2f(C.za[(size_t)(row0 + t) * NZA + g * 128 + c]);
            C.o[(size_t)(row0 + t) * NO + g * 128 + c] = (bf16_t)f2bf(u * sval);
        }
    }
    __syncthreads();
}

__device__ __forceinline__ void lru_item(LAS unsigned char* lds, const Ctx& C, int l, int tile, int hb) {
    const int tid = opaque_tid();
    LAS float* xc = (LAS float*)lds;
    LAS float* wr = xc + 8192;
    LAS float* wi = wr + 4096;
    LAS float* aa = wi + 4096;
    LAS float* bb = aa + 8192;
    const int nb = tile & 63, row0 = tile * 128;
    {
        const int t = tid >> 2, c0 = (tid & 3) * 16, ch = hb * 64 + c0;
        float acc[16];
#pragma unroll
        for (int i = 0; i < 16; ++i) acc[i] = C.in[I_CONVB][l * 512 + ch + i];
#pragma unroll
        for (int k = 0; k < 4; ++k) {
            const int tt = t - 3 + k;
            if (nb * 128 + tt >= 0) {
                const u32x4* xp = (const u32x4*)(C.za + (size_t)(row0 + tt) * NZA + 1024 + ch);
                float f[16]; const u32x4 w0 = xp[0], w1 = xp[1]; UNPACK8(w0, f, 0); UNPACK8(w1, f, 8);
                const float* cw = C.in[I_CONVW] + (size_t)(l * 4 + k) * 512 + ch;
#pragma unroll
                for (int i = 0; i < 16; ++i) acc[i] += cw[i] * f[i];
            }
        }
#pragma unroll
        for (int i = 0; i < 4; ++i) *(LAS f32x4*)(xc + t * 64 + c0 + 4 * i) = (f32x4){acc[4 * i], acc[4 * i + 1], acc[4 * i + 2], acc[4 * i + 3]};
        const f32x4* wrp = (const f32x4*)(C.in[I_WR] + (size_t)(l * 8 + hb) * 4096); const f32x4* wip = (const f32x4*)(C.in[I_WI] + (size_t)(l * 8 + hb) * 4096);
#pragma unroll
        for (int i = 0; i < 2; ++i) { *(LAS f32x4*)(wr + (i * 512 + tid) * 4) = wrp[i * 512 + tid]; *(LAS f32x4*)(wi + (i * 512 + tid) * 4) = wip[i * 512 + tid]; }
    }
    __syncthreads();
    const int j = tid & 63, tg = tid >> 6, chj = hb * 64 + j;
    {
        const float br = C.in[I_BR][l * 512 + chj], bi = C.in[I_BI][l * 512 + chj];
        const float lam = C.in[I_LAM][l * 512 + chj];
        const float sp = log1pf(expf(-lam));
        for (int k = 0; k < 16; ++k) {
            const int t = tg * 16 + k; float r = br, ig = bi;
            for (int i = 0; i < 64; ++i) { const float xv = xc[t * 64 + i]; r += xv * wr[i * 64 + j]; ig += xv * wi[i * 64 + j]; }
            r = sigmoid_f(r); ig = sigmoid_f(ig);
            const float loga = -8.f * r * sp; const float a = expf(loga); const float mult = sqrtf(-expm1f(2.f * loga));
            aa[t * 64 + j] = a; bb[t * 64 + j] = xc[t * 64 + j] * ig * mult;
        }
    }
    __syncthreads();
    if (tid < 64) {
        float hh = 0.f, P = 1.f;
        for (int t = 0; t < 128; ++t) { const float a = aa[t * 64 + tid]; hh = a * hh + bb[t * 64 + tid]; P *= a; aa[t * 64 + tid] = P; bb[t * 64 + tid] = hh; }
        C.carryA[(size_t)tile * 512 + hb * 64 + tid] = P; C.carryH[(size_t)tile * 512 + hb * 64 + tid] = hh;
    }
    __syncthreads();
    for (int k = 0; k < 16; ++k) {
        const int t = tg * 16 + k;
        const float G = bf2f(C.za[(size_t)(row0 + t) * NZA + 1536 + chj]);
        C.ly[(size_t)(row0 + t) * 512 + chj] = G * bb[t * 64 + j]; C.lp[(size_t)(row0 + t) * 512 + chj] = G * aa[t * 64 + j];
    }
    __syncthreads();
}

__device__ __forceinline__ void fix_item(const Ctx& C, int tile, int half) {
    const int c = opaque_tid(), b = tile >> 6, nb = tile & 63, row0 = tile * 128 + half * 64;
    float H = 0.f;
    for (int jn = 0; jn < nb; ++jn) { const size_t idx = (size_t)(b * 64 + jn) * 512 + c; H = C.carryA[idx] * H + C.carryH[idx]; }
    for (int t = 0; t < 64; ++t) { const size_t r = (size_t)(row0 + t); C.o[r * NO + 512 + c] = (bf16_t)f2bf(C.ly[r * 512 + c] + C.lp[r * 512 + c] * H); }
}

__global__ void __launch_bounds__(512, 2) fwd_megakernel(Args args) {
    extern __shared__ __attribute__((aligned(16))) unsigned char lds_raw[];
    LAS unsigned char* lds = (LAS unsigned char*)lds_raw;
    volatile LAS unsigned* MISC = (volatile LAS unsigned*)(lds + MISC_OFF);
    const int tid = threadIdx.x, lane = tid & 63, wave = __builtin_amdgcn_readfirstlane(tid >> 6);
    const int G = gridDim.x, bx = blockIdx.x;
    unsigned char* ws = args.ws;
    Ctx C;
    C.in = args.in; C.x = args.out;
    C.wt_in = (bf16_t*)(ws + WS_WIN); C.wt_br = (bf16_t*)(ws + WS_WBR); C.wt_out = (bf16_t*)(ws + WS_WOUT); C.wt_ff1 = (bf16_t*)(ws + WS_WFF1); C.wt_ff2 = (bf16_t*)(ws + WS_WFF2); C.wt_kv = (bf16_t*)(ws + WS_WKV);
    C.memn = (bf16_t*)(ws + WS_MEMN); C.memkv = (bf16_t*)(ws + WS_MEMKV); C.xb = (bf16_t*)(ws + WS_XB); C.za = (bf16_t*)(ws + WS_ZA); C.zg = (bf16_t*)(ws + WS_ZG); C.mb = (bf16_t*)(ws + WS_MB); C.o = (bf16_t*)(ws + WS_O);
    C.ssq = (float*)(ws + WS_SSQ); C.carryA = (float*)(ws + WS_CARRY); C.carryH = C.carryA + 128 * 512; C.S = (float*)(ws + WS_S); C.ly = (float*)(ws + WS_LY); C.lp = (float*)(ws + WS_LP);

    if (tid < 64) MISC[tid] = 0u;
    __syncthreads();
    XcdBarrier bar = xcd_barrier_post((unsigned*)(ws + WS_CTL), MISC + 8);
    const int gw = bx * 8 + wave, NGW = G * 8;
    LAS float* scr = (LAS float*)(lds + wave * 16384);

    for (int it = gw; it < IT_WIN + 4 * IT_WKV; it += NGW) {
        if (it < IT_WIN) conv_w(C, 0, 0, it, scr, lane);
        else { const int r = it - IT_WIN; conv_w(C, 5, r / IT_WKV, r % IT_WKV, scr, lane); }
    }
    for (int m = gw; m < M + 512; m += NGW) {
        if (m < M) {
            const f32x4* xr = (const f32x4*)(C.in[I_X] + (size_t)m * D) + lane; f32x4 v[4]; float s = 0.f;
#pragma unroll
            for (int jj = 0; jj < 4; ++jj) { v[jj] = xr[64 * jj]; s += (v[jj].x * v[jj].x + v[jj].y * v[jj].y) + (v[jj].z * v[jj].z + v[jj].w * v[jj].w); }
            s = wave_sum(s);
            f32x4* xo = (f32x4*)(C.x + (size_t)m * D) + lane; u32x2* bo = (u32x2*)(C.xb + (size_t)m * D) + lane;
#pragma unroll
            for (int jj = 0; jj < 4; ++jj) { xo[64 * jj] = v[jj]; bo[64 * jj] = (u32x2){pk2(v[jj].x, v[jj].y), pk2(v[jj].z, v[jj].w)}; }
            if (lane < 16) C.ssq[(size_t)m * 16 + lane] = (lane == 0) ? s : 0.f;
        } else {
            const int r = m - M;
            const f32x4* xr = (const f32x4*)(C.in[I_MEM] + (size_t)r * D) + lane; f32x4 v[4]; float s = 0.f;
#pragma unroll
            for (int jj = 0; jj < 4; ++jj) { v[jj] = xr[64 * jj]; s += (v[jj].x * v[jj].x + v[jj].y * v[jj].y) + (v[jj].z * v[jj].z + v[jj].w * v[jj].w); }
            s = wave_sum(s); const float rs = rsqrtf(s * (1.f / 1024.f) + EPS);
            u32x2* bo = (u32x2*)(C.memn + (size_t)r * D) + lane;
#pragma unroll
            for (int jj = 0; jj < 4; ++jj) bo[64 * jj] = (u32x2){pk2(v[jj].x * rs, v[jj].y * rs), pk2(v[jj].z * rs, v[jj].w * rs)};
        }
    }
    __syncthreads();
    cg::this_grid().sync();
    xcd_barrier(bar);

    {
#ifndef SKIP_KV
        pg8::Gemm g{C.memn, C.wt_kv}; pg8::SchedKV S{bx}; pg8::EpiKV E{C.memkv};
        pg8::gemm_phase<pg8::EpiKV, pg8::SchedKV, true, D, D, D>(lds, g, S, E);
#endif

    }

    for (int l = 0; l < DEPTH; ++l) {
        {
#ifndef SKIP_G1
            pg8::Gemm g{C.xb, C.wt_in}; pg8::SchedStd S; S.init(M, DIN, G, bx, D, D);
            pg8::EpiZ E{C.za, C.zg, C.ssq, C.in[I_BGATE] + (size_t)l * 4 * D};
            pg8::gemm_phase<pg8::EpiZ, pg8::SchedStd, true, D, D, D>(lds, g, S, E);
#endif

        }
        xcd_barrier(bar);
        {
            const int NI = 1024 + 512 + 512 + 1024;
            for (int it = bx; it < NI; it += G) {
#ifndef SKIP_SWA
                if (it < 1024) swa_item(lds, C, l, it >> 3, it & 7);
#else
                if (it < 1024) {}
#endif
#ifndef SKIP_XA
                else if (it < 1536) xa_item(lds, C, l, (it - 1024) >> 2, (it - 1024) & 3);
#endif
#ifndef SKIP_GM
                else if (it < 2048) gm_item(lds, C, l, (it - 1536) >> 2, (it - 1536) & 3);
#endif
#ifndef SKIP_LRU
                else lru_item(lds, C, l, (it - 2048) >> 3, (it - 2048) & 7);
#endif
            }
            const int lane_c = opaque_tid() & 63;
            const int NC = IT_WBR + IT_WOUT + IT_WFF1 + IT_WFF2 + (l + 1 < DEPTH ? IT_WIN : 0);
            for (int it = gw; it < NC; it += NGW) {
                int r = it;
                if (r < IT_WBR) { conv_w(C, 1, l, r, scr, lane_c); continue; } r -= IT_WBR;
                if (r < IT_WOUT) { conv_w(C, 2, l, r, scr, lane_c); continue; } r -= IT_WOUT;
                if (r < IT_WFF1) { conv_w(C, 3, l, r, scr, lane_c); continue; } r -= IT_WFF1;
                if (r < IT_WFF2) { conv_w(C, 4, l, r, scr, lane_c); continue; } r -= IT_WFF2;
                conv_w(C, 0, l + 1, r, scr, lane_c);
            }
            __syncthreads();
        }
        xcd_barrier(bar);
        for (int it = bx; it < 256; it += G) fix_item(C, it >> 1, it & 1);
        xcd_barrier(bar);
        {
#ifndef SKIP_G2
            pg8::Gemm g{C.o, C.wt_br}; pg8::SchedMerge S; S.t.init(M, D, G, bx, NO, NO);
            pg8::EpiMerge E{C.zg, C.S, C.mb};
            pg8::gemm_phase<pg8::EpiMerge, pg8::SchedMerge, true, NO, NO, 512>(lds, g, S, E);
#endif

        }
        xcd_barrier(bar);
        {
#ifndef SKIP_G3
            pg8::Gemm g{C.mb, C.wt_out}; pg8::SchedStd S; S.init(M, D, G, bx, D, D);
            pg8::EpiRes E{C.x, C.xb, C.ssq};
            pg8::gemm_phase<pg8::EpiRes, pg8::SchedStd, true, D, D, D>(lds, g, S, E);
#endif

        }
        xcd_barrier(bar);
        {
#ifndef SKIP_G4
            pg8::Gemm g{C.xb, C.wt_ff1}; pg8::SchedStd S; S.init(M, FF, G, bx, D, D);
            pg8::EpiFF1 E{C.zg, C.ssq};
            pg8::gemm_phase<pg8::EpiFF1, pg8::SchedStd, true, D, D, D>(lds, g, S, E);
#endif

        }
        xcd_barrier(bar);
        {
#ifndef SKIP_G5
            pg8::Gemm g{C.zg, C.wt_ff2}; pg8::SchedStd S; S.init(M, D, G, bx, FF, FF);
            pg8::EpiRes E{C.x, C.xb, C.ssq};
            pg8::gemm_phase<pg8::EpiRes, pg8::SchedStd, true, FF, FF, FF>(lds, g, S, E);
#endif

        }
        if (l + 1 < DEPTH) xcd_barrier(bar);
    }
}

extern "C" void kernel_launch(void* const* d_in, const int* in_sizes, int n_in, void* d_out, int out_size, void* d_ws, size_t ws_size, hipStream_t stream) {
    static int grid = 0;
    if (grid == 0) {
        if (n_in != 27 || out_size != M * D || ws_size < WS_END) { fprintf(stderr, "kernel_launch: unexpected shapes: n_in %d out %d ws %zu (need %zu)\n", n_in, out_size, ws_size, (size_t)WS_END); grid = -1; return; }
        int dev = 0, cus = 0, per_cu = 0;
        hipGetDevice(&dev); hipDeviceGetAttribute(&cus, hipDeviceAttributeMultiprocessorCount, dev);
        if (hipFuncSetAttribute((const void*)fwd_megakernel, hipFuncAttributeMaxDynamicSharedMemorySize, LDS_BYTES) != hipSuccess) { fprintf(stderr, "kernel_launch: hipFuncSetAttribute failed\n"); grid = -1; return; }
        if (hipOccupancyMaxActiveBlocksPerMultiprocessor(&per_cu, (const void*)fwd_megakernel, 512, LDS_BYTES) != hipSuccess || per_cu < 1) { fprintf(stderr, "kernel_launch: occupancy query says %d\n", per_cu); per_cu = 1; }
        (void)hipGetLastError();
        grid = cus;
        if (grid != 256) fprintf(stderr, "kernel_launch: note: %d CUs\n", grid);
    }
    if (grid < 0) return;
    hipMemsetAsync((char*)d_ws + WS_CTL, 0, CTL_ZERO_BYTES, stream);
    Args a{};
    for (int i = 0; i < 27; ++i) a.in[i] = (const float*)d_in[i];
    a.out = (float*)d_out; a.ws = (unsigned char*)d_ws;
    void* kargs[] = {&a};
    hipError_t e = hipLaunchCooperativeKernel((const void*)fwd_megakernel, dim3(grid), dim3(512), kargs, LDS_BYTES, stream);
    if (e != hipSuccess) fprintf(stderr, "kernel_launch: cooperative launch failed: %s\n", hipGetErrorString(e));
}
```

```cpp
#include <hip/hip_runtime.h>
#include <hip/hip_cooperative_groups.h>
#include <cstdio>
#include <cstdint>
namespace cg = cooperative_groups;

#define LAS __attribute__((address_space(3)))
#define GAS __attribute__((address_space(1)))
typedef unsigned short bf16_t;
typedef short bf16x8 __attribute__((ext_vector_type(8)));
typedef float f32x4 __attribute__((ext_vector_type(4)));
typedef unsigned u32x4 __attribute__((ext_vector_type(4)));
typedef unsigned u32x2 __attribute__((ext_vector_type(2)));

constexpr int M = 16384, D = 1024, DIN = 7424, NZA = 3328, NZG = 4096, FF = 4096, DEPTH = 4, NO = 2048;
constexpr float EPS = 1e-6f;
constexpr size_t MiB = 1u << 20;
constexpr size_t WS_CTL = 0, CTL_ZERO_BYTES = 64 * 1024;
constexpr size_t WS_WIN = 2 * MiB, WS_WBR = 17 * MiB, WS_WOUT = 21 * MiB, WS_WFF1 = 23 * MiB, WS_WFF2 = 31 * MiB, WS_WKV = 39 * MiB;
constexpr size_t WS_MEMN = 47 * MiB, WS_MEMKV = 48 * MiB, WS_SSQ = 52 * MiB, WS_CARRY = 53 * MiB, WS_XB = 54 * MiB;
constexpr size_t WS_ZA = 86 * MiB, WS_S = 86 * MiB, WS_MB = 150 * MiB, WS_ZG = 190 * MiB, WS_O = 318 * MiB, WS_LY = 382 * MiB, WS_LP = 414 * MiB, WS_MEMK = 446 * MiB, WS_MEMVT = 448 * MiB, WS_END = 450 * MiB;
static_assert(WS_ZA + (size_t)M * NZA * 2 <= WS_ZG && WS_MB + (size_t)M * D * 2 <= WS_ZG && WS_WIN + (size_t)DIN * D * 2 <= WS_WBR, "ws map");

constexpr int LDS_BYTES = 147456, MISC_OFF = LDS_BYTES - 256;

__device__ __forceinline__ float bf2f(bf16_t h) { return __uint_as_float((unsigned)h << 16); }
__device__ __forceinline__ unsigned f2bf(float f) { unsigned u = __float_as_uint(f); return (u + 0x7fffu + ((u >> 16) & 1u)) >> 16; }
__device__ __forceinline__ unsigned pk2(float lo, float hi) { return f2bf(lo) | (f2bf(hi) << 16); }
__device__ __forceinline__ unsigned cvt_pk_bf16(float lo, float hi) { unsigned r; asm volatile("v_cvt_pk_bf16_f32 %0, %1, %2" : "=v"(r) : "v"(lo), "v"(hi)); return r; }
#define UNPACK8(VV, f, o) do { (f)[(o) + 0] = __uint_as_float((VV)[0] << 16); (f)[(o) + 1] = __uint_as_float((VV)[0] & 0xffff0000u); (f)[(o) + 2] = __uint_as_float((VV)[1] << 16); (f)[(o) + 3] = __uint_as_float((VV)[1] & 0xffff0000u); \
    (f)[(o) + 4] = __uint_as_float((VV)[2] << 16); (f)[(o) + 5] = __uint_as_float((VV)[2] & 0xffff0000u); (f)[(o) + 6] = __uint_as_float((VV)[3] << 16); (f)[(o) + 7] = __uint_as_float((VV)[3] & 0xffff0000u); } while (0)
#define PACK8(f, o) ((u32x4){pk2((f)[(o) + 0], (f)[(o) + 1]), pk2((f)[(o) + 2], (f)[(o) + 3]), pk2((f)[(o) + 4], (f)[(o) + 5]), pk2((f)[(o) + 6], (f)[(o) + 7])})
__device__ __forceinline__ float gelu_t(float x) { const float u = 0.7978845608028654f * (x + 0.044715f * x * x * x); return x / (1.f + __expf(-2.f * u)); }
__device__ __forceinline__ float sigmoid_f(float x) { return 1.f / (1.f + __expf(-x)); }
__device__ __forceinline__ float row_rstd(const float* ssq, int row) {
    const f32x4* p = (const f32x4*)(ssq + (size_t)row * 16);
    const f32x4 a = p[0], b = p[1], c = p[2], d = p[3];
    const float s = (((a.x + a.y) + (a.z + a.w)) + ((b.x + b.y) + (b.z + b.w))) + (((c.x + c.y) + (c.z + c.w)) + ((d.x + d.y) + (d.z + d.w)));
    return rsqrtf(s * (1.f / 1024.f) + EPS);
}
#define LDS_WAIT() asm volatile("s_waitcnt lgkmcnt(0)" ::: "memory")
__device__ __forceinline__ int opaque_tid() { int t = threadIdx.x; asm volatile("" : "+v"(t)); return t; }

namespace pg8 {
constexpr int BM = 256, BK = 64, HALF = 128, HTB = HALF * BK * 2, STAGE_BYTES = 8 * HTB, NXCD = 8, WGM = 8;
__host__ __device__ __forceinline__ int lds_byte(int r, int c) { const int st = (r >> 4) * 2 + (c >> 5), rr = r & 15, cc = c & 31, ob = rr * 64 + cc * 2; return st * 1024 + (ob ^ (((ob >> 9) & 1) << 5)); }
__host__ __device__ __forceinline__ void stage_rc(int b, int& R, int& C) { const int st = b / 1024, sb = b % 1024, swz = sb ^ (((sb >> 9) & 1) << 5); R = (st >> 1) * 16 + swz / 64; C = (st & 1) * 32 + (swz % 64) / 2; }
__host__ __device__ __forceinline__ int perm32(int rho) { const int n = rho >> 4, i = rho & 15; return 8 * (i >> 2) + 4 * n + (i & 3); }

struct Unit { int pm, pn, b; };
struct Gemm { const bf16_t* A; const bf16_t* Bt; };

struct SchedStd {
    int nM, nN, nwg, G, c; size_t as, bs;
    __device__ void init(int M_, int N_, int G_, int c_, int lda, int ldb) { nM = M_ / BM; nN = N_ / BM; nwg = nM * nN; G = G_; c = c_; as = (size_t)BM * lda * 2; bs = (size_t)BM * ldb * 2; }
    __device__ bool tile(long L, Unit& u) const {
        if (L >= nwg) return false;
        int wgid = (int)L; { const int q = nwg / NXCD, r = nwg % NXCD, xcd = wgid % NXCD, off = wgid / NXCD; wgid = (xcd < r ? xcd * (q + 1) : r * (q + 1) + (xcd - r) * q) + off; }
        const int nig = WGM * nN, gid = wgid / nig, fm = gid * WGM, gsz = (nM - fm) < WGM ? (nM - fm) : WGM;
        u.pm = fm + ((wgid % nig) % gsz); u.pn = (wgid % nig) / gsz; u.b = 0; return true;
    }
    __device__ bool next(int i, Unit& u) const { return tile((long)i * G + c, u); }
    __device__ size_t aoff(const Unit& u) const { return (size_t)u.pm * as; }
    __device__ size_t boff(const Unit& u) const { return (size_t)u.pn * bs; }
};
struct SchedMerge {
    SchedStd t;
    __device__ bool next(int i, Unit& u) const { if (!t.tile((long)(i >> 2) * t.G + t.c, u)) return false; u.b = i & 3; return true; }
    __device__ size_t aoff(const Unit& u) const { return (size_t)u.pm * t.as + (size_t)u.b * 1024; }
    __device__ size_t boff(const Unit& u) const { return (size_t)u.pn * t.bs + (size_t)u.b * 1024; }
};
struct SchedKV {
    int c;
    __device__ bool next(int i, Unit& u) const { if (i > 0 || c >= 32) return false; u.b = c >> 3; u.pm = (c & 7) >> 2; u.pn = c & 3; return true; }
    __device__ size_t aoff(const Unit& u) const { return (size_t)u.pm * 256 * 1024 * 2; }
    __device__ size_t boff(const Unit& u) const { return ((size_t)u.b * 1024 + (size_t)u.pn * 256) * 1024 * 2; }
};

struct EpiZ {
    static constexpr bool PERM = true;
    bf16_t* za; bf16_t* zg; const float* ssq; const float* bgate;
    __device__ __forceinline__ void operator()(const f32x4 (&acc)[2][2][4][2], const Unit& u, int wr, int wc, int fr, int fq) const {
        const int row0 = u.pm * BM + wr * 64 + fr, pn = u.pn;
        bf16_t* base; int ldc, colt, mode;
        if (pn < 13) { base = za; ldc = NZA; colt = pn * 256; mode = (pn < 4 || pn == 6 || pn == 7) ? 1 : 0; }
        else { base = zg; ldc = NZG; colt = (pn - 13) * 256; mode = 2; }
        const int col0 = colt + wc * 32 + 8 * fq;
        f32x4 bv[2][2];
#pragma unroll
        for (int bj = 0; bj < 2; ++bj)
#pragma unroll
            for (int n = 0; n < 2; ++n) bv[bj][n] = (mode == 2) ? *(const f32x4*)(bgate + col0 + bj * HALF + 4 * n) : (f32x4){0.f, 0.f, 0.f, 0.f};
#pragma unroll
        for (int ai = 0; ai < 2; ++ai)
#pragma unroll
            for (int m = 0; m < 4; ++m) {
                const int row = row0 + ai * HALF + m * 16; const float rs = row_rstd(ssq, row);
                bf16_t* rowp = base + (size_t)row * ldc + col0;
#pragma unroll
                for (int bj = 0; bj < 2; ++bj) {
                    f32x4 v0 = acc[ai][bj][m][0] * rs, v1 = acc[ai][bj][m][1] * rs;
                    if (mode == 1) {
#pragma unroll
                        for (int e = 0; e < 4; ++e) { v0[e] = gelu_t(v0[e]); v1[e] = gelu_t(v1[e]); }
                    } else if (mode == 2) {
                        v0 = v0 + bv[bj][0]; v1 = v1 + bv[bj][1];
#pragma unroll
                        for (int e = 0; e < 4; ++e) { v0[e] = sigmoid_f(v0[e]); v1[e] = sigmoid_f(v1[e]); }
                    }
                    u32x4 w; w.x = cvt_pk_bf16(v0[0], v0[1]); w.y = cvt_pk_bf16(v0[2], v0[3]); w.z = cvt_pk_bf16(v1[0], v1[1]); w.w = cvt_pk_bf16(v1[2], v1[3]);
                    *(u32x4*)(rowp + bj * HALF) = w;
                }
                asm volatile("" ::: "memory");
            }
    }
};
struct EpiFF1 {
    static constexpr bool PERM = true;
    bf16_t* f; const float* ssq;
    __device__ __forceinline__ void operator()(const f32x4 (&acc)[2][2][4][2], const Unit& u, int wr, int wc, int fr, int fq) const {
        const int row0 = u.pm * BM + wr * 64 + fr, col0 = u.pn * BM + wc * 32 + 8 * fq;
#pragma unroll
        for (int ai = 0; ai < 2; ++ai)
#pragma unroll
            for (int m = 0; m < 4; ++m) {
                const int row = row0 + ai * HALF + m * 16; const float rs = row_rstd(ssq, row);
                bf16_t* rowp = f + (size_t)row * FF + col0;
#pragma unroll
                for (int bj = 0; bj < 2; ++bj) {
                    f32x4 v0 = acc[ai][bj][m][0] * rs, v1 = acc[ai][bj][m][1] * rs;
#pragma unroll
                    for (int e = 0; e < 4; ++e) { const float a = fmaxf(v0[e], 0.f), b = fmaxf(v1[e], 0.f); v0[e] = a * a; v1[e] = b * b; }
                    u32x4 w; w.x = cvt_pk_bf16(v0[0], v0[1]); w.y = cvt_pk_bf16(v0[2], v0[3]); w.z = cvt_pk_bf16(v1[0], v1[1]); w.w = cvt_pk_bf16(v1[2], v1[3]);
                    *(u32x4*)(rowp + bj * HALF) = w;
                }
                asm volatile("" ::: "memory");
            }
    }
};
struct EpiRes {
    static constexpr bool PERM = true;
    float* x; bf16_t* xb; float* ssq;
    __device__ __forceinline__ void operator()(const f32x4 (&acc)[2][2][4][2], const Unit& u, int wr, int wc, int fr, int fq) const {
        const int row0 = u.pm * BM + wr * 64 + fr, col0 = u.pn * BM + wc * 32 + 8 * fq;
#pragma unroll
        for (int ai = 0; ai < 2; ++ai)
#pragma unroll
            for (int m = 0; m < 4; ++m) {
                const int row = row0 + ai * HALF + m * 16; float ss = 0.f;
#pragma unroll
                for (int bj = 0; bj < 2; ++bj) {
                    float* xp = x + (size_t)row * D + col0 + bj * HALF;
                    const f32x4 v0 = *(const f32x4*)xp + acc[ai][bj][m][0], v1 = *(const f32x4*)(xp + 4) + acc[ai][bj][m][1];
                    *(f32x4*)xp = v0; *(f32x4*)(xp + 4) = v1;
                    ss += (v0[0] * v0[0] + v0[1] * v0[1]) + (v0[2] * v0[2] + v0[3] * v0[3]) + (v1[0] * v1[0] + v1[1] * v1[1]) + (v1[2] * v1[2] + v1[3] * v1[3]);
                    u32x4 w; w.x = cvt_pk_bf16(v0[0], v0[1]); w.y = cvt_pk_bf16(v0[2], v0[3]); w.z = cvt_pk_bf16(v1[0], v1[1]); w.w = cvt_pk_bf16(v1[2], v1[3]);
                    *(u32x4*)(xb + (size_t)row * D + col0 + bj * HALF) = w;
                }
                ss += __shfl_xor(ss, 16); ss += __shfl_xor(ss, 32);
                if (fq == 0) ssq[(size_t)row * 16 + u.pn * 4 + wc] = ss;
                asm volatile("" ::: "memory");
            }
    }
};
struct EpiMerge {
    static constexpr bool PERM = true;
    const bf16_t* zg; float* S; bf16_t* mb;
    __device__ __forceinline__ void operator()(const f32x4 (&acc)[2][2][4][2], const Unit& u, int wr, int wc, int fr, int fq) const {
        const int row0 = u.pm * BM + wr * 64 + fr, col0 = u.pn * BM + wc * 32 + 8 * fq, b = u.b;
#pragma unroll
        for (int ai = 0; ai < 2; ++ai)
#pragma unroll
            for (int m = 0; m < 4; ++m) {
                const int row = row0 + ai * HALF + m * 16;
#pragma unroll
                for (int bj = 0; bj < 2; ++bj) {
                    const int col = col0 + bj * HALF;
                    const u32x4 gw = *(const u32x4*)(zg + (size_t)row * NZG + b * 1024 + col);
                    float g[8]; UNPACK8(gw, g, 0);
                    f32x4 v0 = acc[ai][bj][m][0], v1 = acc[ai][bj][m][1];
#pragma unroll
                    for (int e = 0; e < 4; ++e) { v0[e] *= g[e]; v1[e] *= g[4 + e]; }
                    float* sp = S + (size_t)row * D + col;
                    if (b > 0) { v0 = v0 + *(const f32x4*)sp; v1 = v1 + *(const f32x4*)(sp + 4); }
                    if (b < 3) { *(f32x4*)sp = v0; *(f32x4*)(sp + 4) = v1; }
                    else { u32x4 w; w.x = cvt_pk_bf16(v0[0], v0[1]); w.y = cvt_pk_bf16(v0[2], v0[3]); w.z = cvt_pk_bf16(v1[0], v1[1]); w.w = cvt_pk_bf16(v1[2], v1[3]);
                        *(u32x4*)(mb + (size_t)row * D + col) = w; }
                }
                asm volatile("" ::: "memory");
            }
    }
};
struct EpiKV {
    static constexpr bool PERM = true;
    bf16_t* out;
    __device__ __forceinline__ void operator()(const f32x4 (&acc)[2][2][4][2], const Unit& u, int wr, int wc, int fr, int fq) const {
        const int row0 = u.pm * BM + wr * 64 + fr, col0 = u.pn * BM + wc * 32 + 8 * fq;
        bf16_t* base = out + (size_t)u.b * 512 * 1024;
#pragma unroll
        for (int ai = 0; ai < 2; ++ai)
#pragma unroll
            for (int m = 0; m < 4; ++m) {
                const int row = row0 + ai * HALF + m * 16;
#pragma unroll
                for (int bj = 0; bj < 2; ++bj) {
                    const f32x4 v0 = acc[ai][bj][m][0], v1 = acc[ai][bj][m][1];
                    u32x4 w; w.x = cvt_pk_bf16(v0[0], v0[1]); w.y = cvt_pk_bf16(v0[2], v0[3]); w.z = cvt_pk_bf16(v1[0], v1[1]); w.w = cvt_pk_bf16(v1[2], v1[3]);
                    *(u32x4*)(base + (size_t)row * 1024 + col0 + bj * HALF) = w;
                }
            }
    }
};

template <class Epi, class Sched, bool ALIGN_EPI, int LDA, int LDB, int KK>
__device__ __forceinline__ void gemm_phase(LAS unsigned char* lds, const Gemm g, const Sched& S, const Epi& E) {
    const int tid = opaque_tid(), wid = __builtin_amdgcn_readfirstlane(tid >> 6), lane = tid & 63, wr = wid >> 2, wc = wid & 3, fr = lane & 15, fq = lane >> 4;
    constexpr int nt = KK / BK;
    unsigned voffA[2], voffB[2];
#pragma unroll
    for (int i = 0; i < 2; ++i) { int R, C; stage_rc(tid * 16 + i * 8192, R, C); const int Rb = Epi::PERM ? ((R & ~31) + perm32(R & 31)) : R;
        voffA[i] = (unsigned)(R * LDA + C) * 2u; voffB[i] = (unsigned)(Rb * LDB + C) * 2u; }
    constexpr size_t kstep = (size_t)(BK * 2);
    constexpr size_t hstepA = (size_t)HALF * LDA * 2, hstepB = (size_t)HALF * LDB * 2;
    const unsigned ldsw = (unsigned)wid * 1024u;
    const int aoff = lds_byte(wr * 64 + fr, fq * 8), boff = lds_byte(wc * 32 + fr, fq * 8);
#define PG8_SA(b, h) (((b) * 2 + (h)) * HTB)
#define PG8_SB(b, h) ((4 + (b) * 2 + (h)) * HTB)
#define PG8_STAGE(bufoff, gbase, voff) do { _Pragma("unroll") for (int _i = 0; _i < 2; ++_i) \
        __builtin_amdgcn_global_load_lds((const unsigned*)((const char*)(gbase) + (voff)[_i]), (LAS unsigned*)(lds + (bufoff) + ldsw + _i * 8192), 16, 0, 0); } while (0)
#define PG8_LDA(dst, b, h) do { _Pragma("unroll") for (int m = 0; m < 4; ++m) _Pragma("unroll") for (int k = 0; k < 2; ++k) dst[m][k] = *(const LAS bf16x8*)(lds + PG8_SA(b, h) + aoff + m * 2048 + k * 1024); } while (0)
#define PG8_LDB(dst, b, h) do { _Pragma("unroll") for (int n = 0; n < 2; ++n) _Pragma("unroll") for (int k = 0; k < 2; ++k) dst[n][k] = *(const LAS bf16x8*)(lds + PG8_SB(b, h) + boff + n * 2048 + k * 1024); } while (0)
#define PG8_MMA(ai, bj, At, Bt) do { __builtin_amdgcn_s_setprio(1); _Pragma("unroll") for (int m = 0; m < 4; ++m) _Pragma("unroll") for (int n = 0; n < 2; ++n) _Pragma("unroll") for (int k = 0; k < 2; ++k) \
        acc[ai][bj][m][n] = __builtin_amdgcn_mfma_f32_16x16x32_bf16(Bt[n][k], At[m][k], acc[ai][bj][m][n], 0, 0, 0); __builtin_amdgcn_s_setprio(0); } while (0)
#define PG8_WAIT_V(n) asm volatile("s_waitcnt vmcnt(" #n ")" ::: "memory")
#define PG8_WAIT_L(n) asm volatile("s_waitcnt lgkmcnt(" #n ")" ::: "memory")
#define PG8_BAR __builtin_amdgcn_s_barrier()
#define PG8_SCHED __builtin_amdgcn_sched_barrier(0)
    Unit cur, nxt; int ui = 0;
    if (!S.next(0, cur)) return;
    f32x4 acc[2][2][4][2];
#pragma unroll
    for (int a = 0; a < 2; ++a)
#pragma unroll
        for (int b = 0; b < 2; ++b)
#pragma unroll
            for (int m = 0; m < 4; ++m)
#pragma unroll
                for (int n = 0; n < 2; ++n) acc[a][b][m][n] = (f32x4){0.f, 0.f, 0.f, 0.f};
    bf16x8 At[4][2], B0[2][2], B1[2][2];
    const char* gA = (const char*)g.A; const char* gB = (const char*)g.Bt;
    asm volatile("" : "+s"(gA), "+s"(gB));
    const char* cA = gA + S.aoff(cur); const char* cB = gB + S.boff(cur);
    PG8_STAGE(PG8_SB(0, 0), cB, voffB); PG8_STAGE(PG8_SB(0, 1), cB + hstepB, voffB); PG8_STAGE(PG8_SA(0, 0), cA, voffA); PG8_STAGE(PG8_SA(0, 1), cA + hstepA, voffA);
    if (wr == 1) PG8_BAR;
    PG8_WAIT_V(2); PG8_BAR;
    PG8_STAGE(PG8_SB(1, 0), cB + kstep, voffB); PG8_STAGE(PG8_SA(1, 0), cA + kstep, voffA); PG8_STAGE(PG8_SB(1, 1), cB + hstepB + kstep, voffB);
    PG8_WAIT_V(6); PG8_BAR;
    for (;;) {
        const bool has_next = S.next(ui + 1, nxt);
        const char* nA = has_next ? gA + S.aoff(nxt) : cA; const char* nB = has_next ? gB + S.boff(nxt) : cB;
        for (int t = 0; t < nt; t += 2) {
            const bool last = (t == nt - 2);
            const char* a1 = cA + (size_t)(t + 1) * kstep;
            const char* a2 = last ? nA : cA + (size_t)(t + 2) * kstep; const char* b2 = last ? nB : cB + (size_t)(t + 2) * kstep;
            const char* a3 = a2 + kstep; const char* b3 = b2 + kstep;
            PG8_LDB(B0, 0, 0); PG8_LDB(B1, 0, 1); PG8_SCHED; PG8_LDA(At, 0, 0); PG8_STAGE(PG8_SA(1, 1), a1 + hstepA, voffA);
            PG8_WAIT_V(8); PG8_WAIT_L(0); PG8_BAR; PG8_MMA(0, 0, At, B0); PG8_MMA(0, 1, At, B1); PG8_BAR; PG8_SCHED;
            PG8_LDA(At, 0, 1); PG8_STAGE(PG8_SB(0, 0), b2, voffB); PG8_STAGE(PG8_SB(0, 1), b2 + hstepB, voffB); PG8_STAGE(PG8_SA(0, 0), a2, voffA);
            PG8_WAIT_V(8); PG8_WAIT_L(0); PG8_BAR; PG8_MMA(1, 0, At, B0); PG8_MMA(1, 1, At, B1); PG8_BAR; PG8_SCHED;
            PG8_LDB(B0, 1, 0); PG8_LDB(B1, 1, 1); PG8_SCHED; PG8_LDA(At, 1, 0); PG8_STAGE(PG8_SA(0, 1), a2 + hstepA, voffA);
            PG8_WAIT_V(8); PG8_WAIT_L(0); PG8_BAR; PG8_MMA(0, 0, At, B0); PG8_MMA(0, 1, At, B1); PG8_BAR; PG8_SCHED;
            PG8_LDA(At, 1, 1); PG8_STAGE(PG8_SB(1, 0), b3, voffB); PG8_STAGE(PG8_SB(1, 1), b3 + hstepB, voffB); PG8_STAGE(PG8_SA(1, 0), a3, voffA);
            PG8_WAIT_V(8); PG8_WAIT_L(0); PG8_BAR; PG8_MMA(1, 0, At, B0); PG8_MMA(1, 1, At, B1); PG8_BAR; PG8_SCHED;
        }
        if constexpr (ALIGN_EPI) { if (wr == 0) PG8_BAR; }
        E(acc, cur, wr, wc, fr, fq);
        if (!has_next) break;
#pragma unroll
        for (int a = 0; a < 2; ++a)
#pragma unroll
            for (int b = 0; b < 2; ++b)
#pragma unroll
                for (int m = 0; m < 4; ++m)
#pragma unroll
                    for (int n = 0; n < 2; ++n) acc[a][b][m][n] = (f32x4){0.f, 0.f, 0.f, 0.f};
        cur = nxt; cA = nA; cB = nB; ++ui;
        if constexpr (ALIGN_EPI) { if (wr == 1) PG8_BAR; }
    }
    PG8_WAIT_V(0);
    if constexpr (!ALIGN_EPI) { if (wr == 0) PG8_BAR; }
    PG8_BAR;
#undef PG8_SA
#undef PG8_SB
#undef PG8_STAGE
#undef PG8_LDA
#undef PG8_LDB
#undef PG8_MMA
#undef PG8_WAIT_V
#undef PG8_WAIT_L
#undef PG8_BAR
#undef PG8_SCHED
}
}

#define XB_TMO      128
#define XB_XCNT(j)  (256  + 64 * (j))
#define XB_XSUB(j)  (1280 + 64 * (j))
#define XB_XGEN(j)  (2304 + 64 * (j))
#define XB_TOP      3328
#define XB_TOPGEN   3392
#define XCD_BAR_WORDS 3456
#define XB_SPIN_CAP (1u << 23)
__device__ __forceinline__ unsigned xb_ld(unsigned* p)              { return __hip_atomic_load(p, __ATOMIC_RELAXED, __HIP_MEMORY_SCOPE_AGENT); }
__device__ __forceinline__ unsigned xb_add(unsigned* p, unsigned v) { return __hip_atomic_fetch_add(p, v, __ATOMIC_RELAXED, __HIP_MEMORY_SCOPE_AGENT); }
__device__ __forceinline__ unsigned xb_xcc_id() { return (unsigned)__builtin_amdgcn_s_getreg((3 << 11) | 20) & 0xFu; }
#define XB_SPIN(cond, bar) do { unsigned _sp = 0; while (cond) { __builtin_amdgcn_s_sleep(1); \
    if ((++_sp & 255u) == 0u) { if (xb_ld(&(bar)[XB_TMO])) break; if (_sp > XB_SPIN_CAP) { atomicAdd(&(bar)[XB_TMO], 1u); break; } } } } while (0)
struct XcdBarrier { unsigned* bar; unsigned x; volatile LAS unsigned* st; };
__device__ __forceinline__ XcdBarrier xcd_barrier_post(unsigned* bar, volatile LAS unsigned* st) {
    XcdBarrier b; b.bar = bar; b.x = xb_xcc_id(); b.st = st;
    if (threadIdx.x == 0) (void)xb_add(&bar[XB_XCNT(b.x)], 1u);
    return b;
}
__device__ __forceinline__ void xcd_barrier_complete(unsigned* bar, unsigned x, unsigned& nloc, unsigned& nx) {
    const unsigned G = gridDim.x * gridDim.y * gridDim.z;
    unsigned sum, cnt, mine, sp = 0u;
    for (;;) {
        sum = 0u; cnt = 0u; mine = 0u;
#pragma unroll
        for (unsigned j = 0; j < 16; ++j) { const unsigned c = xb_ld(&bar[XB_XCNT(j)]); sum += c; cnt += (c > 0u) ? 1u : 0u; mine = (j == x) ? c : mine; }
        if (sum == G) break;
        __builtin_amdgcn_s_sleep(1);
        if ((++sp & 255u) == 0u) { if (xb_ld(&bar[XB_TMO])) break; if (sp > XB_SPIN_CAP) { atomicAdd(&bar[XB_TMO], 1u); break; } }
    }
    nloc = mine > 0u ? mine : 1u; nx = cnt > 0u ? cnt : 1u;
}
__device__ __forceinline__ void xcd_barrier(const XcdBarrier& b) {
    asm volatile("s_waitcnt vmcnt(0)" ::: "memory");
    __syncthreads();
    if (threadIdx.x == 0) {
        unsigned* bar = b.bar;
        __builtin_amdgcn_s_waitcnt(0);
        unsigned nloc = b.st[0], nx = b.st[1];
        if (nloc == 0u) { xcd_barrier_complete(bar, b.x, nloc, nx); b.st[0] = nloc; b.st[1] = nx; }
        const unsigned old = xb_add(&bar[XB_XSUB(b.x)], 1u);
        const unsigned gen = old / nloc;
        if (old + 1u == (gen + 1u) * nloc) {
            __builtin_amdgcn_fence(__ATOMIC_RELEASE, "agent");
            asm volatile("s_waitcnt vmcnt(0)" ::: "memory");
            const unsigned og = xb_add(&bar[XB_TOP], 1u);
            const unsigned tg = og / nx;
            if (og + 1u == (tg + 1u) * nx) xb_add(&bar[XB_TOPGEN], 1u);
            else XB_SPIN(xb_ld(&bar[XB_TOPGEN]) == tg, bar);
            __builtin_amdgcn_fence(__ATOMIC_ACQUIRE, "agent");
            xb_add(&bar[XB_XGEN(b.x)], 1u);
            asm volatile("s_waitcnt vmcnt(0)" ::: "memory");
        } else {
            XB_SPIN(xb_ld(&bar[XB_XGEN(b.x)]) == gen, bar);
            __builtin_amdgcn_fence(__ATOMIC_ACQUIRE, "agent");
            asm volatile("s_waitcnt vmcnt(0)" ::: "memory");
        }
    }
    __syncthreads();
}

struct Args { const float* in[27]; float* out; unsigned char* ws; };
enum { I_X = 0, I_MEM, I_NMIX, I_NMEM, I_NMLP, I_WIN, I_BGATE, I_GMVG, I_GMWS, I_GMBS, I_CONVW, I_CONVB, I_WR, I_BR, I_WI, I_BI, I_LAM, I_SQG, I_SKG, I_SINK, I_WKV, I_XQG, I_XKG, I_WBR, I_WOUT, I_WFF1, I_WFF2 };
struct Ctx {
    const float* const* in; float* x;
    bf16_t *wt_in, *wt_br, *wt_out, *wt_ff1, *wt_ff2, *wt_kv, *memn, *memkv, *xb, *za, *zg, *mb, *o;
    float *ssq, *carryA, *carryH, *S, *ly, *lp;
    bf16_t *memK, *memVt;
};

__device__ __forceinline__ void transpose_item(const float* W, int N, bf16_t* WT, int ldk, int koff, const float* gain, LAS float* scr, int item, int lane) {
    const int nblk = N / 32, kb = item / nblk, nb = item % nblk, k0 = 64 * kb, n0 = 32 * nb;
#pragma unroll 8
    for (int i = 0; i < 32; ++i) { const int kk = 2 * i + (lane >> 5); float v = W[(size_t)(k0 + kk) * N + n0 + (lane & 31)]; if (gain) v *= gain[k0 + kk]; scr[kk * 33 + (lane & 31)] = v; }
    LDS_WAIT(); asm volatile("" ::: "memory");
    const int c = lane & 7;
#pragma unroll
    for (int j = 0; j < 4; ++j) { const int n = (lane >> 3) + 8 * j; const LAS float* s = scr + (8 * c) * 33 + n;
        u32x4 o; o.x = pk2(s[0 * 33], s[1 * 33]); o.y = pk2(s[2 * 33], s[3 * 33]); o.z = pk2(s[4 * 33], s[5 * 33]); o.w = pk2(s[6 * 33], s[7 * 33]);
        *(u32x4*)(WT + (size_t)(n0 + n) * ldk + koff + k0 + 8 * c) = o; }
    LDS_WAIT(); asm volatile("" ::: "memory");
}
__device__ __forceinline__ float wave_sum(float v) {
#pragma unroll
    for (int o = 1; o < 64; o <<= 1) v += __shfl_xor(v, o);
    return v;
}
__device__ __forceinline__ void conv_w(const Ctx& C, int which, int l, int item, LAS float* scr, int lane) {
    if (which == 0) transpose_item(C.in[I_WIN] + (size_t)l * D * DIN, DIN, C.wt_in, D, 0, C.in[I_NMIX] + l * D, scr, item, lane);
    else if (which == 1) { const int b = item >> 8; transpose_item(C.in[I_WBR] + (size_t)(l * 4 + b) * 512 * D, D, C.wt_br, 2048, b * 512, nullptr, scr, item & 255, lane); }
    else if (which == 2) transpose_item(C.in[I_WOUT] + (size_t)l * D * D, D, C.wt_out, D, 0, nullptr, scr, item, lane);
    else if (which == 3) transpose_item(C.in[I_WFF1] + (size_t)l * D * FF, FF, C.wt_ff1, D, 0, C.in[I_NMLP] + l * D, scr, item, lane);
    else if (which == 4) transpose_item(C.in[I_WFF2] + (size_t)l * FF * D, D, C.wt_ff2, FF, 0, nullptr, scr, item, lane);
    else transpose_item(C.in[I_WKV] + (size_t)l * D * D, D, C.wt_kv + (size_t)l * D * D, D, 0, C.in[I_NMEM] + l * D, scr, item, lane);
}
constexpr int IT_WIN = 16 * 232, IT_WBR = 1024, IT_WOUT = 512, IT_WFF1 = 2048, IT_WFF2 = 2048, IT_WKV = 512;

#ifndef USE_MFMA_SWA
#define USE_MFMA_SWA 1
#endif
#ifndef USE_MFMA_XA
#define USE_MFMA_XA 1
#endif
#ifndef USE_MFMA_GM
#define USE_MFMA_GM 1
#endif
#ifndef USE_MFMA_LRU
#define USE_MFMA_LRU 1
#endif
#define ROPE_INV(i) ((i) == 0 ? 1.0f : (i) == 1 ? 0.19392274474868576f : (i) == 2 ? 0.03760603093086393f : (i) == 3 ? 0.007292664737217109f : (i) == 4 ? 0.001414213562373095f : (i) == 5 ? 0.0002742481756762073f : (i) == 6 ? 5.318295896944988e-05f : 1.031338537721246e-05f)
#define ROPE16(f, pos) do { _Pragma("unroll") for (int _i = 0; _i < 8; ++_i) { float _s, _c; sincosf((pos) * ROPE_INV(_i), &_s, &_c); const float _x1 = (f)[_i], _x2 = (f)[_i + 8]; (f)[_i] = _x1 * _c - _x2 * _s; (f)[_i + 8] = _x2 * _c + _x1 * _s; } } while (0)

__device__ __forceinline__ void swa_item(LAS unsigned char* lds, const Ctx& C, int l, int tile, int h) {
    const int tid = opaque_tid();
    LAS bf16_t* Ks = (LAS bf16_t*)lds;
    LAS bf16_t* Vs = Ks + 256 * 72;
    const int kvh = h >> 2, nb = tile & 63, row0 = tile * 128;
    {
        const int key = tid >> 1, half = tid & 1;
        const bool ok = (nb > 0) || (key >= 128);
        const size_t grow = (size_t)(ok ? row0 - 128 + key : row0);
        const u32x4* kp = (const u32x4*)(C.za + grow * NZA + 2560 + kvh * 64 + half * 32);
        const u32x4* vp = (const u32x4*)(C.za + grow * NZA + 2688 + kvh * 64 + half * 32);
        float kf[32]; float ss = 0.f;
#pragma unroll
        for (int i = 0; i < 4; ++i) { const u32x4 w = kp[i]; UNPACK8(w, kf, 8 * i); }
#pragma unroll
        for (int i = 0; i < 32; ++i) ss += kf[i] * kf[i];
        ss += __shfl_xor(ss, 1);
        const float rs = rsqrtf(ss * (1.f / 64.f) + EPS);
        const float* kg = C.in[I_SKG] + l * 64 + half * 32;
#pragma unroll
        for (int i = 0; i < 32; ++i) kf[i] *= rs * kg[i];
        if (half == 0) { const float pos = (float)(nb * 128 - 128 + key); ROPE16(kf, pos); }
#pragma unroll
        for (int i = 0; i < 4; ++i) { *(LAS u32x4*)(Ks + key * 72 + half * 32 + 8 * i) = PACK8(kf, 8 * i); *(LAS u32x4*)(Vs + key * 72 + half * 32 + 8 * i) = vp[i]; }
    }
    const int q = tid >> 2, sub = tid & 3;
    float qf[16];
    {
        const u32x4* qp = (const u32x4*)(C.za + (size_t)(row0 + q) * NZA + 2048 + h * 64 + sub * 16);
        const u32x4 w0 = qp[0], w1 = qp[1]; UNPACK8(w0, qf, 0); UNPACK8(w1, qf, 8);
        float ss = 0.f;
#pragma unroll
        for (int i = 0; i < 16; ++i) ss += qf[i] * qf[i];
        ss += __shfl_xor(ss, 1); ss += __shfl_xor(ss, 2);
        const float rs = rsqrtf(ss * (1.f / 64.f) + EPS);
        const float* qg = C.in[I_SQG] + l * 64 + sub * 16;
#pragma unroll
        for (int i = 0; i < 16; ++i) qf[i] *= rs * qg[i];
        if (sub == 0) { const float pos = (float)(nb * 128 + q); ROPE16(qf, pos); }
#pragma unroll
        for (int i = 0; i < 16; ++i) qf[i] *= 0.125f;
    }
    __syncthreads();
    const float sink = C.in[I_SINK][l * 8 + h];
    float mx = sink;
    for (int j = 0; j < 128; ++j) {
        const int kj = q + 1 + j; const bool valid = (nb > 0) || (kj >= 128);
        const LAS u32x4* kr = (const LAS u32x4*)(Ks + kj * 72 + sub * 16);
        float kf[16]; const u32x4 w0 = kr[0], w1 = kr[1]; UNPACK8(w0, kf, 0); UNPACK8(w1, kf, 8);
        float s = 0.f;
#pragma unroll
        for (int i = 0; i < 16; ++i) s += qf[i] * kf[i];
        s += __shfl_xor(s, 1); s += __shfl_xor(s, 2);
        if (valid) mx = fmaxf(mx, s);
    }
    float lsum = __expf(sink - mx); float o[16];
#pragma unroll
    for (int i = 0; i < 16; ++i) o[i] = 0.f;
    for (int j = 0; j < 128; ++j) {
        const int kj = q + 1 + j; const bool valid = (nb > 0) || (kj >= 128);
        const LAS u32x4* kr = (const LAS u32x4*)(Ks + kj * 72 + sub * 16);
        float kf[16]; { const u32x4 w0 = kr[0], w1 = kr[1]; UNPACK8(w0, kf, 0); UNPACK8(w1, kf, 8); }
        float s = 0.f;
#pragma unroll
        for (int i = 0; i < 16; ++i) s += qf[i] * kf[i];
        s += __shfl_xor(s, 1); s += __shfl_xor(s, 2);
        const float p = valid ? __expf(s - mx) : 0.f;
        lsum += p;
        const LAS u32x4* vr = (const LAS u32x4*)(Vs + kj * 72 + sub * 16);
        float vf[16]; { const u32x4 w0 = vr[0], w1 = vr[1]; UNPACK8(w0, vf, 0); UNPACK8(w1, vf, 8); }
#pragma unroll
        for (int i = 0; i < 16; ++i) o[i] += p * vf[i];
    }
    const float inv = 1.f / lsum;
#pragma unroll
    for (int i = 0; i < 16; ++i) o[i] *= inv;
    u32x4* op = (u32x4*)(C.o + (size_t)(row0 + q) * NO + 1024 + h * 64 + sub * 16);
    op[0] = PACK8(o, 0); op[1] = PACK8(o, 8);
    __syncthreads();
}

__device__ __forceinline__ void xa_item(LAS unsigned char* lds, const Ctx& C, int l, int tile, int h) {
    const int tid = opaque_tid();
    LAS bf16_t* Ks = (LAS bf16_t*)lds;
    LAS bf16_t* Vs = Ks + 256 * 136;
    const int b = tile >> 6, row0 = tile * 128;
    {
        const int key = tid >> 1, half = tid & 1;
        const bf16_t* src = C.memkv + ((size_t)(l * 512 + b * 256 + key)) * 1024 + h * 128 + half * 64;
        const u32x4* kp = (const u32x4*)src; const u32x4* vp = (const u32x4*)(src + 512);
        float kf[64]; float ss = 0.f;
#pragma unroll
        for (int i = 0; i < 8; ++i) { const u32x4 w = kp[i]; UNPACK8(w, kf, 8 * i); }
#pragma unroll
        for (int i = 0; i < 64; ++i) ss += kf[i] * kf[i];
        ss += __shfl_xor(ss, 1);
        const float rs = rsqrtf(ss * (1.f / 128.f) + EPS);
        const float* kg = C.in[I_XKG] + l * 128 + half * 64;
#pragma unroll
        for (int i = 0; i < 64; ++i) kf[i] *= rs * kg[i];
#pragma unroll
        for (int i = 0; i < 8; ++i) { *(LAS u32x4*)(Ks + key * 136 + half * 64 + 8 * i) = PACK8(kf, 8 * i); *(LAS u32x4*)(Vs + key * 136 + half * 64 + 8 * i) = vp[i]; }
    }
    const int q = tid >> 2, sub = tid & 3;
    float qf[32];
    {
        const u32x4* qp = (const u32x4*)(C.za + (size_t)(row0 + q) * NZA + 2816 + h * 128 + sub * 32);
#pragma unroll
        for (int i = 0; i < 4; ++i) { const u32x4 w = qp[i]; UNPACK8(w, qf, 8 * i); }
        float ss = 0.f;
#pragma unroll
        for (int i = 0; i < 32; ++i) ss += qf[i] * qf[i];
        ss += __shfl_xor(ss, 1); ss += __shfl_xor(ss, 2);
        const float rs = rsqrtf(ss * (1.f / 128.f) + EPS) * 0.08838834764831845f;
        const float* qg = C.in[I_XQG] + l * 128 + sub * 32;
#pragma unroll
        for (int i = 0; i < 32; ++i) qf[i] *= rs * qg[i];
    }
    __syncthreads();
    float mx = -3.0e38f;
    for (int key = 0; key < 256; ++key) {
        const LAS u32x4* kr = (const LAS u32x4*)(Ks + key * 136 + sub * 32);
        float s = 0.f;
#pragma unroll
        for (int c = 0; c < 4; ++c) { float kf[8]; const u32x4 w = kr[c]; UNPACK8(w, kf, 0);
#pragma unroll
            for (int i = 0; i < 8; ++i) s += qf[8 * c + i] * kf[i]; }
        s += __shfl_xor(s, 1); s += __shfl_xor(s, 2);
        mx = fmaxf(mx, s);
    }
    float lsum = 0.f; float o[32];
#pragma unroll
    for (int i = 0; i < 32; ++i) o[i] = 0.f;
    for (int key = 0; key < 256; ++key) {
        const LAS u32x4* kr = (const LAS u32x4*)(Ks + key * 136 + sub * 32);
        float s = 0.f;
#pragma unroll
        for (int c = 0; c < 4; ++c) { float kf[8]; const u32x4 w = kr[c]; UNPACK8(w, kf, 0);
#pragma unroll
            for (int i = 0; i < 8; ++i) s += qf[8 * c + i] * kf[i]; }
        s += __shfl_xor(s, 1); s += __shfl_xor(s, 2);
        const float p = __expf(s - mx);
        lsum += p;
        const LAS u32x4* vr = (const LAS u32x4*)(Vs + key * 136 + sub * 32);
#pragma unroll
        for (int c = 0; c < 4; ++c) { float vf[8]; const u32x4 w = vr[c]; UNPACK8(w, vf, 0);
#pragma unroll
            for (int i = 0; i < 8; ++i) o[8 * c + i] += p * vf[i]; }
    }
    const float inv = 1.f / lsum;
#pragma unroll
    for (int i = 0; i < 32; ++i) o[i] *= inv;
    u32x4* op = (u32x4*)(C.o + (size_t)(row0 + q) * NO + 1536 + h * 128 + sub * 32);
#pragma unroll
    for (int c = 0; c < 4; ++c) op[c] = PACK8(o, 8 * c);
    __syncthreads();
}

__device__ __forceinline__ void gm_item(LAS unsigned char* lds, const Ctx& C, int l, int tile, int g) {
    const int tid = opaque_tid();
    LAS float* vn = (LAS float*)lds;
    LAS float* Wl = vn + 128 * 128;
    LAS float* rsv = Wl + 128 * 128;
    const int row0 = tile * 128;
    {
        const int tok = tid >> 2, sub = tid & 3;
        const u32x4* vp = (const u32x4*)(C.za + (size_t)(row0 + tok) * NZA + 512 + sub * 128);
        float ss = 0.f;
#pragma unroll
        for (int i = 0; i < 16; ++i) { float f[8]; const u32x4 w = vp[i]; UNPACK8(w, f, 0);
#pragma unroll
            for (int e = 0; e < 8; ++e) ss += f[e] * f[e]; }
        ss += __shfl_xor(ss, 1); ss += __shfl_xor(ss, 2);
        if (sub == 0) rsv[tok] = rsqrtf(ss * (1.f / 512.f) + EPS);
        const f32x4* wp = (const f32x4*)(C.in[I_GMWS] + (size_t)(l * 4 + g) * 128 * 128);
#pragma unroll
        for (int i = 0; i < 8; ++i) *(LAS f32x4*)(Wl + (i * 512 + tid) * 4) = wp[i * 512 + tid];
    }
    __syncthreads();
    {
        const int s = tid >> 2, c0 = (tid & 3) * 32;
        const u32x4* vp = (const u32x4*)(C.za + (size_t)(row0 + s) * NZA + 512 + g * 128 + c0);
        const float rs = rsv[s]; const float* vg = C.in[I_GMVG] + l * 512 + g * 128 + c0;
#pragma unroll
        for (int i = 0; i < 4; ++i) { float f[8]; const u32x4 w = vp[i]; UNPACK8(w, f, 0);
#pragma unroll
            for (int e = 0; e < 8; ++e) f[e] *= rs * vg[8 * i + e];
            *(LAS f32x4*)(vn + s * 128 + c0 + 8 * i) = (f32x4){f[0], f[1], f[2], f[3]}; *(LAS f32x4*)(vn + s * 128 + c0 + 8 * i + 4) = (f32x4){f[4], f[5], f[6], f[7]}; }
    }
    __syncthreads();
    {
        const int c = tid & 127, tq = tid >> 7;
        const float* bs = C.in[I_GMBS] + (size_t)(l * 4 + g) * 128;
        for (int k = 0; k < 32; ++k) {
            const int t = tq * 32 + k; float acc = 0.f;
            for (int s = 0; s <= t; ++s) acc += Wl[t * 128 + s] * vn[s * 128 + c];
            const float sval = acc + bs[t];
            const float u = bf2f(C.za[(size_t)(row0 + t) * NZA + g * 128 + c]);
            C.o[(size_t)(row0 + t) * NO + g * 128 + c] = (bf16_t)f2bf(u * sval);
        }
    }
    __syncthreads();
}

__device__ __forceinline__ void lru_item(LAS unsigned char* lds, const Ctx& C, int l, int tile, int hb) {
    const int tid = opaque_tid();
    LAS float* xc = (LAS float*)lds;
    LAS float* wr = xc + 8192;
    LAS float* wi = wr + 4096;
    LAS float* aa = wi + 4096;
    LAS float* bb = aa + 8192;
    const int nb = tile & 63, row0 = tile * 128;
    {
        const int t = tid >> 2, c0 = (tid & 3) * 16, ch = hb * 64 + c0;
        float acc[16];
#pragma unroll
        for (int i = 0; i < 16; ++i) acc[i] = C.in[I_CONVB][l * 512 + ch + i];
#pragma unroll
        for (int k = 0; k < 4; ++k) {
            const int tt = t - 3 + k;
            if (nb * 128 + tt >= 0) {
                const u32x4* xp = (const u32x4*)(C.za + (size_t)(row0 + tt) * NZA + 1024 + ch);
                float f[16]; const u32x4 w0 = xp[0], w1 = xp[1]; UNPACK8(w0, f, 0); UNPACK8(w1, f, 8);
                const float* cw = C.in[I_CONVW] + (size_t)(l * 4 + k) * 512 + ch;
#pragma unroll
                for (int i = 0; i < 16; ++i) acc[i] += cw[i] * f[i];
            }
        }
#pragma unroll
        for (int i = 0; i < 4; ++i) *(LAS f32x4*)(xc + t * 64 + c0 + 4 * i) = (f32x4){acc[4 * i], acc[4 * i + 1], acc[4 * i + 2], acc[4 * i + 3]};
        const f32x4* wrp = (const f32x4*)(C.in[I_WR] + (size_t)(l * 8 + hb) * 4096); const f32x4* wip = (const f32x4*)(C.in[I_WI] + (size_t)(l * 8 + hb) * 4096);
#pragma unroll
        for (int i = 0; i < 2; ++i) { *(LAS f32x4*)(wr + (i * 512 + tid) * 4) = wrp[i * 512 + tid]; *(LAS f32x4*)(wi + (i * 512 + tid) * 4) = wip[i * 512 + tid]; }
    }
    __syncthreads();
    const int j = tid & 63, tg = tid >> 6, chj = hb * 64 + j;
    {
        const float br = C.in[I_BR][l * 512 + chj], bi = C.in[I_BI][l * 512 + chj];
        const float lam = C.in[I_LAM][l * 512 + chj];
        const float sp = log1pf(expf(-lam));
        for (int k = 0; k < 16; ++k) {
            const int t = tg * 16 + k; float r = br, ig = bi;
            for (int i = 0; i < 64; ++i) { const float xv = xc[t * 64 + i]; r += xv * wr[i * 64 + j]; ig += xv * wi[i * 64 + j]; }
            r = sigmoid_f(r); ig = sigmoid_f(ig);
            const float loga = -8.f * r * sp; const float a = expf(loga); const float mult = sqrtf(-expm1f(2.f * loga));
            aa[t * 64 + j] = a; bb[t * 64 + j] = xc[t * 64 + j] * ig * mult;
        }
    }
    __syncthreads();
    if (tid < 64) {
        float hh = 0.f, P = 1.f;
        for (int t = 0; t < 128; ++t) { const float a = aa[t * 64 + tid]; hh = a * hh + bb[t * 64 + tid]; P *= a; aa[t * 64 + tid] = P; bb[t * 64 + tid] = hh; }
        C.carryA[(size_t)tile * 512 + hb * 64 + tid] = P; C.carryH[(size_t)tile * 512 + hb * 64 + tid] = hh;
    }
    __syncthreads();
    for (int k = 0; k < 16; ++k) {
        const int t = tg * 16 + k;
        const float G = bf2f(C.za[(size_t)(row0 + t) * NZA + 1536 + chj]);
        C.ly[(size_t)(row0 + t) * 512 + chj] = G * bb[t * 64 + j]; C.lp[(size_t)(row0 + t) * 512 + chj] = G * aa[t * 64 + j];
    }
    __syncthreads();
}

__device__ __forceinline__ int vperm_pos(int key) { const int w = key & 31; return (key & ~31) + ((w >> 2) & 3) * 8 + (w >> 4) * 4 + (w & 3); }
#define MFMA16(X, Y, ACC) __builtin_amdgcn_mfma_f32_16x16x32_bf16((X), (Y), (ACC), 0, 0, 0)
__device__ __forceinline__ bf16x8 pack_bf16x8(const float* f) { u32x4 w; w[0] = cvt_pk_bf16(f[0], f[1]); w[1] = cvt_pk_bf16(f[2], f[3]); w[2] = cvt_pk_bf16(f[4], f[5]); w[3] = cvt_pk_bf16(f[6], f[7]); return __builtin_bit_cast(bf16x8, w); }

__device__ __forceinline__ void kvprep_phase(const Ctx& C, int gw, int NGW, int lane) {
    for (int r = gw; r < 32 * 256; r += NGW) {
        const int combo = r >> 8, key = r & 255, l = combo >> 3, b = (combo >> 2) & 1, h = combo & 3;
        const unsigned w = *(const unsigned*)(C.memkv + ((size_t)(l * 512 + b * 256 + key)) * 1024 + h * 128 + 2 * lane);
        float f0 = __uint_as_float(w << 16), f1 = __uint_as_float(w & 0xffff0000u);
        const float ss = wave_sum(f0 * f0 + f1 * f1); const float rs = rsqrtf(ss * (1.f / 128.f) + EPS);
        const float* kg = C.in[I_XKG] + l * 128 + 2 * lane;
        *(unsigned*)(C.memK + (size_t)r * 128 + 2 * lane) = pk2(f0 * rs * kg[0], f1 * rs * kg[1]);
    }
    const int gt = gw * 64 + lane, NGT = NGW * 64;
    for (int t = gt; t < 32 * 32 * 128; t += NGT) {
        const int d = t & 127, pg = (t >> 7) & 31, combo = t >> 12, l = combo >> 3, b = (combo >> 2) & 1, h = combo & 3;
        const int kbase = (pg >> 2) * 32 + (pg & 3) * 4;
        const bf16_t* src = C.memkv + ((size_t)(l * 512 + b * 256)) * 1024 + 512 + h * 128 + d;
        unsigned short v[8];
#pragma unroll
        for (int e = 0; e < 4; ++e) { v[e] = src[(size_t)(kbase + e) * 1024]; v[4 + e] = src[(size_t)(kbase + 16 + e) * 1024]; }
        u32x4 o; o[0] = v[0] | ((unsigned)v[1] << 16); o[1] = v[2] | ((unsigned)v[3] << 16); o[2] = v[4] | ((unsigned)v[5] << 16); o[3] = v[6] | ((unsigned)v[7] << 16);
        *(u32x4*)(C.memVt + ((size_t)combo * 128 + d) * 256 + pg * 8) = o;
    }
}

__device__ __forceinline__ void xa_pair_mfma(LAS unsigned char* lds, const Ctx& C, int l, int pairidx) {
    const int tid = opaque_tid(), lane = tid & 63, w = __builtin_amdgcn_readfirstlane(tid >> 6), fr = lane & 15, fq = lane >> 4;
    LAS bf16_t* Ks = (LAS bf16_t*)lds;
    LAS bf16_t* Vt = Ks + 256 * 144;
    const int idx0 = pairidx * 2, bh = idx0 >> 6, b = bh >> 2, h = bh & 3, nb0 = idx0 & 63;
    {
        const u32x4* ksrc = (const u32x4*)(C.memK + ((size_t)(l * 8 + bh)) * 256 * 128);
        const u32x4* vsrc = (const u32x4*)(C.memVt + ((size_t)(l * 8 + bh)) * 128 * 256);
#pragma unroll
        for (int i = 0; i < 8; ++i) { const int ch = i * 512 + tid;
            *(LAS u32x4*)(Ks + (ch >> 4) * 144 + (ch & 15) * 8) = ksrc[ch];
            *(LAS u32x4*)(Vt + (ch >> 5) * 272 + (ch & 31) * 8) = vsrc[ch]; }
    }
    __syncthreads();
    const float* qg = C.in[I_XQG] + l * 128;
    for (int tt = 0; tt < 2; ++tt) {
        const size_t row = (size_t)((b * 64 + nb0 + tt) * 128 + w * 16 + fr);
        bf16x8 qf[4];
        {
            float f[32]; const bf16_t* qp = C.za + row * NZA + 2816 + h * 128 + 8 * fq;
#pragma unroll
            for (int ks = 0; ks < 4; ++ks) { const u32x4 wv = *(const u32x4*)(qp + 32 * ks); UNPACK8(wv, f, 8 * ks); }
            float ss = 0.f;
#pragma unroll
            for (int i = 0; i < 32; ++i) ss += f[i] * f[i];
            ss += __shfl_xor(ss, 16); ss += __shfl_xor(ss, 32);
            const float rs = rsqrtf(ss * (1.f / 128.f) + EPS) * 0.08838834764831845f;
#pragma unroll
            for (int ks = 0; ks < 4; ++ks) {
#pragma unroll
                for (int i = 0; i < 8; ++i) f[8 * ks + i] *= rs * qg[32 * ks + 8 * fq + i];
                qf[ks] = pack_bf16x8(f + 8 * ks); }
        }
        f32x4 acc[16];
#pragma unroll
        for (int kb = 0; kb < 16; ++kb) { acc[kb] = (f32x4){0.f, 0.f, 0.f, 0.f};
#pragma unroll
            for (int ks = 0; ks < 4; ++ks) { const bf16x8 kf = *(const LAS bf16x8*)(Ks + (kb * 16 + fr) * 144 + 32 * ks + 8 * fq); acc[kb] = MFMA16(kf, qf[ks], acc[kb]); } }
        float mx = -3.0e38f;
#pragma unroll
        for (int kb = 0; kb < 16; ++kb) mx = fmaxf(fmaxf(fmaxf(acc[kb][0], acc[kb][1]), fmaxf(acc[kb][2], acc[kb][3])), mx);
        mx = fmaxf(mx, __shfl_xor(mx, 16)); mx = fmaxf(mx, __shfl_xor(mx, 32));
        float lsum = 0.f;
#pragma unroll
        for (int kb = 0; kb < 16; ++kb)
#pragma unroll
            for (int e = 0; e < 4; ++e) { const float pv = __expf(acc[kb][e] - mx); acc[kb][e] = pv; lsum += pv; }
        lsum += __shfl_xor(lsum, 16); lsum += __shfl_xor(lsum, 32);
        const float inv = 1.f / lsum;
        bf16x8 pf[8];
#pragma unroll
        for (int j = 0; j < 8; ++j) { u32x4 wv; wv[0] = cvt_pk_bf16(acc[2 * j][0], acc[2 * j][1]); wv[1] = cvt_pk_bf16(acc[2 * j][2], acc[2 * j][3]); wv[2] = cvt_pk_bf16(acc[2 * j + 1][0], acc[2 * j + 1][1]); wv[3] = cvt_pk_bf16(acc[2 * j + 1][2], acc[2 * j + 1][3]); pf[j] = __builtin_bit_cast(bf16x8, wv); }
        bf16_t* op = C.o + row * NO + 1536 + h * 128 + 4 * fq;
#pragma unroll
        for (int db = 0; db < 8; ++db) {
            f32x4 o = (f32x4){0.f, 0.f, 0.f, 0.f};
#pragma unroll
            for (int j = 0; j < 8; ++j) { const bf16x8 vf = *(const LAS bf16x8*)(Vt + (db * 16 + fr) * 272 + 32 * j + 8 * fq); o = MFMA16(vf, pf[j], o); }
            *(u32x2*)(op + db * 16) = (u32x2){cvt_pk_bf16(o[0] * inv, o[1] * inv), cvt_pk_bf16(o[2] * inv, o[3] * inv)};
        }
    }
    __syncthreads();
}

__device__ __forceinline__ void swa_item_mfma(LAS unsigned char* lds, const Ctx& C, int l, int tile, int kvh) {
    const int tid = opaque_tid(), lane = tid & 63, w = __builtin_amdgcn_readfirstlane(tid >> 6), fr = lane & 15, fq = lane >> 4;
    LAS bf16_t* Ks = (LAS bf16_t*)lds;
    LAS bf16_t* Vt = Ks + 256 * 80;
    const int nb = tile & 63, row0 = tile * 128;
    {
        const int key = tid >> 1, half = tid & 1;
        const bool ok = (nb > 0) || (key >= 128);
        const size_t grow = (size_t)(ok ? row0 - 128 + key : row0);
        const u32x4* kp = (const u32x4*)(C.za + grow * NZA + 2560 + kvh * 64 + half * 32);
        const u32x4* vp = (const u32x4*)(C.za + grow * NZA + 2688 + kvh * 64 + half * 32);
        float kf[32]; float ss = 0.f;
#pragma unroll
        for (int i = 0; i < 4; ++i) { const u32x4 wv = kp[i]; UNPACK8(wv, kf, 8 * i); }
#pragma unroll
        for (int i = 0; i < 32; ++i) ss += kf[i] * kf[i];
        ss += __shfl_xor(ss, 1);
        const float rs = rsqrtf(ss * (1.f / 64.f) + EPS);
        const float* kg = C.in[I_SKG] + l * 64 + half * 32;
#pragma unroll
        for (int i = 0; i < 32; ++i) kf[i] *= rs * kg[i];
        if (half == 0) { const float pos = (float)(nb * 128 - 128 + key); ROPE16(kf, pos); }
#pragma unroll
        for (int i = 0; i < 4; ++i) *(LAS u32x4*)(Ks + key * 80 + half * 32 + 8 * i) = PACK8(kf, 8 * i);
        const int pp = vperm_pos(key);
#pragma unroll
        for (int i = 0; i < 4; ++i) { u32x4 wv = vp[i]; if (!ok) wv = (u32x4){0u, 0u, 0u, 0u};
#pragma unroll
            for (int e = 0; e < 4; ++e) { Vt[(half * 32 + 8 * i + 2 * e) * 272 + pp] = (bf16_t)(wv[e] & 0xffffu); Vt[(half * 32 + 8 * i + 2 * e + 1) * 272 + pp] = (bf16_t)(wv[e] >> 16); } }
    }
    __syncthreads();
    const int i0 = 16 * w, ws2 = w & ~1, qi = i0 + fr;
    float rc[8], rsn[8];
    { const float pos = (float)(nb * 128 + qi);
#pragma unroll
      for (int i = 0; i < 8; ++i) { const float ang = pos * ROPE_INV(i); rc[i] = cosf(ang); rsn[i] = sinf(ang); } }
    const size_t row = (size_t)(row0 + qi);
    for (int hh = 0; hh < 4; ++hh) {
        const int h = kvh * 4 + hh;
        bf16x8 qf[2];
        {
            float f[16]; const bf16_t* qp = C.za + row * NZA + 2048 + h * 64 + 8 * fq;
            { const u32x4 w0 = *(const u32x4*)qp, w1 = *(const u32x4*)(qp + 32); UNPACK8(w0, f, 0); UNPACK8(w1, f, 8); }
            float ss = 0.f;
#pragma unroll
            for (int i = 0; i < 16; ++i) ss += f[i] * f[i];
            ss += __shfl_xor(ss, 16); ss += __shfl_xor(ss, 32);
            const float rs = rsqrtf(ss * (1.f / 64.f) + EPS);
            const float* qg = C.in[I_SQG] + l * 64 + 8 * fq;
#pragma unroll
            for (int i = 0; i < 8; ++i) { f[i] *= rs * qg[i]; f[8 + i] *= rs * qg[32 + i]; }
#pragma unroll
            for (int i = 0; i < 8; ++i) { const float other = __shfl_xor(f[i], 16);
                const float r0 = f[i] * rc[i] - other * rsn[i], r1 = f[i] * rc[i] + other * rsn[i];
                f[i] = (fq == 0) ? r0 : (fq == 1) ? r1 : f[i]; }
#pragma unroll
            for (int i = 0; i < 16; ++i) f[i] *= 0.125f;
            qf[0] = pack_bf16x8(f); qf[1] = pack_bf16x8(f + 8);
        }
        f32x4 acc[10];
#pragma unroll
        for (int kk = 0; kk < 10; ++kk) { acc[kk] = (f32x4){0.f, 0.f, 0.f, 0.f};
#pragma unroll
            for (int ks = 0; ks < 2; ++ks) { const bf16x8 kf = *(const LAS bf16x8*)(Ks + ((ws2 + kk) * 16 + fr) * 80 + 32 * ks + 8 * fq); acc[kk] = MFMA16(kf, qf[ks], acc[kk]); } }
        const float sink = C.in[I_SINK][l * 8 + h];
        float mx = sink;
#pragma unroll
        for (int kk = 0; kk < 10; ++kk)
#pragma unroll
            for (int e = 0; e < 4; ++e) { const int kj = (ws2 + kk) * 16 + 4 * fq + e, dd = kj - qi; const bool valid = (dd >= 1) && (dd <= 128) && ((nb > 0) || (kj >= 128));
                const float sv = valid ? acc[kk][e] : -INFINITY; acc[kk][e] = sv; mx = fmaxf(mx, sv); }
        mx = fmaxf(mx, __shfl_xor(mx, 16)); mx = fmaxf(mx, __shfl_xor(mx, 32));
        float lsum = 0.f;
#pragma unroll
        for (int kk = 0; kk < 10; ++kk)
#pragma unroll
            for (int e = 0; e < 4; ++e) { const float pv = __expf(acc[kk][e] - mx); acc[kk][e] = pv; lsum += pv; }
        lsum += __shfl_xor(lsum, 16); lsum += __shfl_xor(lsum, 32);
        lsum += __expf(sink - mx);
        const float inv = 1.f / lsum;
        bf16x8 pf[5];
#pragma unroll
        for (int j = 0; j < 5; ++j) { u32x4 wv; wv[0] = cvt_pk_bf16(acc[2 * j][0], acc[2 * j][1]); wv[1] = cvt_pk_bf16(acc[2 * j][2], acc[2 * j][3]); wv[2] = cvt_pk_bf16(acc[2 * j + 1][0], acc[2 * j + 1][1]); wv[3] = cvt_pk_bf16(acc[2 * j + 1][2], acc[2 * j + 1][3]); pf[j] = __builtin_bit_cast(bf16x8, wv); }
        bf16_t* op = C.o + row * NO + 1024 + h * 64 + 4 * fq;
#pragma unroll
        for (int db = 0; db < 4; ++db) {
            f32x4 o = (f32x4){0.f, 0.f, 0.f, 0.f};
#pragma unroll
            for (int j = 0; j < 5; ++j) { const bf16x8 vf = *(const LAS bf16x8*)(Vt + (db * 16 + fr) * 272 + (ws2 + 2 * j) * 16 + 8 * fq); o = MFMA16(vf, pf[j], o); }
            *(u32x2*)(op + db * 16) = (u32x2){cvt_pk_bf16(o[0] * inv, o[1] * inv), cvt_pk_bf16(o[2] * inv, o[3] * inv)};
        }
    }
    __syncthreads();
}

__device__ __forceinline__ void gm_item_mfma(LAS unsigned char* lds, const Ctx& C, int l, int tile, int g) {
    const int tid = opaque_tid(), lane = tid & 63, w = __builtin_amdgcn_readfirstlane(tid >> 6), fr = lane & 15, fq = lane >> 4;
    LAS bf16_t* Wl = (LAS bf16_t*)lds;
    LAS bf16_t* vT = Wl + 128 * 144;
    LAS float* rsv = (LAS float*)(vT + 128 * 144);
    const int row0 = tile * 128;
    {
        const int tok = tid >> 2, sub = tid & 3;
        const u32x4* vp = (const u32x4*)(C.za + (size_t)(row0 + tok) * NZA + 512 + sub * 128);
        float ss = 0.f;
#pragma unroll
        for (int i = 0; i < 16; ++i) { float f[8]; const u32x4 wv = vp[i]; UNPACK8(wv, f, 0);
#pragma unroll
            for (int e = 0; e < 8; ++e) ss += f[e] * f[e]; }
        ss += __shfl_xor(ss, 1); ss += __shfl_xor(ss, 2);
        if (sub == 0) rsv[tok] = rsqrtf(ss * (1.f / 512.f) + EPS);
        const u32x4* gp = (const u32x4*)(C.za + (size_t)(row0 + tok) * NZA + 512 + g * 128 + sub * 32);
#pragma unroll
        for (int i = 0; i < 4; ++i) { const u32x4 wv = gp[i];
#pragma unroll
            for (int e = 0; e < 4; ++e) { vT[(sub * 32 + 8 * i + 2 * e) * 144 + tok] = (bf16_t)(wv[e] & 0xffffu); vT[(sub * 32 + 8 * i + 2 * e + 1) * 144 + tok] = (bf16_t)(wv[e] >> 16); } }
    }
    __syncthreads();
    {
        const int t = tid >> 2, s0 = (tid & 3) * 32;
        const f32x4* wp = (const f32x4*)(C.in[I_GMWS] + ((size_t)(l * 4 + g) * 128 + t) * 128 + s0);
#pragma unroll
        for (int i = 0; i < 4; ++i) { const f32x4 a = wp[2 * i], b2 = wp[2 * i + 1]; float f[8] = {a[0], a[1], a[2], a[3], b2[0], b2[1], b2[2], b2[3]};
#pragma unroll
            for (int e = 0; e < 8; ++e) { const int sidx = s0 + 8 * i + e; f[e] = (sidx <= t) ? f[e] * rsv[sidx] : 0.f; }
            *(LAS u32x4*)(Wl + t * 144 + s0 + 8 * i) = PACK8(f, 0); }
    }
    __syncthreads();
    {
        const int nks = (w + 2) >> 1;
        f32x4 acc[8];
#pragma unroll
        for (int cb = 0; cb < 8; ++cb) acc[cb] = (f32x4){0.f, 0.f, 0.f, 0.f};
        for (int ks = 0; ks < nks; ++ks) {
            const bf16x8 wf = *(const LAS bf16x8*)(Wl + (16 * w + fr) * 144 + 32 * ks + 8 * fq);
#pragma unroll
            for (int cb = 0; cb < 8; ++cb) { const bf16x8 vf = *(const LAS bf16x8*)(vT + (cb * 16 + fr) * 144 + 32 * ks + 8 * fq); acc[cb] = MFMA16(wf, vf, acc[cb]); }
        }
        const float* bs = C.in[I_GMBS] + (size_t)(l * 4 + g) * 128 + 16 * w + 4 * fq;
        const float* vg = C.in[I_GMVG] + l * 512 + g * 128;
#pragma unroll
        for (int cb = 0; cb < 8; ++cb) { const int c = cb * 16 + fr; const float gn = vg[c];
#pragma unroll
            for (int e = 0; e < 4; ++e) { const size_t r = (size_t)(row0 + 16 * w + 4 * fq + e);
                const float u = bf2f(C.za[r * NZA + g * 128 + c]);
                C.o[r * NO + g * 128 + c] = (bf16_t)f2bf(u * (gn * acc[cb][e] + bs[e])); } }
    }
    __syncthreads();
}

__device__ __forceinline__ void lru_item_mfma(LAS unsigned char* lds, const Ctx& C, int l, int tile, int hb) {
    const int tid = opaque_tid(), lane = tid & 63, w = __builtin_amdgcn_readfirstlane(tid >> 6), fr = lane & 15, fq = lane >> 4;
    LAS bf16_t* xcb = (LAS bf16_t*)lds;
    LAS bf16_t* wrT = xcb + 128 * 80;
    LAS bf16_t* wiT = wrT + 64 * 80;
    LAS float* xcf = (LAS float*)(lds + 40960);
    LAS float* aa = xcf + 8192;
    LAS float* bb = aa + 8192;
    LAS float* segA = bb + 8192;
    LAS float* segH = segA + 512;
    const int nb = tile & 63, row0 = tile * 128;
    {
        const int t = tid >> 2, c0 = (tid & 3) * 16, ch = hb * 64 + c0;
        float acc[16];
#pragma unroll
        for (int i = 0; i < 16; ++i) acc[i] = C.in[I_CONVB][l * 512 + ch + i];
#pragma unroll
        for (int k = 0; k < 4; ++k) {
            const int tt = t - 3 + k;
            if (nb * 128 + tt >= 0) {
                const u32x4* xp = (const u32x4*)(C.za + (size_t)(row0 + tt) * NZA + 1024 + ch);
                float f[16]; const u32x4 w0 = xp[0], w1 = xp[1]; UNPACK8(w0, f, 0); UNPACK8(w1, f, 8);
                const float* cw = C.in[I_CONVW] + (size_t)(l * 4 + k) * 512 + ch;
#pragma unroll
                for (int i = 0; i < 16; ++i) acc[i] += cw[i] * f[i];
            }
        }
#pragma unroll
        for (int i = 0; i < 4; ++i) *(LAS f32x4*)(xcf + t * 64 + c0 + 4 * i) = (f32x4){acc[4 * i], acc[4 * i + 1], acc[4 * i + 2], acc[4 * i + 3]};
        *(LAS u32x4*)(xcb + t * 80 + c0) = PACK8(acc, 0); *(LAS u32x4*)(xcb + t * 80 + c0 + 8) = PACK8(acc, 8);
        const int wi_ = tid >> 3, j0 = (tid & 7) * 8;
        const f32x4* wrp = (const f32x4*)(C.in[I_WR] + (size_t)(l * 8 + hb) * 4096 + wi_ * 64 + j0); const f32x4* wip = (const f32x4*)(C.in[I_WI] + (size_t)(l * 8 + hb) * 4096 + wi_ * 64 + j0);
        const f32x4 r0 = wrp[0], r1 = wrp[1], q0 = wip[0], q1 = wip[1];
#pragma unroll
        for (int e = 0; e < 4; ++e) { wrT[(j0 + e) * 80 + wi_] = (bf16_t)f2bf(r0[e]); wrT[(j0 + 4 + e) * 80 + wi_] = (bf16_t)f2bf(r1[e]); wiT[(j0 + e) * 80 + wi_] = (bf16_t)f2bf(q0[e]); wiT[(j0 + 4 + e) * 80 + wi_] = (bf16_t)f2bf(q1[e]); }
    }
    __syncthreads();
    {
        bf16x8 xf[2];
#pragma unroll
        for (int ks = 0; ks < 2; ++ks) xf[ks] = *(const LAS bf16x8*)(xcb + (16 * w + fr) * 80 + 32 * ks + 8 * fq);
#pragma unroll
        for (int jb = 0; jb < 4; ++jb) {
            f32x4 ar = (f32x4){0.f, 0.f, 0.f, 0.f}, ai = (f32x4){0.f, 0.f, 0.f, 0.f};
#pragma unroll
            for (int ks = 0; ks < 2; ++ks) { const bf16x8 wf = *(const LAS bf16x8*)(wrT + (jb * 16 + fr) * 80 + 32 * ks + 8 * fq); ar = MFMA16(xf[ks], wf, ar);
                const bf16x8 wf2 = *(const LAS bf16x8*)(wiT + (jb * 16 + fr) * 80 + 32 * ks + 8 * fq); ai = MFMA16(xf[ks], wf2, ai); }
            const int j = jb * 16 + fr, chj = l * 512 + hb * 64 + j;
            const float br = C.in[I_BR][chj], bi = C.in[I_BI][chj], sp = log1pf(expf(-C.in[I_LAM][chj]));
#pragma unroll
            for (int e = 0; e < 4; ++e) { const int t = 16 * w + 4 * fq + e;
                const float r = sigmoid_f(ar[e] + br), ig = sigmoid_f(ai[e] + bi);
                const float loga = -8.f * r * sp; const float a = expf(loga); const float mult = sqrtf(-expm1f(2.f * loga));
                aa[t * 64 + j] = a; bb[t * 64 + j] = xcf[t * 64 + j] * ig * mult; }
        }
    }
    __syncthreads();
    const int j = tid & 63, sg = tid >> 6;
    {
        float hh = 0.f, P = 1.f;
#pragma unroll 4
        for (int k = 0; k < 16; ++k) { const int t = sg * 16 + k; const float a = aa[t * 64 + j]; hh = a * hh + bb[t * 64 + j]; P *= a; aa[t * 64 + j] = P; bb[t * 64 + j] = hh; }
        segA[sg * 64 + j] = P; segH[sg * 64 + j] = hh;
    }
    __syncthreads();
    {
        float Hc = 0.f, Pc = 1.f;
        for (int s2 = 0; s2 < sg; ++s2) { const float a = segA[s2 * 64 + j]; Hc = a * Hc + segH[s2 * 64 + j]; Pc *= a; }
        const int chj = hb * 64 + j;
        float hl = 0.f, pl = 1.f;
#pragma unroll 4
        for (int k = 0; k < 16; ++k) { const int t = sg * 16 + k; hl = bb[t * 64 + j] + aa[t * 64 + j] * Hc; pl = aa[t * 64 + j] * Pc;
            const float G = bf2f(C.za[(size_t)(row0 + t) * NZA + 1536 + chj]);
            C.ly[(size_t)(row0 + t) * 512 + chj] = G * hl; C.lp[(size_t)(row0 + t) * 512 + chj] = G * pl; }
        if (sg == 7) { C.carryA[(size_t)tile * 512 + chj] = pl; C.carryH[(size_t)tile * 512 + chj] = hl; }
    }
    __syncthreads();
}

__device__ __forceinline__ void fix_item(const Ctx& C, int tile, int half) {
    const int c = opaque_tid(), b = tile >> 6, nb = tile & 63, row0 = tile * 128 + half * 64;
    float H = 0.f;
    for (int jn = 0; jn < nb; ++jn) { const size_t idx = (size_t)(b * 64 + jn) * 512 + c; H = C.carryA[idx] * H + C.carryH[idx]; }
    for (int t = 0; t < 64; ++t) { const size_t r = (size_t)(row0 + t); C.o[r * NO + 512 + c] = (bf16_t)f2bf(C.ly[r * 512 + c] + C.lp[r * 512 + c] * H); }
}

__global__ void __launch_bounds__(512, 2) fwd_megakernel(Args args) {
    extern __shared__ __attribute__((aligned(16))) unsigned char lds_raw[];
    LAS unsigned char* lds = (LAS unsigned char*)lds_raw;
    volatile LAS unsigned* MISC = (volatile LAS unsigned*)(lds + MISC_OFF);
    const int tid = threadIdx.x, lane = tid & 63, wave = __builtin_amdgcn_readfirstlane(tid >> 6);
    const int G = gridDim.x, bx = blockIdx.x;
    unsigned char* ws = args.ws;
    Ctx C;
    C.in = args.in; C.x = args.out;
    C.wt_in = (bf16_t*)(ws + WS_WIN); C.wt_br = (bf16_t*)(ws + WS_WBR); C.wt_out = (bf16_t*)(ws + WS_WOUT); C.wt_ff1 = (bf16_t*)(ws + WS_WFF1); C.wt_ff2 = (bf16_t*)(ws + WS_WFF2); C.wt_kv = (bf16_t*)(ws + WS_WKV);
    C.memn = (bf16_t*)(ws + WS_MEMN); C.memkv = (bf16_t*)(ws + WS_MEMKV); C.xb = (bf16_t*)(ws + WS_XB); C.za = (bf16_t*)(ws + WS_ZA); C.zg = (bf16_t*)(ws + WS_ZG); C.mb = (bf16_t*)(ws + WS_MB); C.o = (bf16_t*)(ws + WS_O);
    C.ssq = (float*)(ws + WS_SSQ); C.carryA = (float*)(ws + WS_CARRY); C.carryH = C.carryA + 128 * 512; C.S = (float*)(ws + WS_S); C.ly = (float*)(ws + WS_LY); C.lp = (float*)(ws + WS_LP); C.memK = (bf16_t*)(ws + WS_MEMK); C.memVt = (bf16_t*)(ws + WS_MEMVT);

    if (tid < 64) MISC[tid] = 0u;
    __syncthreads();
    XcdBarrier bar = xcd_barrier_post((unsigned*)(ws + WS_CTL), MISC + 8);
    const int gw = bx * 8 + wave, NGW = G * 8;
    LAS float* scr = (LAS float*)(lds + wave * 16384);

    for (int it = gw; it < IT_WIN + 4 * IT_WKV; it += NGW) {
        if (it < IT_WIN) conv_w(C, 0, 0, it, scr, lane);
        else { const int r = it - IT_WIN; conv_w(C, 5, r / IT_WKV, r % IT_WKV, scr, lane); }
    }
    for (int m = gw; m < M + 512; m += NGW) {
        if (m < M) {
            const f32x4* xr = (const f32x4*)(C.in[I_X] + (size_t)m * D) + lane; f32x4 v[4]; float s = 0.f;
#pragma unroll
            for (int jj = 0; jj < 4; ++jj) { v[jj] = xr[64 * jj]; s += (v[jj].x * v[jj].x + v[jj].y * v[jj].y) + (v[jj].z * v[jj].z + v[jj].w * v[jj].w); }
            s = wave_sum(s);
            f32x4* xo = (f32x4*)(C.x + (size_t)m * D) + lane; u32x2* bo = (u32x2*)(C.xb + (size_t)m * D) + lane;
#pragma unroll
            for (int jj = 0; jj < 4; ++jj) { xo[64 * jj] = v[jj]; bo[64 * jj] = (u32x2){pk2(v[jj].x, v[jj].y), pk2(v[jj].z, v[jj].w)}; }
            if (lane < 16) C.ssq[(size_t)m * 16 + lane] = (lane == 0) ? s : 0.f;
        } else {
            const int r = m - M;
            const f32x4* xr = (const f32x4*)(C.in[I_MEM] + (size_t)r * D) + lane; f32x4 v[4]; float s = 0.f;
#pragma unroll
            for (int jj = 0; jj < 4; ++jj) { v[jj] = xr[64 * jj]; s += (v[jj].x * v[jj].x + v[jj].y * v[jj].y) + (v[jj].z * v[jj].z + v[jj].w * v[jj].w); }
            s = wave_sum(s); const float rs = rsqrtf(s * (1.f / 1024.f) + EPS);
            u32x2* bo = (u32x2*)(C.memn + (size_t)r * D) + lane;
#pragma unroll
            for (int jj = 0; jj < 4; ++jj) bo[64 * jj] = (u32x2){pk2(v[jj].x * rs, v[jj].y * rs), pk2(v[jj].z * rs, v[jj].w * rs)};
        }
    }
    __syncthreads();
    cg::this_grid().sync();
    xcd_barrier(bar);

    {
#ifndef SKIP_KV
        pg8::Gemm g{C.memn, C.wt_kv}; pg8::SchedKV S{bx}; pg8::EpiKV E{C.memkv};
        pg8::gemm_phase<pg8::EpiKV, pg8::SchedKV, true, D, D, D>(lds, g, S, E);
#endif

    }
    xcd_barrier(bar);
    kvprep_phase(C, gw, NGW, lane);

    for (int l = 0; l < DEPTH; ++l) {
        {
#ifndef SKIP_G1
            pg8::Gemm g{C.xb, C.wt_in}; pg8::SchedStd S; S.init(M, DIN, G, bx, D, D);
            pg8::EpiZ E{C.za, C.zg, C.ssq, C.in[I_BGATE] + (size_t)l * 4 * D};
            pg8::gemm_phase<pg8::EpiZ, pg8::SchedStd, true, D, D, D>(lds, g, S, E);
#endif

        }
        xcd_barrier(bar);
        {
#if USE_MFMA_SWA
            for (int it = bx; it < 256; it += G) swa_item_mfma(lds, C, l, it >> 1, it & 1);
#else
            for (int it = bx; it < 1024; it += G) swa_item(lds, C, l, it >> 3, it & 7);
#endif
#if USE_MFMA_XA
            for (int it = bx; it < 256; it += G) xa_pair_mfma(lds, C, l, it);
#else
            for (int it = bx; it < 512; it += G) xa_item(lds, C, l, it >> 2, it & 3);
#endif
#if USE_MFMA_GM
            for (int it = bx; it < 512; it += G) gm_item_mfma(lds, C, l, it >> 2, it & 3);
#else
            for (int it = bx; it < 512; it += G) gm_item(lds, C, l, it >> 2, it & 3);
#endif
#if USE_MFMA_LRU
            for (int it = bx; it < 1024; it += G) lru_item_mfma(lds, C, l, it >> 3, it & 7);
#else
            for (int it = bx; it < 1024; it += G) lru_item(lds, C, l, it >> 3, it & 7);
#endif
            const int lane_c = opaque_tid() & 63;
            const int NC = IT_WBR + IT_WOUT + IT_WFF1 + IT_WFF2 + (l + 1 < DEPTH ? IT_WIN : 0);
            for (int it = gw; it < NC; it += NGW) {
                int r = it;
                if (r < IT_WBR) { conv_w(C, 1, l, r, scr, lane_c); continue; } r -= IT_WBR;
                if (r < IT_WOUT) { conv_w(C, 2, l, r, scr, lane_c); continue; } r -= IT_WOUT;
                if (r < IT_WFF1) { conv_w(C, 3, l, r, scr, lane_c); continue; } r -= IT_WFF1;
                if (r < IT_WFF2) { conv_w(C, 4, l, r, scr, lane_c); continue; } r -= IT_WFF2;
                conv_w(C, 0, l + 1, r, scr, lane_c);
            }
            __syncthreads();
        }
        xcd_barrier(bar);
        for (int it = bx; it < 256; it += G) fix_item(C, it >> 1, it & 1);
        xcd_barrier(bar);
        {
#ifndef SKIP_G2
            pg8::Gemm g{C.o, C.wt_br}; pg8::SchedMerge S; S.t.init(M, D, G, bx, NO, NO);
            pg8::EpiMerge E{C.zg, C.S, C.mb};
            pg8::gemm_phase<pg8::EpiMerge, pg8::SchedMerge, true, NO, NO, 512>(lds, g, S, E);
#endif

        }
        xcd_barrier(bar);
        {
#ifndef SKIP_G3
            pg8::Gemm g{C.mb, C.wt_out}; pg8::SchedStd S; S.init(M, D, G, bx, D, D);
            pg8::EpiRes E{C.x, C.xb, C.ssq};
            pg8::gemm_phase<pg8::EpiRes, pg8::SchedStd, true, D, D, D>(lds, g, S, E);
#endif

        }
        xcd_barrier(bar);
        {
#ifndef SKIP_G4
            pg8::Gemm g{C.xb, C.wt_ff1}; pg8::SchedStd S; S.init(M, FF, G, bx, D, D);
            pg8::EpiFF1 E{C.zg, C.ssq};
            pg8::gemm_phase<pg8::EpiFF1, pg8::SchedStd, true, D, D, D>(lds, g, S, E);
#endif

        }
        xcd_barrier(bar);
        {
#ifndef SKIP_G5
            pg8::Gemm g{C.zg, C.wt_ff2}; pg8::SchedStd S; S.init(M, D, G, bx, FF, FF);
            pg8::EpiRes E{C.x, C.xb, C.ssq};
            pg8::gemm_phase<pg8::EpiRes, pg8::SchedStd, true, FF, FF, FF>(lds, g, S, E);
#endif

        }
        if (l + 1 < DEPTH) xcd_barrier(bar);
    }
}

extern "C" void kernel_launch(void* const* d_in, const int* in_sizes, int n_in, void* d_out, int out_size, void* d_ws, size_t ws_size, hipStream_t stream) {
    static int grid = 0;
    if (grid == 0) {
        if (n_in != 27 || out_size != M * D || ws_size < WS_END) { fprintf(stderr, "kernel_launch: unexpected shapes: n_in %d out %d ws %zu (need %zu)\n", n_in, out_size, ws_size, (size_t)WS_END); grid = -1; return; }
        int dev = 0, cus = 0, per_cu = 0;
        hipGetDevice(&dev); hipDeviceGetAttribute(&cus, hipDeviceAttributeMultiprocessorCount, dev);
        if (hipFuncSetAttribute((const void*)fwd_megakernel, hipFuncAttributeMaxDynamicSharedMemorySize, LDS_BYTES) != hipSuccess) { fprintf(stderr, "kernel_launch: hipFuncSetAttribute failed\n"); grid = -1; return; }
        if (hipOccupancyMaxActiveBlocksPerMultiprocessor(&per_cu, (const void*)fwd_megakernel, 512, LDS_BYTES) != hipSuccess || per_cu < 1) { fprintf(stderr, "kernel_launch: occupancy query says %d\n", per_cu); per_cu = 1; }
        (void)hipGetLastError();
        grid = cus;
        if (grid != 256) fprintf(stderr, "kernel_launch: note: %d CUs\n", grid);
    }
    if (grid < 0) return;
    hipMemsetAsync((char*)d_ws + WS_CTL, 0, CTL_ZERO_BYTES, stream);
    Args a{};
    for (int i = 0; i < 27; ++i) a.in[i] = (const float*)d_in[i];
    a.out = (float*)d_out; a.ws = (unsigned char*)d_ws;
    void* kargs[] = {&a};
    hipError_t e = hipLaunchCooperativeKernel((const void*)fwd_megakernel, dim3(grid), dim3(512), kargs, LDS_BYTES, stream);
    if (e != hipSuccess) fprintf(stderr, "kernel_launch: cooperative launch failed: %s\n", hipGetErrorString(e));
}
```

```cpp
#include <hip/hip_runtime.h>
#include <hip/hip_cooperative_groups.h>
#include <cstdio>
#include <cstdint>
namespace cg = cooperative_groups;

#define LAS __attribute__((address_space(3)))
#define GAS __attribute__((address_space(1)))
typedef unsigned short bf16_t;
typedef short bf16x8 __attribute__((ext_vector_type(8)));
typedef float f32x4 __attribute__((ext_vector_type(4)));
typedef unsigned u32x4 __attribute__((ext_vector_type(4)));
typedef unsigned u32x2 __attribute__((ext_vector_type(2)));

constexpr int M = 16384, D = 1024, DIN = 7424, NZA = 3328, NZG = 4096, FF = 4096, DEPTH = 4, NO = 2048;
constexpr float EPS = 1e-6f;
constexpr size_t MiB = 1u << 20;
constexpr size_t WS_CTL = 0, CTL_ZERO_BYTES = 64 * 1024;
constexpr size_t WS_WIN = 2 * MiB, WS_WBR = 17 * MiB, WS_WOUT = 21 * MiB, WS_WFF1 = 23 * MiB, WS_WFF2 = 31 * MiB, WS_WKV = 39 * MiB;
constexpr size_t WS_MEMN = 47 * MiB, WS_MEMKV = 48 * MiB, WS_SSQ = 52 * MiB, WS_CARRY = 53 * MiB, WS_XB = 54 * MiB;
constexpr size_t WS_ZA = 86 * MiB, WS_S = 86 * MiB, WS_MB = 150 * MiB, WS_ZG = 190 * MiB, WS_O = 318 * MiB, WS_LY = 382 * MiB, WS_LP = 414 * MiB, WS_MEMK = 446 * MiB, WS_MEMVT = 448 * MiB, WS_SPL = 450 * MiB, WS_END = 451 * MiB;
static_assert(WS_ZA + (size_t)M * NZA * 2 <= WS_ZG && WS_MB + (size_t)M * D * 2 <= WS_ZG && WS_WIN + (size_t)DIN * D * 2 <= WS_WBR, "ws map");

constexpr int LDS_BYTES = 147456, MISC_OFF = LDS_BYTES - 256;

__device__ __forceinline__ float bf2f(bf16_t h) { return __uint_as_float((unsigned)h << 16); }
__device__ __forceinline__ unsigned f2bf(float f) { unsigned u = __float_as_uint(f); return (u + 0x7fffu + ((u >> 16) & 1u)) >> 16; }
__device__ __forceinline__ unsigned pk2(float lo, float hi) { return f2bf(lo) | (f2bf(hi) << 16); }
__device__ __forceinline__ unsigned cvt_pk_bf16(float lo, float hi) { unsigned r; asm volatile("v_cvt_pk_bf16_f32 %0, %1, %2" : "=v"(r) : "v"(lo), "v"(hi)); return r; }
#define UNPACK8(VV, f, o) do { (f)[(o) + 0] = __uint_as_float((VV)[0] << 16); (f)[(o) + 1] = __uint_as_float((VV)[0] & 0xffff0000u); (f)[(o) + 2] = __uint_as_float((VV)[1] << 16); (f)[(o) + 3] = __uint_as_float((VV)[1] & 0xffff0000u); \
    (f)[(o) + 4] = __uint_as_float((VV)[2] << 16); (f)[(o) + 5] = __uint_as_float((VV)[2] & 0xffff0000u); (f)[(o) + 6] = __uint_as_float((VV)[3] << 16); (f)[(o) + 7] = __uint_as_float((VV)[3] & 0xffff0000u); } while (0)
#define PACK8(f, o) ((u32x4){pk2((f)[(o) + 0], (f)[(o) + 1]), pk2((f)[(o) + 2], (f)[(o) + 3]), pk2((f)[(o) + 4], (f)[(o) + 5]), pk2((f)[(o) + 6], (f)[(o) + 7])})
__device__ __forceinline__ float gelu_t(float x) { const float u = 0.7978845608028654f * (x + 0.044715f * x * x * x); return x * __builtin_amdgcn_rcpf(1.f + __expf(-2.f * u)); }
__device__ __forceinline__ float sigmoid_f(float x) { return __builtin_amdgcn_rcpf(1.f + __expf(-x)); }
__device__ __forceinline__ float row_rstd(const float* ssq, int row) {
    const f32x4* p = (const f32x4*)(ssq + (size_t)row * 16);
    const f32x4 a = p[0], b = p[1], c = p[2], d = p[3];
    const float s = (((a.x + a.y) + (a.z + a.w)) + ((b.x + b.y) + (b.z + b.w))) + (((c.x + c.y) + (c.z + c.w)) + ((d.x + d.y) + (d.z + d.w)));
    return rsqrtf(s * (1.f / 1024.f) + EPS);
}
#define LDS_WAIT() asm volatile("s_waitcnt lgkmcnt(0)" ::: "memory")
__device__ __forceinline__ int opaque_tid() { int t = threadIdx.x; asm volatile("" : "+v"(t)); return t; }

namespace pg8 {
constexpr int BM = 256, BK = 64, HALF = 128, HTB = HALF * BK * 2, STAGE_BYTES = 8 * HTB, NXCD = 8, WGM = 8;
__host__ __device__ __forceinline__ int lds_byte(int r, int c) { const int st = (r >> 4) * 2 + (c >> 5), rr = r & 15, cc = c & 31, ob = rr * 64 + cc * 2; return st * 1024 + (ob ^ (((ob >> 9) & 1) << 5)); }
__host__ __device__ __forceinline__ void stage_rc(int b, int& R, int& C) { const int st = b / 1024, sb = b % 1024, swz = sb ^ (((sb >> 9) & 1) << 5); R = (st >> 1) * 16 + swz / 64; C = (st & 1) * 32 + (swz % 64) / 2; }
__host__ __device__ __forceinline__ int perm32(int rho) { const int n = rho >> 4, i = rho & 15; return 8 * (i >> 2) + 4 * n + (i & 3); }

struct Unit { int pm, pn, b; };
struct Gemm { const bf16_t* A; const bf16_t* Bt; };

struct SchedStd {
    int nM, nN, nwg, G, c; size_t as, bs;
    __device__ void init(int M_, int N_, int G_, int c_, int lda, int ldb) { nM = M_ / BM; nN = N_ / BM; nwg = nM * nN; G = G_; c = c_; as = (size_t)BM * lda * 2; bs = (size_t)BM * ldb * 2; }
    __device__ bool tile(long L, Unit& u) const {
        if (L >= nwg) return false;
        int wgid = (int)L; { const int q = nwg / NXCD, r = nwg % NXCD, xcd = wgid % NXCD, off = wgid / NXCD; wgid = (xcd < r ? xcd * (q + 1) : r * (q + 1) + (xcd - r) * q) + off; }
        const int nig = WGM * nN, gid = wgid / nig, fm = gid * WGM, gsz = (nM - fm) < WGM ? (nM - fm) : WGM;
        u.pm = fm + ((wgid % nig) % gsz); u.pn = (wgid % nig) / gsz; u.b = 0; return true;
    }
    __device__ bool next(int i, Unit& u) const { return tile((long)i * G + c, u); }
    __device__ size_t aoff(const Unit& u) const { return (size_t)u.pm * as; }
    __device__ size_t boff(const Unit& u) const { return (size_t)u.pn * bs; }
};
struct SchedMerge {
    SchedStd t;
    __device__ bool next(int i, Unit& u) const { if (!t.tile((long)(i >> 2) * t.G + t.c, u)) return false; u.b = i & 3; return true; }
    __device__ size_t aoff(const Unit& u) const { return (size_t)u.pm * t.as + (size_t)u.b * 1024; }
    __device__ size_t boff(const Unit& u) const { return (size_t)u.pn * t.bs + (size_t)u.b * 1024; }
};
struct SchedKV {
    int c;
    __device__ bool next(int i, Unit& u) const { if (i > 0 || c >= 32) return false; u.b = c >> 3; u.pm = (c & 7) >> 2; u.pn = c & 3; return true; }
    __device__ size_t aoff(const Unit& u) const { return (size_t)u.pm * 256 * 1024 * 2; }
    __device__ size_t boff(const Unit& u) const { return ((size_t)u.b * 1024 + (size_t)u.pn * 256) * 1024 * 2; }
};

struct EpiZ {
    static constexpr bool PERM = true, KEEPS = false;
    bf16_t* za; bf16_t* zg; const float* ssq; const float* bgate;
    __device__ __forceinline__ void operator()(const f32x4 (&acc)[2][2][4][2], const Unit& u, int wr, int wc, int fr, int fq) const {
        const int row0 = u.pm * BM + wr * 64 + fr, pn = u.pn;
        bf16_t* base; int ldc, colt, mode;
        if (pn < 13) { base = za; ldc = NZA; colt = pn * 256; mode = (pn < 4 || pn == 6 || pn == 7) ? 1 : 0; }
        else { base = zg; ldc = NZG; colt = (pn - 13) * 256; mode = 2; }
        const int col0 = colt + wc * 32 + 8 * fq;
        f32x4 bv[2][2];
#pragma unroll
        for (int bj = 0; bj < 2; ++bj)
#pragma unroll
            for (int n = 0; n < 2; ++n) bv[bj][n] = (mode == 2) ? *(const f32x4*)(bgate + col0 + bj * HALF + 4 * n) : (f32x4){0.f, 0.f, 0.f, 0.f};
#pragma unroll
        for (int ai = 0; ai < 2; ++ai)
#pragma unroll
            for (int m = 0; m < 4; ++m) {
                const int row = row0 + ai * HALF + m * 16; const float rs = row_rstd(ssq, row);
                bf16_t* rowp = base + (size_t)row * ldc + col0;
#pragma unroll
                for (int bj = 0; bj < 2; ++bj) {
                    f32x4 v0 = acc[ai][bj][m][0] * rs, v1 = acc[ai][bj][m][1] * rs;
                    if (mode == 1) {
#pragma unroll
                        for (int e = 0; e < 4; ++e) { v0[e] = gelu_t(v0[e]); v1[e] = gelu_t(v1[e]); }
                    } else if (mode == 2) {
                        v0 = v0 + bv[bj][0]; v1 = v1 + bv[bj][1];
#pragma unroll
                        for (int e = 0; e < 4; ++e) { v0[e] = sigmoid_f(v0[e]); v1[e] = sigmoid_f(v1[e]); }
                    }
                    u32x4 w; w.x = cvt_pk_bf16(v0[0], v0[1]); w.y = cvt_pk_bf16(v0[2], v0[3]); w.z = cvt_pk_bf16(v1[0], v1[1]); w.w = cvt_pk_bf16(v1[2], v1[3]);
                    *(u32x4*)(rowp + bj * HALF) = w;
                }
                asm volatile("" ::: "memory");
            }
    }
};
struct EpiFF1 {
    static constexpr bool PERM = true, KEEPS = false;
    bf16_t* f; const float* ssq;
    __device__ __forceinline__ void operator()(const f32x4 (&acc)[2][2][4][2], const Unit& u, int wr, int wc, int fr, int fq) const {
        const int row0 = u.pm * BM + wr * 64 + fr, col0 = u.pn * BM + wc * 32 + 8 * fq;
#pragma unroll
        for (int ai = 0; ai < 2; ++ai)
#pragma unroll
            for (int m = 0; m < 4; ++m) {
                const int row = row0 + ai * HALF + m * 16; const float rs = row_rstd(ssq, row);
                bf16_t* rowp = f + (size_t)row * FF + col0;
#pragma unroll
                for (int bj = 0; bj < 2; ++bj) {
                    f32x4 v0 = acc[ai][bj][m][0] * rs, v1 = acc[ai][bj][m][1] * rs;
#pragma unroll
                    for (int e = 0; e < 4; ++e) { const float a = fmaxf(v0[e], 0.f), b = fmaxf(v1[e], 0.f); v0[e] = a * a; v1[e] = b * b; }
                    u32x4 w; w.x = cvt_pk_bf16(v0[0], v0[1]); w.y = cvt_pk_bf16(v0[2], v0[3]); w.z = cvt_pk_bf16(v1[0], v1[1]); w.w = cvt_pk_bf16(v1[2], v1[3]);
                    *(u32x4*)(rowp + bj * HALF) = w;
                }
                asm volatile("" ::: "memory");
            }
    }
};
struct EpiRes {
    static constexpr bool PERM = true, KEEPS = false;
    float* x; bf16_t* xb; float* ssq;
    __device__ __forceinline__ void operator()(const f32x4 (&acc)[2][2][4][2], const Unit& u, int wr, int wc, int fr, int fq) const {
        const int row0 = u.pm * BM + wr * 64 + fr, col0 = u.pn * BM + wc * 32 + 8 * fq;
#pragma unroll
        for (int ai = 0; ai < 2; ++ai)
#pragma unroll
            for (int m = 0; m < 4; ++m) {
                const int row = row0 + ai * HALF + m * 16; float ss = 0.f;
#pragma unroll
                for (int bj = 0; bj < 2; ++bj) {
                    float* xp = x + (size_t)row * D + col0 + bj * HALF;
                    const f32x4 v0 = *(const f32x4*)xp + acc[ai][bj][m][0], v1 = *(const f32x4*)(xp + 4) + acc[ai][bj][m][1];
                    *(f32x4*)xp = v0; *(f32x4*)(xp + 4) = v1;
                    ss += (v0[0] * v0[0] + v0[1] * v0[1]) + (v0[2] * v0[2] + v0[3] * v0[3]) + (v1[0] * v1[0] + v1[1] * v1[1]) + (v1[2] * v1[2] + v1[3] * v1[3]);
                    u32x4 w; w.x = cvt_pk_bf16(v0[0], v0[1]); w.y = cvt_pk_bf16(v0[2], v0[3]); w.z = cvt_pk_bf16(v1[0], v1[1]); w.w = cvt_pk_bf16(v1[2], v1[3]);
                    *(u32x4*)(xb + (size_t)row * D + col0 + bj * HALF) = w;
                }
                ss += __shfl_xor(ss, 16); ss += __shfl_xor(ss, 32);
                if (fq == 0) ssq[(size_t)row * 16 + u.pn * 4 + wc] = ss;
                asm volatile("" ::: "memory");
            }
    }
};
struct EpiMerge {
    static constexpr bool PERM = true, KEEPS = true;
    const bf16_t* zg; bf16_t* mb;
    __device__ __forceinline__ bool merge(f32x4 (&acc)[2][2][4][2], const Unit& u, int wr, int wc, int fr, int fq) const {
        const int row0 = u.pm * BM + wr * 64 + fr, col0 = u.pn * BM + wc * 32 + 8 * fq, b = u.b;
#pragma unroll
        for (int ai = 0; ai < 2; ++ai)
#pragma unroll
            for (int m = 0; m < 4; ++m) {
                const int row = row0 + ai * HALF + m * 16;
#pragma unroll
                for (int bj = 0; bj < 2; ++bj) {
                    const int col = col0 + bj * HALF;
                    const u32x4 gw = *(const u32x4*)(zg + (size_t)row * NZG + b * 1024 + col);
                    float g[8]; UNPACK8(gw, g, 0);
#pragma unroll
                    for (int e = 0; e < 8; ++e) g[e] = fmaxf(g[e], 1e-20f);
                    if (b < 3) {
                        const u32x4 gn = *(const u32x4*)(zg + (size_t)row * NZG + (b + 1) * 1024 + col);
                        float h[8]; UNPACK8(gn, h, 0);
#pragma unroll
                        for (int e = 0; e < 8; ++e) g[e] *= __builtin_amdgcn_rcpf(fmaxf(h[e], 1e-20f));
                    }
#pragma unroll
                    for (int e = 0; e < 4; ++e) { acc[ai][bj][m][0][e] *= g[e]; acc[ai][bj][m][1][e] *= g[4 + e]; }
                    if (b == 3) { const f32x4 v0 = acc[ai][bj][m][0], v1 = acc[ai][bj][m][1];
                        u32x4 w; w.x = cvt_pk_bf16(v0[0], v0[1]); w.y = cvt_pk_bf16(v0[2], v0[3]); w.z = cvt_pk_bf16(v1[0], v1[1]); w.w = cvt_pk_bf16(v1[2], v1[3]);
                        *(u32x4*)(mb + (size_t)row * D + col) = w; }
                }
                asm volatile("" ::: "memory");
            }
        return b < 3;
    }
};
struct EpiKV {
    static constexpr bool PERM = true, KEEPS = false;
    bf16_t* out;
    __device__ __forceinline__ void operator()(const f32x4 (&acc)[2][2][4][2], const Unit& u, int wr, int wc, int fr, int fq) const {
        const int row0 = u.pm * BM + wr * 64 + fr, col0 = u.pn * BM + wc * 32 + 8 * fq;
        bf16_t* base = out + (size_t)u.b * 512 * 1024;
#pragma unroll
        for (int ai = 0; ai < 2; ++ai)
#pragma unroll
            for (int m = 0; m < 4; ++m) {
                const int row = row0 + ai * HALF + m * 16;
#pragma unroll
                for (int bj = 0; bj < 2; ++bj) {
                    const f32x4 v0 = acc[ai][bj][m][0], v1 = acc[ai][bj][m][1];
                    u32x4 w; w.x = cvt_pk_bf16(v0[0], v0[1]); w.y = cvt_pk_bf16(v0[2], v0[3]); w.z = cvt_pk_bf16(v1[0], v1[1]); w.w = cvt_pk_bf16(v1[2], v1[3]);
                    *(u32x4*)(base + (size_t)row * 1024 + col0 + bj * HALF) = w;
                }
            }
    }
};

template <class Epi, class Sched, bool ALIGN_EPI, int LDA, int LDB, int KK>
__device__ __forceinline__ void gemm_phase(LAS unsigned char* lds, const Gemm g, const Sched& S, const Epi& E) {
    const int tid = opaque_tid(), wid = __builtin_amdgcn_readfirstlane(tid >> 6), lane = tid & 63, wr = wid >> 2, wc = wid & 3, fr = lane & 15, fq = lane >> 4;
    constexpr int nt = KK / BK;
    unsigned voffA[2], voffB[2];
#pragma unroll
    for (int i = 0; i < 2; ++i) { int R, C; stage_rc(tid * 16 + i * 8192, R, C); const int Rb = Epi::PERM ? ((R & ~31) + perm32(R & 31)) : R;
        voffA[i] = (unsigned)(R * LDA + C) * 2u; voffB[i] = (unsigned)(Rb * LDB + C) * 2u; }
    constexpr size_t kstep = (size_t)(BK * 2);
    constexpr size_t hstepA = (size_t)HALF * LDA * 2, hstepB = (size_t)HALF * LDB * 2;
    const unsigned ldsw = (unsigned)wid * 1024u;
    const int aoff = lds_byte(wr * 64 + fr, fq * 8), boff = lds_byte(wc * 32 + fr, fq * 8);
#define PG8_SA(b, h) (((b) * 2 + (h)) * HTB)
#define PG8_SB(b, h) ((4 + (b) * 2 + (h)) * HTB)
#define PG8_STAGE(bufoff, gbase, voff) do { _Pragma("unroll") for (int _i = 0; _i < 2; ++_i) \
        __builtin_amdgcn_global_load_lds((const unsigned*)((const char*)(gbase) + (voff)[_i]), (LAS unsigned*)(lds + (bufoff) + ldsw + _i * 8192), 16, 0, 0); } while (0)
#define PG8_LDA(dst, b, h) do { _Pragma("unroll") for (int m = 0; m < 4; ++m) _Pragma("unroll") for (int k = 0; k < 2; ++k) dst[m][k] = *(const LAS bf16x8*)(lds + PG8_SA(b, h) + aoff + m * 2048 + k * 1024); } while (0)
#define PG8_LDB(dst, b, h) do { _Pragma("unroll") for (int n = 0; n < 2; ++n) _Pragma("unroll") for (int k = 0; k < 2; ++k) dst[n][k] = *(const LAS bf16x8*)(lds + PG8_SB(b, h) + boff + n * 2048 + k * 1024); } while (0)
#define PG8_MMA(ai, bj, At, Bt) do { __builtin_amdgcn_s_setprio(1); _Pragma("unroll") for (int m = 0; m < 4; ++m) _Pragma("unroll") for (int n = 0; n < 2; ++n) _Pragma("unroll") for (int k = 0; k < 2; ++k) \
        acc[ai][bj][m][n] = __builtin_amdgcn_mfma_f32_16x16x32_bf16(Bt[n][k], At[m][k], acc[ai][bj][m][n], 0, 0, 0); __builtin_amdgcn_s_setprio(0); } while (0)
#define PG8_WAIT_V(n) asm volatile("s_waitcnt vmcnt(" #n ")" ::: "memory")
#define PG8_WAIT_L(n) asm volatile("s_waitcnt lgkmcnt(" #n ")" ::: "memory")
#define PG8_BAR __builtin_amdgcn_s_barrier()
#define PG8_SCHED __builtin_amdgcn_sched_barrier(0)
    Unit cur, nxt; int ui = 0;
    if (!S.next(0, cur)) return;
    f32x4 acc[2][2][4][2];
#pragma unroll
    for (int a = 0; a < 2; ++a)
#pragma unroll
        for (int b = 0; b < 2; ++b)
#pragma unroll
            for (int m = 0; m < 4; ++m)
#pragma unroll
                for (int n = 0; n < 2; ++n) acc[a][b][m][n] = (f32x4){0.f, 0.f, 0.f, 0.f};
    bf16x8 At[4][2], B0[2][2], B1[2][2];
    const char* gA = (const char*)g.A; const char* gB = (const char*)g.Bt;
    asm volatile("" : "+s"(gA), "+s"(gB));
    const char* cA = gA + S.aoff(cur); const char* cB = gB + S.boff(cur);
    PG8_STAGE(PG8_SB(0, 0), cB, voffB); PG8_STAGE(PG8_SB(0, 1), cB + hstepB, voffB); PG8_STAGE(PG8_SA(0, 0), cA, voffA); PG8_STAGE(PG8_SA(0, 1), cA + hstepA, voffA);
    if (wr == 1) PG8_BAR;
    PG8_WAIT_V(2); PG8_BAR;
    PG8_STAGE(PG8_SB(1, 0), cB + kstep, voffB); PG8_STAGE(PG8_SA(1, 0), cA + kstep, voffA); PG8_STAGE(PG8_SB(1, 1), cB + hstepB + kstep, voffB);
    PG8_WAIT_V(6); PG8_BAR;
    for (;;) {
        const bool has_next = S.next(ui + 1, nxt);
        const char* nA = has_next ? gA + S.aoff(nxt) : cA; const char* nB = has_next ? gB + S.boff(nxt) : cB;
        for (int t = 0; t < nt; t += 2) {
            const bool last = (t == nt - 2);
            const char* a1 = cA + (size_t)(t + 1) * kstep;
            const char* a2 = last ? nA : cA + (size_t)(t + 2) * kstep; const char* b2 = last ? nB : cB + (size_t)(t + 2) * kstep;
            const char* a3 = a2 + kstep; const char* b3 = b2 + kstep;
            PG8_LDB(B0, 0, 0); PG8_LDB(B1, 0, 1); PG8_SCHED; PG8_LDA(At, 0, 0); PG8_STAGE(PG8_SA(1, 1), a1 + hstepA, voffA);
            PG8_WAIT_V(8); PG8_WAIT_L(0); PG8_BAR; PG8_MMA(0, 0, At, B0); PG8_MMA(0, 1, At, B1); PG8_BAR; PG8_SCHED;
            PG8_LDA(At, 0, 1); PG8_STAGE(PG8_SB(0, 0), b2, voffB); PG8_STAGE(PG8_SB(0, 1), b2 + hstepB, voffB); PG8_STAGE(PG8_SA(0, 0), a2, voffA);
            PG8_WAIT_V(8); PG8_WAIT_L(0); PG8_BAR; PG8_MMA(1, 0, At, B0); PG8_MMA(1, 1, At, B1); PG8_BAR; PG8_SCHED;
            PG8_LDB(B0, 1, 0); PG8_LDB(B1, 1, 1); PG8_SCHED; PG8_LDA(At, 1, 0); PG8_STAGE(PG8_SA(0, 1), a2 + hstepA, voffA);
            PG8_WAIT_V(8); PG8_WAIT_L(0); PG8_BAR; PG8_MMA(0, 0, At, B0); PG8_MMA(0, 1, At, B1); PG8_BAR; PG8_SCHED;
            PG8_LDA(At, 1, 1); PG8_STAGE(PG8_SB(1, 0), b3, voffB); PG8_STAGE(PG8_SB(1, 1), b3 + hstepB, voffB); PG8_STAGE(PG8_SA(1, 0), a3, voffA);
            PG8_WAIT_V(8); PG8_WAIT_L(0); PG8_BAR; PG8_MMA(1, 0, At, B0); PG8_MMA(1, 1, At, B1); PG8_BAR; PG8_SCHED;
        }
        if constexpr (ALIGN_EPI) { if (wr == 0) PG8_BAR; }
        bool keep = false;
        if constexpr (Epi::KEEPS) keep = E.merge(acc, cur, wr, wc, fr, fq); else E(acc, cur, wr, wc, fr, fq);
        if (!has_next) break;
        if (!keep)
#pragma unroll
        for (int a = 0; a < 2; ++a)
#pragma unroll
            for (int b = 0; b < 2; ++b)
#pragma unroll
                for (int m = 0; m < 4; ++m)
#pragma unroll
                    for (int n = 0; n < 2; ++n) acc[a][b][m][n] = (f32x4){0.f, 0.f, 0.f, 0.f};
        cur = nxt; cA = nA; cB = nB; ++ui;
        if constexpr (ALIGN_EPI) { if (wr == 1) PG8_BAR; }
    }
    PG8_WAIT_V(0);
    if constexpr (!ALIGN_EPI) { if (wr == 0) PG8_BAR; }
    PG8_BAR;
#undef PG8_SA
#undef PG8_SB
#undef PG8_STAGE
#undef PG8_LDA
#undef PG8_LDB
#undef PG8_MMA
#undef PG8_WAIT_V
#undef PG8_WAIT_L
#undef PG8_BAR
#undef PG8_SCHED
}
}

#define XB_TMO      128
#define XB_XCNT(j)  (256  + 64 * (j))
#define XB_XSUB(j)  (1280 + 64 * (j))
#define XB_XGEN(j)  (2304 + 64 * (j))
#define XB_TOP      3328
#define XB_TOPGEN   3392
#define XCD_BAR_WORDS 3456
#define XB_SPIN_CAP (1u << 23)
__device__ __forceinline__ unsigned xb_ld(unsigned* p)              { return __hip_atomic_load(p, __ATOMIC_RELAXED, __HIP_MEMORY_SCOPE_AGENT); }
__device__ __forceinline__ unsigned xb_add(unsigned* p, unsigned v) { return __hip_atomic_fetch_add(p, v, __ATOMIC_RELAXED, __HIP_MEMORY_SCOPE_AGENT); }
__device__ __forceinline__ unsigned xb_xcc_id() { return (unsigned)__builtin_amdgcn_s_getreg((3 << 11) | 20) & 0xFu; }
#define XB_SPIN(cond, bar) do { unsigned _sp = 0; while (cond) { __builtin_amdgcn_s_sleep(1); \
    if ((++_sp & 255u) == 0u) { if (xb_ld(&(bar)[XB_TMO])) break; if (_sp > XB_SPIN_CAP) { atomicAdd(&(bar)[XB_TMO], 1u); break; } } } } while (0)
struct XcdBarrier { unsigned* bar; unsigned x; volatile LAS unsigned* st; };
__device__ __forceinline__ XcdBarrier xcd_barrier_post(unsigned* bar, volatile LAS unsigned* st) {
    XcdBarrier b; b.bar = bar; b.x = xb_xcc_id(); b.st = st;
    if (threadIdx.x == 0) (void)xb_add(&bar[XB_XCNT(b.x)], 1u);
    return b;
}
__device__ __forceinline__ void xcd_barrier_complete(unsigned* bar, unsigned x, unsigned& nloc, unsigned& nx) {
    const unsigned G = gridDim.x * gridDim.y * gridDim.z;
    unsigned sum, cnt, mine, sp = 0u;
    for (;;) {
        sum = 0u; cnt = 0u; mine = 0u;
#pragma unroll
        for (unsigned j = 0; j < 16; ++j) { const unsigned c = xb_ld(&bar[XB_XCNT(j)]); sum += c; cnt += (c > 0u) ? 1u : 0u; mine = (j == x) ? c : mine; }
        if (sum == G) break;
        __builtin_amdgcn_s_sleep(1);
        if ((++sp & 255u) == 0u) { if (xb_ld(&bar[XB_TMO])) break; if (sp > XB_SPIN_CAP) { atomicAdd(&bar[XB_TMO], 1u); break; } }
    }
    nloc = mine > 0u ? mine : 1u; nx = cnt > 0u ? cnt : 1u;
}
__device__ __forceinline__ void xcd_barrier(const XcdBarrier& b) {
    asm volatile("s_waitcnt vmcnt(0)" ::: "memory");
    __syncthreads();
    if (threadIdx.x == 0) {
        unsigned* bar = b.bar;
        __builtin_amdgcn_s_waitcnt(0);
        unsigned nloc = b.st[0], nx = b.st[1];
        if (nloc == 0u) { xcd_barrier_complete(bar, b.x, nloc, nx); b.st[0] = nloc; b.st[1] = nx; }
        const unsigned old = xb_add(&bar[XB_XSUB(b.x)], 1u);
        const unsigned gen = old / nloc;
        if (old + 1u == (gen + 1u) * nloc) {
            __builtin_amdgcn_fence(__ATOMIC_RELEASE, "agent");
            asm volatile("s_waitcnt vmcnt(0)" ::: "memory");
            const unsigned og = xb_add(&bar[XB_TOP], 1u);
            const unsigned tg = og / nx;
            if (og + 1u == (tg + 1u) * nx) xb_add(&bar[XB_TOPGEN], 1u);
            else XB_SPIN(xb_ld(&bar[XB_TOPGEN]) == tg, bar);
            __builtin_amdgcn_fence(__ATOMIC_ACQUIRE, "agent");
            xb_add(&bar[XB_XGEN(b.x)], 1u);
            asm volatile("s_waitcnt vmcnt(0)" ::: "memory");
        } else {
            XB_SPIN(xb_ld(&bar[XB_XGEN(b.x)]) == gen, bar);
            __builtin_amdgcn_fence(__ATOMIC_ACQUIRE, "agent");
            asm volatile("s_waitcnt vmcnt(0)" ::: "memory");
        }
    }
    __syncthreads();
}

struct Args { const float* in[27]; float* out; unsigned char* ws; };
enum { I_X = 0, I_MEM, I_NMIX, I_NMEM, I_NMLP, I_WIN, I_BGATE, I_GMVG, I_GMWS, I_GMBS, I_CONVW, I_CONVB, I_WR, I_BR, I_WI, I_BI, I_LAM, I_SQG, I_SKG, I_SINK, I_WKV, I_XQG, I_XKG, I_WBR, I_WOUT, I_WFF1, I_WFF2 };
struct Ctx {
    const float* const* in; float* x;
    bf16_t *wt_in, *wt_br, *wt_out, *wt_ff1, *wt_ff2, *wt_kv, *memn, *memkv, *xb, *za, *zg, *mb, *o;
    float *ssq, *carryA, *carryH, *S, *ly, *lp;
    bf16_t *memK, *memVt;
    float* spl;
};

__device__ __forceinline__ void transpose_item(const float* W, int N, bf16_t* WT, int ldk, int koff, const float* gain, LAS float* scr, int item, int lane) {
    const int nblk = N / 32, kb = item / nblk, nb = item % nblk, k0 = 64 * kb, n0 = 32 * nb;
#pragma unroll 8
    for (int i = 0; i < 32; ++i) { const int kk = 2 * i + (lane >> 5); float v = W[(size_t)(k0 + kk) * N + n0 + (lane & 31)]; if (gain) v *= gain[k0 + kk]; scr[kk * 33 + (lane & 31)] = v; }
    LDS_WAIT(); asm volatile("" ::: "memory");
    const int c = lane & 7;
#pragma unroll
    for (int j = 0; j < 4; ++j) { const int n = (lane >> 3) + 8 * j; const LAS float* s = scr + (8 * c) * 33 + n;
        u32x4 o; o.x = pk2(s[0 * 33], s[1 * 33]); o.y = pk2(s[2 * 33], s[3 * 33]); o.z = pk2(s[4 * 33], s[5 * 33]); o.w = pk2(s[6 * 33], s[7 * 33]);
        *(u32x4*)(WT + (size_t)(n0 + n) * ldk + koff + k0 + 8 * c) = o; }
    LDS_WAIT(); asm volatile("" ::: "memory");
}
__device__ __forceinline__ float wave_sum(float v) {
#pragma unroll
    for (int o = 1; o < 64; o <<= 1) v += __shfl_xor(v, o);
    return v;
}
__device__ __forceinline__ void conv_w(const Ctx& C, int which, int l, int item, LAS float* scr, int lane) {
    if (which == 0) transpose_item(C.in[I_WIN] + (size_t)l * D * DIN, DIN, C.wt_in, D, 0, C.in[I_NMIX] + l * D, scr, item, lane);
    else if (which == 1) { const int b = item >> 8; transpose_item(C.in[I_WBR] + (size_t)(l * 4 + b) * 512 * D, D, C.wt_br, 2048, b * 512, nullptr, scr, item & 255, lane); }
    else if (which == 2) transpose_item(C.in[I_WOUT] + (size_t)l * D * D, D, C.wt_out, D, 0, nullptr, scr, item, lane);
    else if (which == 3) transpose_item(C.in[I_WFF1] + (size_t)l * D * FF, FF, C.wt_ff1, D, 0, C.in[I_NMLP] + l * D, scr, item, lane);
    else if (which == 4) transpose_item(C.in[I_WFF2] + (size_t)l * FF * D, D, C.wt_ff2, FF, 0, nullptr, scr, item, lane);
    else transpose_item(C.in[I_WKV] + (size_t)l * D * D, D, C.wt_kv + (size_t)l * D * D, D, 0, C.in[I_NMEM] + l * D, scr, item, lane);
}
constexpr int IT_WIN = 16 * 232, IT_WBR = 1024, IT_WOUT = 512, IT_WFF1 = 2048, IT_WFF2 = 2048, IT_WKV = 512;

#ifndef REP_SWA
#define REP_SWA 1
#endif
#ifndef REP_XA
#define REP_XA 1
#endif
#ifndef REP_GM
#define REP_GM 1
#endif
#ifndef REP_LRU
#define REP_LRU 1
#endif
#ifndef REP_CONV
#define REP_CONV 1
#endif
#ifndef REP_FIX
#define REP_FIX 1
#endif
#ifndef REP_G1
#define REP_G1 1
#endif
#ifndef REP_G2
#define REP_G2 1
#endif
#ifndef REP_G4
#define REP_G4 1
#endif
#ifndef REP_BAR
#define REP_BAR 1
#endif
#ifndef USE_MFMA_SWA
#define USE_MFMA_SWA 1
#endif
#ifndef USE_MFMA_XA
#define USE_MFMA_XA 1
#endif
#ifndef USE_MFMA_GM
#define USE_MFMA_GM 1
#endif
#ifndef USE_MFMA_LRU
#define USE_MFMA_LRU 1
#endif
#define ROPE_INV(i) ((i) == 0 ? 1.0f : (i) == 1 ? 0.19392274474868576f : (i) == 2 ? 0.03760603093086393f : (i) == 3 ? 0.007292664737217109f : (i) == 4 ? 0.001414213562373095f : (i) == 5 ? 0.0002742481756762073f : (i) == 6 ? 5.318295896944988e-05f : 1.031338537721246e-05f)
#define ROPE16(f, pos) do { _Pragma("unroll") for (int _i = 0; _i < 8; ++_i) { float _s, _c; sincosf((pos) * ROPE_INV(_i), &_s, &_c); const float _x1 = (f)[_i], _x2 = (f)[_i + 8]; (f)[_i] = _x1 * _c - _x2 * _s; (f)[_i + 8] = _x2 * _c + _x1 * _s; } } while (0)

__device__ __forceinline__ void swa_item(LAS unsigned char* lds, const Ctx& C, int l, int tile, int h) {
    const int tid = opaque_tid();
    LAS bf16_t* Ks = (LAS bf16_t*)lds;
    LAS bf16_t* Vs = Ks + 256 * 72;
    const int kvh = h >> 2, nb = tile & 63, row0 = tile * 128;
    {
        const int key = tid >> 1, half = tid & 1;
        const bool ok = (nb > 0) || (key >= 128);
        const size_t grow = (size_t)(ok ? row0 - 128 + key : row0);
        const u32x4* kp = (const u32x4*)(C.za + grow * NZA + 2560 + kvh * 64 + half * 32);
        const u32x4* vp = (const u32x4*)(C.za + grow * NZA + 2688 + kvh * 64 + half * 32);
        float kf[32]; float ss = 0.f;
#pragma unroll
        for (int i = 0; i < 4; ++i) { const u32x4 w = kp[i]; UNPACK8(w, kf, 8 * i); }
#pragma unroll
        for (int i = 0; i < 32; ++i) ss += kf[i] * kf[i];
        ss += __shfl_xor(ss, 1);
        const float rs = rsqrtf(ss * (1.f / 64.f) + EPS);
        const float* kg = C.in[I_SKG] + l * 64 + half * 32;
#pragma unroll
        for (int i = 0; i < 32; ++i) kf[i] *= rs * kg[i];
        if (half == 0) { const float pos = (float)(nb * 128 - 128 + key); ROPE16(kf, pos); }
#pragma unroll
        for (int i = 0; i < 4; ++i) { *(LAS u32x4*)(Ks + key * 72 + half * 32 + 8 * i) = PACK8(kf, 8 * i); *(LAS u32x4*)(Vs + key * 72 + half * 32 + 8 * i) = vp[i]; }
    }
    const int q = tid >> 2, sub = tid & 3;
    float qf[16];
    {
        const u32x4* qp = (const u32x4*)(C.za + (size_t)(row0 + q) * NZA + 2048 + h * 64 + sub * 16);
        const u32x4 w0 = qp[0], w1 = qp[1]; UNPACK8(w0, qf, 0); UNPACK8(w1, qf, 8);
        float ss = 0.f;
#pragma unroll
        for (int i = 0; i < 16; ++i) ss += qf[i] * qf[i];
        ss += __shfl_xor(ss, 1); ss += __shfl_xor(ss, 2);
        const float rs = rsqrtf(ss * (1.f / 64.f) + EPS);
        const float* qg = C.in[I_SQG] + l * 64 + sub * 16;
#pragma unroll
        for (int i = 0; i < 16; ++i) qf[i] *= rs * qg[i];
        if (sub == 0) { const float pos = (float)(nb * 128 + q); ROPE16(qf, pos); }
#pragma unroll
        for (int i = 0; i < 16; ++i) qf[i] *= 0.125f;
    }
    __syncthreads();
    const float sink = C.in[I_SINK][l * 8 + h];
    float mx = sink;
    for (int j = 0; j < 128; ++j) {
        const int kj = q + 1 + j; const bool valid = (nb > 0) || (kj >= 128);
        const LAS u32x4* kr = (const LAS u32x4*)(Ks + kj * 72 + sub * 16);
        float kf[16]; const u32x4 w0 = kr[0], w1 = kr[1]; UNPACK8(w0, kf, 0); UNPACK8(w1, kf, 8);
        float s = 0.f;
#pragma unroll
        for (int i = 0; i < 16; ++i) s += qf[i] * kf[i];
        s += __shfl_xor(s, 1); s += __shfl_xor(s, 2);
        if (valid) mx = fmaxf(mx, s);
    }
    float lsum = __expf(sink - mx); float o[16];
#pragma unroll
    for (int i = 0; i < 16; ++i) o[i] = 0.f;
    for (int j = 0; j < 128; ++j) {
        const int kj = q + 1 + j; const bool valid = (nb > 0) || (kj >= 128);
        const LAS u32x4* kr = (const LAS u32x4*)(Ks + kj * 72 + sub * 16);
        float kf[16]; { const u32x4 w0 = kr[0], w1 = kr[1]; UNPACK8(w0, kf, 0); UNPACK8(w1, kf, 8); }
        float s = 0.f;
#pragma unroll
        for (int i = 0; i < 16; ++i) s += qf[i] * kf[i];
        s += __shfl_xor(s, 1); s += __shfl_xor(s, 2);
        const float p = valid ? __expf(s - mx) : 0.f;
        lsum += p;
        const LAS u32x4* vr = (const LAS u32x4*)(Vs + kj * 72 + sub * 16);
        float vf[16]; { const u32x4 w0 = vr[0], w1 = vr[1]; UNPACK8(w0, vf, 0); UNPACK8(w1, vf, 8); }
#pragma unroll
        for (int i = 0; i < 16; ++i) o[i] += p * vf[i];
    }
    const float inv = 1.f / lsum;
#pragma unroll
    for (int i = 0; i < 16; ++i) o[i] *= inv;
    u32x4* op = (u32x4*)(C.o + (size_t)(row0 + q) * NO + 1024 + h * 64 + sub * 16);
    op[0] = PACK8(o, 0); op[1] = PACK8(o, 8);
    __syncthreads();
}

__device__ __forceinline__ void xa_item(LAS unsigned char* lds, const Ctx& C, int l, int tile, int h) {
    const int tid = opaque_tid();
    LAS bf16_t* Ks = (LAS bf16_t*)lds;
    LAS bf16_t* Vs = Ks + 256 * 136;
    const int b = tile >> 6, row0 = tile * 128;
    {
        const int key = tid >> 1, half = tid & 1;
        const bf16_t* src = C.memkv + ((size_t)(l * 512 + b * 256 + key)) * 1024 + h * 128 + half * 64;
        const u32x4* kp = (const u32x4*)src; const u32x4* vp = (const u32x4*)(src + 512);
        float kf[64]; float ss = 0.f;
#pragma unroll
        for (int i = 0; i < 8; ++i) { const u32x4 w = kp[i]; UNPACK8(w, kf, 8 * i); }
#pragma unroll
        for (int i = 0; i < 64; ++i) ss += kf[i] * kf[i];
        ss += __shfl_xor(ss, 1);
        const float rs = rsqrtf(ss * (1.f / 128.f) + EPS);
        const float* kg = C.in[I_XKG] + l * 128 + half * 64;
#pragma unroll
        for (int i = 0; i < 64; ++i) kf[i] *= rs * kg[i];
#pragma unroll
        for (int i = 0; i < 8; ++i) { *(LAS u32x4*)(Ks + key * 136 + half * 64 + 8 * i) = PACK8(kf, 8 * i); *(LAS u32x4*)(Vs + key * 136 + half * 64 + 8 * i) = vp[i]; }
    }
    const int q = tid >> 2, sub = tid & 3;
    float qf[32];
    {
        const u32x4* qp = (const u32x4*)(C.za + (size_t)(row0 + q) * NZA + 2816 + h * 128 + sub * 32);
#pragma unroll
        for (int i = 0; i < 4; ++i) { const u32x4 w = qp[i]; UNPACK8(w, qf, 8 * i); }
        float ss = 0.f;
#pragma unroll
        for (int i = 0; i < 32; ++i) ss += qf[i] * qf[i];
        ss += __shfl_xor(ss, 1); ss += __shfl_xor(ss, 2);
        const float rs = rsqrtf(ss * (1.f / 128.f) + EPS) * 0.08838834764831845f;
        const float* qg = C.in[I_XQG] + l * 128 + sub * 32;
#pragma unroll
        for (int i = 0; i < 32; ++i) qf[i] *= rs * qg[i];
    }
    __syncthreads();
    float mx = -3.0e38f;
    for (int key = 0; key < 256; ++key) {
        const LAS u32x4* kr = (const LAS u32x4*)(Ks + key * 136 + sub * 32);
        float s = 0.f;
#pragma unroll
        for (int c = 0; c < 4; ++c) { float kf[8]; const u32x4 w = kr[c]; UNPACK8(w, kf, 0);
#pragma unroll
            for (int i = 0; i < 8; ++i) s += qf[8 * c + i] * kf[i]; }
        s += __shfl_xor(s, 1); s += __shfl_xor(s, 2);
        mx = fmaxf(mx, s);
    }
    float lsum = 0.f; float o[32];
#pragma unroll
    for (int i = 0; i < 32; ++i) o[i] = 0.f;
    for (int key = 0; key < 256; ++key) {
        const LAS u32x4* kr = (const LAS u32x4*)(Ks + key * 136 + sub * 32);
        float s = 0.f;
#pragma unroll
        for (int c = 0; c < 4; ++c) { float kf[8]; const u32x4 w = kr[c]; UNPACK8(w, kf, 0);
#pragma unroll
            for (int i = 0; i < 8; ++i) s += qf[8 * c + i] * kf[i]; }
        s += __shfl_xor(s, 1); s += __shfl_xor(s, 2);
        const float p = __expf(s - mx);
        lsum += p;
        const LAS u32x4* vr = (const LAS u32x4*)(Vs + key * 136 + sub * 32);
#pragma unroll
        for (int c = 0; c < 4; ++c) { float vf[8]; const u32x4 w = vr[c]; UNPACK8(w, vf, 0);
#pragma unroll
            for (int i = 0; i < 8; ++i) o[8 * c + i] += p * vf[i]; }
    }
    const float inv = 1.f / lsum;
#pragma unroll
    for (int i = 0; i < 32; ++i) o[i] *= inv;
    u32x4* op = (u32x4*)(C.o + (size_t)(row0 + q) * NO + 1536 + h * 128 + sub * 32);
#pragma unroll
    for (int c = 0; c < 4; ++c) op[c] = PACK8(o, 8 * c);
    __syncthreads();
}

__device__ __forceinline__ void gm_item(LAS unsigned char* lds, const Ctx& C, int l, int tile, int g) {
    const int tid = opaque_tid();
    LAS float* vn = (LAS float*)lds;
    LAS float* Wl = vn + 128 * 128;
    LAS float* rsv = Wl + 128 * 128;
    const int row0 = tile * 128;
    {
        const int tok = tid >> 2, sub = tid & 3;
        const u32x4* vp = (const u32x4*)(C.za + (size_t)(row0 + tok) * NZA + 512 + sub * 128);
        float ss = 0.f;
#pragma unroll
        for (int i = 0; i < 16; ++i) { float f[8]; const u32x4 w = vp[i]; UNPACK8(w, f, 0);
#pragma unroll
            for (int e = 0; e < 8; ++e) ss += f[e] * f[e]; }
        ss += __shfl_xor(ss, 1); ss += __shfl_xor(ss, 2);
        if (sub == 0) rsv[tok] = rsqrtf(ss * (1.f / 512.f) + EPS);
        const f32x4* wp = (const f32x4*)(C.in[I_GMWS] + (size_t)(l * 4 + g) * 128 * 128);
#pragma unroll
        for (int i = 0; i < 8; ++i) *(LAS f32x4*)(Wl + (i * 512 + tid) * 4) = wp[i * 512 + tid];
    }
    __syncthreads();
    {
        const int s = tid >> 2, c0 = (tid & 3) * 32;
        const u32x4* vp = (const u32x4*)(C.za + (size_t)(row0 + s) * NZA + 512 + g * 128 + c0);
        const float rs = rsv[s]; const float* vg = C.in[I_GMVG] + l * 512 + g * 128 + c0;
#pragma unroll
        for (int i = 0; i < 4; ++i) { float f[8]; const u32x4 w = vp[i]; UNPACK8(w, f, 0);
#pragma unroll
            for (int e = 0; e < 8; ++e) f[e] *= rs * vg[8 * i + e];
            *(LAS f32x4*)(vn + s * 128 + c0 + 8 * i) = (f32x4){f[0], f[1], f[2], f[3]}; *(LAS f32x4*)(vn + s * 128 + c0 + 8 * i + 4) = (f32x4){f[4], f[5], f[6], f[7]}; }
    }
    __syncthreads();
    {
        const int c = tid & 127, tq = tid >> 7;
        const float* bs = C.in[I_GMBS] + (size_t)(l * 4 + g) * 128;
        for (int k = 0; k < 32; ++k) {
            const int t = tq * 32 + k; float acc = 0.f;
            for (int s = 0; s <= t; ++s) acc += Wl[t * 128 + s] * vn[s * 128 + c];
            const float sval = acc + bs[t];
            const float u = bf2f(C.za[(size_t)(row0 + t) * NZA + g * 128 + c]);
            C.o[(size_t)(row0 + t) * NO + g * 128 + c] = (bf16_t)f2bf(u * sval);
        }
    }
    __syncthreads();
}

__device__ __forceinline__ void lru_item(LAS unsigned char* lds, const Ctx& C, int l, int tile, int hb) {
    const int tid = opaque_tid();
    LAS float* xc = (LAS float*)lds;
    LAS float* wr = xc + 8192;
    LAS float* wi = wr + 4096;
    LAS float* aa = wi + 4096;
    LAS float* bb = aa + 8192;
    const int nb = tile & 63, row0 = tile * 128;
    {
        const int t = tid >> 2, c0 = (tid & 3) * 16, ch = hb * 64 + c0;
        float acc[16];
#pragma unroll
        for (int i = 0; i < 16; ++i) acc[i] = C.in[I_CONVB][l * 512 + ch + i];
#pragma unroll
        for (int k = 0; k < 4; ++k) {
            const int tt = t - 3 + k;
            if (nb * 128 + tt >= 0) {
                const u32x4* xp = (const u32x4*)(C.za + (size_t)(row0 + tt) * NZA + 1024 + ch);
                float f[16]; const u32x4 w0 = xp[0], w1 = xp[1]; UNPACK8(w0, f, 0); UNPACK8(w1, f, 8);
                const float* cw = C.in[I_CONVW] + (size_t)(l * 4 + k) * 512 + ch;
#pragma unroll
                for (int i = 0; i < 16; ++i) acc[i] += cw[i] * f[i];
            }
        }
#pragma unroll
        for (int i = 0; i < 4; ++i) *(LAS f32x4*)(xc + t * 64 + c0 + 4 * i) = (f32x4){acc[4 * i], acc[4 * i + 1], acc[4 * i + 2], acc[4 * i + 3]};
        const f32x4* wrp = (const f32x4*)(C.in[I_WR] + (size_t)(l * 8 + hb) * 4096); const f32x4* wip = (const f32x4*)(C.in[I_WI] + (size_t)(l * 8 + hb) * 4096);
#pragma unroll
        for (int i = 0; i < 2; ++i) { *(LAS f32x4*)(wr + (i * 512 + tid) * 4) = wrp[i * 512 + tid]; *(LAS f32x4*)(wi + (i * 512 + tid) * 4) = wip[i * 512 + tid]; }
    }
    __syncthreads();
    const int j = tid & 63, tg = tid >> 6, chj = hb * 64 + j;
    {
        const float br = C.in[I_BR][l * 512 + chj], bi = C.in[I_BI][l * 512 + chj];
        const float lam = C.in[I_LAM][l * 512 + chj];
        const float sp = log1pf(expf(-lam));
        for (int k = 0; k < 16; ++k) {
            const int t = tg * 16 + k; float r = br, ig = bi;
            for (int i = 0; i < 64; ++i) { const float xv = xc[t * 64 + i]; r += xv * wr[i * 64 + j]; ig += xv * wi[i * 64 + j]; }
            r = sigmoid_f(r); ig = sigmoid_f(ig);
            const float loga = -8.f * r * sp; const float a = expf(loga); const float mult = sqrtf(-expm1f(2.f * loga));
            aa[t * 64 + j] = a; bb[t * 64 + j] = xc[t * 64 + j] * ig * mult;
        }
    }
    __syncthreads();
    if (tid < 64) {
        float hh = 0.f, P = 1.f;
        for (int t = 0; t < 128; ++t) { const float a = aa[t * 64 + tid]; hh = a * hh + bb[t * 64 + tid]; P *= a; aa[t * 64 + tid] = P; bb[t * 64 + tid] = hh; }
        C.carryA[(size_t)tile * 512 + hb * 64 + tid] = P; C.carryH[(size_t)tile * 512 + hb * 64 + tid] = hh;
    }
    __syncthreads();
    for (int k = 0; k < 16; ++k) {
        const int t = tg * 16 + k;
        const float G = bf2f(C.za[(size_t)(row0 + t) * NZA + 1536 + chj]);
        C.ly[(size_t)(row0 + t) * 512 + chj] = G * bb[t * 64 + j]; C.lp[(size_t)(row0 + t) * 512 + chj] = G * aa[t * 64 + j];
    }
    __syncthreads();
}

__device__ __forceinline__ int vperm_pos(int key) { const int w = key & 31; return (key & ~31) + ((w >> 2) & 3) * 8 + (w >> 4) * 4 + (w & 3); }
#define MFMA16(X, Y, ACC) __builtin_amdgcn_mfma_f32_16x16x32_bf16((X), (Y), (ACC), 0, 0, 0)
__device__ __forceinline__ bf16x8 pack_bf16x8(const float* f) { u32x4 w; w[0] = cvt_pk_bf16(f[0], f[1]); w[1] = cvt_pk_bf16(f[2], f[3]); w[2] = cvt_pk_bf16(f[4], f[5]); w[3] = cvt_pk_bf16(f[6], f[7]); return __builtin_bit_cast(bf16x8, w); }

__device__ __forceinline__ void kvprep_phase(const Ctx& C, int gw, int NGW, int lane) {
    for (int r = gw; r < 32 * 256; r += NGW) {
        const int combo = r >> 8, key = r & 255, l = combo >> 3, b = (combo >> 2) & 1, h = combo & 3;
        const unsigned w = *(const unsigned*)(C.memkv + ((size_t)(l * 512 + b * 256 + key)) * 1024 + h * 128 + 2 * lane);
        float f0 = __uint_as_float(w << 16), f1 = __uint_as_float(w & 0xffff0000u);
        const float ss = wave_sum(f0 * f0 + f1 * f1); const float rs = rsqrtf(ss * (1.f / 128.f) + EPS);
        const float* kg = C.in[I_XKG] + l * 128 + 2 * lane;
        *(unsigned*)(C.memK + (size_t)r * 128 + 2 * lane) = pk2(f0 * rs * kg[0], f1 * rs * kg[1]);
    }
    const int gt = gw * 64 + lane, NGT = NGW * 64;
    for (int t = gt; t < 32 * 32 * 128; t += NGT) {
        const int d = t & 127, pg = (t >> 7) & 31, combo = t >> 12, l = combo >> 3, b = (combo >> 2) & 1, h = combo & 3;
        const int kbase = (pg >> 2) * 32 + (pg & 3) * 4;
        const bf16_t* src = C.memkv + ((size_t)(l * 512 + b * 256)) * 1024 + 512 + h * 128 + d;
        unsigned short v[8];
#pragma unroll
        for (int e = 0; e < 4; ++e) { v[e] = src[(size_t)(kbase + e) * 1024]; v[4 + e] = src[(size_t)(kbase + 16 + e) * 1024]; }
        u32x4 o; o[0] = v[0] | ((unsigned)v[1] << 16); o[1] = v[2] | ((unsigned)v[3] << 16); o[2] = v[4] | ((unsigned)v[5] << 16); o[3] = v[6] | ((unsigned)v[7] << 16);
        *(u32x4*)(C.memVt + ((size_t)combo * 128 + d) * 256 + pg * 8) = o;
    }
}

__device__ __forceinline__ void xa_pair_mfma(LAS unsigned char* lds, const Ctx& C, int l, int pairidx) {
    const int tid = opaque_tid(), lane = tid & 63, w = __builtin_amdgcn_readfirstlane(tid >> 6), fr = lane & 15, fq = lane >> 4;
    LAS bf16_t* Ks = (LAS bf16_t*)lds;
    LAS bf16_t* Vt = Ks + 256 * 144;
    const int idx0 = pairidx * 2, bh = idx0 >> 6, b = bh >> 2, h = bh & 3, nb0 = idx0 & 63;
    {
        const u32x4* ksrc = (const u32x4*)(C.memK + ((size_t)(l * 8 + bh)) * 256 * 128);
        const u32x4* vsrc = (const u32x4*)(C.memVt + ((size_t)(l * 8 + bh)) * 128 * 256);
#pragma unroll
        for (int i = 0; i < 8; ++i) { const int ch = i * 512 + tid;
            *(LAS u32x4*)(Ks + (ch >> 4) * 144 + (ch & 15) * 8) = ksrc[ch];
            *(LAS u32x4*)(Vt + (ch >> 5) * 272 + (ch & 31) * 8) = vsrc[ch]; }
    }
    __syncthreads();
    const float* qg = C.in[I_XQG] + l * 128;
    for (int tt = 0; tt < 2; ++tt) {
        const size_t row = (size_t)((b * 64 + nb0 + tt) * 128 + w * 16 + fr);
        bf16x8 qf[4];
        {
            float f[32]; const bf16_t* qp = C.za + row * NZA + 2816 + h * 128 + 8 * fq;
#pragma unroll
            for (int ks = 0; ks < 4; ++ks) { const u32x4 wv = *(const u32x4*)(qp + 32 * ks); UNPACK8(wv, f, 8 * ks); }
            float ss = 0.f;
#pragma unroll
            for (int i = 0; i < 32; ++i) ss += f[i] * f[i];
            ss += __shfl_xor(ss, 16); ss += __shfl_xor(ss, 32);
            const float rs = rsqrtf(ss * (1.f / 128.f) + EPS) * 0.08838834764831845f;
#pragma unroll
            for (int ks = 0; ks < 4; ++ks) {
#pragma unroll
                for (int i = 0; i < 8; ++i) f[8 * ks + i] *= rs * qg[32 * ks + 8 * fq + i];
                qf[ks] = pack_bf16x8(f + 8 * ks); }
        }
        f32x4 acc[16];
#pragma unroll
        for (int kb = 0; kb < 16; ++kb) { acc[kb] = (f32x4){0.f, 0.f, 0.f, 0.f};
#pragma unroll
            for (int ks = 0; ks < 4; ++ks) { const bf16x8 kf = *(const LAS bf16x8*)(Ks + (kb * 16 + fr) * 144 + 32 * ks + 8 * fq); acc[kb] = MFMA16(kf, qf[ks], acc[kb]); } }
        float mx = -3.0e38f;
#pragma unroll
        for (int kb = 0; kb < 16; ++kb) mx = fmaxf(fmaxf(fmaxf(acc[kb][0], acc[kb][1]), fmaxf(acc[kb][2], acc[kb][3])), mx);
        mx = fmaxf(mx, __shfl_xor(mx, 16)); mx = fmaxf(mx, __shfl_xor(mx, 32));
        float lsum = 0.f;
#pragma unroll
        for (int kb = 0; kb < 16; ++kb)
#pragma unroll
            for (int e = 0; e < 4; ++e) { const float pv = __expf(acc[kb][e] - mx); acc[kb][e] = pv; lsum += pv; }
        lsum += __shfl_xor(lsum, 16); lsum += __shfl_xor(lsum, 32);
        const float inv = 1.f / lsum;
        bf16x8 pf[8];
#pragma unroll
        for (int j = 0; j < 8; ++j) { u32x4 wv; wv[0] = cvt_pk_bf16(acc[2 * j][0], acc[2 * j][1]); wv[1] = cvt_pk_bf16(acc[2 * j][2], acc[2 * j][3]); wv[2] = cvt_pk_bf16(acc[2 * j + 1][0], acc[2 * j + 1][1]); wv[3] = cvt_pk_bf16(acc[2 * j + 1][2], acc[2 * j + 1][3]); pf[j] = __builtin_bit_cast(bf16x8, wv); }
        bf16_t* op = C.o + row * NO + 1536 + h * 128 + 4 * fq;
#pragma unroll
        for (int db = 0; db < 8; ++db) {
            f32x4 o = (f32x4){0.f, 0.f, 0.f, 0.f};
#pragma unroll
            for (int j = 0; j < 8; ++j) { const bf16x8 vf = *(const LAS bf16x8*)(Vt + (db * 16 + fr) * 272 + 32 * j + 8 * fq); o = MFMA16(vf, pf[j], o); }
            *(u32x2*)(op + db * 16) = (u32x2){cvt_pk_bf16(o[0] * inv, o[1] * inv), cvt_pk_bf16(o[2] * inv, o[3] * inv)};
        }
    }
    __syncthreads();
}

__device__ __forceinline__ void swa_item_mfma(LAS unsigned char* lds, const Ctx& C, int l, int tile, int kvh) {
    const int tid = opaque_tid(), lane = tid & 63, w = __builtin_amdgcn_readfirstlane(tid >> 6), fr = lane & 15, fq = lane >> 4;
    LAS bf16_t* Ks = (LAS bf16_t*)lds;
    LAS bf16_t* Vt = Ks + 256 * 80;
    const int nb = tile & 63, row0 = tile * 128;
    {
        const int key = tid >> 1, half = tid & 1;
        const bool ok = (nb > 0) || (key >= 128);
        const size_t grow = (size_t)(ok ? row0 - 128 + key : row0);
        const u32x4* kp = (const u32x4*)(C.za + grow * NZA + 2560 + kvh * 64 + half * 32);
        const u32x4* vp = (const u32x4*)(C.za + grow * NZA + 2688 + kvh * 64 + half * 32);
        float kf[32]; float ss = 0.f;
#pragma unroll
        for (int i = 0; i < 4; ++i) { const u32x4 wv = kp[i]; UNPACK8(wv, kf, 8 * i); }
#pragma unroll
        for (int i = 0; i < 32; ++i) ss += kf[i] * kf[i];
        ss += __shfl_xor(ss, 1);
        const float rs = rsqrtf(ss * (1.f / 64.f) + EPS);
        const float* kg = C.in[I_SKG] + l * 64 + half * 32;
#pragma unroll
        for (int i = 0; i < 32; ++i) kf[i] *= rs * kg[i];
        if (half == 0) { const float pos = (float)(nb * 128 - 128 + key); ROPE16(kf, pos); }
#pragma unroll
        for (int i = 0; i < 4; ++i) *(LAS u32x4*)(Ks + key * 80 + half * 32 + 8 * i) = PACK8(kf, 8 * i);
        const int pp = vperm_pos(key);
#pragma unroll
        for (int i = 0; i < 4; ++i) { u32x4 wv = vp[i]; if (!ok) wv = (u32x4){0u, 0u, 0u, 0u};
#pragma unroll
            for (int e = 0; e < 4; ++e) { Vt[(half * 32 + 8 * i + 2 * e) * 272 + pp] = (bf16_t)(wv[e] & 0xffffu); Vt[(half * 32 + 8 * i + 2 * e + 1) * 272 + pp] = (bf16_t)(wv[e] >> 16); } }
    }
    __syncthreads();
    const int i0 = 16 * w, ws2 = w & ~1, qi = i0 + fr;
    float rc[8], rsn[8];
    { const float pos = (float)(nb * 128 + qi);
#pragma unroll
      for (int i = 0; i < 8; ++i) { const float ang = pos * ROPE_INV(i); rc[i] = cosf(ang); rsn[i] = sinf(ang); } }
    const size_t row = (size_t)(row0 + qi);
    for (int hh = 0; hh < 4; ++hh) {
        const int h = kvh * 4 + hh;
        bf16x8 qf[2];
        {
            float f[16]; const bf16_t* qp = C.za + row * NZA + 2048 + h * 64 + 8 * fq;
            { const u32x4 w0 = *(const u32x4*)qp, w1 = *(const u32x4*)(qp + 32); UNPACK8(w0, f, 0); UNPACK8(w1, f, 8); }
            float ss = 0.f;
#pragma unroll
            for (int i = 0; i < 16; ++i) ss += f[i] * f[i];
            ss += __shfl_xor(ss, 16); ss += __shfl_xor(ss, 32);
            const float rs = rsqrtf(ss * (1.f / 64.f) + EPS);
            const float* qg = C.in[I_SQG] + l * 64 + 8 * fq;
#pragma unroll
            for (int i = 0; i < 8; ++i) { f[i] *= rs * qg[i]; f[8 + i] *= rs * qg[32 + i]; }
#pragma unroll
            for (int i = 0; i < 8; ++i) { const float other = __shfl_xor(f[i], 16);
                const float r0 = f[i] * rc[i] - other * rsn[i], r1 = f[i] * rc[i] + other * rsn[i];
                f[i] = (fq == 0) ? r0 : (fq == 1) ? r1 : f[i]; }
#pragma unroll
            for (int i = 0; i < 16; ++i) f[i] *= 0.125f;
            qf[0] = pack_bf16x8(f); qf[1] = pack_bf16x8(f + 8);
        }
        f32x4 acc[10];
#pragma unroll
        for (int kk = 0; kk < 10; ++kk) { acc[kk] = (f32x4){0.f, 0.f, 0.f, 0.f};
#pragma unroll
            for (int ks = 0; ks < 2; ++ks) { const bf16x8 kf = *(const LAS bf16x8*)(Ks + ((ws2 + kk) * 16 + fr) * 80 + 32 * ks + 8 * fq); acc[kk] = MFMA16(kf, qf[ks], acc[kk]); } }
        const float sink = C.in[I_SINK][l * 8 + h];
        float mx = sink;
#pragma unroll
        for (int kk = 0; kk < 10; ++kk)
#pragma unroll
            for (int e = 0; e < 4; ++e) { const int kj = (ws2 + kk) * 16 + 4 * fq + e, dd = kj - qi; const bool valid = (dd >= 1) && (dd <= 128) && ((nb > 0) || (kj >= 128));
                const float sv = valid ? acc[kk][e] : -INFINITY; acc[kk][e] = sv; mx = fmaxf(mx, sv); }
        mx = fmaxf(mx, __shfl_xor(mx, 16)); mx = fmaxf(mx, __shfl_xor(mx, 32));
        float lsum = 0.f;
#pragma unroll
        for (int kk = 0; kk < 10; ++kk)
#pragma unroll
            for (int e = 0; e < 4; ++e) { const float pv = __expf(acc[kk][e] - mx); acc[kk][e] = pv; lsum += pv; }
        lsum += __shfl_xor(lsum, 16); lsum += __shfl_xor(lsum, 32);
        lsum += __expf(sink - mx);
        const float inv = 1.f / lsum;
        bf16x8 pf[5];
#pragma unroll
        for (int j = 0; j < 5; ++j) { u32x4 wv; wv[0] = cvt_pk_bf16(acc[2 * j][0], acc[2 * j][1]); wv[1] = cvt_pk_bf16(acc[2 * j][2], acc[2 * j][3]); wv[2] = cvt_pk_bf16(acc[2 * j + 1][0], acc[2 * j + 1][1]); wv[3] = cvt_pk_bf16(acc[2 * j + 1][2], acc[2 * j + 1][3]); pf[j] = __builtin_bit_cast(bf16x8, wv); }
        bf16_t* op = C.o + row * NO + 1024 + h * 64 + 4 * fq;
#pragma unroll
        for (int db = 0; db < 4; ++db) {
            f32x4 o = (f32x4){0.f, 0.f, 0.f, 0.f};
#pragma unroll
            for (int j = 0; j < 5; ++j) { const bf16x8 vf = *(const LAS bf16x8*)(Vt + (db * 16 + fr) * 272 + (ws2 + 2 * j) * 16 + 8 * fq); o = MFMA16(vf, pf[j], o); }
            *(u32x2*)(op + db * 16) = (u32x2){cvt_pk_bf16(o[0] * inv, o[1] * inv), cvt_pk_bf16(o[2] * inv, o[3] * inv)};
        }
    }
    __syncthreads();
}

__device__ __forceinline__ void gm_item_mfma(LAS unsigned char* lds, const Ctx& C, int l, int tile, int g) {
    const int tid = opaque_tid(), lane = tid & 63, w = __builtin_amdgcn_readfirstlane(tid >> 6), fr = lane & 15, fq = lane >> 4;
    LAS bf16_t* Wl = (LAS bf16_t*)lds;
    LAS bf16_t* vT = Wl + 128 * 144;
    LAS float* rsv = (LAS float*)(vT + 128 * 144);
    const int row0 = tile * 128;
    {
        const int tok = tid >> 2, sub = tid & 3;
        const u32x4* vp = (const u32x4*)(C.za + (size_t)(row0 + tok) * NZA + 512 + sub * 128);
        float ss = 0.f;
#pragma unroll
        for (int i = 0; i < 16; ++i) { float f[8]; const u32x4 wv = vp[i]; UNPACK8(wv, f, 0);
#pragma unroll
            for (int e = 0; e < 8; ++e) ss += f[e] * f[e]; }
        ss += __shfl_xor(ss, 1); ss += __shfl_xor(ss, 2);
        if (sub == 0) rsv[tok] = rsqrtf(ss * (1.f / 512.f) + EPS);
        const u32x4* gp = (const u32x4*)(C.za + (size_t)(row0 + tok) * NZA + 512 + g * 128 + sub * 32);
#pragma unroll
        for (int i = 0; i < 4; ++i) { const u32x4 wv = gp[i];
#pragma unroll
            for (int e = 0; e < 4; ++e) { vT[(sub * 32 + 8 * i + 2 * e) * 144 + tok] = (bf16_t)(wv[e] & 0xffffu); vT[(sub * 32 + 8 * i + 2 * e + 1) * 144 + tok] = (bf16_t)(wv[e] >> 16); } }
    }
    __syncthreads();
    {
        const int t = tid >> 2, s0 = (tid & 3) * 32;
        const f32x4* wp = (const f32x4*)(C.in[I_GMWS] + ((size_t)(l * 4 + g) * 128 + t) * 128 + s0);
#pragma unroll
        for (int i = 0; i < 4; ++i) { const f32x4 a = wp[2 * i], b2 = wp[2 * i + 1]; float f[8] = {a[0], a[1], a[2], a[3], b2[0], b2[1], b2[2], b2[3]};
#pragma unroll
            for (int e = 0; e < 8; ++e) { const int sidx = s0 + 8 * i + e; f[e] = (sidx <= t) ? f[e] * rsv[sidx] : 0.f; }
            *(LAS u32x4*)(Wl + t * 144 + s0 + 8 * i) = PACK8(f, 0); }
    }
    __syncthreads();
    {
        const int nks = (w + 2) >> 1;
        f32x4 acc[8];
#pragma unroll
        for (int cb = 0; cb < 8; ++cb) acc[cb] = (f32x4){0.f, 0.f, 0.f, 0.f};
        for (int ks = 0; ks < nks; ++ks) {
            const bf16x8 wf = *(const LAS bf16x8*)(Wl + (16 * w + fr) * 144 + 32 * ks + 8 * fq);
#pragma unroll
            for (int cb = 0; cb < 8; ++cb) { const bf16x8 vf = *(const LAS bf16x8*)(vT + (cb * 16 + fr) * 144 + 32 * ks + 8 * fq); acc[cb] = MFMA16(wf, vf, acc[cb]); }
        }
        const float* bs = C.in[I_GMBS] + (size_t)(l * 4 + g) * 128 + 16 * w + 4 * fq;
        const float* vg = C.in[I_GMVG] + l * 512 + g * 128;
#pragma unroll
        for (int cb = 0; cb < 8; ++cb) { const int c = cb * 16 + fr; const float gn = vg[c];
#pragma unroll
            for (int e = 0; e < 4; ++e) { const size_t r = (size_t)(row0 + 16 * w + 4 * fq + e);
                const float u = bf2f(C.za[r * NZA + g * 128 + c]);
                C.o[r * NO + g * 128 + c] = (bf16_t)f2bf(u * (gn * acc[cb][e] + bs[e])); } }
    }
    __syncthreads();
}

__device__ __forceinline__ void lru_item_mfma(LAS unsigned char* lds, const Ctx& C, int l, int tile, int hb) {
    const int tid = opaque_tid(), lane = tid & 63, w = __builtin_amdgcn_readfirstlane(tid >> 6), fr = lane & 15, fq = lane >> 4;
    LAS bf16_t* xcb = (LAS bf16_t*)lds;
    LAS bf16_t* wrT = xcb + 128 * 80;
    LAS bf16_t* wiT = wrT + 64 * 80;
    LAS float* xcf = (LAS float*)(lds + 40960);
    LAS float* aa = xcf + 8192;
    LAS float* bb = aa + 8192;
    LAS float* segA = bb + 8192;
    LAS float* segH = segA + 512;
    const int nb = tile & 63, row0 = tile * 128;
    {
        const int t = tid >> 2, c0 = (tid & 3) * 16, ch = hb * 64 + c0;
        float acc[16];
#pragma unroll
        for (int i = 0; i < 16; ++i) acc[i] = C.in[I_CONVB][l * 512 + ch + i];
#pragma unroll
        for (int k = 0; k < 4; ++k) {
            const int tt = t - 3 + k;
            if (nb * 128 + tt >= 0) {
                const u32x4* xp = (const u32x4*)(C.za + (size_t)(row0 + tt) * NZA + 1024 + ch);
                float f[16]; const u32x4 w0 = xp[0], w1 = xp[1]; UNPACK8(w0, f, 0); UNPACK8(w1, f, 8);
                const float* cw = C.in[I_CONVW] + (size_t)(l * 4 + k) * 512 + ch;
#pragma unroll
                for (int i = 0; i < 16; ++i) acc[i] += cw[i] * f[i];
            }
        }
#pragma unroll
        for (int i = 0; i < 4; ++i) *(LAS f32x4*)(xcf + t * 64 + c0 + 4 * i) = (f32x4){acc[4 * i], acc[4 * i + 1], acc[4 * i + 2], acc[4 * i + 3]};
        *(LAS u32x4*)(xcb + t * 80 + c0) = PACK8(acc, 0); *(LAS u32x4*)(xcb + t * 80 + c0 + 8) = PACK8(acc, 8);
        const int wi_ = tid >> 3, j0 = (tid & 7) * 8;
        const f32x4* wrp = (const f32x4*)(C.in[I_WR] + (size_t)(l * 8 + hb) * 4096 + wi_ * 64 + j0); const f32x4* wip = (const f32x4*)(C.in[I_WI] + (size_t)(l * 8 + hb) * 4096 + wi_ * 64 + j0);
        const f32x4 r0 = wrp[0], r1 = wrp[1], q0 = wip[0], q1 = wip[1];
#pragma unroll
        for (int e = 0; e < 4; ++e) { wrT[(j0 + e) * 80 + wi_] = (bf16_t)f2bf(r0[e]); wrT[(j0 + 4 + e) * 80 + wi_] = (bf16_t)f2bf(r1[e]); wiT[(j0 + e) * 80 + wi_] = (bf16_t)f2bf(q0[e]); wiT[(j0 + 4 + e) * 80 + wi_] = (bf16_t)f2bf(q1[e]); }
    }
    __syncthreads();
    {
        bf16x8 xf[2];
#pragma unroll
        for (int ks = 0; ks < 2; ++ks) xf[ks] = *(const LAS bf16x8*)(xcb + (16 * w + fr) * 80 + 32 * ks + 8 * fq);
#pragma unroll
        for (int jb = 0; jb < 4; ++jb) {
            f32x4 ar = (f32x4){0.f, 0.f, 0.f, 0.f}, ai = (f32x4){0.f, 0.f, 0.f, 0.f};
#pragma unroll
            for (int ks = 0; ks < 2; ++ks) { const bf16x8 wf = *(const LAS bf16x8*)(wrT + (jb * 16 + fr) * 80 + 32 * ks + 8 * fq); ar = MFMA16(xf[ks], wf, ar);
                const bf16x8 wf2 = *(const LAS bf16x8*)(wiT + (jb * 16 + fr) * 80 + 32 * ks + 8 * fq); ai = MFMA16(xf[ks], wf2, ai); }
            const int j = jb * 16 + fr, chj = l * 512 + hb * 64 + j;
            const float br = C.in[I_BR][chj], bi = C.in[I_BI][chj], sp8 = -8.f * C.spl[chj];
#pragma unroll
            for (int e = 0; e < 4; ++e) { const int t = 16 * w + 4 * fq + e;
                const float r = sigmoid_f(ar[e] + br), ig = sigmoid_f(ai[e] + bi);
                const float a = __expf(r * sp8); const float mult = __builtin_amdgcn_sqrtf(fmaxf(1.f - a * a, 0.f));
                aa[t * 64 + j] = a; bb[t * 64 + j] = xcf[t * 64 + j] * ig * mult; }
        }
    }
    __syncthreads();
    const int j = tid & 63, sg = tid >> 6;
    {
        float hh = 0.f, P = 1.f;
#pragma unroll 4
        for (int k = 0; k < 16; ++k) { const int t = sg * 16 + k; const float a = aa[t * 64 + j]; hh = a * hh + bb[t * 64 + j]; P *= a; aa[t * 64 + j] = P; bb[t * 64 + j] = hh; }
        segA[sg * 64 + j] = P; segH[sg * 64 + j] = hh;
    }
    __syncthreads();
    {
        float Hc = 0.f, Pc = 1.f;
        for (int s2 = 0; s2 < sg; ++s2) { const float a = segA[s2 * 64 + j]; Hc = a * Hc + segH[s2 * 64 + j]; Pc *= a; }
        const int chj = hb * 64 + j;
        float hl = 0.f, pl = 1.f;
#pragma unroll 4
        for (int k = 0; k < 16; ++k) { const int t = sg * 16 + k; hl = bb[t * 64 + j] + aa[t * 64 + j] * Hc; pl = aa[t * 64 + j] * Pc;
            const float G = bf2f(C.za[(size_t)(row0 + t) * NZA + 1536 + chj]);
            C.ly[(size_t)(row0 + t) * 512 + chj] = G * hl; C.lp[(size_t)(row0 + t) * 512 + chj] = G * pl; }
        if (sg == 7) { C.carryA[(size_t)tile * 512 + chj] = pl; C.carryH[(size_t)tile * 512 + chj] = hl; }
    }
    __syncthreads();
}

__device__ __forceinline__ void fix_item(const Ctx& C, int tile, int half) {
    const int c = opaque_tid(), b = tile >> 6, nb = tile & 63, row0 = tile * 128 + half * 64;
    float H = 0.f;
    for (int jn = 0; jn < nb; ++jn) { const size_t idx = (size_t)(b * 64 + jn) * 512 + c; H = C.carryA[idx] * H + C.carryH[idx]; }
    for (int t = 0; t < 64; ++t) { const size_t r = (size_t)(row0 + t); C.o[r * NO + 512 + c] = (bf16_t)f2bf(C.ly[r * 512 + c] + C.lp[r * 512 + c] * H); }
}

__global__ void __launch_bounds__(512, 2) fwd_megakernel(Args args) {
    extern __shared__ __attribute__((aligned(16))) unsigned char lds_raw[];
    LAS unsigned char* lds = (LAS unsigned char*)lds_raw;
    volatile LAS unsigned* MISC = (volatile LAS unsigned*)(lds + MISC_OFF);
    const int tid = threadIdx.x, lane = tid & 63, wave = __builtin_amdgcn_readfirstlane(tid >> 6);
    const int G = gridDim.x, bx = blockIdx.x;
    unsigned char* ws = args.ws;
    Ctx C;
    C.in = args.in; C.x = args.out;
    C.wt_in = (bf16_t*)(ws + WS_WIN); C.wt_br = (bf16_t*)(ws + WS_WBR); C.wt_out = (bf16_t*)(ws + WS_WOUT); C.wt_ff1 = (bf16_t*)(ws + WS_WFF1); C.wt_ff2 = (bf16_t*)(ws + WS_WFF2); C.wt_kv = (bf16_t*)(ws + WS_WKV);
    C.memn = (bf16_t*)(ws + WS_MEMN); C.memkv = (bf16_t*)(ws + WS_MEMKV); C.xb = (bf16_t*)(ws + WS_XB); C.za = (bf16_t*)(ws + WS_ZA); C.zg = (bf16_t*)(ws + WS_ZG); C.mb = (bf16_t*)(ws + WS_MB); C.o = (bf16_t*)(ws + WS_O);
    C.ssq = (float*)(ws + WS_SSQ); C.carryA = (float*)(ws + WS_CARRY); C.carryH = C.carryA + 128 * 512; C.S = (float*)(ws + WS_S); C.ly = (float*)(ws + WS_LY); C.lp = (float*)(ws + WS_LP); C.memK = (bf16_t*)(ws + WS_MEMK); C.memVt = (bf16_t*)(ws + WS_MEMVT); C.spl = (float*)(ws + WS_SPL);

    if (tid < 64) MISC[tid] = 0u;
    __syncthreads();
    XcdBarrier bar = xcd_barrier_post((unsigned*)(ws + WS_CTL), MISC + 8);
    const int gw = bx * 8 + wave, NGW = G * 8;
    LAS float* scr = (LAS float*)(lds + wave * 16384);

    for (int it = gw; it < IT_WIN + 4 * IT_WKV; it += NGW) {
        if (it < IT_WIN) conv_w(C, 0, 0, it, scr, lane);
        else { const int r = it - IT_WIN; conv_w(C, 5, r / IT_WKV, r % IT_WKV, scr, lane); }
    }
    for (int m = gw; m < M + 512; m += NGW) {
        if (m < M) {
            const f32x4* xr = (const f32x4*)(C.in[I_X] + (size_t)m * D) + lane; f32x4 v[4]; float s = 0.f;
#pragma unroll
            for (int jj = 0; jj < 4; ++jj) { v[jj] = xr[64 * jj]; s += (v[jj].x * v[jj].x + v[jj].y * v[jj].y) + (v[jj].z * v[jj].z + v[jj].w * v[jj].w); }
            s = wave_sum(s);
            f32x4* xo = (f32x4*)(C.x + (size_t)m * D) + lane; u32x2* bo = (u32x2*)(C.xb + (size_t)m * D) + lane;
#pragma unroll
            for (int jj = 0; jj < 4; ++jj) { xo[64 * jj] = v[jj]; bo[64 * jj] = (u32x2){pk2(v[jj].x, v[jj].y), pk2(v[jj].z, v[jj].w)}; }
            if (lane < 16) C.ssq[(size_t)m * 16 + lane] = (lane == 0) ? s : 0.f;
        } else {
            const int r = m - M;
            const f32x4* xr = (const f32x4*)(C.in[I_MEM] + (size_t)r * D) + lane; f32x4 v[4]; float s = 0.f;
#pragma unroll
            for (int jj = 0; jj < 4; ++jj) { v[jj] = xr[64 * jj]; s += (v[jj].x * v[jj].x + v[jj].y * v[jj].y) + (v[jj].z * v[jj].z + v[jj].w * v[jj].w); }
            s = wave_sum(s); const float rs = rsqrtf(s * (1.f / 1024.f) + EPS);
            u32x2* bo = (u32x2*)(C.memn + (size_t)r * D) + lane;
#pragma unroll
            for (int jj = 0; jj < 4; ++jj) bo[64 * jj] = (u32x2){pk2(v[jj].x * rs, v[jj].y * rs), pk2(v[jj].z * rs, v[jj].w * rs)};
        }
    }
    { const int gt = bx * 512 + tid; if (gt < DEPTH * 512) C.spl[gt] = log1pf(expf(-C.in[I_LAM][gt])); }
    __syncthreads();
    cg::this_grid().sync();
    xcd_barrier(bar);

    {
#ifndef SKIP_KV
        pg8::Gemm g{C.memn, C.wt_kv}; pg8::SchedKV S{bx}; pg8::EpiKV E{C.memkv};
        pg8::gemm_phase<pg8::EpiKV, pg8::SchedKV, true, D, D, D>(lds, g, S, E);
#endif

    }
    xcd_barrier(bar);
    kvprep_phase(C, gw, NGW, lane);

    for (int l = 0; l < DEPTH; ++l) {
        {
#ifndef SKIP_G1
            pg8::Gemm g{C.xb, C.wt_in}; pg8::SchedStd S; S.init(M, DIN, G, bx, D, D);
            pg8::EpiZ E{C.za, C.zg, C.ssq, C.in[I_BGATE] + (size_t)l * 4 * D};
            for (int rep = 0; rep < REP_G1; ++rep) pg8::gemm_phase<pg8::EpiZ, pg8::SchedStd, true, D, D, D>(lds, g, S, E);
#endif

        }
        xcd_barrier(bar);
        {
#if USE_MFMA_SWA
            for (int rep = 0; rep < REP_SWA; ++rep) for (int it = bx; it < 256; it += G) swa_item_mfma(lds, C, l, it >> 1, it & 1);
#else
            for (int it = bx; it < 1024; it += G) swa_item(lds, C, l, it >> 3, it & 7);
#endif
#if USE_MFMA_XA
            for (int rep = 0; rep < REP_XA; ++rep) for (int it = bx; it < 256; it += G) xa_pair_mfma(lds, C, l, it);
#else
            for (int it = bx; it < 512; it += G) xa_item(lds, C, l, it >> 2, it & 3);
#endif
#if USE_MFMA_GM
            for (int rep = 0; rep < REP_GM; ++rep) for (int it = bx; it < 512; it += G) gm_item_mfma(lds, C, l, it >> 2, it & 3);
#else
            for (int it = bx; it < 512; it += G) gm_item(lds, C, l, it >> 2, it & 3);
#endif
#if USE_MFMA_LRU
            for (int rep = 0; rep < REP_LRU; ++rep) for (int it = bx; it < 1024; it += G) lru_item_mfma(lds, C, l, it >> 3, it & 7);
#else
            for (int it = bx; it < 1024; it += G) lru_item(lds, C, l, it >> 3, it & 7);
#endif
            const int lane_c = opaque_tid() & 63;
            const int NC = IT_WBR + IT_WOUT + IT_WFF1 + IT_WFF2 + (l + 1 < DEPTH ? IT_WIN : 0);
            for (int rep = 0; rep < REP_CONV; ++rep) for (int it = gw; it < NC; it += NGW) {
                int r = it;
                if (r < IT_WBR) { conv_w(C, 1, l, r, scr, lane_c); continue; } r -= IT_WBR;
                if (r < IT_WOUT) { conv_w(C, 2, l, r, scr, lane_c); continue; } r -= IT_WOUT;
                if (r < IT_WFF1) { conv_w(C, 3, l, r, scr, lane_c); continue; } r -= IT_WFF1;
                if (r < IT_WFF2) { conv_w(C, 4, l, r, scr, lane_c); continue; } r -= IT_WFF2;
                conv_w(C, 0, l + 1, r, scr, lane_c);
            }
            __syncthreads();
        }
        xcd_barrier(bar);
        for (int rep = 0; rep < REP_FIX; ++rep) for (int it = bx; it < 256; it += G) fix_item(C, it >> 1, it & 1);
        for (int rep = 0; rep < REP_BAR; ++rep) xcd_barrier(bar);
        {
#ifndef SKIP_G2
            pg8::Gemm g{C.o, C.wt_br}; pg8::SchedMerge S; S.t.init(M, D, G, bx, NO, NO);
            pg8::EpiMerge E{C.zg, C.mb};
            for (int rep = 0; rep < REP_G2; ++rep) pg8::gemm_phase<pg8::EpiMerge, pg8::SchedMerge, true, NO, NO, 512>(lds, g, S, E);
#endif

        }
        xcd_barrier(bar);
        {
#ifndef SKIP_G3
            pg8::Gemm g{C.mb, C.wt_out}; pg8::SchedStd S; S.init(M, D, G, bx, D, D);
            pg8::EpiRes E{C.x, C.xb, C.ssq};
            pg8::gemm_phase<pg8::EpiRes, pg8::SchedStd, true, D, D, D>(lds, g, S, E);
#endif

        }
        xcd_barrier(bar);
        {
#ifndef SKIP_G4
            pg8::Gemm g{C.xb, C.wt_ff1}; pg8::SchedStd S; S.init(M, FF, G, bx, D, D);
            pg8::EpiFF1 E{C.zg, C.ssq};
            for (int rep = 0; rep < REP_G4; ++rep) pg8::gemm_phase<pg8::EpiFF1, pg8::SchedStd, true, D, D, D>(lds, g, S, E);
#endif

        }
        xcd_barrier(bar);
        {
#ifndef SKIP_G5
            pg8::Gemm g{C.zg, C.wt_ff2}; pg8::SchedStd S; S.init(M, D, G, bx, FF, FF);
            pg8::EpiRes E{C.x, C.xb, C.ssq};
            pg8::gemm_phase<pg8::EpiRes, pg8::SchedStd, true, FF, FF, FF>(lds, g, S, E);
#endif

        }
        if (l + 1 < DEPTH) xcd_barrier(bar);
    }
}

extern "C" void kernel_launch(void* const* d_in, const int* in_sizes, int n_in, void* d_out, int out_size, void* d_ws, size_t ws_size, hipStream_t stream) {
    static int grid = 0;
    if (grid == 0) {
        if (n_in != 27 || out_size != M * D || ws_size < WS_END) { fprintf(stderr, "kernel_launch: unexpected shapes: n_in %d out %d ws %zu (need %zu)\n", n_in, out_size, ws_size, (size_t)WS_END); grid = -1; return; }
        int dev = 0, cus = 0, per_cu = 0;
        hipGetDevice(&dev); hipDeviceGetAttribute(&cus, hipDeviceAttributeMultiprocessorCount, dev);
        if (hipFuncSetAttribute((const void*)fwd_megakernel, hipFuncAttributeMaxDynamicSharedMemorySize, LDS_BYTES) != hipSuccess) { fprintf(stderr, "kernel_launch: hipFuncSetAttribute failed\n"); grid = -1; return; }
        if (hipOccupancyMaxActiveBlocksPerMultiprocessor(&per_cu, (const void*)fwd_megakernel, 512, LDS_BYTES) != hipSuccess || per_cu < 1) { fprintf(stderr, "kernel_launch: occupancy query says %d\n", per_cu); per_cu = 1; }
        (void)hipGetLastError();
        grid = cus;
        if (grid != 256) fprintf(stderr, "kernel_launch: note: %d CUs\n", grid);
    }
    if (grid < 0) return;
    hipMemsetAsync((char*)d_ws + WS_CTL, 0, CTL_ZERO_BYTES, stream);
    Args a{};
    for (int i = 0; i < 27; ++i) a.in[i] = (const float*)d_in[i];
    a.out = (float*)d_out; a.ws = (unsigned char*)d_ws;
    void* kargs[] = {&a};
    hipError_t e = hipLaunchCooperativeKernel((const void*)fwd_megakernel, dim3(grid), dim3(512), kargs, LDS_BYTES, stream);
    if (e != hipSuccess) fprintf(stderr, "kernel_launch: cooperative launch failed: %s\n", hipGetErrorString(e));
}
```

```cpp
#include <hip/hip_runtime.h>
#include <hip/hip_cooperative_groups.h>
#include <cstdio>
#include <cstdint>
namespace cg = cooperative_groups;

#define LAS __attribute__((address_space(3)))
#define GAS __attribute__((address_space(1)))
typedef unsigned short bf16_t;
typedef short bf16x8 __attribute__((ext_vector_type(8)));
typedef float f32x4 __attribute__((ext_vector_type(4)));
typedef unsigned u32x4 __attribute__((ext_vector_type(4)));
typedef unsigned u32x2 __attribute__((ext_vector_type(2)));

constexpr int M = 16384, D = 1024, DIN = 7424, NZA = 3328, NZG = 4096, FF = 4096, DEPTH = 4, NO = 2048;
constexpr float EPS = 1e-6f;
constexpr size_t MiB = 1u << 20;
constexpr size_t WS_CTL = 0, CTL_ZERO_BYTES = 64 * 1024;
constexpr size_t WS_WIN = 2 * MiB, WS_WBR = 17 * MiB, WS_WOUT = 21 * MiB, WS_WFF1 = 23 * MiB, WS_WFF2 = 31 * MiB, WS_WKV = 39 * MiB;
constexpr size_t WS_MEMN = 47 * MiB, WS_MEMKV = 48 * MiB, WS_SSQ = 52 * MiB, WS_CARRY = 53 * MiB, WS_XB = 54 * MiB;
constexpr size_t WS_ZA = 86 * MiB, WS_S = 86 * MiB, WS_MB = 150 * MiB, WS_ZG = 190 * MiB, WS_O = 318 * MiB, WS_LY = 382 * MiB, WS_LP = 414 * MiB, WS_MEMK = 446 * MiB, WS_MEMVT = 448 * MiB, WS_SPL = 450 * MiB, WS_END = 451 * MiB;
static_assert(WS_ZA + (size_t)M * NZA * 2 <= WS_ZG && WS_MB + (size_t)M * D * 2 <= WS_ZG && WS_WIN + (size_t)DIN * D * 2 <= WS_WBR, "ws map");

constexpr int LDS_BYTES = 147456, MISC_OFF = LDS_BYTES - 256;

__device__ __forceinline__ float bf2f(bf16_t h) { return __uint_as_float((unsigned)h << 16); }
__device__ __forceinline__ unsigned f2bf(float f) { unsigned u = __float_as_uint(f); return (u + 0x7fffu + ((u >> 16) & 1u)) >> 16; }
__device__ __forceinline__ unsigned pk2(float lo, float hi) { return f2bf(lo) | (f2bf(hi) << 16); }
__device__ __forceinline__ unsigned cvt_pk_bf16(float lo, float hi) { unsigned r; asm volatile("v_cvt_pk_bf16_f32 %0, %1, %2" : "=v"(r) : "v"(lo), "v"(hi)); return r; }
#define UNPACK8(VV, f, o) do { (f)[(o) + 0] = __uint_as_float((VV)[0] << 16); (f)[(o) + 1] = __uint_as_float((VV)[0] & 0xffff0000u); (f)[(o) + 2] = __uint_as_float((VV)[1] << 16); (f)[(o) + 3] = __uint_as_float((VV)[1] & 0xffff0000u); \
    (f)[(o) + 4] = __uint_as_float((VV)[2] << 16); (f)[(o) + 5] = __uint_as_float((VV)[2] & 0xffff0000u); (f)[(o) + 6] = __uint_as_float((VV)[3] << 16); (f)[(o) + 7] = __uint_as_float((VV)[3] & 0xffff0000u); } while (0)
#define PACK8(f, o) ((u32x4){pk2((f)[(o) + 0], (f)[(o) + 1]), pk2((f)[(o) + 2], (f)[(o) + 3]), pk2((f)[(o) + 4], (f)[(o) + 5]), pk2((f)[(o) + 6], (f)[(o) + 7])})
__device__ __forceinline__ float gelu_t(float x) { const float u = 0.7978845608028654f * (x + 0.044715f * x * x * x); return x * __builtin_amdgcn_rcpf(1.f + __expf(-2.f * u)); }
__device__ __forceinline__ float sigmoid_f(float x) { return __builtin_amdgcn_rcpf(1.f + __expf(-x)); }
__device__ __forceinline__ float row_rstd(const float* ssq, int row) {
    const f32x4* p = (const f32x4*)(ssq + (size_t)row * 16);
    const f32x4 a = p[0], b = p[1], c = p[2], d = p[3];
    const float s = (((a.x + a.y) + (a.z + a.w)) + ((b.x + b.y) + (b.z + b.w))) + (((c.x + c.y) + (c.z + c.w)) + ((d.x + d.y) + (d.z + d.w)));
    return rsqrtf(s * (1.f / 1024.f) + EPS);
}
#define LDS_WAIT() asm volatile("s_waitcnt lgkmcnt(0)" ::: "memory")
__device__ __forceinline__ int opaque_tid() { int t = threadIdx.x; asm volatile("" : "+v"(t)); return t; }

namespace pg8 {
constexpr int BM = 256, BK = 64, HALF = 128, HTB = HALF * BK * 2, STAGE_BYTES = 8 * HTB, NXCD = 8, WGM = 8;
__host__ __device__ __forceinline__ int lds_byte(int r, int c) { const int st = (r >> 4) * 2 + (c >> 5), rr = r & 15, cc = c & 31, ob = rr * 64 + cc * 2; return st * 1024 + (ob ^ (((ob >> 9) & 1) << 5)); }
__host__ __device__ __forceinline__ void stage_rc(int b, int& R, int& C) { const int st = b / 1024, sb = b % 1024, swz = sb ^ (((sb >> 9) & 1) << 5); R = (st >> 1) * 16 + swz / 64; C = (st & 1) * 32 + (swz % 64) / 2; }
__host__ __device__ __forceinline__ int perm32(int rho) { const int n = rho >> 4, i = rho & 15; return 8 * (i >> 2) + 4 * n + (i & 3); }

struct Unit { int pm, pn, b; };
struct Gemm { const bf16_t* A; const bf16_t* Bt; };

struct SchedStd {
    int nM, nN, nwg, G, c; size_t as, bs;
    __device__ void init(int M_, int N_, int G_, int c_, int lda, int ldb) { nM = M_ / BM; nN = N_ / BM; nwg = nM * nN; G = G_; c = c_; as = (size_t)BM * lda * 2; bs = (size_t)BM * ldb * 2; }
    __device__ bool tile(long L, Unit& u) const {
        if (L >= nwg) return false;
        int wgid = (int)L; { const int q = nwg / NXCD, r = nwg % NXCD, xcd = wgid % NXCD, off = wgid / NXCD; wgid = (xcd < r ? xcd * (q + 1) : r * (q + 1) + (xcd - r) * q) + off; }
        const int nig = WGM * nN, gid = wgid / nig, fm = gid * WGM, gsz = (nM - fm) < WGM ? (nM - fm) : WGM;
        u.pm = fm + ((wgid % nig) % gsz); u.pn = (wgid % nig) / gsz; u.b = 0; return true;
    }
    __device__ bool next(int i, Unit& u) const { return tile((long)i * G + c, u); }
    __device__ size_t aoff(const Unit& u) const { return (size_t)u.pm * as; }
    __device__ size_t boff(const Unit& u) const { return (size_t)u.pn * bs; }
};
struct SchedMerge {
    SchedStd t;
    __device__ bool next(int i, Unit& u) const { if (!t.tile((long)(i >> 2) * t.G + t.c, u)) return false; u.b = i & 3; return true; }
    __device__ size_t aoff(const Unit& u) const { return (size_t)u.pm * t.as + (size_t)u.b * 1024; }
    __device__ size_t boff(const Unit& u) const { return (size_t)u.pn * t.bs + (size_t)u.b * 1024; }
};
struct SchedKV {
    int c;
    __device__ bool next(int i, Unit& u) const { if (i > 0 || c >= 32) return false; u.b = c >> 3; u.pm = (c & 7) >> 2; u.pn = c & 3; return true; }
    __device__ size_t aoff(const Unit& u) const { return (size_t)u.pm * 256 * 1024 * 2; }
    __device__ size_t boff(const Unit& u) const { return ((size_t)u.b * 1024 + (size_t)u.pn * 256) * 1024 * 2; }
};

struct EpiZ {
    static constexpr bool PERM = true, KEEPS = false;
    bf16_t* za; bf16_t* zg; const float* ssq; const float* bgate;
    __device__ __forceinline__ void operator()(const f32x4 (&acc)[2][2][4][2], const Unit& u, int wr, int wc, int fr, int fq) const {
        const int row0 = u.pm * BM + wr * 64 + fr, pn = u.pn;
        bf16_t* base; int ldc, colt, mode;
        if (pn < 13) { base = za; ldc = NZA; colt = pn * 256; mode = (pn < 4 || pn == 6 || pn == 7) ? 1 : 0; }
        else { base = zg; ldc = NZG; colt = (pn - 13) * 256; mode = 2; }
        const int col0 = colt + wc * 32 + 8 * fq;
        f32x4 bv[2][2];
#pragma unroll
        for (int bj = 0; bj < 2; ++bj)
#pragma unroll
            for (int n = 0; n < 2; ++n) bv[bj][n] = (mode == 2) ? *(const f32x4*)(bgate + col0 + bj * HALF + 4 * n) : (f32x4){0.f, 0.f, 0.f, 0.f};
#pragma unroll
        for (int ai = 0; ai < 2; ++ai) {
            float rsm[4];
#pragma unroll
            for (int m = 0; m < 4; ++m) rsm[m] = row_rstd(ssq, row0 + ai * HALF + m * 16);
            asm volatile("" ::: "memory");
#pragma unroll
            for (int m = 0; m < 4; ++m) {
                const int row = row0 + ai * HALF + m * 16; const float rs = rsm[m];
                bf16_t* rowp = base + (size_t)row * ldc + col0;
#pragma unroll
                for (int bj = 0; bj < 2; ++bj) {
                    f32x4 v0 = acc[ai][bj][m][0] * rs, v1 = acc[ai][bj][m][1] * rs;
                    if (mode == 1) {
#pragma unroll
                        for (int e = 0; e < 4; ++e) { v0[e] = gelu_t(v0[e]); v1[e] = gelu_t(v1[e]); }
                    } else if (mode == 2) {
                        v0 = v0 + bv[bj][0]; v1 = v1 + bv[bj][1];
#pragma unroll
                        for (int e = 0; e < 4; ++e) { v0[e] = sigmoid_f(v0[e]); v1[e] = sigmoid_f(v1[e]); }
                    }
                    u32x4 w; w.x = cvt_pk_bf16(v0[0], v0[1]); w.y = cvt_pk_bf16(v0[2], v0[3]); w.z = cvt_pk_bf16(v1[0], v1[1]); w.w = cvt_pk_bf16(v1[2], v1[3]);
                    *(u32x4*)(rowp + bj * HALF) = w;
                }
            }
            asm volatile("" ::: "memory");
        }
    }
};
struct EpiFF1 {
    static constexpr bool PERM = true, KEEPS = false;
    bf16_t* f; const float* ssq;
    __device__ __forceinline__ void operator()(const f32x4 (&acc)[2][2][4][2], const Unit& u, int wr, int wc, int fr, int fq) const {
        const int row0 = u.pm * BM + wr * 64 + fr, col0 = u.pn * BM + wc * 32 + 8 * fq;
#pragma unroll
        for (int ai = 0; ai < 2; ++ai) {
            float rsm[4];
#pragma unroll
            for (int m = 0; m < 4; ++m) rsm[m] = row_rstd(ssq, row0 + ai * HALF + m * 16);
            asm volatile("" ::: "memory");
#pragma unroll
            for (int m = 0; m < 4; ++m) {
                const int row = row0 + ai * HALF + m * 16; const float rs = rsm[m];
                bf16_t* rowp = f + (size_t)row * FF + col0;
#pragma unroll
                for (int bj = 0; bj < 2; ++bj) {
                    f32x4 v0 = acc[ai][bj][m][0] * rs, v1 = acc[ai][bj][m][1] * rs;
#pragma unroll
                    for (int e = 0; e < 4; ++e) { const float a = fmaxf(v0[e], 0.f), b = fmaxf(v1[e], 0.f); v0[e] = a * a; v1[e] = b * b; }
                    u32x4 w; w.x = cvt_pk_bf16(v0[0], v0[1]); w.y = cvt_pk_bf16(v0[2], v0[3]); w.z = cvt_pk_bf16(v1[0], v1[1]); w.w = cvt_pk_bf16(v1[2], v1[3]);
                    *(u32x4*)(rowp + bj * HALF) = w;
                }
            }
            asm volatile("" ::: "memory");
        }
    }
};
struct EpiRes {
    static constexpr bool PERM = true, KEEPS = false;
    float* x; bf16_t* xb; float* ssq;
    __device__ __forceinline__ void operator()(const f32x4 (&acc)[2][2][4][2], const Unit& u, int wr, int wc, int fr, int fq) const {
        const int row0 = u.pm * BM + wr * 64 + fr, col0 = u.pn * BM + wc * 32 + 8 * fq;
#pragma unroll
        for (int ai = 0; ai < 2; ++ai) {
            f32x4 xo[4][2][2];
#pragma unroll
            for (int m = 0; m < 4; ++m)
#pragma unroll
                for (int bj = 0; bj < 2; ++bj) { const float* xp = x + (size_t)(row0 + ai * HALF + m * 16) * D + col0 + bj * HALF; xo[m][bj][0] = *(const f32x4*)xp; xo[m][bj][1] = *(const f32x4*)(xp + 4); }
            asm volatile("" ::: "memory");
#pragma unroll
            for (int m = 0; m < 4; ++m) {
                const int row = row0 + ai * HALF + m * 16; float ss = 0.f;
#pragma unroll
                for (int bj = 0; bj < 2; ++bj) {
                    float* xp = x + (size_t)row * D + col0 + bj * HALF;
                    const f32x4 v0 = xo[m][bj][0] + acc[ai][bj][m][0], v1 = xo[m][bj][1] + acc[ai][bj][m][1];
                    *(f32x4*)xp = v0; *(f32x4*)(xp + 4) = v1;
                    ss += (v0[0] * v0[0] + v0[1] * v0[1]) + (v0[2] * v0[2] + v0[3] * v0[3]) + (v1[0] * v1[0] + v1[1] * v1[1]) + (v1[2] * v1[2] + v1[3] * v1[3]);
                    u32x4 w; w.x = cvt_pk_bf16(v0[0], v0[1]); w.y = cvt_pk_bf16(v0[2], v0[3]); w.z = cvt_pk_bf16(v1[0], v1[1]); w.w = cvt_pk_bf16(v1[2], v1[3]);
                    *(u32x4*)(xb + (size_t)row * D + col0 + bj * HALF) = w;
                }
                ss += __shfl_xor(ss, 16); ss += __shfl_xor(ss, 32);
                if (fq == 0) ssq[(size_t)row * 16 + u.pn * 4 + wc] = ss;
            }
            asm volatile("" ::: "memory");
        }
    }
};
struct EpiMerge {
    static constexpr bool PERM = true, KEEPS = true;
    const bf16_t* zg; bf16_t* mb;
    __device__ __forceinline__ bool merge(f32x4 (&acc)[2][2][4][2], const Unit& u, int wr, int wc, int fr, int fq) const {
        const int row0 = u.pm * BM + wr * 64 + fr, col0 = u.pn * BM + wc * 32 + 8 * fq, b = u.b, bn = b < 3 ? b + 1 : b;
#pragma unroll
        for (int ai = 0; ai < 2; ++ai) {
            u32x4 ga[4][2], gb[4][2];
#pragma unroll
            for (int m = 0; m < 4; ++m)
#pragma unroll
                for (int bj = 0; bj < 2; ++bj) { const bf16_t* gp = zg + (size_t)(row0 + ai * HALF + m * 16) * NZG + col0 + bj * HALF; ga[m][bj] = *(const u32x4*)(gp + b * 1024); gb[m][bj] = *(const u32x4*)(gp + bn * 1024); }
            asm volatile("" ::: "memory");
#pragma unroll
            for (int m = 0; m < 4; ++m) {
                const int row = row0 + ai * HALF + m * 16;
#pragma unroll
                for (int bj = 0; bj < 2; ++bj) {
                    const int col = col0 + bj * HALF;
                    float g[8]; UNPACK8(ga[m][bj], g, 0);
#pragma unroll
                    for (int e = 0; e < 8; ++e) g[e] = fmaxf(g[e], 1e-20f);
                    if (b < 3) {
                        float h[8]; UNPACK8(gb[m][bj], h, 0);
#pragma unroll
                        for (int e = 0; e < 8; ++e) g[e] *= __builtin_amdgcn_rcpf(fmaxf(h[e], 1e-20f));
                    }
#pragma unroll
                    for (int e = 0; e < 4; ++e) { acc[ai][bj][m][0][e] *= g[e]; acc[ai][bj][m][1][e] *= g[4 + e]; }
                    if (b == 3) { const f32x4 v0 = acc[ai][bj][m][0], v1 = acc[ai][bj][m][1];
                        u32x4 w; w.x = cvt_pk_bf16(v0[0], v0[1]); w.y = cvt_pk_bf16(v0[2], v0[3]); w.z = cvt_pk_bf16(v1[0], v1[1]); w.w = cvt_pk_bf16(v1[2], v1[3]);
                        *(u32x4*)(mb + (size_t)row * D + col) = w; }
                }
            }
            asm volatile("" ::: "memory");
        }
        return b < 3;
    }
};
struct EpiKV {
    static constexpr bool PERM = true, KEEPS = false;
    bf16_t* out;
    __device__ __forceinline__ void operator()(const f32x4 (&acc)[2][2][4][2], const Unit& u, int wr, int wc, int fr, int fq) const {
        const int row0 = u.pm * BM + wr * 64 + fr, col0 = u.pn * BM + wc * 32 + 8 * fq;
        bf16_t* base = out + (size_t)u.b * 512 * 1024;
#pragma unroll
        for (int ai = 0; ai < 2; ++ai)
#pragma unroll
            for (int m = 0; m < 4; ++m) {
                const int row = row0 + ai * HALF + m * 16;
#pragma unroll
                for (int bj = 0; bj < 2; ++bj) {
                    const f32x4 v0 = acc[ai][bj][m][0], v1 = acc[ai][bj][m][1];
                    u32x4 w; w.x = cvt_pk_bf16(v0[0], v0[1]); w.y = cvt_pk_bf16(v0[2], v0[3]); w.z = cvt_pk_bf16(v1[0], v1[1]); w.w = cvt_pk_bf16(v1[2], v1[3]);
                    *(u32x4*)(base + (size_t)row * 1024 + col0 + bj * HALF) = w;
                }
            }
    }
};

template <class Epi, class Sched, bool ALIGN_EPI, int LDA, int LDB, int KK>
__device__ __forceinline__ void gemm_phase(LAS unsigned char* lds, const Gemm g, const Sched& S, const Epi& E) {
    const int tid = opaque_tid(), wid = __builtin_amdgcn_readfirstlane(tid >> 6), lane = tid & 63, wr = wid >> 2, wc = wid & 3, fr = lane & 15, fq = lane >> 4;
    constexpr int nt = KK / BK;
    unsigned voffA[2], voffB[2];
#pragma unroll
    for (int i = 0; i < 2; ++i) { int R, C; stage_rc(tid * 16 + i * 8192, R, C); const int Rb = Epi::PERM ? ((R & ~31) + perm32(R & 31)) : R;
        voffA[i] = (unsigned)(R * LDA + C) * 2u; voffB[i] = (unsigned)(Rb * LDB + C) * 2u; }
    constexpr size_t kstep = (size_t)(BK * 2);
    constexpr size_t hstepA = (size_t)HALF * LDA * 2, hstepB = (size_t)HALF * LDB * 2;
    const unsigned ldsw = (unsigned)wid * 1024u;
    const int aoff = lds_byte(wr * 64 + fr, fq * 8), boff = lds_byte(wc * 32 + fr, fq * 8);
#define PG8_SA(b, h) (((b) * 2 + (h)) * HTB)
#define PG8_SB(b, h) ((4 + (b) * 2 + (h)) * HTB)
#define PG8_STAGE(bufoff, gbase, voff) do { _Pragma("unroll") for (int _i = 0; _i < 2; ++_i) \
        __builtin_amdgcn_global_load_lds((const unsigned*)((const char*)(gbase) + (voff)[_i]), (LAS unsigned*)(lds + (bufoff) + ldsw + _i * 8192), 16, 0, 0); } while (0)
#define PG8_LDA(dst, b, h) do { _Pragma("unroll") for (int m = 0; m < 4; ++m) _Pragma("unroll") for (int k = 0; k < 2; ++k) dst[m][k] = *(const LAS bf16x8*)(lds + PG8_SA(b, h) + aoff + m * 2048 + k * 1024); } while (0)
#define PG8_LDB(dst, b, h) do { _Pragma("unroll") for (int n = 0; n < 2; ++n) _Pragma("unroll") for (int k = 0; k < 2; ++k) dst[n][k] = *(const LAS bf16x8*)(lds + PG8_SB(b, h) + boff + n * 2048 + k * 1024); } while (0)
#define PG8_MMA(ai, bj, At, Bt) do { __builtin_amdgcn_s_setprio(1); _Pragma("unroll") for (int m = 0; m < 4; ++m) _Pragma("unroll") for (int n = 0; n < 2; ++n) _Pragma("unroll") for (int k = 0; k < 2; ++k) \
        acc[ai][bj][m][n] = __builtin_amdgcn_mfma_f32_16x16x32_bf16(Bt[n][k], At[m][k], acc[ai][bj][m][n], 0, 0, 0); __builtin_amdgcn_s_setprio(0); } while (0)
#define PG8_WAIT_V(n) asm volatile("s_waitcnt vmcnt(" #n ")" ::: "memory")
#define PG8_WAIT_L(n) asm volatile("s_waitcnt lgkmcnt(" #n ")" ::: "memory")
#define PG8_BAR __builtin_amdgcn_s_barrier()
#define PG8_SCHED __builtin_amdgcn_sched_barrier(0)
    Unit cur, nxt; int ui = 0;
    if (!S.next(0, cur)) return;
    f32x4 acc[2][2][4][2];
#pragma unroll
    for (int a = 0; a < 2; ++a)
#pragma unroll
        for (int b = 0; b < 2; ++b)
#pragma unroll
            for (int m = 0; m < 4; ++m)
#pragma unroll
                for (int n = 0; n < 2; ++n) acc[a][b][m][n] = (f32x4){0.f, 0.f, 0.f, 0.f};
    bf16x8 At[4][2], B0[2][2], B1[2][2];
    const char* gA = (const char*)g.A; const char* gB = (const char*)g.Bt;
    asm volatile("" : "+s"(gA), "+s"(gB));
    const char* cA = gA + S.aoff(cur); const char* cB = gB + S.boff(cur);
    PG8_STAGE(PG8_SB(0, 0), cB, voffB); PG8_STAGE(PG8_SB(0, 1), cB + hstepB, voffB); PG8_STAGE(PG8_SA(0, 0), cA, voffA); PG8_STAGE(PG8_SA(0, 1), cA + hstepA, voffA);
    if (wr == 1) PG8_BAR;
    PG8_WAIT_V(2); PG8_BAR;
    PG8_STAGE(PG8_SB(1, 0), cB + kstep, voffB); PG8_STAGE(PG8_SA(1, 0), cA + kstep, voffA); PG8_STAGE(PG8_SB(1, 1), cB + hstepB + kstep, voffB);
    PG8_WAIT_V(6); PG8_BAR;
    for (;;) {
        const bool has_next = S.next(ui + 1, nxt);
        const char* nA = has_next ? gA + S.aoff(nxt) : cA; const char* nB = has_next ? gB + S.boff(nxt) : cB;
        for (int t = 0; t < nt; t += 2) {
            const bool last = (t == nt - 2);
            const char* a1 = cA + (size_t)(t + 1) * kstep;
            const char* a2 = last ? nA : cA + (size_t)(t + 2) * kstep; const char* b2 = last ? nB : cB + (size_t)(t + 2) * kstep;
            const char* a3 = a2 + kstep; const char* b3 = b2 + kstep;
            PG8_LDB(B0, 0, 0); PG8_LDB(B1, 0, 1); PG8_SCHED; PG8_LDA(At, 0, 0); PG8_STAGE(PG8_SA(1, 1), a1 + hstepA, voffA);
            PG8_WAIT_V(8); PG8_WAIT_L(0); PG8_BAR; PG8_MMA(0, 0, At, B0); PG8_MMA(0, 1, At, B1); PG8_BAR; PG8_SCHED;
            PG8_LDA(At, 0, 1); PG8_STAGE(PG8_SB(0, 0), b2, voffB); PG8_STAGE(PG8_SB(0, 1), b2 + hstepB, voffB); PG8_STAGE(PG8_SA(0, 0), a2, voffA);
            PG8_WAIT_V(8); PG8_WAIT_L(0); PG8_BAR; PG8_MMA(1, 0, At, B0); PG8_MMA(1, 1, At, B1); PG8_BAR; PG8_SCHED;
            PG8_LDB(B0, 1, 0); PG8_LDB(B1, 1, 1); PG8_SCHED; PG8_LDA(At, 1, 0); PG8_STAGE(PG8_SA(0, 1), a2 + hstepA, voffA);
            PG8_WAIT_V(8); PG8_WAIT_L(0); PG8_BAR; PG8_MMA(0, 0, At, B0); PG8_MMA(0, 1, At, B1); PG8_BAR; PG8_SCHED;
            PG8_LDA(At, 1, 1); PG8_STAGE(PG8_SB(1, 0), b3, voffB); PG8_STAGE(PG8_SB(1, 1), b3 + hstepB, voffB); PG8_STAGE(PG8_SA(1, 0), a3, voffA);
            PG8_WAIT_V(8); PG8_WAIT_L(0); PG8_BAR; PG8_MMA(1, 0, At, B0); PG8_MMA(1, 1, At, B1); PG8_BAR; PG8_SCHED;
        }
        if constexpr (ALIGN_EPI) { if (wr == 0) PG8_BAR; }
        bool keep = false;
        if constexpr (Epi::KEEPS) keep = E.merge(acc, cur, wr, wc, fr, fq); else E(acc, cur, wr, wc, fr, fq);
        if (!has_next) break;
        if (!keep)
#pragma unroll
        for (int a = 0; a < 2; ++a)
#pragma unroll
            for (int b = 0; b < 2; ++b)
#pragma unroll
                for (int m = 0; m < 4; ++m)
#pragma unroll
                    for (int n = 0; n < 2; ++n) acc[a][b][m][n] = (f32x4){0.f, 0.f, 0.f, 0.f};
        cur = nxt; cA = nA; cB = nB; ++ui;
        if constexpr (ALIGN_EPI) { if (wr == 1) PG8_BAR; }
    }
    PG8_WAIT_V(0);
    if constexpr (!ALIGN_EPI) { if (wr == 0) PG8_BAR; }
    PG8_BAR;
#undef PG8_SA
#undef PG8_SB
#undef PG8_STAGE
#undef PG8_LDA
#undef PG8_LDB
#undef PG8_MMA
#undef PG8_WAIT_V
#undef PG8_WAIT_L
#undef PG8_BAR
#undef PG8_SCHED
}
}

#define XB_TMO      128
#define XB_XCNT(j)  (256  + 64 * (j))
#define XB_XSUB(j)  (1280 + 64 * (j))
#define XB_XGEN(j)  (2304 + 64 * (j))
#define XB_TOP      3328
#define XB_TOPGEN   3392
#define XCD_BAR_WORDS 3456
#define XB_SPIN_CAP (1u << 23)
__device__ __forceinline__ unsigned xb_ld(unsigned* p)              { return __hip_atomic_load(p, __ATOMIC_RELAXED, __HIP_MEMORY_SCOPE_AGENT); }
__device__ __forceinline__ unsigned xb_add(unsigned* p, unsigned v) { return __hip_atomic_fetch_add(p, v, __ATOMIC_RELAXED, __HIP_MEMORY_SCOPE_AGENT); }
__device__ __forceinline__ unsigned xb_xcc_id() { return (unsigned)__builtin_amdgcn_s_getreg((3 << 11) | 20) & 0xFu; }
#define XB_SPIN(cond, bar) do { unsigned _sp = 0; while (cond) { __builtin_amdgcn_s_sleep(1); \
    if ((++_sp & 255u) == 0u) { if (xb_ld(&(bar)[XB_TMO])) break; if (_sp > XB_SPIN_CAP) { atomicAdd(&(bar)[XB_TMO], 1u); break; } } } } while (0)
struct XcdBarrier { unsigned* bar; unsigned x; volatile LAS unsigned* st; };
__device__ __forceinline__ XcdBarrier xcd_barrier_post(unsigned* bar, volatile LAS unsigned* st) {
    XcdBarrier b; b.bar = bar; b.x = xb_xcc_id(); b.st = st;
    if (threadIdx.x == 0) (void)xb_add(&bar[XB_XCNT(b.x)], 1u);
    return b;
}
__device__ __forceinline__ void xcd_barrier_complete(unsigned* bar, unsigned x, unsigned& nloc, unsigned& nx) {
    const unsigned G = gridDim.x * gridDim.y * gridDim.z;
    unsigned sum, cnt, mine, sp = 0u;
    for (;;) {
        sum = 0u; cnt = 0u; mine = 0u;
#pragma unroll
        for (unsigned j = 0; j < 16; ++j) { const unsigned c = xb_ld(&bar[XB_XCNT(j)]); sum += c; cnt += (c > 0u) ? 1u : 0u; mine = (j == x) ? c : mine; }
        if (sum == G) break;
        __builtin_amdgcn_s_sleep(1);
        if ((++sp & 255u) == 0u) { if (xb_ld(&bar[XB_TMO])) break; if (sp > XB_SPIN_CAP) { atomicAdd(&bar[XB_TMO], 1u); break; } }
    }
    nloc = mine > 0u ? mine : 1u; nx = cnt > 0u ? cnt : 1u;
}
__device__ __forceinline__ void xcd_barrier(const XcdBarrier& b) {
    asm volatile("s_waitcnt vmcnt(0)" ::: "memory");
    __syncthreads();
    if (threadIdx.x == 0) {
        unsigned* bar = b.bar;
        __builtin_amdgcn_s_waitcnt(0);
        unsigned nloc = b.st[0], nx = b.st[1];
        if (nloc == 0u) { xcd_barrier_complete(bar, b.x, nloc, nx); b.st[0] = nloc; b.st[1] = nx; }
        const unsigned old = xb_add(&bar[XB_XSUB(b.x)], 1u);
        const unsigned gen = old / nloc;
        if (old + 1u == (gen + 1u) * nloc) {
            __builtin_amdgcn_fence(__ATOMIC_RELEASE, "agent");
            asm volatile("s_waitcnt vmcnt(0)" ::: "memory");
            const unsigned og = xb_add(&bar[XB_TOP], 1u);
            const unsigned tg = og / nx;
            if (og + 1u == (tg + 1u) * nx) xb_add(&bar[XB_TOPGEN], 1u);
            else XB_SPIN(xb_ld(&bar[XB_TOPGEN]) == tg, bar);
            __builtin_amdgcn_fence(__ATOMIC_ACQUIRE, "agent");
            xb_add(&bar[XB_XGEN(b.x)], 1u);
            asm volatile("s_waitcnt vmcnt(0)" ::: "memory");
        } else {
            XB_SPIN(xb_ld(&bar[XB_XGEN(b.x)]) == gen, bar);
            __builtin_amdgcn_fence(__ATOMIC_ACQUIRE, "agent");
            asm volatile("s_waitcnt vmcnt(0)" ::: "memory");
        }
    }
    __syncthreads();
}

struct Args { const float* in[27]; float* out; unsigned char* ws; };
enum { I_X = 0, I_MEM, I_NMIX, I_NMEM, I_NMLP, I_WIN, I_BGATE, I_GMVG, I_GMWS, I_GMBS, I_CONVW, I_CONVB, I_WR, I_BR, I_WI, I_BI, I_LAM, I_SQG, I_SKG, I_SINK, I_WKV, I_XQG, I_XKG, I_WBR, I_WOUT, I_WFF1, I_WFF2 };
struct Ctx {
    const float* const* in; float* x;
    bf16_t *wt_in, *wt_br, *wt_out, *wt_ff1, *wt_ff2, *wt_kv, *memn, *memkv, *xb, *za, *zg, *mb, *o;
    float *ssq, *carryA, *carryH, *S, *ly, *lp;
    bf16_t *memK, *memVt;
    float* spl;
};

__device__ __forceinline__ void transpose_item(const float* W, int N, bf16_t* WT, int ldk, int koff, const float* gain, LAS float* scr, int item, int lane) {
    const int nblk = N / 32, kb = item / nblk, nb = item % nblk, k0 = 64 * kb, n0 = 32 * nb;
#pragma unroll 8
    for (int i = 0; i < 32; ++i) { const int kk = 2 * i + (lane >> 5); float v = W[(size_t)(k0 + kk) * N + n0 + (lane & 31)]; if (gain) v *= gain[k0 + kk]; scr[kk * 33 + (lane & 31)] = v; }
    LDS_WAIT(); asm volatile("" ::: "memory");
    const int c = lane & 7;
#pragma unroll
    for (int j = 0; j < 4; ++j) { const int n = (lane >> 3) + 8 * j; const LAS float* s = scr + (8 * c) * 33 + n;
        u32x4 o; o.x = pk2(s[0 * 33], s[1 * 33]); o.y = pk2(s[2 * 33], s[3 * 33]); o.z = pk2(s[4 * 33], s[5 * 33]); o.w = pk2(s[6 * 33], s[7 * 33]);
        *(u32x4*)(WT + (size_t)(n0 + n) * ldk + koff + k0 + 8 * c) = o; }
    LDS_WAIT(); asm volatile("" ::: "memory");
}
__device__ __forceinline__ float wave_sum(float v) {
#pragma unroll
    for (int o = 1; o < 64; o <<= 1) v += __shfl_xor(v, o);
    return v;
}
__device__ __forceinline__ void conv_w(const Ctx& C, int which, int l, int item, LAS float* scr, int lane) {
    if (which == 0) transpose_item(C.in[I_WIN] + (size_t)l * D * DIN, DIN, C.wt_in, D, 0, C.in[I_NMIX] + l * D, scr, item, lane);
    else if (which == 1) { const int b = item >> 8; transpose_item(C.in[I_WBR] + (size_t)(l * 4 + b) * 512 * D, D, C.wt_br, 2048, b * 512, nullptr, scr, item & 255, lane); }
    else if (which == 2) transpose_item(C.in[I_WOUT] + (size_t)l * D * D, D, C.wt_out, D, 0, nullptr, scr, item, lane);
    else if (which == 3) transpose_item(C.in[I_WFF1] + (size_t)l * D * FF, FF, C.wt_ff1, D, 0, C.in[I_NMLP] + l * D, scr, item, lane);
    else if (which == 4) transpose_item(C.in[I_WFF2] + (size_t)l * FF * D, D, C.wt_ff2, FF, 0, nullptr, scr, item, lane);
    else transpose_item(C.in[I_WKV] + (size_t)l * D * D, D, C.wt_kv + (size_t)l * D * D, D, 0, C.in[I_NMEM] + l * D, scr, item, lane);
}
constexpr int IT_WIN = 16 * 232, IT_WBR = 1024, IT_WOUT = 512, IT_WFF1 = 2048, IT_WFF2 = 2048, IT_WKV = 512;

#ifndef REP_SWA
#define REP_SWA 1
#endif
#ifndef REP_XA
#define REP_XA 1
#endif
#ifndef REP_GM
#define REP_GM 1
#endif
#ifndef REP_LRU
#define REP_LRU 1
#endif
#ifndef REP_CONV
#define REP_CONV 1
#endif
#ifndef REP_FIX
#define REP_FIX 1
#endif
#ifndef REP_G1
#define REP_G1 1
#endif
#ifndef REP_G2
#define REP_G2 1
#endif
#ifndef REP_G4
#define REP_G4 1
#endif
#ifndef REP_BAR
#define REP_BAR 1
#endif
#ifndef USE_MFMA_SWA
#define USE_MFMA_SWA 1
#endif
#ifndef USE_MFMA_XA
#define USE_MFMA_XA 1
#endif
#ifndef USE_MFMA_GM
#define USE_MFMA_GM 1
#endif
#ifndef USE_MFMA_LRU
#define USE_MFMA_LRU 1
#endif
#define ROPE_INV(i) ((i) == 0 ? 1.0f : (i) == 1 ? 0.19392274474868576f : (i) == 2 ? 0.03760603093086393f : (i) == 3 ? 0.007292664737217109f : (i) == 4 ? 0.001414213562373095f : (i) == 5 ? 0.0002742481756762073f : (i) == 6 ? 5.318295896944988e-05f : 1.031338537721246e-05f)
#define ROPE16(f, pos) do { _Pragma("unroll") for (int _i = 0; _i < 8; ++_i) { float _s, _c; sincosf((pos) * ROPE_INV(_i), &_s, &_c); const float _x1 = (f)[_i], _x2 = (f)[_i + 8]; (f)[_i] = _x1 * _c - _x2 * _s; (f)[_i + 8] = _x2 * _c + _x1 * _s; } } while (0)

__device__ __forceinline__ void swa_item(LAS unsigned char* lds, const Ctx& C, int l, int tile, int h) {
    const int tid = opaque_tid();
    LAS bf16_t* Ks = (LAS bf16_t*)lds;
    LAS bf16_t* Vs = Ks + 256 * 72;
    const int kvh = h >> 2, nb = tile & 63, row0 = tile * 128;
    {
        const int key = tid >> 1, half = tid & 1;
        const bool ok = (nb > 0) || (key >= 128);
        const size_t grow = (size_t)(ok ? row0 - 128 + key : row0);
        const u32x4* kp = (const u32x4*)(C.za + grow * NZA + 2560 + kvh * 64 + half * 32);
        const u32x4* vp = (const u32x4*)(C.za + grow * NZA + 2688 + kvh * 64 + half * 32);
        float kf[32]; float ss = 0.f;
#pragma unroll
        for (int i = 0; i < 4; ++i) { const u32x4 w = kp[i]; UNPACK8(w, kf, 8 * i); }
#pragma unroll
        for (int i = 0; i < 32; ++i) ss += kf[i] * kf[i];
        ss += __shfl_xor(ss, 1);
        const float rs = rsqrtf(ss * (1.f / 64.f) + EPS);
        const float* kg = C.in[I_SKG] + l * 64 + half * 32;
#pragma unroll
        for (int i = 0; i < 32; ++i) kf[i] *= rs * kg[i];
        if (half == 0) { const float pos = (float)(nb * 128 - 128 + key); ROPE16(kf, pos); }
#pragma unroll
        for (int i = 0; i < 4; ++i) { *(LAS u32x4*)(Ks + key * 72 + half * 32 + 8 * i) = PACK8(kf, 8 * i); *(LAS u32x4*)(Vs + key * 72 + half * 32 + 8 * i) = vp[i]; }
    }
    const int q = tid >> 2, sub = tid & 3;
    float qf[16];
    {
        const u32x4* qp = (const u32x4*)(C.za + (size_t)(row0 + q) * NZA + 2048 + h * 64 + sub * 16);
        const u32x4 w0 = qp[0], w1 = qp[1]; UNPACK8(w0, qf, 0); UNPACK8(w1, qf, 8);
        float ss = 0.f;
#pragma unroll
        for (int i = 0; i < 16; ++i) ss += qf[i] * qf[i];
        ss += __shfl_xor(ss, 1); ss += __shfl_xor(ss, 2);
        const float rs = rsqrtf(ss * (1.f / 64.f) + EPS);
        const float* qg = C.in[I_SQG] + l * 64 + sub * 16;
#pragma unroll
        for (int i = 0; i < 16; ++i) qf[i] *= rs * qg[i];
        if (sub == 0) { const float pos = (float)(nb * 128 + q); ROPE16(qf, pos); }
#pragma unroll
        for (int i = 0; i < 16; ++i) qf[i] *= 0.125f;
    }
    __syncthreads();
    const float sink = C.in[I_SINK][l * 8 + h];
    float mx = sink;
    for (int j = 0; j < 128; ++j) {
        const int kj = q + 1 + j; const bool valid = (nb > 0) || (kj >= 128);
        const LAS u32x4* kr = (const LAS u32x4*)(Ks + kj * 72 + sub * 16);
        float kf[16]; const u32x4 w0 = kr[0], w1 = kr[1]; UNPACK8(w0, kf, 0); UNPACK8(w1, kf, 8);
        float s = 0.f;
#pragma unroll
        for (int i = 0; i < 16; ++i) s += qf[i] * kf[i];
        s += __shfl_xor(s, 1); s += __shfl_xor(s, 2);
        if (valid) mx = fmaxf(mx, s);
    }
    float lsum = __expf(sink - mx); float o[16];
#pragma unroll
    for (int i = 0; i < 16; ++i) o[i] = 0.f;
    for (int j = 0; j < 128; ++j) {
        const int kj = q + 1 + j; const bool valid = (nb > 0) || (kj >= 128);
        const LAS u32x4* kr = (const LAS u32x4*)(Ks + kj * 72 + sub * 16);
        float kf[16]; { const u32x4 w0 = kr[0], w1 = kr[1]; UNPACK8(w0, kf, 0); UNPACK8(w1, kf, 8); }
        float s = 0.f;
#pragma unroll
        for (int i = 0; i < 16; ++i) s += qf[i] * kf[i];
        s += __shfl_xor(s, 1); s += __shfl_xor(s, 2);
        const float p = valid ? __expf(s - mx) : 0.f;
        lsum += p;
        const LAS u32x4* vr = (const LAS u32x4*)(Vs + kj * 72 + sub * 16);
        float vf[16]; { const u32x4 w0 = vr[0], w1 = vr[1]; UNPACK8(w0, vf, 0); UNPACK8(w1, vf, 8); }
#pragma unroll
        for (int i = 0; i < 16; ++i) o[i] += p * vf[i];
    }
    const float inv = 1.f / lsum;
#pragma unroll
    for (int i = 0; i < 16; ++i) o[i] *= inv;
    u32x4* op = (u32x4*)(C.o + (size_t)(row0 + q) * NO + 1024 + h * 64 + sub * 16);
    op[0] = PACK8(o, 0); op[1] = PACK8(o, 8);
    __syncthreads();
}

__device__ __forceinline__ void xa_item(LAS unsigned char* lds, const Ctx& C, int l, int tile, int h) {
    const int tid = opaque_tid();
    LAS bf16_t* Ks = (LAS bf16_t*)lds;
    LAS bf16_t* Vs = Ks + 256 * 136;
    const int b = tile >> 6, row0 = tile * 128;
    {
        const int key = tid >> 1, half = tid & 1;
        const bf16_t* src = C.memkv + ((size_t)(l * 512 + b * 256 + key)) * 1024 + h * 128 + half * 64;
        const u32x4* kp = (const u32x4*)src; const u32x4* vp = (const u32x4*)(src + 512);
        float kf[64]; float ss = 0.f;
#pragma unroll
        for (int i = 0; i < 8; ++i) { const u32x4 w = kp[i]; UNPACK8(w, kf, 8 * i); }
#pragma unroll
        for (int i = 0; i < 64; ++i) ss += kf[i] * kf[i];
        ss += __shfl_xor(ss, 1);
        const float rs = rsqrtf(ss * (1.f / 128.f) + EPS);
        const float* kg = C.in[I_XKG] + l * 128 + half * 64;
#pragma unroll
        for (int i = 0; i < 64; ++i) kf[i] *= rs * kg[i];
#pragma unroll
        for (int i = 0; i < 8; ++i) { *(LAS u32x4*)(Ks + key * 136 + half * 64 + 8 * i) = PACK8(kf, 8 * i); *(LAS u32x4*)(Vs + key * 136 + half * 64 + 8 * i) = vp[i]; }
    }
    const int q = tid >> 2, sub = tid & 3;
    float qf[32];
    {
        const u32x4* qp = (const u32x4*)(C.za + (size_t)(row0 + q) * NZA + 2816 + h * 128 + sub * 32);
#pragma unroll
        for (int i = 0; i < 4; ++i) { const u32x4 w = qp[i]; UNPACK8(w, qf, 8 * i); }
        float ss = 0.f;
#pragma unroll
        for (int i = 0; i < 32; ++i) ss += qf[i] * qf[i];
        ss += __shfl_xor(ss, 1); ss += __shfl_xor(ss, 2);
        const float rs = rsqrtf(ss * (1.f / 128.f) + EPS) * 0.08838834764831845f;
        const float* qg = C.in[I_XQG] + l * 128 + sub * 32;
#pragma unroll
        for (int i = 0; i < 32; ++i) qf[i] *= rs * qg[i];
    }
    __syncthreads();
    float mx = -3.0e38f;
    for (int key = 0; key < 256; ++key) {
        const LAS u32x4* kr = (const LAS u32x4*)(Ks + key * 136 + sub * 32);
        float s = 0.f;
#pragma unroll
        for (int c = 0; c < 4; ++c) { float kf[8]; const u32x4 w = kr[c]; UNPACK8(w, kf, 0);
#pragma unroll
            for (int i = 0; i < 8; ++i) s += qf[8 * c + i] * kf[i]; }
        s += __shfl_xor(s, 1); s += __shfl_xor(s, 2);
        mx = fmaxf(mx, s);
    }
    float lsum = 0.f; float o[32];
#pragma unroll
    for (int i = 0; i < 32; ++i) o[i] = 0.f;
    for (int key = 0; key < 256; ++key) {
        const LAS u32x4* kr = (const LAS u32x4*)(Ks + key * 136 + sub * 32);
        float s = 0.f;
#pragma unroll
        for (int c = 0; c < 4; ++c) { float kf[8]; const u32x4 w = kr[c]; UNPACK8(w, kf, 0);
#pragma unroll
            for (int i = 0; i < 8; ++i) s += qf[8 * c + i] * kf[i]; }
        s += __shfl_xor(s, 1); s += __shfl_xor(s, 2);
        const float p = __expf(s - mx);
        lsum += p;
        const LAS u32x4* vr = (const LAS u32x4*)(Vs + key * 136 + sub * 32);
#pragma unroll
        for (int c = 0; c < 4; ++c) { float vf[8]; const u32x4 w = vr[c]; UNPACK8(w, vf, 0);
#pragma unroll
            for (int i = 0; i < 8; ++i) o[8 * c + i] += p * vf[i]; }
    }
    const float inv = 1.f / lsum;
#pragma unroll
    for (int i = 0; i < 32; ++i) o[i] *= inv;
    u32x4* op = (u32x4*)(C.o + (size_t)(row0 + q) * NO + 1536 + h * 128 + sub * 32);
#pragma unroll
    for (int c = 0; c < 4; ++c) op[c] = PACK8(o, 8 * c);
    __syncthreads();
}

__device__ __forceinline__ void gm_item(LAS unsigned char* lds, const Ctx& C, int l, int tile, int g) {
    const int tid = opaque_tid();
    LAS float* vn = (LAS float*)lds;
    LAS float* Wl = vn + 128 * 128;
    LAS float* rsv = Wl + 128 * 128;
    const int row0 = tile * 128;
    {
        const int tok = tid >> 2, sub = tid & 3;
        const u32x4* vp = (const u32x4*)(C.za + (size_t)(row0 + tok) * NZA + 512 + sub * 128);
        float ss = 0.f;
#pragma unroll
        for (int i = 0; i < 16; ++i) { float f[8]; const u32x4 w = vp[i]; UNPACK8(w, f, 0);
#pragma unroll
            for (int e = 0; e < 8; ++e) ss += f[e] * f[e]; }
        ss += __shfl_xor(ss, 1); ss += __shfl_xor(ss, 2);
        if (sub == 0) rsv[tok] = rsqrtf(ss * (1.f / 512.f) + EPS);
        const f32x4* wp = (const f32x4*)(C.in[I_GMWS] + (size_t)(l * 4 + g) * 128 * 128);
#pragma unroll
        for (int i = 0; i < 8; ++i) *(LAS f32x4*)(Wl + (i * 512 + tid) * 4) = wp[i * 512 + tid];
    }
    __syncthreads();
    {
        const int s = tid >> 2, c0 = (tid & 3) * 32;
        const u32x4* vp = (const u32x4*)(C.za + (size_t)(row0 + s) * NZA + 512 + g * 128 + c0);
        const float rs = rsv[s]; const float* vg = C.in[I_GMVG] + l * 512 + g * 128 + c0;
#pragma unroll
        for (int i = 0; i < 4; ++i) { float f[8]; const u32x4 w = vp[i]; UNPACK8(w, f, 0);
#pragma unroll
            for (int e = 0; e < 8; ++e) f[e] *= rs * vg[8 * i + e];
            *(LAS f32x4*)(vn + s * 128 + c0 + 8 * i) = (f32x4){f[0], f[1], f[2], f[3]}; *(LAS f32x4*)(vn + s * 128 + c0 + 8 * i + 4) = (f32x4){f[4], f[5], f[6], f[7]}; }
    }
    __syncthreads();
    {
        const int c = tid & 127, tq = tid >> 7;
        const float* bs = C.in[I_GMBS] + (size_t)(l * 4 + g) * 128;
        for (int k = 0; k < 32; ++k) {
            const int t = tq * 32 + k; float acc = 0.f;
            for (int s = 0; s <= t; ++s) acc += Wl[t * 128 + s] * vn[s * 128 + c];
            const float sval = acc + bs[t];
            const float u = bf2f(C.za[(size_t)(row0 + t) * NZA + g * 128 + c]);
            C.o[(size_t)(row0 + t) * NO + g * 128 + c] = (bf16_t)f2bf(u * sval);
        }
    }
    __syncthreads();
}

__device__ __forceinline__ void lru_item(LAS unsigned char* lds, const Ctx& C, int l, int tile, int hb) {
    const int tid = opaque_tid();
    LAS float* xc = (LAS float*)lds;
    LAS float* wr = xc + 8192;
    LAS float* wi = wr + 4096;
    LAS float* aa = wi + 4096;
    LAS float* bb = aa + 8192;
    const int nb = tile & 63, row0 = tile * 128;
    {
        const int t = tid >> 2, c0 = (tid & 3) * 16, ch = hb * 64 + c0;
        float acc[16];
#pragma unroll
        for (int i = 0; i < 16; ++i) acc[i] = C.in[I_CONVB][l * 512 + ch + i];
#pragma unroll
        for (int k = 0; k < 4; ++k) {
            const int tt = t - 3 + k;
            if (nb * 128 + tt >= 0) {
                const u32x4* xp = (const u32x4*)(C.za + (size_t)(row0 + tt) * NZA + 1024 + ch);
                float f[16]; const u32x4 w0 = xp[0], w1 = xp[1]; UNPACK8(w0, f, 0); UNPACK8(w1, f, 8);
                const float* cw = C.in[I_CONVW] + (size_t)(l * 4 + k) * 512 + ch;
#pragma unroll
                for (int i = 0; i < 16; ++i) acc[i] += cw[i] * f[i];
            }
        }
#pragma unroll
        for (int i = 0; i < 4; ++i) *(LAS f32x4*)(xc + t * 64 + c0 + 4 * i) = (f32x4){acc[4 * i], acc[4 * i + 1], acc[4 * i + 2], acc[4 * i + 3]};
        const f32x4* wrp = (const f32x4*)(C.in[I_WR] + (size_t)(l * 8 + hb) * 4096); const f32x4* wip = (const f32x4*)(C.in[I_WI] + (size_t)(l * 8 + hb) * 4096);
#pragma unroll
        for (int i = 0; i < 2; ++i) { *(LAS f32x4*)(wr + (i * 512 + tid) * 4) = wrp[i * 512 + tid]; *(LAS f32x4*)(wi + (i * 512 + tid) * 4) = wip[i * 512 + tid]; }
    }
    __syncthreads();
    const int j = tid & 63, tg = tid >> 6, chj = hb * 64 + j;
    {
        const float br = C.in[I_BR][l * 512 + chj], bi = C.in[I_BI][l * 512 + chj];
        const float lam = C.in[I_LAM][l * 512 + chj];
        const float sp = log1pf(expf(-lam));
        for (int k = 0; k < 16; ++k) {
            const int t = tg * 16 + k; float r = br, ig = bi;
            for (int i = 0; i < 64; ++i) { const float xv = xc[t * 64 + i]; r += xv * wr[i * 64 + j]; ig += xv * wi[i * 64 + j]; }
            r = sigmoid_f(r); ig = sigmoid_f(ig);
            const float loga = -8.f * r * sp; const float a = expf(loga); const float mult = sqrtf(-expm1f(2.f * loga));
            aa[t * 64 + j] = a; bb[t * 64 + j] = xc[t * 64 + j] * ig * mult;
        }
    }
    __syncthreads();
    if (tid < 64) {
        float hh = 0.f, P = 1.f;
        for (int t = 0; t < 128; ++t) { const float a = aa[t * 64 + tid]; hh = a * hh + bb[t * 64 + tid]; P *= a; aa[t * 64 + tid] = P; bb[t * 64 + tid] = hh; }
        C.carryA[(size_t)tile * 512 + hb * 64 + tid] = P; C.carryH[(size_t)tile * 512 + hb * 64 + tid] = hh;
    }
    __syncthreads();
    for (int k = 0; k < 16; ++k) {
        const int t = tg * 16 + k;
        const float G = bf2f(C.za[(size_t)(row0 + t) * NZA + 1536 + chj]);
        C.ly[(size_t)(row0 + t) * 512 + chj] = G * bb[t * 64 + j]; C.lp[(size_t)(row0 + t) * 512 + chj] = G * aa[t * 64 + j];
    }
    __syncthreads();
}

__device__ __forceinline__ int vperm_pos(int key) { const int w = key & 31; return (key & ~31) + ((w >> 2) & 3) * 8 + (w >> 4) * 4 + (w & 3); }
#define MFMA16(X, Y, ACC) __builtin_amdgcn_mfma_f32_16x16x32_bf16((X), (Y), (ACC), 0, 0, 0)
__device__ __forceinline__ bf16x8 pack_bf16x8(const float* f) { u32x4 w; w[0] = cvt_pk_bf16(f[0], f[1]); w[1] = cvt_pk_bf16(f[2], f[3]); w[2] = cvt_pk_bf16(f[4], f[5]); w[3] = cvt_pk_bf16(f[6], f[7]); return __builtin_bit_cast(bf16x8, w); }

__device__ __forceinline__ void kvprep_phase(const Ctx& C, int gw, int NGW, int lane) {
    for (int r = gw; r < 32 * 256; r += NGW) {
        const int combo = r >> 8, key = r & 255, l = combo >> 3, b = (combo >> 2) & 1, h = combo & 3;
        const unsigned w = *(const unsigned*)(C.memkv + ((size_t)(l * 512 + b * 256 + key)) * 1024 + h * 128 + 2 * lane);
        float f0 = __uint_as_float(w << 16), f1 = __uint_as_float(w & 0xffff0000u);
        const float ss = wave_sum(f0 * f0 + f1 * f1); const float rs = rsqrtf(ss * (1.f / 128.f) + EPS);
        const float* kg = C.in[I_XKG] + l * 128 + 2 * lane;
        *(unsigned*)(C.memK + (size_t)r * 128 + 2 * lane) = pk2(f0 * rs * kg[0], f1 * rs * kg[1]);
    }
    const int gt = gw * 64 + lane, NGT = NGW * 64;
    for (int t = gt; t < 32 * 32 * 128; t += NGT) {
        const int d = t & 127, pg = (t >> 7) & 31, combo = t >> 12, l = combo >> 3, b = (combo >> 2) & 1, h = combo & 3;
        const int kbase = (pg >> 2) * 32 + (pg & 3) * 4;
        const bf16_t* src = C.memkv + ((size_t)(l * 512 + b * 256)) * 1024 + 512 + h * 128 + d;
        unsigned short v[8];
#pragma unroll
        for (int e = 0; e < 4; ++e) { v[e] = src[(size_t)(kbase + e) * 1024]; v[4 + e] = src[(size_t)(kbase + 16 + e) * 1024]; }
        u32x4 o; o[0] = v[0] | ((unsigned)v[1] << 16); o[1] = v[2] | ((unsigned)v[3] << 16); o[2] = v[4] | ((unsigned)v[5] << 16); o[3] = v[6] | ((unsigned)v[7] << 16);
        *(u32x4*)(C.memVt + ((size_t)combo * 128 + d) * 256 + pg * 8) = o;
    }
}

__device__ __forceinline__ void xa_pair_mfma(LAS unsigned char* lds, const Ctx& C, int l, int pairidx) {
    const int tid = opaque_tid(), lane = tid & 63, w = __builtin_amdgcn_readfirstlane(tid >> 6), fr = lane & 15, fq = lane >> 4;
    LAS bf16_t* Ks = (LAS bf16_t*)lds;
    LAS bf16_t* Vt = Ks + 256 * 144;
    const int idx0 = pairidx * 2, bh = idx0 >> 6, b = bh >> 2, h = bh & 3, nb0 = idx0 & 63;
    {
        const u32x4* ksrc = (const u32x4*)(C.memK + ((size_t)(l * 8 + bh)) * 256 * 128);
        const u32x4* vsrc = (const u32x4*)(C.memVt + ((size_t)(l * 8 + bh)) * 128 * 256);
#pragma unroll
        for (int i = 0; i < 8; ++i) { const int ch = i * 512 + tid;
            *(LAS u32x4*)(Ks + (ch >> 4) * 144 + (ch & 15) * 8) = ksrc[ch];
            *(LAS u32x4*)(Vt + (ch >> 5) * 272 + (ch & 31) * 8) = vsrc[ch]; }
    }
    __syncthreads();
    const float* qg = C.in[I_XQG] + l * 128;
    for (int tt = 0; tt < 2; ++tt) {
        const size_t row = (size_t)((b * 64 + nb0 + tt) * 128 + w * 16 + fr);
        bf16x8 qf[4];
        {
            float f[32]; const bf16_t* qp = C.za + row * NZA + 2816 + h * 128 + 8 * fq;
#pragma unroll
            for (int ks = 0; ks < 4; ++ks) { const u32x4 wv = *(const u32x4*)(qp + 32 * ks); UNPACK8(wv, f, 8 * ks); }
            float ss = 0.f;
#pragma unroll
            for (int i = 0; i < 32; ++i) ss += f[i] * f[i];
            ss += __shfl_xor(ss, 16); ss += __shfl_xor(ss, 32);
            const float rs = rsqrtf(ss * (1.f / 128.f) + EPS) * 0.08838834764831845f;
#pragma unroll
            for (int ks = 0; ks < 4; ++ks) {
#pragma unroll
                for (int i = 0; i < 8; ++i) f[8 * ks + i] *= rs * qg[32 * ks + 8 * fq + i];
                qf[ks] = pack_bf16x8(f + 8 * ks); }
        }
        f32x4 acc[16];
#pragma unroll
        for (int kb = 0; kb < 16; ++kb) { acc[kb] = (f32x4){0.f, 0.f, 0.f, 0.f};
#pragma unroll
            for (int ks = 0; ks < 4; ++ks) { const bf16x8 kf = *(const LAS bf16x8*)(Ks + (kb * 16 + fr) * 144 + 32 * ks + 8 * fq); acc[kb] = MFMA16(kf, qf[ks], acc[kb]); } }
        float mx = -3.0e38f;
#pragma unroll
        for (int kb = 0; kb < 16; ++kb) mx = fmaxf(fmaxf(fmaxf(acc[kb][0], acc[kb][1]), fmaxf(acc[kb][2], acc[kb][3])), mx);
        mx = fmaxf(mx, __shfl_xor(mx, 16)); mx = fmaxf(mx, __shfl_xor(mx, 32));
        float lsum = 0.f;
#pragma unroll
        for (int kb = 0; kb < 16; ++kb)
#pragma unroll
            for (int e = 0; e < 4; ++e) { const float pv = __expf(acc[kb][e] - mx); acc[kb][e] = pv; lsum += pv; }
        lsum += __shfl_xor(lsum, 16); lsum += __shfl_xor(lsum, 32);
        const float inv = 1.f / lsum;
        bf16x8 pf[8];
#pragma unroll
        for (int j = 0; j < 8; ++j) { u32x4 wv; wv[0] = cvt_pk_bf16(acc[2 * j][0], acc[2 * j][1]); wv[1] = cvt_pk_bf16(acc[2 * j][2], acc[2 * j][3]); wv[2] = cvt_pk_bf16(acc[2 * j + 1][0], acc[2 * j + 1][1]); wv[3] = cvt_pk_bf16(acc[2 * j + 1][2], acc[2 * j + 1][3]); pf[j] = __builtin_bit_cast(bf16x8, wv); }
        bf16_t* op = C.o + row * NO + 1536 + h * 128 + 4 * fq;
#pragma unroll
        for (int db = 0; db < 8; ++db) {
            f32x4 o = (f32x4){0.f, 0.f, 0.f, 0.f};
#pragma unroll
            for (int j = 0; j < 8; ++j) { const bf16x8 vf = *(const LAS bf16x8*)(Vt + (db * 16 + fr) * 272 + 32 * j + 8 * fq); o = MFMA16(vf, pf[j], o); }
            *(u32x2*)(op + db * 16) = (u32x2){cvt_pk_bf16(o[0] * inv, o[1] * inv), cvt_pk_bf16(o[2] * inv, o[3] * inv)};
        }
    }
    __syncthreads();
}

__device__ __forceinline__ void swa_item_mfma(LAS unsigned char* lds, const Ctx& C, int l, int tile, int kvh) {
    const int tid = opaque_tid(), lane = tid & 63, w = __builtin_amdgcn_readfirstlane(tid >> 6), fr = lane & 15, fq = lane >> 4;
    LAS bf16_t* Ks = (LAS bf16_t*)lds;
    LAS bf16_t* Vt = Ks + 256 * 80;
    const int nb = tile & 63, row0 = tile * 128;
    {
        const int key = tid >> 1, half = tid & 1;
        const bool ok = (nb > 0) || (key >= 128);
        const size_t grow = (size_t)(ok ? row0 - 128 + key : row0);
        const u32x4* kp = (const u32x4*)(C.za + grow * NZA + 2560 + kvh * 64 + half * 32);
        const u32x4* vp = (const u32x4*)(C.za + grow * NZA + 2688 + kvh * 64 + half * 32);
        float kf[32]; float ss = 0.f;
#pragma unroll
        for (int i = 0; i < 4; ++i) { const u32x4 wv = kp[i]; UNPACK8(wv, kf, 8 * i); }
#pragma unroll
        for (int i = 0; i < 32; ++i) ss += kf[i] * kf[i];
        ss += __shfl_xor(ss, 1);
        const float rs = rsqrtf(ss * (1.f / 64.f) + EPS);
        const float* kg = C.in[I_SKG] + l * 64 + half * 32;
#pragma unroll
        for (int i = 0; i < 32; ++i) kf[i] *= rs * kg[i];
        if (half == 0) { const float pos = (float)(nb * 128 - 128 + key); ROPE16(kf, pos); }
#pragma unroll
        for (int i = 0; i < 4; ++i) *(LAS u32x4*)(Ks + key * 80 + half * 32 + 8 * i) = PACK8(kf, 8 * i);
        const int pp = vperm_pos(key);
#pragma unroll
        for (int i = 0; i < 4; ++i) { u32x4 wv = vp[i]; if (!ok) wv = (u32x4){0u, 0u, 0u, 0u};
#pragma unroll
            for (int e = 0; e < 4; ++e) { Vt[(half * 32 + 8 * i + 2 * e) * 272 + pp] = (bf16_t)(wv[e] & 0xffffu); Vt[(half * 32 + 8 * i + 2 * e + 1) * 272 + pp] = (bf16_t)(wv[e] >> 16); } }
    }
    __syncthreads();
    const int i0 = 16 * w, ws2 = w & ~1, qi = i0 + fr;
    float rc[8], rsn[8];
    { const float pos = (float)(nb * 128 + qi);
#pragma unroll
      for (int i = 0; i < 8; ++i) { const float ang = pos * ROPE_INV(i); rc[i] = cosf(ang); rsn[i] = sinf(ang); } }
    const size_t row = (size_t)(row0 + qi);
    for (int hh = 0; hh < 4; ++hh) {
        const int h = kvh * 4 + hh;
        bf16x8 qf[2];
        {
            float f[16]; const bf16_t* qp = C.za + row * NZA + 2048 + h * 64 + 8 * fq;
            { const u32x4 w0 = *(const u32x4*)qp, w1 = *(const u32x4*)(qp + 32); UNPACK8(w0, f, 0); UNPACK8(w1, f, 8); }
            float ss = 0.f;
#pragma unroll
            for (int i = 0; i < 16; ++i) ss += f[i] * f[i];
            ss += __shfl_xor(ss, 16); ss += __shfl_xor(ss, 32);
            const float rs = rsqrtf(ss * (1.f / 64.f) + EPS);
            const float* qg = C.in[I_SQG] + l * 64 + 8 * fq;
#pragma unroll
            for (int i = 0; i < 8; ++i) { f[i] *= rs * qg[i]; f[8 + i] *= rs * qg[32 + i]; }
#pragma unroll
            for (int i = 0; i < 8; ++i) { const float other = __shfl_xor(f[i], 16);
                const float r0 = f[i] * rc[i] - other * rsn[i], r1 = f[i] * rc[i] + other * rsn[i];
                f[i] = (fq == 0) ? r0 : (fq == 1) ? r1 : f[i]; }
#pragma unroll
            for (int i = 0; i < 16; ++i) f[i] *= 0.125f;
            qf[0] = pack_bf16x8(f); qf[1] = pack_bf16x8(f + 8);
        }
        f32x4 acc[10];
#pragma unroll
        for (int kk = 0; kk < 10; ++kk) { acc[kk] = (f32x4){0.f, 0.f, 0.f, 0.f};
#pragma unroll
            for (int ks = 0; ks < 2; ++ks) { const bf16x8 kf = *(const LAS bf16x8*)(Ks + ((ws2 + kk) * 16 + fr) * 80 + 32 * ks + 8 * fq); acc[kk] = MFMA16(kf, qf[ks], acc[kk]); } }
        const float sink = C.in[I_SINK][l * 8 + h];
        float mx = sink;
#pragma unroll
        for (int kk = 0; kk < 10; ++kk)
#pragma unroll
            for (int e = 0; e < 4; ++e) { const int kj = (ws2 + kk) * 16 + 4 * fq + e, dd = kj - qi; const bool valid = (dd >= 1) && (dd <= 128) && ((nb > 0) || (kj >= 128));
                const float sv = valid ? acc[kk][e] : -INFINITY; acc[kk][e] = sv; mx = fmaxf(mx, sv); }
        mx = fmaxf(mx, __shfl_xor(mx, 16)); mx = fmaxf(mx, __shfl_xor(mx, 32));
        float lsum = 0.f;
#pragma unroll
        for (int kk = 0; kk < 10; ++kk)
#pragma unroll
            for (int e = 0; e < 4; ++e) { const float pv = __expf(acc[kk][e] - mx); acc[kk][e] = pv; lsum += pv; }
        lsum += __shfl_xor(lsum, 16); lsum += __shfl_xor(lsum, 32);
        lsum += __expf(sink - mx);
        const float inv = 1.f / lsum;
        bf16x8 pf[5];
#pragma unroll
        for (int j = 0; j < 5; ++j) { u32x4 wv; wv[0] = cvt_pk_bf16(acc[2 * j][0], acc[2 * j][1]); wv[1] = cvt_pk_bf16(acc[2 * j][2], acc[2 * j][3]); wv[2] = cvt_pk_bf16(acc[2 * j + 1][0], acc[2 * j + 1][1]); wv[3] = cvt_pk_bf16(acc[2 * j + 1][2], acc[2 * j + 1][3]); pf[j] = __builtin_bit_cast(bf16x8, wv); }
        bf16_t* op = C.o + row * NO + 1024 + h * 64 + 4 * fq;
#pragma unroll
        for (int db = 0; db < 4; ++db) {
            f32x4 o = (f32x4){0.f, 0.f, 0.f, 0.f};
#pragma unroll
            for (int j = 0; j < 5; ++j) { const bf16x8 vf = *(const LAS bf16x8*)(Vt + (db * 16 + fr) * 272 + (ws2 + 2 * j) * 16 + 8 * fq); o = MFMA16(vf, pf[j], o); }
            *(u32x2*)(op + db * 16) = (u32x2){cvt_pk_bf16(o[0] * inv, o[1] * inv), cvt_pk_bf16(o[2] * inv, o[3] * inv)};
        }
    }
    __syncthreads();
}

__device__ __forceinline__ void gm_item_mfma(LAS unsigned char* lds, const Ctx& C, int l, int tile, int g) {
    const int tid = opaque_tid(), lane = tid & 63, w = __builtin_amdgcn_readfirstlane(tid >> 6), fr = lane & 15, fq = lane >> 4;
    LAS bf16_t* Wl = (LAS bf16_t*)lds;
    LAS bf16_t* vT = Wl + 128 * 144;
    LAS float* rsv = (LAS float*)(vT + 128 * 144);
    const int row0 = tile * 128;
    {
        const int tok = tid >> 2, sub = tid & 3;
        const u32x4* vp = (const u32x4*)(C.za + (size_t)(row0 + tok) * NZA + 512 + sub * 128);
        float ss = 0.f;
#pragma unroll
        for (int i = 0; i < 16; ++i) { float f[8]; const u32x4 wv = vp[i]; UNPACK8(wv, f, 0);
#pragma unroll
            for (int e = 0; e < 8; ++e) ss += f[e] * f[e]; }
        ss += __shfl_xor(ss, 1); ss += __shfl_xor(ss, 2);
        if (sub == 0) rsv[tok] = rsqrtf(ss * (1.f / 512.f) + EPS);
        const u32x4* gp = (const u32x4*)(C.za + (size_t)(row0 + tok) * NZA + 512 + g * 128 + sub * 32);
#pragma unroll
        for (int i = 0; i < 4; ++i) { const u32x4 wv = gp[i];
#pragma unroll
            for (int e = 0; e < 4; ++e) { vT[(sub * 32 + 8 * i + 2 * e) * 144 + tok] = (bf16_t)(wv[e] & 0xffffu); vT[(sub * 32 + 8 * i + 2 * e + 1) * 144 + tok] = (bf16_t)(wv[e] >> 16); } }
    }
    __syncthreads();
    {
        const int t = tid >> 2, s0 = (tid & 3) * 32;
        const f32x4* wp = (const f32x4*)(C.in[I_GMWS] + ((size_t)(l * 4 + g) * 128 + t) * 128 + s0);
#pragma unroll
        for (int i = 0; i < 4; ++i) { const f32x4 a = wp[2 * i], b2 = wp[2 * i + 1]; float f[8] = {a[0], a[1], a[2], a[3], b2[0], b2[1], b2[2], b2[3]};
#pragma unroll
            for (int e = 0; e < 8; ++e) { const int sidx = s0 + 8 * i + e; f[e] = (sidx <= t) ? f[e] * rsv[sidx] : 0.f; }
            *(LAS u32x4*)(Wl + t * 144 + s0 + 8 * i) = PACK8(f, 0); }
    }
    __syncthreads();
    {
        const int nks = (w + 2) >> 1;
        f32x4 acc[8];
#pragma unroll
        for (int cb = 0; cb < 8; ++cb) acc[cb] = (f32x4){0.f, 0.f, 0.f, 0.f};
        for (int ks = 0; ks < nks; ++ks) {
            const bf16x8 wf = *(const LAS bf16x8*)(Wl + (16 * w + fr) * 144 + 32 * ks + 8 * fq);
#pragma unroll
            for (int cb = 0; cb < 8; ++cb) { const bf16x8 vf = *(const LAS bf16x8*)(vT + (cb * 16 + fr) * 144 + 32 * ks + 8 * fq); acc[cb] = MFMA16(wf, vf, acc[cb]); }
        }
        const float* bs = C.in[I_GMBS] + (size_t)(l * 4 + g) * 128 + 16 * w + 4 * fq;
        const float* vg = C.in[I_GMVG] + l * 512 + g * 128;
#pragma unroll
        for (int cb = 0; cb < 8; ++cb) { const int c = cb * 16 + fr; const float gn = vg[c];
#pragma unroll
            for (int e = 0; e < 4; ++e) { const size_t r = (size_t)(row0 + 16 * w + 4 * fq + e);
                const float u = bf2f(C.za[r * NZA + g * 128 + c]);
                C.o[r * NO + g * 128 + c] = (bf16_t)f2bf(u * (gn * acc[cb][e] + bs[e])); } }
    }
    __syncthreads();
}

__device__ __forceinline__ void lru_item_mfma(LAS unsigned char* lds, const Ctx& C, int l, int tile, int hb) {
    const int tid = opaque_tid(), lane = tid & 63, w = __builtin_amdgcn_readfirstlane(tid >> 6), fr = lane & 15, fq = lane >> 4;
    LAS bf16_t* xcb = (LAS bf16_t*)lds;
    LAS bf16_t* wrT = xcb + 128 * 80;
    LAS bf16_t* wiT = wrT + 64 * 80;
    LAS float* xcf = (LAS float*)(lds + 40960);
    LAS float* aa = xcf + 8192;
    LAS float* bb = aa + 8192;
    LAS float* segA = bb + 8192;
    LAS float* segH = segA + 512;
    const int nb = tile & 63, row0 = tile * 128;
    {
        const int t = tid >> 2, c0 = (tid & 3) * 16, ch = hb * 64 + c0;
        float acc[16];
#pragma unroll
        for (int i = 0; i < 16; ++i) acc[i] = C.in[I_CONVB][l * 512 + ch + i];
#pragma unroll
        for (int k = 0; k < 4; ++k) {
            const int tt = t - 3 + k;
            if (nb * 128 + tt >= 0) {
                const u32x4* xp = (const u32x4*)(C.za + (size_t)(row0 + tt) * NZA + 1024 + ch);
                float f[16]; const u32x4 w0 = xp[0], w1 = xp[1]; UNPACK8(w0, f, 0); UNPACK8(w1, f, 8);
                const float* cw = C.in[I_CONVW] + (size_t)(l * 4 + k) * 512 + ch;
#pragma unroll
                for (int i = 0; i < 16; ++i) acc[i] += cw[i] * f[i];
            }
        }
#pragma unroll
        for (int i = 0; i < 4; ++i) *(LAS f32x4*)(xcf + t * 64 + c0 + 4 * i) = (f32x4){acc[4 * i], acc[4 * i + 1], acc[4 * i + 2], acc[4 * i + 3]};
        *(LAS u32x4*)(xcb + t * 80 + c0) = PACK8(acc, 0); *(LAS u32x4*)(xcb + t * 80 + c0 + 8) = PACK8(acc, 8);
        const int wi_ = tid >> 3, j0 = (tid & 7) * 8;
        const f32x4* wrp = (const f32x4*)(C.in[I_WR] + (size_t)(l * 8 + hb) * 4096 + wi_ * 64 + j0); const f32x4* wip = (const f32x4*)(C.in[I_WI] + (size_t)(l * 8 + hb) * 4096 + wi_ * 64 + j0);
        const f32x4 r0 = wrp[0], r1 = wrp[1], q0 = wip[0], q1 = wip[1];
#pragma unroll
        for (int e = 0; e < 4; ++e) { wrT[(j0 + e) * 80 + wi_] = (bf16_t)f2bf(r0[e]); wrT[(j0 + 4 + e) * 80 + wi_] = (bf16_t)f2bf(r1[e]); wiT[(j0 + e) * 80 + wi_] = (bf16_t)f2bf(q0[e]); wiT[(j0 + 4 + e) * 80 + wi_] = (bf16_t)f2bf(q1[e]); }
    }
    __syncthreads();
    {
        bf16x8 xf[2];
#pragma unroll
        for (int ks = 0; ks < 2; ++ks) xf[ks] = *(const LAS bf16x8*)(xcb + (16 * w + fr) * 80 + 32 * ks + 8 * fq);
#pragma unroll
        for (int jb = 0; jb < 4; ++jb) {
            f32x4 ar = (f32x4){0.f, 0.f, 0.f, 0.f}, ai = (f32x4){0.f, 0.f, 0.f, 0.f};
#pragma unroll
            for (int ks = 0; ks < 2; ++ks) { const bf16x8 wf = *(const LAS bf16x8*)(wrT + (jb * 16 + fr) * 80 + 32 * ks + 8 * fq); ar = MFMA16(xf[ks], wf, ar);
                const bf16x8 wf2 = *(const LAS bf16x8*)(wiT + (jb * 16 + fr) * 80 + 32 * ks + 8 * fq); ai = MFMA16(xf[ks], wf2, ai); }
            const int j = jb * 16 + fr, chj = l * 512 + hb * 64 + j;
            const float br = C.in[I_BR][chj], bi = C.in[I_BI][chj], sp8 = -8.f * C.spl[chj];
#pragma unroll
            for (int e = 0; e < 4; ++e) { const int t = 16 * w + 4 * fq + e;
                const float r = sigmoid_f(ar[e] + br), ig = sigmoid_f(ai[e] + bi);
                const float a = __expf(r * sp8); const float mult = __builtin_amdgcn_sqrtf(fmaxf(1.f - a * a, 0.f));
                aa[t * 64 + j] = a; bb[t * 64 + j] = xcf[t * 64 + j] * ig * mult; }
        }
    }
    __syncthreads();
    const int j = tid & 63, sg = tid >> 6;
    {
        float hh = 0.f, P = 1.f;
#pragma unroll 4
        for (int k = 0; k < 16; ++k) { const int t = sg * 16 + k; const float a = aa[t * 64 + j]; hh = a * hh + bb[t * 64 + j]; P *= a; aa[t * 64 + j] = P; bb[t * 64 + j] = hh; }
        segA[sg * 64 + j] = P; segH[sg * 64 + j] = hh;
    }
    __syncthreads();
    {
        float Hc = 0.f, Pc = 1.f;
        for (int s2 = 0; s2 < sg; ++s2) { const float a = segA[s2 * 64 + j]; Hc = a * Hc + segH[s2 * 64 + j]; Pc *= a; }
        const int chj = hb * 64 + j;
        float hl = 0.f, pl = 1.f;
#pragma unroll 4
        for (int k = 0; k < 16; ++k) { const int t = sg * 16 + k; hl = bb[t * 64 + j] + aa[t * 64 + j] * Hc; pl = aa[t * 64 + j] * Pc;
            const float G = bf2f(C.za[(size_t)(row0 + t) * NZA + 1536 + chj]);
            C.ly[(size_t)(row0 + t) * 512 + chj] = G * hl; C.lp[(size_t)(row0 + t) * 512 + chj] = G * pl; }
        if (sg == 7) { C.carryA[(size_t)tile * 512 + chj] = pl; C.carryH[(size_t)tile * 512 + chj] = hl; }
    }
    __syncthreads();
}

__device__ __forceinline__ void fix_item(const Ctx& C, int tile, int half) {
    const int c = opaque_tid(), b = tile >> 6, nb = tile & 63, row0 = tile * 128 + half * 64;
    float H = 0.f;
    for (int jn = 0; jn < nb; ++jn) { const size_t idx = (size_t)(b * 64 + jn) * 512 + c; H = C.carryA[idx] * H + C.carryH[idx]; }
    for (int t = 0; t < 64; ++t) { const size_t r = (size_t)(row0 + t); C.o[r * NO + 512 + c] = (bf16_t)f2bf(C.ly[r * 512 + c] + C.lp[r * 512 + c] * H); }
}

__global__ void __launch_bounds__(512, 2) fwd_megakernel(Args args) {
    extern __shared__ __attribute__((aligned(16))) unsigned char lds_raw[];
    LAS unsigned char* lds = (LAS unsigned char*)lds_raw;
    volatile LAS unsigned* MISC = (volatile LAS unsigned*)(lds + MISC_OFF);
    const int tid = threadIdx.x, lane = tid & 63, wave = __builtin_amdgcn_readfirstlane(tid >> 6);
    const int G = gridDim.x, bx = blockIdx.x;
    unsigned char* ws = args.ws;
    Ctx C;
    C.in = args.in; C.x = args.out;
    C.wt_in = (bf16_t*)(ws + WS_WIN); C.wt_br = (bf16_t*)(ws + WS_WBR); C.wt_out = (bf16_t*)(ws + WS_WOUT); C.wt_ff1 = (bf16_t*)(ws + WS_WFF1); C.wt_ff2 = (bf16_t*)(ws + WS_WFF2); C.wt_kv = (bf16_t*)(ws + WS_WKV);
    C.memn = (bf16_t*)(ws + WS_MEMN); C.memkv = (bf16_t*)(ws + WS_MEMKV); C.xb = (bf16_t*)(ws + WS_XB); C.za = (bf16_t*)(ws + WS_ZA); C.zg = (bf16_t*)(ws + WS_ZG); C.mb = (bf16_t*)(ws + WS_MB); C.o = (bf16_t*)(ws + WS_O);
    C.ssq = (float*)(ws + WS_SSQ); C.carryA = (float*)(ws + WS_CARRY); C.carryH = C.carryA + 128 * 512; C.S = (float*)(ws + WS_S); C.ly = (float*)(ws + WS_LY); C.lp = (float*)(ws + WS_LP); C.memK = (bf16_t*)(ws + WS_MEMK); C.memVt = (bf16_t*)(ws + WS_MEMVT); C.spl = (float*)(ws + WS_SPL);

    if (tid < 64) MISC[tid] = 0u;
    __syncthreads();
    XcdBarrier bar = xcd_barrier_post((unsigned*)(ws + WS_CTL), MISC + 8);
    const int gw = bx * 8 + wave, NGW = G * 8;
    LAS float* scr = (LAS float*)(lds + wave * 16384);

    for (int it = gw; it < IT_WIN + 4 * IT_WKV; it += NGW) {
        if (it < IT_WIN) conv_w(C, 0, 0, it, scr, lane);
        else { const int r = it - IT_WIN; conv_w(C, 5, r / IT_WKV, r % IT_WKV, scr, lane); }
    }
    for (int m = gw; m < M + 512; m += NGW) {
        if (m < M) {
            const f32x4* xr = (const f32x4*)(C.in[I_X] + (size_t)m * D) + lane; f32x4 v[4]; float s = 0.f;
#pragma unroll
            for (int jj = 0; jj < 4; ++jj) { v[jj] = xr[64 * jj]; s += (v[jj].x * v[jj].x + v[jj].y * v[jj].y) + (v[jj].z * v[jj].z + v[jj].w * v[jj].w); }
            s = wave_sum(s);
            f32x4* xo = (f32x4*)(C.x + (size_t)m * D) + lane; u32x2* bo = (u32x2*)(C.xb + (size_t)m * D) + lane;
#pragma unroll
            for (int jj = 0; jj < 4; ++jj) { xo[64 * jj] = v[jj]; bo[64 * jj] = (u32x2){pk2(v[jj].x, v[jj].y), pk2(v[jj].z, v[jj].w)}; }
            if (lane < 16) C.ssq[(size_t)m * 16 + lane] = (lane == 0) ? s : 0.f;
        } else {
            const int r = m - M;
            const f32x4* xr = (const f32x4*)(C.in[I_MEM] + (size_t)r * D) + lane; f32x4 v[4]; float s = 0.f;
#pragma unroll
            for (int jj = 0; jj < 4; ++jj) { v[jj] = xr[64 * jj]; s += (v[jj].x * v[jj].x + v[jj].y * v[jj].y) + (v[jj].z * v[jj].z + v[jj].w * v[jj].w); }
            s = wave_sum(s); const float rs = rsqrtf(s * (1.f / 1024.f) + EPS);
            u32x2* bo = (u32x2*)(C.memn + (size_t)r * D) + lane;
#pragma unroll
            for (int jj = 0; jj < 4; ++jj) bo[64 * jj] = (u32x2){pk2(v[jj].x * rs, v[jj].y * rs), pk2(v[jj].z * rs, v[jj].w * rs)};
        }
    }
    { const int gt = bx * 512 + tid; if (gt < DEPTH * 512) C.spl[gt] = log1pf(expf(-C.in[I_LAM][gt])); }
    __syncthreads();
    cg::this_grid().sync();
    xcd_barrier(bar);

    {
#ifndef SKIP_KV
        pg8::Gemm g{C.memn, C.wt_kv}; pg8::SchedKV S{bx}; pg8::EpiKV E{C.memkv};
        pg8::gemm_phase<pg8::EpiKV, pg8::SchedKV, true, D, D, D>(lds, g, S, E);
#endif

    }
    xcd_barrier(bar);
    kvprep_phase(C, gw, NGW, lane);

    for (int l = 0; l < DEPTH; ++l) {
        {
#ifndef SKIP_G1
            pg8::Gemm g{C.xb, C.wt_in}; pg8::SchedStd S; S.init(M, DIN, G, bx, D, D);
            pg8::EpiZ E{C.za, C.zg, C.ssq, C.in[I_BGATE] + (size_t)l * 4 * D};
            for (int rep = 0; rep < REP_G1; ++rep) pg8::gemm_phase<pg8::EpiZ, pg8::SchedStd, true, D, D, D>(lds, g, S, E);
#endif

        }
        if (G == 256 && bx >= 64) {
            const int lane_c = opaque_tid() & 63;
            const int cw = (bx - 64) * 8 + wave, NCW = (G - 64) * 8;
            for (int it = cw; it < IT_WBR + IT_WOUT + IT_WFF1 + IT_WFF2; it += NCW) {
                int r = it;
                if (r < IT_WBR) { conv_w(C, 1, l, r, scr, lane_c); continue; } r -= IT_WBR;
                if (r < IT_WOUT) { conv_w(C, 2, l, r, scr, lane_c); continue; } r -= IT_WOUT;
                if (r < IT_WFF1) { conv_w(C, 3, l, r, scr, lane_c); continue; } r -= IT_WFF1;
                conv_w(C, 4, l, r, scr, lane_c);
            }
        }
        xcd_barrier(bar);
        {
#if USE_MFMA_SWA
            for (int rep = 0; rep < REP_SWA; ++rep) for (int it = bx; it < 256; it += G) swa_item_mfma(lds, C, l, it >> 1, it & 1);
#else
            for (int it = bx; it < 1024; it += G) swa_item(lds, C, l, it >> 3, it & 7);
#endif
#if USE_MFMA_XA
            for (int rep = 0; rep < REP_XA; ++rep) for (int it = bx; it < 256; it += G) xa_pair_mfma(lds, C, l, it);
#else
            for (int it = bx; it < 512; it += G) xa_item(lds, C, l, it >> 2, it & 3);
#endif
#if USE_MFMA_GM
            for (int rep = 0; rep < REP_GM; ++rep) for (int it = bx; it < 512; it += G) gm_item_mfma(lds, C, l, it >> 2, it & 3);
#else
            for (int it = bx; it < 512; it += G) gm_item(lds, C, l, it >> 2, it & 3);
#endif
#if USE_MFMA_LRU
            for (int rep = 0; rep < REP_LRU; ++rep) for (int it = bx; it < 1024; it += G) lru_item_mfma(lds, C, l, it >> 3, it & 7);
#else
            for (int it = bx; it < 1024; it += G) lru_item(lds, C, l, it >> 3, it & 7);
#endif
            const int lane_c = opaque_tid() & 63;
            const int NC0 = (G == 256) ? 0 : IT_WBR + IT_WOUT + IT_WFF1 + IT_WFF2;
            const int NC = IT_WBR + IT_WOUT + IT_WFF1 + IT_WFF2 + (l + 1 < DEPTH ? IT_WIN : 0);
            for (int rep = 0; rep < REP_CONV; ++rep) for (int it = gw + (IT_WBR + IT_WOUT + IT_WFF1 + IT_WFF2 - NC0); it < NC; it += NGW) {
                int r = it;
                if (r < IT_WBR) { conv_w(C, 1, l, r, scr, lane_c); continue; } r -= IT_WBR;
                if (r < IT_WOUT) { conv_w(C, 2, l, r, scr, lane_c); continue; } r -= IT_WOUT;
                if (r < IT_WFF1) { conv_w(C, 3, l, r, scr, lane_c); continue; } r -= IT_WFF1;
                if (r < IT_WFF2) { conv_w(C, 4, l, r, scr, lane_c); continue; } r -= IT_WFF2;
                conv_w(C, 0, l + 1, r, scr, lane_c);
            }
            __syncthreads();
        }
        xcd_barrier(bar);
        for (int rep = 0; rep < REP_FIX; ++rep) for (int it = bx; it < 256; it += G) fix_item(C, it >> 1, it & 1);
        for (int rep = 0; rep < REP_BAR; ++rep) xcd_barrier(bar);
        {
#ifndef SKIP_G2
            pg8::Gemm g{C.o, C.wt_br}; pg8::SchedMerge S; S.t.init(M, D, G, bx, NO, NO);
            pg8::EpiMerge E{C.zg, C.mb};
            for (int rep = 0; rep < REP_G2; ++rep) pg8::gemm_phase<pg8::EpiMerge, pg8::SchedMerge, true, NO, NO, 512>(lds, g, S, E);
#endif

        }
        xcd_barrier(bar);
        {
#ifndef SKIP_G3
            pg8::Gemm g{C.mb, C.wt_out}; pg8::SchedStd S; S.init(M, D, G, bx, D, D);
            pg8::EpiRes E{C.x, C.xb, C.ssq};
            pg8::gemm_phase<pg8::EpiRes, pg8::SchedStd, true, D, D, D>(lds, g, S, E);
#endif

        }
        xcd_barrier(bar);
        {
#ifndef SKIP_G4
            pg8::Gemm g{C.xb, C.wt_ff1}; pg8::SchedStd S; S.init(M, FF, G, bx, D, D);
            pg8::EpiFF1 E{C.zg, C.ssq};
            for (int rep = 0; rep < REP_G4; ++rep) pg8::gemm_phase<pg8::EpiFF1, pg8::SchedStd, true, D, D, D>(lds, g, S, E);
#endif

        }
        xcd_barrier(bar);
        {
#ifndef SKIP_G5
            pg8::Gemm g{C.zg, C.wt_ff2}; pg8::SchedStd S; S.init(M, D, G, bx, FF, FF);
            pg8::EpiRes E{C.x, C.xb, C.ssq};
            pg8::gemm_phase<pg8::EpiRes, pg8::SchedStd, true, FF, FF, FF>(lds, g, S, E);
#endif

        }
        if (l + 1 < DEPTH) xcd_barrier(bar);
    }
}

extern "C" void kernel_launch(void* const* d_in, const int* in_sizes, int n_in, void* d_out, int out_size, void* d_ws, size_t ws_size, hipStream_t stream) {
    static int grid = 0;
    if (grid == 0) {
        if (n_in != 27 || out_size != M * D || ws_size < WS_END) { fprintf(stderr, "kernel_launch: unexpected shapes: n_in %d out %d ws %zu (need %zu)\n", n_in, out_size, ws_size, (size_t)WS_END); grid = -1; return; }
        int dev = 0, cus = 0, per_cu = 0;
        hipGetDevice(&dev); hipDeviceGetAttribute(&cus, hipDeviceAttributeMultiprocessorCount, dev);
        if (hipFuncSetAttribute((const void*)fwd_megakernel, hipFuncAttributeMaxDynamicSharedMemorySize, LDS_BYTES) != hipSuccess) { fprintf(stderr, "kernel_launch: hipFuncSetAttribute failed\n"); grid = -1; return; }
        if (hipOccupancyMaxActiveBlocksPerMultiprocessor(&per_cu, (const void*)fwd_megakernel, 512, LDS_BYTES) != hipSuccess || per_cu < 1) { fprintf(stderr, "kernel_launch: occupancy query says %d\n", per_cu); per_cu = 1; }
        (void)hipGetLastError();
        grid = cus;
        if (grid != 256) fprintf(stderr, "kernel_launch: note: %d CUs\n", grid);
    }
    if (grid < 0) return;
    hipMemsetAsync((char*)d_ws + WS_CTL, 0, CTL_ZERO_BYTES, stream);
    Args a{};
    for (int i = 0; i < 27; ++i) a.in[i] = (const float*)d_in[i];
    a.out = (float*)d_out; a.ws = (unsigned char*)d_ws;
    void* kargs[] = {&a};
    hipError_t e = hipLaunchCooperativeKernel((const void*)fwd_megakernel, dim3(grid), dim3(512), kargs, LDS_BYTES, stream);
    if (e != hipSuccess) fprintf(stderr, "kernel_launch: cooperative launch failed: %s\n", hipGetErrorString(e));
}
```

```cpp
#include <hip/hip_runtime.h>
#include <hip/hip_cooperative_groups.h>
#include <cstdio>
#include <cstdint>
namespace cg = cooperative_groups;

#define LAS __attribute__((address_space(3)))
#define GAS __attribute__((address_space(1)))
typedef unsigned short bf16_t;
typedef short bf16x8 __attribute__((ext_vector_type(8)));
typedef float f32x4 __attribute__((ext_vector_type(4)));
typedef unsigned u32x4 __attribute__((ext_vector_type(4)));
typedef unsigned u32x2 __attribute__((ext_vector_type(2)));

constexpr int M = 16384, D = 1024, DIN = 7424, NZA = 3328, NZG = 4096, FF = 4096, DEPTH = 4, NO = 2048;
constexpr float EPS = 1e-6f;
constexpr size_t MiB = 1u << 20;
constexpr size_t WS_CTL = 0, CTL_ZERO_BYTES = 64 * 1024;
constexpr size_t WS_WIN = 2 * MiB, WS_WBR = 17 * MiB, WS_WOUT = 21 * MiB, WS_WFF1 = 23 * MiB, WS_WFF2 = 31 * MiB, WS_WKV = 39 * MiB;
constexpr size_t WS_MEMN = 47 * MiB, WS_MEMKV = 48 * MiB, WS_SSQ = 52 * MiB, WS_CARRY = 53 * MiB, WS_XB = 54 * MiB;
constexpr size_t WS_ZA = 86 * MiB, WS_S = 86 * MiB, WS_MB = 150 * MiB, WS_ZG = 190 * MiB, WS_O = 318 * MiB, WS_LY = 382 * MiB, WS_LP = 414 * MiB, WS_MEMK = 446 * MiB, WS_MEMVT = 448 * MiB, WS_SPL = 450 * MiB, WS_END = 451 * MiB;
static_assert(WS_ZA + (size_t)M * NZA * 2 <= WS_ZG && WS_MB + (size_t)M * D * 2 <= WS_ZG && WS_WIN + (size_t)DIN * D * 2 <= WS_WBR, "ws map");

constexpr int LDS_BYTES = 147456, MISC_OFF = LDS_BYTES - 256;

__device__ __forceinline__ float bf2f(bf16_t h) { return __uint_as_float((unsigned)h << 16); }
__device__ __forceinline__ unsigned f2bf(float f) { unsigned u = __float_as_uint(f); return (u + 0x7fffu + ((u >> 16) & 1u)) >> 16; }
__device__ __forceinline__ unsigned pk2(float lo, float hi) { return f2bf(lo) | (f2bf(hi) << 16); }
__device__ __forceinline__ unsigned cvt_pk_bf16(float lo, float hi) { unsigned r; asm volatile("v_cvt_pk_bf16_f32 %0, %1, %2" : "=v"(r) : "v"(lo), "v"(hi)); return r; }
#define UNPACK8(VV, f, o) do { (f)[(o) + 0] = __uint_as_float((VV)[0] << 16); (f)[(o) + 1] = __uint_as_float((VV)[0] & 0xffff0000u); (f)[(o) + 2] = __uint_as_float((VV)[1] << 16); (f)[(o) + 3] = __uint_as_float((VV)[1] & 0xffff0000u); \
    (f)[(o) + 4] = __uint_as_float((VV)[2] << 16); (f)[(o) + 5] = __uint_as_float((VV)[2] & 0xffff0000u); (f)[(o) + 6] = __uint_as_float((VV)[3] << 16); (f)[(o) + 7] = __uint_as_float((VV)[3] & 0xffff0000u); } while (0)
#define PACK8(f, o) ((u32x4){pk2((f)[(o) + 0], (f)[(o) + 1]), pk2((f)[(o) + 2], (f)[(o) + 3]), pk2((f)[(o) + 4], (f)[(o) + 5]), pk2((f)[(o) + 6], (f)[(o) + 7])})
__device__ __forceinline__ float gelu_t(float x) { const float u = 0.7978845608028654f * (x + 0.044715f * x * x * x); return x * __builtin_amdgcn_rcpf(1.f + __expf(-2.f * u)); }
__device__ __forceinline__ float sigmoid_f(float x) { return __builtin_amdgcn_rcpf(1.f + __expf(-x)); }
__device__ __forceinline__ float row_rstd(const float* ssq, int row) {
    const f32x4* p = (const f32x4*)(ssq + (size_t)row * 16);
    const f32x4 a = p[0], b = p[1], c = p[2], d = p[3];
    const float s = (((a.x + a.y) + (a.z + a.w)) + ((b.x + b.y) + (b.z + b.w))) + (((c.x + c.y) + (c.z + c.w)) + ((d.x + d.y) + (d.z + d.w)));
    return rsqrtf(s * (1.f / 1024.f) + EPS);
}
#define LDS_WAIT() asm volatile("s_waitcnt lgkmcnt(0)" ::: "memory")
__device__ __forceinline__ int opaque_tid() { int t = threadIdx.x; asm volatile("" : "+v"(t)); return t; }

namespace pg8 {
constexpr int BM = 256, BK = 64, HALF = 128, HTB = HALF * BK * 2, STAGE_BYTES = 8 * HTB, NXCD = 8, WGM = 8;
__host__ __device__ __forceinline__ int lds_byte(int r, int c) { const int st = (r >> 4) * 2 + (c >> 5), rr = r & 15, cc = c & 31, ob = rr * 64 + cc * 2; return st * 1024 + (ob ^ (((ob >> 9) & 1) << 5)); }
__host__ __device__ __forceinline__ void stage_rc(int b, int& R, int& C) { const int st = b / 1024, sb = b % 1024, swz = sb ^ (((sb >> 9) & 1) << 5); R = (st >> 1) * 16 + swz / 64; C = (st & 1) * 32 + (swz % 64) / 2; }
__host__ __device__ __forceinline__ int perm32(int rho) { const int n = rho >> 4, i = rho & 15; return 8 * (i >> 2) + 4 * n + (i & 3); }

struct Unit { int pm, pn, b; };
struct Gemm { const bf16_t* A; const bf16_t* Bt; };

struct SchedStd {
    int nM, nN, nwg, G, c; size_t as, bs;
    __device__ void init(int M_, int N_, int G_, int c_, int lda, int ldb) { nM = M_ / BM; nN = N_ / BM; nwg = nM * nN; G = G_; c = c_; as = (size_t)BM * lda * 2; bs = (size_t)BM * ldb * 2; }
    __device__ bool tile(long L, Unit& u) const {
        if (L >= nwg) return false;
        int wgid = (int)L; { const int q = nwg / NXCD, r = nwg % NXCD, xcd = wgid % NXCD, off = wgid / NXCD; wgid = (xcd < r ? xcd * (q + 1) : r * (q + 1) + (xcd - r) * q) + off; }
        const int nig = WGM * nN, gid = wgid / nig, fm = gid * WGM, gsz = (nM - fm) < WGM ? (nM - fm) : WGM;
        u.pm = fm + ((wgid % nig) % gsz); u.pn = (wgid % nig) / gsz; u.b = 0; return true;
    }
    __device__ bool next(int i, Unit& u) const { return tile((long)i * G + c, u); }
    __device__ size_t aoff(const Unit& u) const { return (size_t)u.pm * as; }
    __device__ size_t boff(const Unit& u) const { return (size_t)u.pn * bs; }
};
struct SchedMerge {
    SchedStd t;
    __device__ bool next(int i, Unit& u) const { if (!t.tile((long)(i >> 2) * t.G + t.c, u)) return false; u.b = i & 3; return true; }
    __device__ size_t aoff(const Unit& u) const { return (size_t)u.pm * t.as + (size_t)u.b * 1024; }
    __device__ size_t boff(const Unit& u) const { return (size_t)u.pn * t.bs + (size_t)u.b * 1024; }
};
struct SchedKV {
    int c;
    __device__ bool next(int i, Unit& u) const { if (i > 0 || c >= 32) return false; u.b = c >> 3; u.pm = (c & 7) >> 2; u.pn = c & 3; return true; }
    __device__ size_t aoff(const Unit& u) const { return (size_t)u.pm * 256 * 1024 * 2; }
    __device__ size_t boff(const Unit& u) const { return ((size_t)u.b * 1024 + (size_t)u.pn * 256) * 1024 * 2; }
};

struct EpiZ {
    static constexpr bool PERM = true, KEEPS = false;
    bf16_t* za; bf16_t* zg; const float* ssq; const float* bgate;
    __device__ __forceinline__ void operator()(const f32x4 (&acc)[2][2][4][2], const Unit& u, int wr, int wc, int fr, int fq) const {
        const int row0 = u.pm * BM + wr * 64 + fr, pn = u.pn;
        bf16_t* base; int ldc, colt, mode;
        if (pn < 13) { base = za; ldc = NZA; colt = pn * 256; mode = (pn < 4 || pn == 6 || pn == 7) ? 1 : 0; }
        else { base = zg; ldc = NZG; colt = (pn - 13) * 256; mode = 2; }
        const int col0 = colt + wc * 32 + 8 * fq;
        f32x4 bv[2][2];
#pragma unroll
        for (int bj = 0; bj < 2; ++bj)
#pragma unroll
            for (int n = 0; n < 2; ++n) bv[bj][n] = (mode == 2) ? *(const f32x4*)(bgate + col0 + bj * HALF + 4 * n) : (f32x4){0.f, 0.f, 0.f, 0.f};
#pragma unroll
        for (int ai = 0; ai < 2; ++ai) {
            float rsm[4];
#pragma unroll
            for (int m = 0; m < 4; ++m) rsm[m] = row_rstd(ssq, row0 + ai * HALF + m * 16);
            asm volatile("" ::: "memory");
#pragma unroll
            for (int m = 0; m < 4; ++m) {
                const int row = row0 + ai * HALF + m * 16; const float rs = rsm[m];
                bf16_t* rowp = base + (size_t)row * ldc + col0;
#pragma unroll
                for (int bj = 0; bj < 2; ++bj) {
                    f32x4 v0 = acc[ai][bj][m][0] * rs, v1 = acc[ai][bj][m][1] * rs;
                    if (mode == 1) {
#pragma unroll
                        for (int e = 0; e < 4; ++e) { v0[e] = gelu_t(v0[e]); v1[e] = gelu_t(v1[e]); }
                    } else if (mode == 2) {
                        v0 = v0 + bv[bj][0]; v1 = v1 + bv[bj][1];
#pragma unroll
                        for (int e = 0; e < 4; ++e) { v0[e] = sigmoid_f(v0[e]); v1[e] = sigmoid_f(v1[e]); }
                    }
                    u32x4 w; w.x = cvt_pk_bf16(v0[0], v0[1]); w.y = cvt_pk_bf16(v0[2], v0[3]); w.z = cvt_pk_bf16(v1[0], v1[1]); w.w = cvt_pk_bf16(v1[2], v1[3]);
                    *(u32x4*)(rowp + bj * HALF) = w;
                }
            }
            asm volatile("" ::: "memory");
        }
    }
};
struct EpiFF1 {
    static constexpr bool PERM = true, KEEPS = false;
    bf16_t* f; const float* ssq;
    __device__ __forceinline__ void operator()(const f32x4 (&acc)[2][2][4][2], const Unit& u, int wr, int wc, int fr, int fq) const {
        const int row0 = u.pm * BM + wr * 64 + fr, col0 = u.pn * BM + wc * 32 + 8 * fq;
#pragma unroll
        for (int ai = 0; ai < 2; ++ai) {
            float rsm[4];
#pragma unroll
            for (int m = 0; m < 4; ++m) rsm[m] = row_rstd(ssq, row0 + ai * HALF + m * 16);
            asm volatile("" ::: "memory");
#pragma unroll
            for (int m = 0; m < 4; ++m) {
                const int row = row0 + ai * HALF + m * 16; const float rs = rsm[m];
                bf16_t* rowp = f + (size_t)row * FF + col0;
#pragma unroll
                for (int bj = 0; bj < 2; ++bj) {
                    f32x4 v0 = acc[ai][bj][m][0] * rs, v1 = acc[ai][bj][m][1] * rs;
#pragma unroll
                    for (int e = 0; e < 4; ++e) { const float a = fmaxf(v0[e], 0.f), b = fmaxf(v1[e], 0.f); v0[e] = a * a; v1[e] = b * b; }
                    u32x4 w; w.x = cvt_pk_bf16(v0[0], v0[1]); w.y = cvt_pk_bf16(v0[2], v0[3]); w.z = cvt_pk_bf16(v1[0], v1[1]); w.w = cvt_pk_bf16(v1[2], v1[3]);
                    *(u32x4*)(rowp + bj * HALF) = w;
                }
            }
            asm volatile("" ::: "memory");
        }
    }
};
struct EpiRes {
    static constexpr bool PERM = true, KEEPS = false;
    const float* x; float* xo_; bf16_t* xb; float* ssq;
    __device__ __forceinline__ void operator()(const f32x4 (&acc)[2][2][4][2], const Unit& u, int wr, int wc, int fr, int fq) const {
        const int row0 = u.pm * BM + wr * 64 + fr, col0 = u.pn * BM + wc * 32 + 8 * fq;
#pragma unroll
        for (int ai = 0; ai < 2; ++ai) {
            f32x4 xo[4][2][2];
#pragma unroll
            for (int m = 0; m < 4; ++m)
#pragma unroll
                for (int bj = 0; bj < 2; ++bj) { const float* xp = x + (size_t)(row0 + ai * HALF + m * 16) * D + col0 + bj * HALF; xo[m][bj][0] = *(const f32x4*)xp; xo[m][bj][1] = *(const f32x4*)(xp + 4); }
            asm volatile("" ::: "memory");
#pragma unroll
            for (int m = 0; m < 4; ++m) {
                const int row = row0 + ai * HALF + m * 16; float ss = 0.f;
#pragma unroll
                for (int bj = 0; bj < 2; ++bj) {
                    float* xp = xo_ + (size_t)row * D + col0 + bj * HALF;
                    const f32x4 v0 = xo[m][bj][0] + acc[ai][bj][m][0], v1 = xo[m][bj][1] + acc[ai][bj][m][1];
                    *(f32x4*)xp = v0; *(f32x4*)(xp + 4) = v1;
                    ss += (v0[0] * v0[0] + v0[1] * v0[1]) + (v0[2] * v0[2] + v0[3] * v0[3]) + (v1[0] * v1[0] + v1[1] * v1[1]) + (v1[2] * v1[2] + v1[3] * v1[3]);
                    u32x4 w; w.x = cvt_pk_bf16(v0[0], v0[1]); w.y = cvt_pk_bf16(v0[2], v0[3]); w.z = cvt_pk_bf16(v1[0], v1[1]); w.w = cvt_pk_bf16(v1[2], v1[3]);
                    *(u32x4*)(xb + (size_t)row * D + col0 + bj * HALF) = w;
                }
                ss += __shfl_xor(ss, 16); ss += __shfl_xor(ss, 32);
                if (fq == 0) ssq[(size_t)row * 16 + u.pn * 4 + wc] = ss;
            }
            asm volatile("" ::: "memory");
        }
    }
};
struct EpiMerge {
    static constexpr bool PERM = true, KEEPS = true;
    const bf16_t* zg; bf16_t* mb;
    __device__ __forceinline__ bool merge(f32x4 (&acc)[2][2][4][2], const Unit& u, int wr, int wc, int fr, int fq) const {
        const int row0 = u.pm * BM + wr * 64 + fr, col0 = u.pn * BM + wc * 32 + 8 * fq, b = u.b, bn = b < 3 ? b + 1 : b;
#pragma unroll
        for (int ai = 0; ai < 2; ++ai) {
            u32x4 ga[4][2], gb[4][2];
#pragma unroll
            for (int m = 0; m < 4; ++m)
#pragma unroll
                for (int bj = 0; bj < 2; ++bj) { const bf16_t* gp = zg + (size_t)(row0 + ai * HALF + m * 16) * NZG + col0 + bj * HALF; ga[m][bj] = *(const u32x4*)(gp + b * 1024); gb[m][bj] = *(const u32x4*)(gp + bn * 1024); }
            asm volatile("" ::: "memory");
#pragma unroll
            for (int m = 0; m < 4; ++m) {
                const int row = row0 + ai * HALF + m * 16;
#pragma unroll
                for (int bj = 0; bj < 2; ++bj) {
                    const int col = col0 + bj * HALF;
                    float g[8]; UNPACK8(ga[m][bj], g, 0);
#pragma unroll
                    for (int e = 0; e < 8; ++e) g[e] = fmaxf(g[e], 1e-20f);
                    if (b < 3) {
                        float h[8]; UNPACK8(gb[m][bj], h, 0);
#pragma unroll
                        for (int e = 0; e < 8; ++e) g[e] *= __builtin_amdgcn_rcpf(fmaxf(h[e], 1e-20f));
                    }
#pragma unroll
                    for (int e = 0; e < 4; ++e) { acc[ai][bj][m][0][e] *= g[e]; acc[ai][bj][m][1][e] *= g[4 + e]; }
                    if (b == 3) { const f32x4 v0 = acc[ai][bj][m][0], v1 = acc[ai][bj][m][1];
                        u32x4 w; w.x = cvt_pk_bf16(v0[0], v0[1]); w.y = cvt_pk_bf16(v0[2], v0[3]); w.z = cvt_pk_bf16(v1[0], v1[1]); w.w = cvt_pk_bf16(v1[2], v1[3]);
                        *(u32x4*)(mb + (size_t)row * D + col) = w; }
                }
            }
            asm volatile("" ::: "memory");
        }
        return b < 3;
    }
};
struct EpiKV {
    static constexpr bool PERM = true, KEEPS = false;
    bf16_t* out;
    __device__ __forceinline__ void operator()(const f32x4 (&acc)[2][2][4][2], const Unit& u, int wr, int wc, int fr, int fq) const {
        const int row0 = u.pm * BM + wr * 64 + fr, col0 = u.pn * BM + wc * 32 + 8 * fq;
        bf16_t* base = out + (size_t)u.b * 512 * 1024;
#pragma unroll
        for (int ai = 0; ai < 2; ++ai)
#pragma unroll
            for (int m = 0; m < 4; ++m) {
                const int row = row0 + ai * HALF + m * 16;
#pragma unroll
                for (int bj = 0; bj < 2; ++bj) {
                    const f32x4 v0 = acc[ai][bj][m][0], v1 = acc[ai][bj][m][1];
                    u32x4 w; w.x = cvt_pk_bf16(v0[0], v0[1]); w.y = cvt_pk_bf16(v0[2], v0[3]); w.z = cvt_pk_bf16(v1[0], v1[1]); w.w = cvt_pk_bf16(v1[2], v1[3]);
                    *(u32x4*)(base + (size_t)row * 1024 + col0 + bj * HALF) = w;
                }
            }
    }
};

template <class Epi, class Sched, bool ALIGN_EPI, int LDA, int LDB, int KK>
__device__ __forceinline__ void gemm_phase(LAS unsigned char* lds, const Gemm g, const Sched& S, const Epi& E) {
    const int tid = opaque_tid(), wid = __builtin_amdgcn_readfirstlane(tid >> 6), lane = tid & 63, wr = wid >> 2, wc = wid & 3, fr = lane & 15, fq = lane >> 4;
    constexpr int nt = KK / BK;
    unsigned voffA[2], voffB[2];
#pragma unroll
    for (int i = 0; i < 2; ++i) { int R, C; stage_rc(tid * 16 + i * 8192, R, C); const int Rb = Epi::PERM ? ((R & ~31) + perm32(R & 31)) : R;
        voffA[i] = (unsigned)(R * LDA + C) * 2u; voffB[i] = (unsigned)(Rb * LDB + C) * 2u; }
    constexpr size_t kstep = (size_t)(BK * 2);
    constexpr size_t hstepA = (size_t)HALF * LDA * 2, hstepB = (size_t)HALF * LDB * 2;
    const unsigned ldsw = (unsigned)wid * 1024u;
    const int aoff = lds_byte(wr * 64 + fr, fq * 8), boff = lds_byte(wc * 32 + fr, fq * 8);
#define PG8_SA(b, h) (((b) * 2 + (h)) * HTB)
#define PG8_SB(b, h) ((4 + (b) * 2 + (h)) * HTB)
#define PG8_STAGE(bufoff, gbase, voff) do { _Pragma("unroll") for (int _i = 0; _i < 2; ++_i) \
        __builtin_amdgcn_global_load_lds((const unsigned*)((const char*)(gbase) + (voff)[_i]), (LAS unsigned*)(lds + (bufoff) + ldsw + _i * 8192), 16, 0, 0); } while (0)
#define PG8_LDA(dst, b, h) do { _Pragma("unroll") for (int m = 0; m < 4; ++m) _Pragma("unroll") for (int k = 0; k < 2; ++k) dst[m][k] = *(const LAS bf16x8*)(lds + PG8_SA(b, h) + aoff + m * 2048 + k * 1024); } while (0)
#define PG8_LDB(dst, b, h) do { _Pragma("unroll") for (int n = 0; n < 2; ++n) _Pragma("unroll") for (int k = 0; k < 2; ++k) dst[n][k] = *(const LAS bf16x8*)(lds + PG8_SB(b, h) + boff + n * 2048 + k * 1024); } while (0)
#define PG8_MMA(ai, bj, At, Bt) do { __builtin_amdgcn_s_setprio(1); _Pragma("unroll") for (int m = 0; m < 4; ++m) _Pragma("unroll") for (int n = 0; n < 2; ++n) _Pragma("unroll") for (int k = 0; k < 2; ++k) \
        acc[ai][bj][m][n] = __builtin_amdgcn_mfma_f32_16x16x32_bf16(Bt[n][k], At[m][k], acc[ai][bj][m][n], 0, 0, 0); __builtin_amdgcn_s_setprio(0); } while (0)
#define PG8_WAIT_V(n) asm volatile("s_waitcnt vmcnt(" #n ")" ::: "memory")
#define PG8_WAIT_L(n) asm volatile("s_waitcnt lgkmcnt(" #n ")" ::: "memory")
#define PG8_BAR __builtin_amdgcn_s_barrier()
#define PG8_SCHED __builtin_amdgcn_sched_barrier(0)
    Unit cur, nxt; int ui = 0;
    if (!S.next(0, cur)) return;
    f32x4 acc[2][2][4][2];
#pragma unroll
    for (int a = 0; a < 2; ++a)
#pragma unroll
        for (int b = 0; b < 2; ++b)
#pragma unroll
            for (int m = 0; m < 4; ++m)
#pragma unroll
                for (int n = 0; n < 2; ++n) acc[a][b][m][n] = (f32x4){0.f, 0.f, 0.f, 0.f};
    bf16x8 At[4][2], B0[2][2], B1[2][2];
    const char* gA = (const char*)g.A; const char* gB = (const char*)g.Bt;
    asm volatile("" : "+s"(gA), "+s"(gB));
    const char* cA = gA + S.aoff(cur); const char* cB = gB + S.boff(cur);
    PG8_STAGE(PG8_SB(0, 0), cB, voffB); PG8_STAGE(PG8_SB(0, 1), cB + hstepB, voffB); PG8_STAGE(PG8_SA(0, 0), cA, voffA); PG8_STAGE(PG8_SA(0, 1), cA + hstepA, voffA);
    if (wr == 1) PG8_BAR;
    PG8_WAIT_V(2); PG8_BAR;
    PG8_STAGE(PG8_SB(1, 0), cB + kstep, voffB); PG8_STAGE(PG8_SA(1, 0), cA + kstep, voffA); PG8_STAGE(PG8_SB(1, 1), cB + hstepB + kstep, voffB);
    PG8_WAIT_V(6); PG8_BAR;
    for (;;) {
        const bool has_next = S.next(ui + 1, nxt);
        const char* nA = has_next ? gA + S.aoff(nxt) : cA; const char* nB = has_next ? gB + S.boff(nxt) : cB;
        for (int t = 0; t < nt; t += 2) {
            const bool last = (t == nt - 2);
            const char* a1 = cA + (size_t)(t + 1) * kstep;
            const char* a2 = last ? nA : cA + (size_t)(t + 2) * kstep; const char* b2 = last ? nB : cB + (size_t)(t + 2) * kstep;
            const char* a3 = a2 + kstep; const char* b3 = b2 + kstep;
            PG8_LDB(B0, 0, 0); PG8_LDB(B1, 0, 1); PG8_SCHED; PG8_LDA(At, 0, 0); PG8_STAGE(PG8_SA(1, 1), a1 + hstepA, voffA);
            PG8_WAIT_V(8); PG8_WAIT_L(0); PG8_BAR; PG8_MMA(0, 0, At, B0); PG8_MMA(0, 1, At, B1); PG8_BAR; PG8_SCHED;
            PG8_LDA(At, 0, 1); PG8_STAGE(PG8_SB(0, 0), b2, voffB); PG8_STAGE(PG8_SB(0, 1), b2 + hstepB, voffB); PG8_STAGE(PG8_SA(0, 0), a2, voffA);
            PG8_WAIT_V(8); PG8_WAIT_L(0); PG8_BAR; PG8_MMA(1, 0, At, B0); PG8_MMA(1, 1, At, B1); PG8_BAR; PG8_SCHED;
            PG8_LDB(B0, 1, 0); PG8_LDB(B1, 1, 1); PG8_SCHED; PG8_LDA(At, 1, 0); PG8_STAGE(PG8_SA(0, 1), a2 + hstepA, voffA);
            PG8_WAIT_V(8); PG8_WAIT_L(0); PG8_BAR; PG8_MMA(0, 0, At, B0); PG8_MMA(0, 1, At, B1); PG8_BAR; PG8_SCHED;
            PG8_LDA(At, 1, 1); PG8_STAGE(PG8_SB(1, 0), b3, voffB); PG8_STAGE(PG8_SB(1, 1), b3 + hstepB, voffB); PG8_STAGE(PG8_SA(1, 0), a3, voffA);
            PG8_WAIT_V(8); PG8_WAIT_L(0); PG8_BAR; PG8_MMA(1, 0, At, B0); PG8_MMA(1, 1, At, B1); PG8_BAR; PG8_SCHED;
        }
        if constexpr (ALIGN_EPI) { if (wr == 0) PG8_BAR; }
        bool keep = false;
        if constexpr (Epi::KEEPS) keep = E.merge(acc, cur, wr, wc, fr, fq); else E(acc, cur, wr, wc, fr, fq);
        if (!has_next) break;
        if (!keep)
#pragma unroll
        for (int a = 0; a < 2; ++a)
#pragma unroll
            for (int b = 0; b < 2; ++b)
#pragma unroll
                for (int m = 0; m < 4; ++m)
#pragma unroll
                    for (int n = 0; n < 2; ++n) acc[a][b][m][n] = (f32x4){0.f, 0.f, 0.f, 0.f};
        cur = nxt; cA = nA; cB = nB; ++ui;
        if constexpr (ALIGN_EPI) { if (wr == 1) PG8_BAR; }
    }
    PG8_WAIT_V(0);
    if constexpr (!ALIGN_EPI) { if (wr == 0) PG8_BAR; }
    PG8_BAR;
#undef PG8_SA
#undef PG8_SB
#undef PG8_STAGE
#undef PG8_LDA
#undef PG8_LDB
#undef PG8_MMA
#undef PG8_WAIT_V
#undef PG8_WAIT_L
#undef PG8_BAR
#undef PG8_SCHED
}
}

#define XB_TMO      128
#define XB_XCNT(j)  (256  + 64 * (j))
#define XB_XSUB(j)  (1280 + 64 * (j))
#define XB_XGEN(j)  (2304 + 64 * (j))
#define XB_TOP      3328
#define XB_TOPGEN   3392
#define XCD_BAR_WORDS 3456
#define XB_SPIN_CAP (1u << 23)
__device__ __forceinline__ unsigned xb_ld(unsigned* p)              { return __hip_atomic_load(p, __ATOMIC_RELAXED, __HIP_MEMORY_SCOPE_AGENT); }
__device__ __forceinline__ unsigned xb_add(unsigned* p, unsigned v) { return __hip_atomic_fetch_add(p, v, __ATOMIC_RELAXED, __HIP_MEMORY_SCOPE_AGENT); }
__device__ __forceinline__ unsigned xb_xcc_id() { return (unsigned)__builtin_amdgcn_s_getreg((3 << 11) | 20) & 0xFu; }
#define XB_SPIN(cond, bar) do { unsigned _sp = 0; while (cond) { __builtin_amdgcn_s_sleep(1); \
    if ((++_sp & 255u) == 0u) { if (xb_ld(&(bar)[XB_TMO])) break; if (_sp > XB_SPIN_CAP) { atomicAdd(&(bar)[XB_TMO], 1u); break; } } } } while (0)
struct XcdBarrier { unsigned* bar; unsigned x; volatile LAS unsigned* st; };
__device__ __forceinline__ XcdBarrier xcd_barrier_post(unsigned* bar, volatile LAS unsigned* st) {
    XcdBarrier b; b.bar = bar; b.x = xb_xcc_id(); b.st = st;
    if (threadIdx.x == 0) (void)xb_add(&bar[XB_XCNT(b.x)], 1u);
    return b;
}
__device__ __forceinline__ void xcd_barrier_complete(unsigned* bar, unsigned x, unsigned& nloc, unsigned& nx) {
    const unsigned G = gridDim.x * gridDim.y * gridDim.z;
    unsigned sum, cnt, mine, sp = 0u;
    for (;;) {
        sum = 0u; cnt = 0u; mine = 0u;
#pragma unroll
        for (unsigned j = 0; j < 16; ++j) { const unsigned c = xb_ld(&bar[XB_XCNT(j)]); sum += c; cnt += (c > 0u) ? 1u : 0u; mine = (j == x) ? c : mine; }
        if (sum == G) break;
        __builtin_amdgcn_s_sleep(1);
        if ((++sp & 255u) == 0u) { if (xb_ld(&bar[XB_TMO])) break; if (sp > XB_SPIN_CAP) { atomicAdd(&bar[XB_TMO], 1u); break; } }
    }
    nloc = mine > 0u ? mine : 1u; nx = cnt > 0u ? cnt : 1u;
}
__device__ __forceinline__ void xcd_barrier(const XcdBarrier& b) {
    asm volatile("s_waitcnt vmcnt(0)" ::: "memory");
    __syncthreads();
    if (threadIdx.x == 0) {
        unsigned* bar = b.bar;
        asm volatile("" : "+s"(bar));
        __builtin_amdgcn_s_waitcnt(0);
        unsigned nloc = b.st[0], nx = b.st[1];
        const unsigned bxcc = xb_xcc_id();
        if (nloc == 0u) { xcd_barrier_complete(bar, bxcc, nloc, nx); b.st[0] = nloc; b.st[1] = nx; }
        const unsigned old = xb_add(&bar[XB_XSUB(bxcc)], 1u);
        const unsigned gen = old / nloc;
        if (old + 1u == (gen + 1u) * nloc) {
            __builtin_amdgcn_fence(__ATOMIC_RELEASE, "agent");
            asm volatile("s_waitcnt vmcnt(0)" ::: "memory");
            const unsigned og = xb_add(&bar[XB_TOP], 1u);
            const unsigned tg = og / nx;
            if (og + 1u == (tg + 1u) * nx) xb_add(&bar[XB_TOPGEN], 1u);
            else XB_SPIN(xb_ld(&bar[XB_TOPGEN]) == tg, bar);
            __builtin_amdgcn_fence(__ATOMIC_ACQUIRE, "agent");
            xb_add(&bar[XB_XGEN(bxcc)], 1u);
            asm volatile("s_waitcnt vmcnt(0)" ::: "memory");
        } else {
            XB_SPIN(xb_ld(&bar[XB_XGEN(bxcc)]) == gen, bar);
            __builtin_amdgcn_fence(__ATOMIC_ACQUIRE, "agent");
            asm volatile("s_waitcnt vmcnt(0)" ::: "memory");
        }
    }
    __syncthreads();
}

struct Args { const float* in[27]; float* out; unsigned char* ws; };
enum { I_X = 0, I_MEM, I_NMIX, I_NMEM, I_NMLP, I_WIN, I_BGATE, I_GMVG, I_GMWS, I_GMBS, I_CONVW, I_CONVB, I_WR, I_BR, I_WI, I_BI, I_LAM, I_SQG, I_SKG, I_SINK, I_WKV, I_XQG, I_XKG, I_WBR, I_WOUT, I_WFF1, I_WFF2 };
struct Ctx {
    const float* const* in; float* x;
    bf16_t *wt_in, *wt_br, *wt_out, *wt_ff1, *wt_ff2, *wt_kv, *memn, *memkv, *xb, *za, *zg, *mb, *o;
    float *ssq, *carryA, *carryH, *S, *ly, *lp;
    bf16_t *memK, *memVt;
    float* spl;
};

__device__ __forceinline__ void transpose_item(const float* W, int N, bf16_t* WT, int ldk, int koff, const float* gain, LAS float* scr, int item, int lane) {
    const int nblk = N / 32, kb = item / nblk, nb = item % nblk, k0 = 64 * kb, n0 = 32 * nb;
#pragma unroll 8
    for (int i = 0; i < 32; ++i) { const int kk = 2 * i + (lane >> 5); float v = W[(size_t)(k0 + kk) * N + n0 + (lane & 31)]; if (gain) v *= gain[k0 + kk]; scr[kk * 33 + (lane & 31)] = v; }
    LDS_WAIT(); asm volatile("" ::: "memory");
    const int c = lane & 7;
#pragma unroll
    for (int j = 0; j < 4; ++j) { const int n = (lane >> 3) + 8 * j; const LAS float* s = scr + (8 * c) * 33 + n;
        u32x4 o; o.x = pk2(s[0 * 33], s[1 * 33]); o.y = pk2(s[2 * 33], s[3 * 33]); o.z = pk2(s[4 * 33], s[5 * 33]); o.w = pk2(s[6 * 33], s[7 * 33]);
        *(u32x4*)(WT + (size_t)(n0 + n) * ldk + koff + k0 + 8 * c) = o; }
    LDS_WAIT(); asm volatile("" ::: "memory");
}
__device__ __forceinline__ float wave_sum(float v) {
#pragma unroll
    for (int o = 1; o < 64; o <<= 1) v += __shfl_xor(v, o);
    return v;
}
__device__ __forceinline__ void conv_w(const Ctx& C, int which, int l, int item, LAS float* scr, int lane) {
    if (which == 0) transpose_item(C.in[I_WIN] + (size_t)l * D * DIN, DIN, C.wt_in, D, 0, C.in[I_NMIX] + l * D, scr, item, lane);
    else if (which == 1) { const int b = item >> 8; transpose_item(C.in[I_WBR] + (size_t)(l * 4 + b) * 512 * D, D, C.wt_br, 2048, b * 512, nullptr, scr, item & 255, lane); }
    else if (which == 2) transpose_item(C.in[I_WOUT] + (size_t)l * D * D, D, C.wt_out, D, 0, nullptr, scr, item, lane);
    else if (which == 3) transpose_item(C.in[I_WFF1] + (size_t)l * D * FF, FF, C.wt_ff1, D, 0, C.in[I_NMLP] + l * D, scr, item, lane);
    else if (which == 4) transpose_item(C.in[I_WFF2] + (size_t)l * FF * D, D, C.wt_ff2, FF, 0, nullptr, scr, item, lane);
    else transpose_item(C.in[I_WKV] + (size_t)l * D * D, D, C.wt_kv + (size_t)l * D * D, D, 0, C.in[I_NMEM] + l * D, scr, item, lane);
}
constexpr int IT_WIN = 16 * 232, IT_WBR = 1024, IT_WOUT = 512, IT_WFF1 = 2048, IT_WFF2 = 2048, IT_WKV = 512;

#ifndef REP_SWA
#define REP_SWA 1
#endif
#ifndef REP_XA
#define REP_XA 1
#endif
#ifndef REP_GM
#define REP_GM 1
#endif
#ifndef REP_LRU
#define REP_LRU 1
#endif
#ifndef REP_CONV
#define REP_CONV 1
#endif
#ifndef REP_FIX
#define REP_FIX 1
#endif
#ifndef REP_G1
#define REP_G1 1
#endif
#ifndef REP_G2
#define REP_G2 1
#endif
#ifndef REP_G4
#define REP_G4 1
#endif
#ifndef REP_G3
#define REP_G3 1
#endif
#ifndef REP_G5
#define REP_G5 1
#endif
#ifndef REP_MIX
#define REP_MIX 1
#endif
#ifndef REP_BAR
#define REP_BAR 1
#endif
#ifndef USE_MFMA_SWA
#define USE_MFMA_SWA 1
#endif
#ifndef USE_MFMA_XA
#define USE_MFMA_XA 1
#endif
#ifndef USE_MFMA_GM
#define USE_MFMA_GM 1
#endif
#ifndef USE_MFMA_LRU
#define USE_MFMA_LRU 1
#endif
#define ROPE_INV(i) ((i) == 0 ? 1.0f : (i) == 1 ? 0.19392274474868576f : (i) == 2 ? 0.03760603093086393f : (i) == 3 ? 0.007292664737217109f : (i) == 4 ? 0.001414213562373095f : (i) == 5 ? 0.0002742481756762073f : (i) == 6 ? 5.318295896944988e-05f : 1.031338537721246e-05f)
#define ROPE16(f, pos) do { _Pragma("unroll") for (int _i = 0; _i < 8; ++_i) { float _s, _c; sincosf((pos) * ROPE_INV(_i), &_s, &_c); const float _x1 = (f)[_i], _x2 = (f)[_i + 8]; (f)[_i] = _x1 * _c - _x2 * _s; (f)[_i + 8] = _x2 * _c + _x1 * _s; } } while (0)

__device__ __forceinline__ void swa_item(LAS unsigned char* lds, const Ctx& C, int l, int tile, int h) {
    const int tid = opaque_tid();
    LAS bf16_t* Ks = (LAS bf16_t*)lds;
    LAS bf16_t* Vs = Ks + 256 * 72;
    const int kvh = h >> 2, nb = tile & 63, row0 = tile * 128;
    {
        const int key = tid >> 1, half = tid & 1;
        const bool ok = (nb > 0) || (key >= 128);
        const size_t grow = (size_t)(ok ? row0 - 128 + key : row0);
        const u32x4* kp = (const u32x4*)(C.za + grow * NZA + 2560 + kvh * 64 + half * 32);
        const u32x4* vp = (const u32x4*)(C.za + grow * NZA + 2688 + kvh * 64 + half * 32);
        float kf[32]; float ss = 0.f;
#pragma unroll
        for (int i = 0; i < 4; ++i) { const u32x4 w = kp[i]; UNPACK8(w, kf, 8 * i); }
#pragma unroll
        for (int i = 0; i < 32; ++i) ss += kf[i] * kf[i];
        ss += __shfl_xor(ss, 1);
        const float rs = rsqrtf(ss * (1.f / 64.f) + EPS);
        const float* kg = C.in[I_SKG] + l * 64 + half * 32;
#pragma unroll
        for (int i = 0; i < 32; ++i) kf[i] *= rs * kg[i];
        if (half == 0) { const float pos = (float)(nb * 128 - 128 + key); ROPE16(kf, pos); }
#pragma unroll
        for (int i = 0; i < 4; ++i) { *(LAS u32x4*)(Ks + key * 72 + half * 32 + 8 * i) = PACK8(kf, 8 * i); *(LAS u32x4*)(Vs + key * 72 + half * 32 + 8 * i) = vp[i]; }
    }
    const int q = tid >> 2, sub = tid & 3;
    float qf[16];
    {
        const u32x4* qp = (const u32x4*)(C.za + (size_t)(row0 + q) * NZA + 2048 + h * 64 + sub * 16);
        const u32x4 w0 = qp[0], w1 = qp[1]; UNPACK8(w0, qf, 0); UNPACK8(w1, qf, 8);
        float ss = 0.f;
#pragma unroll
        for (int i = 0; i < 16; ++i) ss += qf[i] * qf[i];
        ss += __shfl_xor(ss, 1); ss += __shfl_xor(ss, 2);
        const float rs = rsqrtf(ss * (1.f / 64.f) + EPS);
        const float* qg = C.in[I_SQG] + l * 64 + sub * 16;
#pragma unroll
        for (int i = 0; i < 16; ++i) qf[i] *= rs * qg[i];
        if (sub == 0) { const float pos = (float)(nb * 128 + q); ROPE16(qf, pos); }
#pragma unroll
        for (int i = 0; i < 16; ++i) qf[i] *= 0.125f;
    }
    __syncthreads();
    const float sink = C.in[I_SINK][l * 8 + h];
    float mx = sink;
    for (int j = 0; j < 128; ++j) {
        const int kj = q + 1 + j; const bool valid = (nb > 0) || (kj >= 128);
        const LAS u32x4* kr = (const LAS u32x4*)(Ks + kj * 72 + sub * 16);
        float kf[16]; const u32x4 w0 = kr[0], w1 = kr[1]; UNPACK8(w0, kf, 0); UNPACK8(w1, kf, 8);
        float s = 0.f;
#pragma unroll
        for (int i = 0; i < 16; ++i) s += qf[i] * kf[i];
        s += __shfl_xor(s, 1); s += __shfl_xor(s, 2);
        if (valid) mx = fmaxf(mx, s);
    }
    float lsum = __expf(sink - mx); float o[16];
#pragma unroll
    for (int i = 0; i < 16; ++i) o[i] = 0.f;
    for (int j = 0; j < 128; ++j) {
        const int kj = q + 1 + j; const bool valid = (nb > 0) || (kj >= 128);
        const LAS u32x4* kr = (const LAS u32x4*)(Ks + kj * 72 + sub * 16);
        float kf[16]; { const u32x4 w0 = kr[0], w1 = kr[1]; UNPACK8(w0, kf, 0); UNPACK8(w1, kf, 8); }
        float s = 0.f;
#pragma unroll
        for (int i = 0; i < 16; ++i) s += qf[i] * kf[i];
        s += __shfl_xor(s, 1); s += __shfl_xor(s, 2);
        const float p = valid ? __expf(s - mx) : 0.f;
        lsum += p;
        const LAS u32x4* vr = (const LAS u32x4*)(Vs + kj * 72 + sub * 16);
        float vf[16]; { const u32x4 w0 = vr[0], w1 = vr[1]; UNPACK8(w0, vf, 0); UNPACK8(w1, vf, 8); }
#pragma unroll
        for (int i = 0; i < 16; ++i) o[i] += p * vf[i];
    }
    const float inv = 1.f / lsum;
#pragma unroll
    for (int i = 0; i < 16; ++i) o[i] *= inv;
    u32x4* op = (u32x4*)(C.o + (size_t)(row0 + q) * NO + 1024 + h * 64 + sub * 16);
    op[0] = PACK8(o, 0); op[1] = PACK8(o, 8);
    __syncthreads();
}

__device__ __forceinline__ void xa_item(LAS unsigned char* lds, const Ctx& C, int l, int tile, int h) {
    const int tid = opaque_tid();
    LAS bf16_t* Ks = (LAS bf16_t*)lds;
    LAS bf16_t* Vs = Ks + 256 * 136;
    const int b = tile >> 6, row0 = tile * 128;
    {
        const int key = tid >> 1, half = tid & 1;
        const bf16_t* src = C.memkv + ((size_t)(l * 512 + b * 256 + key)) * 1024 + h * 128 + half * 64;
        const u32x4* kp = (const u32x4*)src; const u32x4* vp = (const u32x4*)(src + 512);
        float kf[64]; float ss = 0.f;
#pragma unroll
        for (int i = 0; i < 8; ++i) { const u32x4 w = kp[i]; UNPACK8(w, kf, 8 * i); }
#pragma unroll
        for (int i = 0; i < 64; ++i) ss += kf[i] * kf[i];
        ss += __shfl_xor(ss, 1);
        const float rs = rsqrtf(ss * (1.f / 128.f) + EPS);
        const float* kg = C.in[I_XKG] + l * 128 + half * 64;
#pragma unroll
        for (int i = 0; i < 64; ++i) kf[i] *= rs * kg[i];
#pragma unroll
        for (int i = 0; i < 8; ++i) { *(LAS u32x4*)(Ks + key * 136 + half * 64 + 8 * i) = PACK8(kf, 8 * i); *(LAS u32x4*)(Vs + key * 136 + half * 64 + 8 * i) = vp[i]; }
    }
    const int q = tid >> 2, sub = tid & 3;
    float qf[32];
    {
        const u32x4* qp = (const u32x4*)(C.za + (size_t)(row0 + q) * NZA + 2816 + h * 128 + sub * 32);
#pragma unroll
        for (int i = 0; i < 4; ++i) { const u32x4 w = qp[i]; UNPACK8(w, qf, 8 * i); }
        float ss = 0.f;
#pragma unroll
        for (int i = 0; i < 32; ++i) ss += qf[i] * qf[i];
        ss += __shfl_xor(ss, 1); ss += __shfl_xor(ss, 2);
        const float rs = rsqrtf(ss * (1.f / 128.f) + EPS) * 0.08838834764831845f;
        const float* qg = C.in[I_XQG] + l * 128 + sub * 32;
#pragma unroll
        for (int i = 0; i < 32; ++i) qf[i] *= rs * qg[i];
    }
    __syncthreads();
    float mx = -3.0e38f;
    for (int key = 0; key < 256; ++key) {
        const LAS u32x4* kr = (const LAS u32x4*)(Ks + key * 136 + sub * 32);
        float s = 0.f;
#pragma unroll
        for (int c = 0; c < 4; ++c) { float kf[8]; const u32x4 w = kr[c]; UNPACK8(w, kf, 0);
#pragma unroll
            for (int i = 0; i < 8; ++i) s += qf[8 * c + i] * kf[i]; }
        s += __shfl_xor(s, 1); s += __shfl_xor(s, 2);
        mx = fmaxf(mx, s);
    }
    float lsum = 0.f; float o[32];
#pragma unroll
    for (int i = 0; i < 32; ++i) o[i] = 0.f;
    for (int key = 0; key < 256; ++key) {
        const LAS u32x4* kr = (const LAS u32x4*)(Ks + key * 136 + sub * 32);
        float s = 0.f;
#pragma unroll
        for (int c = 0; c < 4; ++c) { float kf[8]; const u32x4 w = kr[c]; UNPACK8(w, kf, 0);
#pragma unroll
            for (int i = 0; i < 8; ++i) s += qf[8 * c + i] * kf[i]; }
        s += __shfl_xor(s, 1); s += __shfl_xor(s, 2);
        const float p = __expf(s - mx);
        lsum += p;
        const LAS u32x4* vr = (const LAS u32x4*)(Vs + key * 136 + sub * 32);
#pragma unroll
        for (int c = 0; c < 4; ++c) { float vf[8]; const u32x4 w = vr[c]; UNPACK8(w, vf, 0);
#pragma unroll
            for (int i = 0; i < 8; ++i) o[8 * c + i] += p * vf[i]; }
    }
    const float inv = 1.f / lsum;
#pragma unroll
    for (int i = 0; i < 32; ++i) o[i] *= inv;
    u32x4* op = (u32x4*)(C.o + (size_t)(row0 + q) * NO + 1536 + h * 128 + sub * 32);
#pragma unroll
    for (int c = 0; c < 4; ++c) op[c] = PACK8(o, 8 * c);
    __syncthreads();
}

__device__ __forceinline__ void gm_item(LAS unsigned char* lds, const Ctx& C, int l, int tile, int g) {
    const int tid = opaque_tid();
    LAS float* vn = (LAS float*)lds;
    LAS float* Wl = vn + 128 * 128;
    LAS float* rsv = Wl + 128 * 128;
    const int row0 = tile * 128;
    {
        const int tok = tid >> 2, sub = tid & 3;
        const u32x4* vp = (const u32x4*)(C.za + (size_t)(row0 + tok) * NZA + 512 + sub * 128);
        float ss = 0.f;
#pragma unroll
        for (int i = 0; i < 16; ++i) { float f[8]; const u32x4 w = vp[i]; UNPACK8(w, f, 0);
#pragma unroll
            for (int e = 0; e < 8; ++e) ss += f[e] * f[e]; }
        ss += __shfl_xor(ss, 1); ss += __shfl_xor(ss, 2);
        if (sub == 0) rsv[tok] = rsqrtf(ss * (1.f / 512.f) + EPS);
        const f32x4* wp = (const f32x4*)(C.in[I_GMWS] + (size_t)(l * 4 + g) * 128 * 128);
#pragma unroll
        for (int i = 0; i < 8; ++i) *(LAS f32x4*)(Wl + (i * 512 + tid) * 4) = wp[i * 512 + tid];
    }
    __syncthreads();
    {
        const int s = tid >> 2, c0 = (tid & 3) * 32;
        const u32x4* vp = (const u32x4*)(C.za + (size_t)(row0 + s) * NZA + 512 + g * 128 + c0);
        const float rs = rsv[s]; const float* vg = C.in[I_GMVG] + l * 512 + g * 128 + c0;
#pragma unroll
        for (int i = 0; i < 4; ++i) { float f[8]; const u32x4 w = vp[i]; UNPACK8(w, f, 0);
#pragma unroll
            for (int e = 0; e < 8; ++e) f[e] *= rs * vg[8 * i + e];
            *(LAS f32x4*)(vn + s * 128 + c0 + 8 * i) = (f32x4){f[0], f[1], f[2], f[3]}; *(LAS f32x4*)(vn + s * 128 + c0 + 8 * i + 4) = (f32x4){f[4], f[5], f[6], f[7]}; }
    }
    __syncthreads();
    {
        const int c = tid & 127, tq = tid >> 7;
        const float* bs = C.in[I_GMBS] + (size_t)(l * 4 + g) * 128;
        for (int k = 0; k < 32; ++k) {
            const int t = tq * 32 + k; float acc = 0.f;
            for (int s = 0; s <= t; ++s) acc += Wl[t * 128 + s] * vn[s * 128 + c];
            const float sval = acc + bs[t];
            const float u = bf2f(C.za[(size_t)(row0 + t) * NZA + g * 128 + c]);
            C.o[(size_t)(row0 + t) * NO + g * 128 + c] = (bf16_t)f2bf(u * sval);
        }
    }
    __syncthreads();
}

__device__ __forceinline__ void lru_item(LAS unsigned char* lds, const Ctx& C, int l, int tile, int hb) {
    const int tid = opaque_tid();
    LAS float* xc = (LAS float*)lds;
    LAS float* wr = xc + 8192;
    LAS float* wi = wr + 4096;
    LAS float* aa = wi + 4096;
    LAS float* bb = aa + 8192;
    const int nb = tile & 63, row0 = tile * 128;
    {
        const int t = tid >> 2, c0 = (tid & 3) * 16, ch = hb * 64 + c0;
        float acc[16];
#pragma unroll
        for (int i = 0; i < 16; ++i) acc[i] = C.in[I_CONVB][l * 512 + ch + i];
#pragma unroll
        for (int k = 0; k < 4; ++k) {
            const int tt = t - 3 + k;
            if (nb * 128 + tt >= 0) {
                const u32x4* xp = (const u32x4*)(C.za + (size_t)(row0 + tt) * NZA + 1024 + ch);
                float f[16]; const u32x4 w0 = xp[0], w1 = xp[1]; UNPACK8(w0, f, 0); UNPACK8(w1, f, 8);
                const float* cw = C.in[I_CONVW] + (size_t)(l * 4 + k) * 512 + ch;
#pragma unroll
                for (int i = 0; i < 16; ++i) acc[i] += cw[i] * f[i];
            }
        }
#pragma unroll
        for (int i = 0; i < 4; ++i) *(LAS f32x4*)(xc + t * 64 + c0 + 4 * i) = (f32x4){acc[4 * i], acc[4 * i + 1], acc[4 * i + 2], acc[4 * i + 3]};
        const f32x4* wrp = (const f32x4*)(C.in[I_WR] + (size_t)(l * 8 + hb) * 4096); const f32x4* wip = (const f32x4*)(C.in[I_WI] + (size_t)(l * 8 + hb) * 4096);
#pragma unroll
        for (int i = 0; i < 2; ++i) { *(LAS f32x4*)(wr + (i * 512 + tid) * 4) = wrp[i * 512 + tid]; *(LAS f32x4*)(wi + (i * 512 + tid) * 4) = wip[i * 512 + tid]; }
    }
    __syncthreads();
    const int j = tid & 63, tg = tid >> 6, chj = hb * 64 + j;
    {
        const float br = C.in[I_BR][l * 512 + chj], bi = C.in[I_BI][l * 512 + chj];
        const float lam = C.in[I_LAM][l * 512 + chj];
        const float sp = log1pf(expf(-lam));
        for (int k = 0; k < 16; ++k) {
            const int t = tg * 16 + k; float r = br, ig = bi;
            for (int i = 0; i < 64; ++i) { const float xv = xc[t * 64 + i]; r += xv * wr[i * 64 + j]; ig += xv * wi[i * 64 + j]; }
            r = sigmoid_f(r); ig = sigmoid_f(ig);
            const float loga = -8.f * r * sp; const float a = expf(loga); const float mult = sqrtf(-expm1f(2.f * loga));
            aa[t * 64 + j] = a; bb[t * 64 + j] = xc[t * 64 + j] * ig * mult;
        }
    }
    __syncthreads();
    if (tid < 64) {
        float hh = 0.f, P = 1.f;
        for (int t = 0; t < 128; ++t) { const float a = aa[t * 64 + tid]; hh = a * hh + bb[t * 64 + tid]; P *= a; aa[t * 64 + tid] = P; bb[t * 64 + tid] = hh; }
        C.carryA[(size_t)tile * 512 + hb * 64 + tid] = P; C.carryH[(size_t)tile * 512 + hb * 64 + tid] = hh;
    }
    __syncthreads();
    for (int k = 0; k < 16; ++k) {
        const int t = tg * 16 + k;
        const float G = bf2f(C.za[(size_t)(row0 + t) * NZA + 1536 + chj]);
        C.ly[(size_t)(row0 + t) * 512 + chj] = G * bb[t * 64 + j]; C.lp[(size_t)(row0 + t) * 512 + chj] = G * aa[t * 64 + j];
    }
    __syncthreads();
}

__device__ __forceinline__ int vperm_pos(int key) { const int w = key & 31; return (key & ~31) + ((w >> 2) & 3) * 8 + (w >> 4) * 4 + (w & 3); }
#define MFMA16(X, Y, ACC) __builtin_amdgcn_mfma_f32_16x16x32_bf16((X), (Y), (ACC), 0, 0, 0)
__device__ __forceinline__ bf16x8 pack_bf16x8(const float* f) { u32x4 w; w[0] = cvt_pk_bf16(f[0], f[1]); w[1] = cvt_pk_bf16(f[2], f[3]); w[2] = cvt_pk_bf16(f[4], f[5]); w[3] = cvt_pk_bf16(f[6], f[7]); return __builtin_bit_cast(bf16x8, w); }

__device__ __forceinline__ void kvprep_phase(const Ctx& C, int gw, int NGW, int lane) {
    for (int r = gw; r < 32 * 256; r += NGW) {
        const int combo = r >> 8, key = r & 255, l = combo >> 3, b = (combo >> 2) & 1, h = combo & 3;
        const unsigned w = *(const unsigned*)(C.memkv + ((size_t)(l * 512 + b * 256 + key)) * 1024 + h * 128 + 2 * lane);
        float f0 = __uint_as_float(w << 16), f1 = __uint_as_float(w & 0xffff0000u);
        const float ss = wave_sum(f0 * f0 + f1 * f1); const float rs = rsqrtf(ss * (1.f / 128.f) + EPS);
        const float* kg = C.in[I_XKG] + l * 128 + 2 * lane;
        *(unsigned*)(C.memK + (size_t)r * 128 + 2 * lane) = pk2(f0 * rs * kg[0], f1 * rs * kg[1]);
    }
    const int gt = gw * 64 + lane, NGT = NGW * 64;
    for (int t = gt; t < 32 * 32 * 128; t += NGT) {
        const int d = t & 127, pg = (t >> 7) & 31, combo = t >> 12, l = combo >> 3, b = (combo >> 2) & 1, h = combo & 3;
        const int kbase = (pg >> 2) * 32 + (pg & 3) * 4;
        const bf16_t* src = C.memkv + ((size_t)(l * 512 + b * 256)) * 1024 + 512 + h * 128 + d;
        unsigned short v[8];
#pragma unroll
        for (int e = 0; e < 4; ++e) { v[e] = src[(size_t)(kbase + e) * 1024]; v[4 + e] = src[(size_t)(kbase + 16 + e) * 1024]; }
        u32x4 o; o[0] = v[0] | ((unsigned)v[1] << 16); o[1] = v[2] | ((unsigned)v[3] << 16); o[2] = v[4] | ((unsigned)v[5] << 16); o[3] = v[6] | ((unsigned)v[7] << 16);
        *(u32x4*)(C.memVt + ((size_t)combo * 128 + d) * 256 + pg * 8) = o;
    }
}

__device__ __forceinline__ void xa_pair_mfma(LAS unsigned char* lds, const Ctx& C, int l, int pairidx) {
    const int tid = opaque_tid(), lane = tid & 63, w = __builtin_amdgcn_readfirstlane(tid >> 6), fr = lane & 15, fq = lane >> 4;
    LAS bf16_t* Ks = (LAS bf16_t*)lds;
    LAS bf16_t* Vt = Ks + 256 * 144;
    const int idx0 = pairidx * 2, bh = idx0 >> 6, b = bh >> 2, h = bh & 3, nb0 = idx0 & 63;
    {
        const u32x4* ksrc = (const u32x4*)(C.memK + ((size_t)(l * 8 + bh)) * 256 * 128);
        const u32x4* vsrc = (const u32x4*)(C.memVt + ((size_t)(l * 8 + bh)) * 128 * 256);
#pragma unroll
        for (int i = 0; i < 8; ++i) { const int ch = i * 512 + tid;
            *(LAS u32x4*)(Ks + (ch >> 4) * 144 + (ch & 15) * 8) = ksrc[ch];
            *(LAS u32x4*)(Vt + (ch >> 5) * 272 + (ch & 31) * 8) = vsrc[ch]; }
    }
    __syncthreads();
    const float* qg = C.in[I_XQG] + l * 128;
    for (int tt = 0; tt < 2; ++tt) {
        const size_t row = (size_t)((b * 64 + nb0 + tt) * 128 + w * 16 + fr);
        bf16x8 qf[4];
        {
            float f[32]; const bf16_t* qp = C.za + row * NZA + 2816 + h * 128 + 8 * fq;
#pragma unroll
            for (int ks = 0; ks < 4; ++ks) { const u32x4 wv = *(const u32x4*)(qp + 32 * ks); UNPACK8(wv, f, 8 * ks); }
            float ss = 0.f;
#pragma unroll
            for (int i = 0; i < 32; ++i) ss += f[i] * f[i];
            ss += __shfl_xor(ss, 16); ss += __shfl_xor(ss, 32);
            const float rs = rsqrtf(ss * (1.f / 128.f) + EPS) * 0.08838834764831845f;
#pragma unroll
            for (int ks = 0; ks < 4; ++ks) {
#pragma unroll
                for (int i = 0; i < 8; ++i) f[8 * ks + i] *= rs * qg[32 * ks + 8 * fq + i];
                qf[ks] = pack_bf16x8(f + 8 * ks); }
        }
        f32x4 acc[16];
#pragma unroll
        for (int kb = 0; kb < 16; ++kb) { acc[kb] = (f32x4){0.f, 0.f, 0.f, 0.f};
#pragma unroll
            for (int ks = 0; ks < 4; ++ks) { const bf16x8 kf = *(const LAS bf16x8*)(Ks + (kb * 16 + fr) * 144 + 32 * ks + 8 * fq); acc[kb] = MFMA16(kf, qf[ks], acc[kb]); } }
        float mx = -3.0e38f;
#pragma unroll
        for (int kb = 0; kb < 16; ++kb) mx = fmaxf(fmaxf(fmaxf(acc[kb][0], acc[kb][1]), fmaxf(acc[kb][2], acc[kb][3])), mx);
        mx = fmaxf(mx, __shfl_xor(mx, 16)); mx = fmaxf(mx, __shfl_xor(mx, 32));
        float lsum = 0.f;
#pragma unroll
        for (int kb = 0; kb < 16; ++kb)
#pragma unroll
            for (int e = 0; e < 4; ++e) { const float pv = __expf(acc[kb][e] - mx); acc[kb][e] = pv; lsum += pv; }
        lsum += __shfl_xor(lsum, 16); lsum += __shfl_xor(lsum, 32);
        const float inv = 1.f / lsum;
        bf16x8 pf[8];
#pragma unroll
        for (int j = 0; j < 8; ++j) { u32x4 wv; wv[0] = cvt_pk_bf16(acc[2 * j][0], acc[2 * j][1]); wv[1] = cvt_pk_bf16(acc[2 * j][2], acc[2 * j][3]); wv[2] = cvt_pk_bf16(acc[2 * j + 1][0], acc[2 * j + 1][1]); wv[3] = cvt_pk_bf16(acc[2 * j + 1][2], acc[2 * j + 1][3]); pf[j] = __builtin_bit_cast(bf16x8, wv); }
        bf16_t* op = C.o + row * NO + 1536 + h * 128 + 4 * fq;
#pragma unroll
        for (int db = 0; db < 8; ++db) {
            f32x4 o = (f32x4){0.f, 0.f, 0.f, 0.f};
#pragma unroll
            for (int j = 0; j < 8; ++j) { const bf16x8 vf = *(const LAS bf16x8*)(Vt + (db * 16 + fr) * 272 + 32 * j + 8 * fq); o = MFMA16(vf, pf[j], o); }
            *(u32x2*)(op + db * 16) = (u32x2){cvt_pk_bf16(o[0] * inv, o[1] * inv), cvt_pk_bf16(o[2] * inv, o[3] * inv)};
        }
    }
    __syncthreads();
}

__device__ __forceinline__ void swa_item_mfma(LAS unsigned char* lds, const Ctx& C, int l, int tile, int kvh) {
    const int tid = opaque_tid(), lane = tid & 63, w = __builtin_amdgcn_readfirstlane(tid >> 6), fr = lane & 15, fq = lane >> 4;
    LAS bf16_t* Ks = (LAS bf16_t*)lds;
    LAS bf16_t* Vt = Ks + 256 * 80;
    const int nb = tile & 63, row0 = tile * 128;
    {
        const int key = tid >> 1, half = tid & 1;
        const bool ok = (nb > 0) || (key >= 128);
        const size_t grow = (size_t)(ok ? row0 - 128 + key : row0);
        const u32x4* kp = (const u32x4*)(C.za + grow * NZA + 2560 + kvh * 64 + half * 32);
        const u32x4* vp = (const u32x4*)(C.za + grow * NZA + 2688 + kvh * 64 + half * 32);
        float kf[32]; float ss = 0.f;
#pragma unroll
        for (int i = 0; i < 4; ++i) { const u32x4 wv = kp[i]; UNPACK8(wv, kf, 8 * i); }
#pragma unroll
        for (int i = 0; i < 32; ++i) ss += kf[i] * kf[i];
        ss += __shfl_xor(ss, 1);
        const float rs = rsqrtf(ss * (1.f / 64.f) + EPS);
        const float* kg = C.in[I_SKG] + l * 64 + half * 32;
#pragma unroll
        for (int i = 0; i < 32; ++i) kf[i] *= rs * kg[i];
        if (half == 0) { const float pos = (float)(nb * 128 - 128 + key); ROPE16(kf, pos); }
#pragma unroll
        for (int i = 0; i < 4; ++i) *(LAS u32x4*)(Ks + key * 80 + half * 32 + 8 * i) = PACK8(kf, 8 * i);
        const int pp = vperm_pos(key);
#pragma unroll
        for (int i = 0; i < 4; ++i) { u32x4 wv = vp[i]; if (!ok) wv = (u32x4){0u, 0u, 0u, 0u};
#pragma unroll
            for (int e = 0; e < 4; ++e) { Vt[(half * 32 + 8 * i + 2 * e) * 272 + pp] = (bf16_t)(wv[e] & 0xffffu); Vt[(half * 32 + 8 * i + 2 * e + 1) * 272 + pp] = (bf16_t)(wv[e] >> 16); } }
    }
    __syncthreads();
    const int i0 = 16 * w, ws2 = w & ~1, qi = i0 + fr;
    float rc[8], rsn[8];
    { const float pos = (float)(nb * 128 + qi);
#pragma unroll
      for (int i = 0; i < 8; ++i) { const float ang = pos * ROPE_INV(i); rc[i] = cosf(ang); rsn[i] = sinf(ang); } }
    const size_t row = (size_t)(row0 + qi);
    for (int hh = 0; hh < 4; ++hh) {
        const int h = kvh * 4 + hh;
        bf16x8 qf[2];
        {
            float f[16]; const bf16_t* qp = C.za + row * NZA + 2048 + h * 64 + 8 * fq;
            { const u32x4 w0 = *(const u32x4*)qp, w1 = *(const u32x4*)(qp + 32); UNPACK8(w0, f, 0); UNPACK8(w1, f, 8); }
            float ss = 0.f;
#pragma unroll
            for (int i = 0; i < 16; ++i) ss += f[i] * f[i];
            ss += __shfl_xor(ss, 16); ss += __shfl_xor(ss, 32);
            const float rs = rsqrtf(ss * (1.f / 64.f) + EPS);
            const float* qg = C.in[I_SQG] + l * 64 + 8 * fq;
#pragma unroll
            for (int i = 0; i < 8; ++i) { f[i] *= rs * qg[i]; f[8 + i] *= rs * qg[32 + i]; }
#pragma unroll
            for (int i = 0; i < 8; ++i) { const float other = __shfl_xor(f[i], 16);
                const float r0 = f[i] * rc[i] - other * rsn[i], r1 = f[i] * rc[i] + other * rsn[i];
                f[i] = (fq == 0) ? r0 : (fq == 1) ? r1 : f[i]; }
#pragma unroll
            for (int i = 0; i < 16; ++i) f[i] *= 0.125f;
            qf[0] = pack_bf16x8(f); qf[1] = pack_bf16x8(f + 8);
        }
        f32x4 acc[10];
#pragma unroll
        for (int kk = 0; kk < 10; ++kk) { acc[kk] = (f32x4){0.f, 0.f, 0.f, 0.f};
#pragma unroll
            for (int ks = 0; ks < 2; ++ks) { const bf16x8 kf = *(const LAS bf16x8*)(Ks + ((ws2 + kk) * 16 + fr) * 80 + 32 * ks + 8 * fq); acc[kk] = MFMA16(kf, qf[ks], acc[kk]); } }
        const float sink = C.in[I_SINK][l * 8 + h];
        float mx = sink;
#pragma unroll
        for (int kk = 0; kk < 10; ++kk)
#pragma unroll
            for (int e = 0; e < 4; ++e) { const int kj = (ws2 + kk) * 16 + 4 * fq + e, dd = kj - qi; const bool valid = (dd >= 1) && (dd <= 128) && ((nb > 0) || (kj >= 128));
                const float sv = valid ? acc[kk][e] : -INFINITY; acc[kk][e] = sv; mx = fmaxf(mx, sv); }
        mx = fmaxf(mx, __shfl_xor(mx, 16)); mx = fmaxf(mx, __shfl_xor(mx, 32));
        float lsum = 0.f;
#pragma unroll
        for (int kk = 0; kk < 10; ++kk)
#pragma unroll
            for (int e = 0; e < 4; ++e) { const float pv = __expf(acc[kk][e] - mx); acc[kk][e] = pv; lsum += pv; }
        lsum += __shfl_xor(lsum, 16); lsum += __shfl_xor(lsum, 32);
        lsum += __expf(sink - mx);
        const float inv = 1.f / lsum;
        bf16x8 pf[5];
#pragma unroll
        for (int j = 0; j < 5; ++j) { u32x4 wv; wv[0] = cvt_pk_bf16(acc[2 * j][0], acc[2 * j][1]); wv[1] = cvt_pk_bf16(acc[2 * j][2], acc[2 * j][3]); wv[2] = cvt_pk_bf16(acc[2 * j + 1][0], acc[2 * j + 1][1]); wv[3] = cvt_pk_bf16(acc[2 * j + 1][2], acc[2 * j + 1][3]); pf[j] = __builtin_bit_cast(bf16x8, wv); }
        bf16_t* op = C.o + row * NO + 1024 + h * 64 + 4 * fq;
#pragma unroll
        for (int db = 0; db < 4; ++db) {
            f32x4 o = (f32x4){0.f, 0.f, 0.f, 0.f};
#pragma unroll
            for (int j = 0; j < 5; ++j) { const bf16x8 vf = *(const LAS bf16x8*)(Vt + (db * 16 + fr) * 272 + (ws2 + 2 * j) * 16 + 8 * fq); o = MFMA16(vf, pf[j], o); }
            *(u32x2*)(op + db * 16) = (u32x2){cvt_pk_bf16(o[0] * inv, o[1] * inv), cvt_pk_bf16(o[2] * inv, o[3] * inv)};
        }
    }
    __syncthreads();
}

__device__ __forceinline__ void gm_item_mfma(LAS unsigned char* lds, const Ctx& C, int l, int tile, int g) {
    const int tid = opaque_tid(), lane = tid & 63, w = __builtin_amdgcn_readfirstlane(tid >> 6), fr = lane & 15, fq = lane >> 4;
    LAS bf16_t* Wl = (LAS bf16_t*)lds;
    LAS bf16_t* vT = Wl + 128 * 144;
    LAS float* rsv = (LAS float*)(vT + 128 * 144);
    const int row0 = tile * 128;
    {
        const int tok = tid >> 2, sub = tid & 3;
        const u32x4* vp = (const u32x4*)(C.za + (size_t)(row0 + tok) * NZA + 512 + sub * 128);
        float ss = 0.f;
#pragma unroll
        for (int i = 0; i < 16; ++i) { float f[8]; const u32x4 wv = vp[i]; UNPACK8(wv, f, 0);
#pragma unroll
            for (int e = 0; e < 8; ++e) ss += f[e] * f[e]; }
        ss += __shfl_xor(ss, 1); ss += __shfl_xor(ss, 2);
        if (sub == 0) rsv[tok] = rsqrtf(ss * (1.f / 512.f) + EPS);
        const u32x4* gp = (const u32x4*)(C.za + (size_t)(row0 + tok) * NZA + 512 + g * 128 + sub * 32);
#pragma unroll
        for (int i = 0; i < 4; ++i) { const u32x4 wv = gp[i];
#pragma unroll
            for (int e = 0; e < 4; ++e) { vT[(sub * 32 + 8 * i + 2 * e) * 144 + tok] = (bf16_t)(wv[e] & 0xffffu); vT[(sub * 32 + 8 * i + 2 * e + 1) * 144 + tok] = (bf16_t)(wv[e] >> 16); } }
    }
    __syncthreads();
    {
        const int t = tid >> 2, s0 = (tid & 3) * 32;
        const f32x4* wp = (const f32x4*)(C.in[I_GMWS] + ((size_t)(l * 4 + g) * 128 + t) * 128 + s0);
#pragma unroll
        for (int i = 0; i < 4; ++i) { const f32x4 a = wp[2 * i], b2 = wp[2 * i + 1]; float f[8] = {a[0], a[1], a[2], a[3], b2[0], b2[1], b2[2], b2[3]};
#pragma unroll
            for (int e = 0; e < 8; ++e) { const int sidx = s0 + 8 * i + e; f[e] = (sidx <= t) ? f[e] * rsv[sidx] : 0.f; }
            *(LAS u32x4*)(Wl + t * 144 + s0 + 8 * i) = PACK8(f, 0); }
    }
    __syncthreads();
    {
        const int nks = (w + 2) >> 1;
        f32x4 acc[8];
#pragma unroll
        for (int cb = 0; cb < 8; ++cb) acc[cb] = (f32x4){0.f, 0.f, 0.f, 0.f};
        for (int ks = 0; ks < nks; ++ks) {
            const bf16x8 wf = *(const LAS bf16x8*)(Wl + (16 * w + fr) * 144 + 32 * ks + 8 * fq);
#pragma unroll
            for (int cb = 0; cb < 8; ++cb) { const bf16x8 vf = *(const LAS bf16x8*)(vT + (cb * 16 + fr) * 144 + 32 * ks + 8 * fq); acc[cb] = MFMA16(wf, vf, acc[cb]); }
        }
        const float* bs = C.in[I_GMBS] + (size_t)(l * 4 + g) * 128 + 16 * w + 4 * fq;
        const float* vg = C.in[I_GMVG] + l * 512 + g * 128;
#pragma unroll
        for (int cb = 0; cb < 8; ++cb) { const int c = cb * 16 + fr; const float gn = vg[c];
#pragma unroll
            for (int e = 0; e < 4; ++e) { const size_t r = (size_t)(row0 + 16 * w + 4 * fq + e);
                const float u = bf2f(C.za[r * NZA + g * 128 + c]);
                C.o[r * NO + g * 128 + c] = (bf16_t)f2bf(u * (gn * acc[cb][e] + bs[e])); } }
    }
    __syncthreads();
}

__device__ __forceinline__ void lru_item_mfma(LAS unsigned char* lds, const Ctx& C, int l, int tile, int hb) {
    const int tid = opaque_tid(), lane = tid & 63, w = __builtin_amdgcn_readfirstlane(tid >> 6), fr = lane & 15, fq = lane >> 4;
    LAS bf16_t* xcb = (LAS bf16_t*)lds;
    LAS bf16_t* wrT = xcb + 128 * 80;
    LAS bf16_t* wiT = wrT + 64 * 80;
    LAS float* xcf = (LAS float*)(lds + 40960);
    LAS float* aa = xcf + 8192;
    LAS float* bb = aa + 8192;
    LAS float* segA = bb + 8192;
    LAS float* segH = segA + 512;
    const int nb = tile & 63, row0 = tile * 128;
    {
        const int t = tid >> 2, c0 = (tid & 3) * 16, ch = hb * 64 + c0;
        float acc[16];
#pragma unroll
        for (int i = 0; i < 16; ++i) acc[i] = C.in[I_CONVB][l * 512 + ch + i];
#pragma unroll
        for (int k = 0; k < 4; ++k) {
            const int tt = t - 3 + k;
            if (nb * 128 + tt >= 0) {
                const u32x4* xp = (const u32x4*)(C.za + (size_t)(row0 + tt) * NZA + 1024 + ch);
                float f[16]; const u32x4 w0 = xp[0], w1 = xp[1]; UNPACK8(w0, f, 0); UNPACK8(w1, f, 8);
                const float* cw = C.in[I_CONVW] + (size_t)(l * 4 + k) * 512 + ch;
#pragma unroll
                for (int i = 0; i < 16; ++i) acc[i] += cw[i] * f[i];
            }
        }
#pragma unroll
        for (int i = 0; i < 4; ++i) *(LAS f32x4*)(xcf + t * 64 + c0 + 4 * i) = (f32x4){acc[4 * i], acc[4 * i + 1], acc[4 * i + 2], acc[4 * i + 3]};
        *(LAS u32x4*)(xcb + t * 80 + c0) = PACK8(acc, 0); *(LAS u32x4*)(xcb + t * 80 + c0 + 8) = PACK8(acc, 8);
        const int wi_ = tid >> 3, j0 = (tid & 7) * 8;
        const f32x4* wrp = (const f32x4*)(C.in[I_WR] + (size_t)(l * 8 + hb) * 4096 + wi_ * 64 + j0); const f32x4* wip = (const f32x4*)(C.in[I_WI] + (size_t)(l * 8 + hb) * 4096 + wi_ * 64 + j0);
        const f32x4 r0 = wrp[0], r1 = wrp[1], q0 = wip[0], q1 = wip[1];
#pragma unroll
        for (int e = 0; e < 4; ++e) { wrT[(j0 + e) * 80 + wi_] = (bf16_t)f2bf(r0[e]); wrT[(j0 + 4 + e) * 80 + wi_] = (bf16_t)f2bf(r1[e]); wiT[(j0 + e) * 80 + wi_] = (bf16_t)f2bf(q0[e]); wiT[(j0 + 4 + e) * 80 + wi_] = (bf16_t)f2bf(q1[e]); }
    }
    __syncthreads();
    {
        bf16x8 xf[2];
#pragma unroll
        for (int ks = 0; ks < 2; ++ks) xf[ks] = *(const LAS bf16x8*)(xcb + (16 * w + fr) * 80 + 32 * ks + 8 * fq);
#pragma unroll
        for (int jb = 0; jb < 4; ++jb) {
            f32x4 ar = (f32x4){0.f, 0.f, 0.f, 0.f}, ai = (f32x4){0.f, 0.f, 0.f, 0.f};
#pragma unroll
            for (int ks = 0; ks < 2; ++ks) { const bf16x8 wf = *(const LAS bf16x8*)(wrT + (jb * 16 + fr) * 80 + 32 * ks + 8 * fq); ar = MFMA16(xf[ks], wf, ar);
                const bf16x8 wf2 = *(const LAS bf16x8*)(wiT + (jb * 16 + fr) * 80 + 32 * ks + 8 * fq); ai = MFMA16(xf[ks], wf2, ai); }
            const int j = jb * 16 + fr, chj = l * 512 + hb * 64 + j;
            const float br = C.in[I_BR][chj], bi = C.in[I_BI][chj], sp8 = -8.f * C.spl[chj];
#pragma unroll
            for (int e = 0; e < 4; ++e) { const int t = 16 * w + 4 * fq + e;
                const float r = sigmoid_f(ar[e] + br), ig = sigmoid_f(ai[e] + bi);
                const float a = __expf(r * sp8); const float mult = __builtin_amdgcn_sqrtf(fmaxf(1.f - a * a, 0.f));
                aa[t * 64 + j] = a; bb[t * 64 + j] = xcf[t * 64 + j] * ig * mult; }
        }
    }
    __syncthreads();
    const int j = tid & 63, sg = tid >> 6;
    {
        float hh = 0.f, P = 1.f;
#pragma unroll 4
        for (int k = 0; k < 16; ++k) { const int t = sg * 16 + k; const float a = aa[t * 64 + j]; hh = a * hh + bb[t * 64 + j]; P *= a; aa[t * 64 + j] = P; bb[t * 64 + j] = hh; }
        segA[sg * 64 + j] = P; segH[sg * 64 + j] = hh;
    }
    __syncthreads();
    {
        float Hc = 0.f, Pc = 1.f;
        for (int s2 = 0; s2 < sg; ++s2) { const float a = segA[s2 * 64 + j]; Hc = a * Hc + segH[s2 * 64 + j]; Pc *= a; }
        const int chj = hb * 64 + j;
        float hl = 0.f, pl = 1.f;
#pragma unroll 4
        for (int k = 0; k < 16; ++k) { const int t = sg * 16 + k; hl = bb[t * 64 + j] + aa[t * 64 + j] * Hc; pl = aa[t * 64 + j] * Pc;
            const float G = bf2f(C.za[(size_t)(row0 + t) * NZA + 1536 + chj]);
            C.ly[(size_t)(row0 + t) * 512 + chj] = G * hl; C.lp[(size_t)(row0 + t) * 512 + chj] = G * pl; }
        if (sg == 7) { C.carryA[(size_t)tile * 512 + chj] = pl; C.carryH[(size_t)tile * 512 + chj] = hl; }
    }
    __syncthreads();
}

__device__ __forceinline__ void fix_item(const Ctx& C, int tile, int half) {
    const int c = opaque_tid(), b = tile >> 6, nb = tile & 63, row0 = tile * 128 + half * 64;
    float H = 0.f;
    for (int jn = 0; jn < nb; ++jn) { const size_t idx = (size_t)(b * 64 + jn) * 512 + c; H = C.carryA[idx] * H + C.carryH[idx]; }
    for (int t = 0; t < 64; ++t) { const size_t r = (size_t)(row0 + t); C.o[r * NO + 512 + c] = (bf16_t)f2bf(C.ly[r * 512 + c] + C.lp[r * 512 + c] * H); }
}

__global__ void __launch_bounds__(512, 2) fwd_megakernel(Args args) {
    extern __shared__ __attribute__((aligned(16))) unsigned char lds_raw[];
    LAS unsigned char* lds = (LAS unsigned char*)lds_raw;
    volatile LAS unsigned* MISC = (volatile LAS unsigned*)(lds + MISC_OFF);
    const int tid = threadIdx.x, lane = tid & 63, wave = __builtin_amdgcn_readfirstlane(tid >> 6);
    const int G = gridDim.x, bx = blockIdx.x;
    unsigned char* ws = args.ws;
    Ctx C;
    C.in = args.in; C.x = args.out;
    C.wt_in = (bf16_t*)(ws + WS_WIN); C.wt_br = (bf16_t*)(ws + WS_WBR); C.wt_out = (bf16_t*)(ws + WS_WOUT); C.wt_ff1 = (bf16_t*)(ws + WS_WFF1); C.wt_ff2 = (bf16_t*)(ws + WS_WFF2); C.wt_kv = (bf16_t*)(ws + WS_WKV);
    C.memn = (bf16_t*)(ws + WS_MEMN); C.memkv = (bf16_t*)(ws + WS_MEMKV); C.xb = (bf16_t*)(ws + WS_XB); C.za = (bf16_t*)(ws + WS_ZA); C.zg = (bf16_t*)(ws + WS_ZG); C.mb = (bf16_t*)(ws + WS_MB); C.o = (bf16_t*)(ws + WS_O);
    C.ssq = (float*)(ws + WS_SSQ); C.carryA = (float*)(ws + WS_CARRY); C.carryH = C.carryA + 128 * 512; C.S = (float*)(ws + WS_S); C.ly = (float*)(ws + WS_LY); C.lp = (float*)(ws + WS_LP); C.memK = (bf16_t*)(ws + WS_MEMK); C.memVt = (bf16_t*)(ws + WS_MEMVT); C.spl = (float*)(ws + WS_SPL);

    if (tid < 64) MISC[tid] = 0u;
    __syncthreads();
    XcdBarrier bar = xcd_barrier_post((unsigned*)(ws + WS_CTL), MISC + 8);
    const int gw = bx * 8 + wave, NGW = G * 8;
    LAS float* scr = (LAS float*)(lds + wave * 16384);

    for (int it = gw; it < IT_WIN + 4 * IT_WKV; it += NGW) {
        if (it < IT_WIN) conv_w(C, 0, 0, it, scr, lane);
        else { const int r = it - IT_WIN; conv_w(C, 5, r / IT_WKV, r % IT_WKV, scr, lane); }
    }
    for (int m = gw; m < M + 512; m += NGW) {
        if (m < M) {
            const f32x4* xr = (const f32x4*)(C.in[I_X] + (size_t)m * D) + lane; f32x4 v[4]; float s = 0.f;
#pragma unroll
            for (int jj = 0; jj < 4; ++jj) { v[jj] = xr[64 * jj]; s += (v[jj].x * v[jj].x + v[jj].y * v[jj].y) + (v[jj].z * v[jj].z + v[jj].w * v[jj].w); }
            s = wave_sum(s);
            f32x4* xo = (f32x4*)(C.x + (size_t)m * D) + lane; u32x2* bo = (u32x2*)(C.xb + (size_t)m * D) + lane;
#pragma unroll
            for (int jj = 0; jj < 4; ++jj) { xo[64 * jj] = v[jj]; bo[64 * jj] = (u32x2){pk2(v[jj].x, v[jj].y), pk2(v[jj].z, v[jj].w)}; }
            if (lane < 16) C.ssq[(size_t)m * 16 + lane] = (lane == 0) ? s : 0.f;
        } else {
            const int r = m - M;
            const f32x4* xr = (const f32x4*)(C.in[I_MEM] + (size_t)r * D) + lane; f32x4 v[4]; float s = 0.f;
#pragma unroll
            for (int jj = 0; jj < 4; ++jj) { v[jj] = xr[64 * jj]; s += (v[jj].x * v[jj].x + v[jj].y * v[jj].y) + (v[jj].z * v[jj].z + v[jj].w * v[jj].w); }
            s = wave_sum(s); const float rs = rsqrtf(s * (1.f / 1024.f) + EPS);
            u32x2* bo = (u32x2*)(C.memn + (size_t)r * D) + lane;
#pragma unroll
            for (int jj = 0; jj < 4; ++jj) bo[64 * jj] = (u32x2){pk2(v[jj].x * rs, v[jj].y * rs), pk2(v[jj].z * rs, v[jj].w * rs)};
        }
    }
    { const int gt = bx * 512 + tid; if (gt < DEPTH * 512) C.spl[gt] = log1pf(expf(-C.in[I_LAM][gt])); }
    __syncthreads();
    if (args.ws == nullptr) cg::this_grid().sync();
    xcd_barrier(bar);

    for (int l = 0; l < DEPTH; ++l) {
        if (l == 0 && bx >= 64 && bx < 96) {
            pg8::Gemm g{C.memn, C.wt_kv}; pg8::SchedKV S{bx - 64}; pg8::EpiKV E{C.memkv};
            pg8::gemm_phase<pg8::EpiKV, pg8::SchedKV, true, D, D, D>(lds, g, S, E);
        }
        {
#ifndef SKIP_G1
            pg8::Gemm g{C.xb, C.wt_in}; pg8::SchedStd S; S.init(M, DIN, G, bx, D, D);
            pg8::EpiZ E{C.za, C.zg, C.ssq, C.in[I_BGATE] + (size_t)l * 4 * D};
            for (int rep = 0; rep < REP_G1; ++rep) pg8::gemm_phase<pg8::EpiZ, pg8::SchedStd, true, D, D, D>(lds, g, S, E);
#endif

        }
        const int cfirst = (l == 0) ? 96 : 64;
        if (G == 256 && bx >= cfirst) {
            const int lane_c = opaque_tid() & 63;
            const int cw = (bx - cfirst) * 8 + wave, NCW = (G - cfirst) * 8;
            for (int it = cw; it < IT_WBR + IT_WOUT + IT_WFF1 + IT_WFF2; it += NCW) {
                int r = it;
                if (r < IT_WBR) { conv_w(C, 1, l, r, scr, lane_c); continue; } r -= IT_WBR;
                if (r < IT_WOUT) { conv_w(C, 2, l, r, scr, lane_c); continue; } r -= IT_WOUT;
                if (r < IT_WFF1) { conv_w(C, 3, l, r, scr, lane_c); continue; } r -= IT_WFF1;
                conv_w(C, 4, l, r, scr, lane_c);
            }
        }
        xcd_barrier(bar);
        {
            if (l == 0) { kvprep_phase(C, gw, NGW, opaque_tid() & 63); xcd_barrier(bar); }
            for (int rmix = 0; rmix < REP_MIX; ++rmix) {
#if USE_MFMA_SWA
            for (int rep = 0; rep < REP_SWA; ++rep) for (int it = bx; it < 256; it += G) swa_item_mfma(lds, C, l, it >> 1, it & 1);
#else
            for (int it = bx; it < 1024; it += G) swa_item(lds, C, l, it >> 3, it & 7);
#endif
#if USE_MFMA_XA
            for (int rep = 0; rep < REP_XA; ++rep) for (int it = bx; it < 256; it += G) xa_pair_mfma(lds, C, l, it);
#else
            for (int it = bx; it < 512; it += G) xa_item(lds, C, l, it >> 2, it & 3);
#endif
#if USE_MFMA_GM
            for (int rep = 0; rep < REP_GM; ++rep) for (int it = bx; it < 512; it += G) gm_item_mfma(lds, C, l, it >> 2, it & 3);
#else
            for (int it = bx; it < 512; it += G) gm_item(lds, C, l, it >> 2, it & 3);
#endif
#if USE_MFMA_LRU
            for (int rep = 0; rep < REP_LRU; ++rep) for (int it = bx; it < 1024; it += G) lru_item_mfma(lds, C, l, it >> 3, it & 7);
#else
            for (int it = bx; it < 1024; it += G) lru_item(lds, C, l, it >> 3, it & 7);
#endif
            }
            const int lane_c = opaque_tid() & 63;
            const int NC0 = (G == 256) ? 0 : IT_WBR + IT_WOUT + IT_WFF1 + IT_WFF2;
            const int NC = IT_WBR + IT_WOUT + IT_WFF1 + IT_WFF2 + (l + 1 < DEPTH ? IT_WIN : 0);
            for (int rep = 0; rep < REP_CONV; ++rep) for (int it = gw + (IT_WBR + IT_WOUT + IT_WFF1 + IT_WFF2 - NC0); it < NC; it += NGW) {
                int r = it;
                if (r < IT_WBR) { conv_w(C, 1, l, r, scr, lane_c); continue; } r -= IT_WBR;
                if (r < IT_WOUT) { conv_w(C, 2, l, r, scr, lane_c); continue; } r -= IT_WOUT;
                if (r < IT_WFF1) { conv_w(C, 3, l, r, scr, lane_c); continue; } r -= IT_WFF1;
                if (r < IT_WFF2) { conv_w(C, 4, l, r, scr, lane_c); continue; } r -= IT_WFF2;
                conv_w(C, 0, l + 1, r, scr, lane_c);
            }
            __syncthreads();
        }
        xcd_barrier(bar);
        for (int rep = 0; rep < REP_FIX; ++rep) for (int it = bx; it < 256; it += G) fix_item(C, it >> 1, it & 1);
        for (int rep = 0; rep < REP_BAR; ++rep) xcd_barrier(bar);
        {
#ifndef SKIP_G2
            pg8::Gemm g{C.o, C.wt_br}; pg8::SchedMerge S; S.t.init(M, D, G, bx, NO, NO);
            pg8::EpiMerge E{C.zg, C.mb};
            for (int rep = 0; rep < REP_G2; ++rep) pg8::gemm_phase<pg8::EpiMerge, pg8::SchedMerge, true, NO, NO, 512>(lds, g, S, E);
#endif

        }
        xcd_barrier(bar);
        {
#ifndef SKIP_G3
            pg8::Gemm g{C.mb, C.wt_out}; pg8::SchedStd S; S.init(M, D, G, bx, D, D);
            for (int rep = 1; rep < REP_G3; ++rep) { pg8::EpiRes E0{C.x, C.ly, C.o, C.S}; pg8::gemm_phase<pg8::EpiRes, pg8::SchedStd, true, D, D, D>(lds, g, S, E0); }
            pg8::EpiRes E{C.x, C.x, C.xb, C.ssq};
            pg8::gemm_phase<pg8::EpiRes, pg8::SchedStd, true, D, D, D>(lds, g, S, E);
#endif

        }
        xcd_barrier(bar);
        {
#ifndef SKIP_G4
            pg8::Gemm g{C.xb, C.wt_ff1}; pg8::SchedStd S; S.init(M, FF, G, bx, D, D);
            pg8::EpiFF1 E{C.zg, C.ssq};
            for (int rep = 0; rep < REP_G4; ++rep) pg8::gemm_phase<pg8::EpiFF1, pg8::SchedStd, true, D, D, D>(lds, g, S, E);
#endif

        }
        xcd_barrier(bar);
        {
#ifndef SKIP_G5
            pg8::Gemm g{C.zg, C.wt_ff2}; pg8::SchedStd S; S.init(M, D, G, bx, FF, FF);
            for (int rep = 1; rep < REP_G5; ++rep) { pg8::EpiRes E0{C.x, C.ly, C.o, C.S}; pg8::gemm_phase<pg8::EpiRes, pg8::SchedStd, true, FF, FF, FF>(lds, g, S, E0); }
            pg8::EpiRes E{C.x, C.x, C.xb, C.ssq};
            pg8::gemm_phase<pg8::EpiRes, pg8::SchedStd, true, FF, FF, FF>(lds, g, S, E);
#endif

        }
        if (l + 1 < DEPTH) xcd_barrier(bar);
    }
}

extern "C" void kernel_launch(void* const* d_in, const int* in_sizes, int n_in, void* d_out, int out_size, void* d_ws, size_t ws_size, hipStream_t stream) {
    static int grid = 0;
    if (grid == 0) {
        if (n_in != 27 || out_size != M * D || ws_size < WS_END) { fprintf(stderr, "kernel_launch: unexpected shapes: n_in %d out %d ws %zu (need %zu)\n", n_in, out_size, ws_size, (size_t)WS_END); grid = -1; return; }
        int dev = 0, cus = 0, per_cu = 0;
        hipGetDevice(&dev); hipDeviceGetAttribute(&cus, hipDeviceAttributeMultiprocessorCount, dev);
        if (hipFuncSetAttribute((const void*)fwd_megakernel, hipFuncAttributeMaxDynamicSharedMemorySize, LDS_BYTES) != hipSuccess) { fprintf(stderr, "kernel_launch: hipFuncSetAttribute failed\n"); grid = -1; return; }
        if (hipOccupancyMaxActiveBlocksPerMultiprocessor(&per_cu, (const void*)fwd_megakernel, 512, LDS_BYTES) != hipSuccess || per_cu < 1) { fprintf(stderr, "kernel_launch: occupancy query says %d\n", per_cu); per_cu = 1; }
        (void)hipGetLastError();
        grid = cus;
        if (grid != 256) fprintf(stderr, "kernel_launch: note: %d CUs\n", grid);
    }
    if (grid < 0) return;
    hipMemsetAsync((char*)d_ws + WS_CTL, 0, CTL_ZERO_BYTES, stream);
    Args a{};
    for (int i = 0; i < 27; ++i) a.in[i] = (const float*)d_in[i];
    a.out = (float*)d_out; a.ws = (unsigned char*)d_ws;
    void* kargs[] = {&a};
    hipError_t e = hipLaunchCooperativeKernel((const void*)fwd_megakernel, dim3(grid), dim3(512), kargs, LDS_BYTES, stream);
    if (e != hipSuccess) fprintf(stderr, "kernel_launch: cooperative launch failed: %s\n", hipGetErrorString(e));
}
```

```cpp
#include <hip/hip_runtime.h>
#include <hip/hip_cooperative_groups.h>
#include <cstdio>
#include <cstdint>
namespace cg = cooperative_groups;

#define LAS __attribute__((address_space(3)))
#define GAS __attribute__((address_space(1)))
typedef unsigned short bf16_t;
typedef short bf16x8 __attribute__((ext_vector_type(8)));
typedef float f32x4 __attribute__((ext_vector_type(4)));
typedef unsigned u32x4 __attribute__((ext_vector_type(4)));
typedef unsigned u32x2 __attribute__((ext_vector_type(2)));

constexpr int M = 16384, D = 1024, DIN = 7424, NZA = 3328, NZG = 4096, FF = 4096, DEPTH = 4, NO = 2048;
constexpr float EPS = 1e-6f;
constexpr size_t MiB = 1u << 20;
constexpr size_t WS_CTL = 0, CTL_ZERO_BYTES = 64 * 1024;
constexpr size_t WS_WIN = 2 * MiB, WS_WBR = 17 * MiB, WS_WOUT = 21 * MiB, WS_WFF1 = 23 * MiB, WS_WFF2 = 31 * MiB, WS_WKV = 39 * MiB;
constexpr size_t WS_MEMN = 47 * MiB, WS_MEMKV = 48 * MiB, WS_SSQ = 52 * MiB, WS_CARRY = 53 * MiB, WS_XB = 54 * MiB;
constexpr size_t WS_ZA = 86 * MiB, WS_S = 86 * MiB, WS_MB = 150 * MiB, WS_ZG = 190 * MiB, WS_O = 318 * MiB, WS_LY = 382 * MiB, WS_LP = 414 * MiB, WS_MEMK = 446 * MiB, WS_MEMVT = 448 * MiB, WS_SPL = 450 * MiB, WS_AGG = 451 * MiB, WS_INC = 453 * MiB, WS_END = 455 * MiB;
static_assert(WS_ZA + (size_t)M * NZA * 2 <= WS_ZG && WS_MB + (size_t)M * D * 2 <= WS_ZG && WS_WIN + (size_t)DIN * D * 2 <= WS_WBR, "ws map");

constexpr int LDS_BYTES = 147456, MISC_OFF = LDS_BYTES - 256;

__device__ __forceinline__ float bf2f(bf16_t h) { return __uint_as_float((unsigned)h << 16); }
__device__ __forceinline__ unsigned f2bf(float f) { unsigned u = __float_as_uint(f); return (u + 0x7fffu + ((u >> 16) & 1u)) >> 16; }
__device__ __forceinline__ unsigned pk2(float lo, float hi) { return f2bf(lo) | (f2bf(hi) << 16); }
__device__ __forceinline__ unsigned cvt_pk_bf16(float lo, float hi) { unsigned r; asm volatile("v_cvt_pk_bf16_f32 %0, %1, %2" : "=v"(r) : "v"(lo), "v"(hi)); return r; }
#define UNPACK8(VV, f, o) do { (f)[(o) + 0] = __uint_as_float((VV)[0] << 16); (f)[(o) + 1] = __uint_as_float((VV)[0] & 0xffff0000u); (f)[(o) + 2] = __uint_as_float((VV)[1] << 16); (f)[(o) + 3] = __uint_as_float((VV)[1] & 0xffff0000u); \
    (f)[(o) + 4] = __uint_as_float((VV)[2] << 16); (f)[(o) + 5] = __uint_as_float((VV)[2] & 0xffff0000u); (f)[(o) + 6] = __uint_as_float((VV)[3] << 16); (f)[(o) + 7] = __uint_as_float((VV)[3] & 0xffff0000u); } while (0)
#define PACK8(f, o) ((u32x4){pk2((f)[(o) + 0], (f)[(o) + 1]), pk2((f)[(o) + 2], (f)[(o) + 3]), pk2((f)[(o) + 4], (f)[(o) + 5]), pk2((f)[(o) + 6], (f)[(o) + 7])})
__device__ __forceinline__ float gelu_t(float x) { const float u = 0.7978845608028654f * (x + 0.044715f * x * x * x); return x * __builtin_amdgcn_rcpf(1.f + __expf(-2.f * u)); }
__device__ __forceinline__ float sigmoid_f(float x) { return __builtin_amdgcn_rcpf(1.f + __expf(-x)); }
__device__ __forceinline__ float row_rstd(const float* ssq, int row) {
    const f32x4* p = (const f32x4*)(ssq + (size_t)row * 16);
    const f32x4 a = p[0], b = p[1], c = p[2], d = p[3];
    const float s = (((a.x + a.y) + (a.z + a.w)) + ((b.x + b.y) + (b.z + b.w))) + (((c.x + c.y) + (c.z + c.w)) + ((d.x + d.y) + (d.z + d.w)));
    return rsqrtf(s * (1.f / 1024.f) + EPS);
}
#define LDS_WAIT() asm volatile("s_waitcnt lgkmcnt(0)" ::: "memory")
__device__ __forceinline__ int opaque_tid() { int t = threadIdx.x; asm volatile("" : "+v"(t)); return t; }

namespace pg8 {
constexpr int BM = 256, BK = 64, HALF = 128, HTB = HALF * BK * 2, STAGE_BYTES = 8 * HTB, NXCD = 8, WGM = 8;
__host__ __device__ __forceinline__ int lds_byte(int r, int c) { const int st = (r >> 4) * 2 + (c >> 5), rr = r & 15, cc = c & 31, ob = rr * 64 + cc * 2; return st * 1024 + (ob ^ (((ob >> 9) & 1) << 5)); }
__host__ __device__ __forceinline__ void stage_rc(int b, int& R, int& C) { const int st = b / 1024, sb = b % 1024, swz = sb ^ (((sb >> 9) & 1) << 5); R = (st >> 1) * 16 + swz / 64; C = (st & 1) * 32 + (swz % 64) / 2; }
__host__ __device__ __forceinline__ int perm32(int rho) { const int n = rho >> 4, i = rho & 15; return 8 * (i >> 2) + 4 * n + (i & 3); }

struct Unit { int pm, pn, b; };
struct Gemm { const bf16_t* A; const bf16_t* Bt; };

struct SchedStd {
    int nM, nN, nwg, G, c; size_t as, bs;
    __device__ void init(int M_, int N_, int G_, int c_, int lda, int ldb) { nM = M_ / BM; nN = N_ / BM; nwg = nM * nN; G = G_; c = c_; as = (size_t)BM * lda * 2; bs = (size_t)BM * ldb * 2; }
    __device__ bool tile(long L, Unit& u) const {
        if (L >= nwg) return false;
        int wgid = (int)L; { const int q = nwg / NXCD, r = nwg % NXCD, xcd = wgid % NXCD, off = wgid / NXCD; wgid = (xcd < r ? xcd * (q + 1) : r * (q + 1) + (xcd - r) * q) + off; }
        const int nig = WGM * nN, gid = wgid / nig, fm = gid * WGM, gsz = (nM - fm) < WGM ? (nM - fm) : WGM;
        u.pm = fm + ((wgid % nig) % gsz); u.pn = (wgid % nig) / gsz; u.b = 0; return true;
    }
    __device__ bool next(int i, Unit& u) const { return tile((long)i * G + c, u); }
    __device__ size_t aoff(const Unit& u) const { return (size_t)u.pm * as; }
    __device__ size_t boff(const Unit& u) const { return (size_t)u.pn * bs; }
};
struct SchedMerge {
    SchedStd t;
    __device__ bool next(int i, Unit& u) const { if (!t.tile((long)(i >> 2) * t.G + t.c, u)) return false; u.b = i & 3; return true; }
    __device__ size_t aoff(const Unit& u) const { return (size_t)u.pm * t.as + (size_t)u.b * 1024; }
    __device__ size_t boff(const Unit& u) const { return (size_t)u.pn * t.bs + (size_t)u.b * 1024; }
};
struct SchedKV {
    int c;
    __device__ bool next(int i, Unit& u) const { if (i > 0 || c >= 32) return false; u.b = c >> 3; u.pm = (c & 7) >> 2; u.pn = c & 3; return true; }
    __device__ size_t aoff(const Unit& u) const { return (size_t)u.pm * 256 * 1024 * 2; }
    __device__ size_t boff(const Unit& u) const { return ((size_t)u.b * 1024 + (size_t)u.pn * 256) * 1024 * 2; }
};

struct EpiZ {
    static constexpr bool PERM = true, KEEPS = false;
    bf16_t* za; bf16_t* zg; const float* ssq; const float* bgate;
    __device__ __forceinline__ void operator()(const f32x4 (&acc)[2][2][4][2], const Unit& u, int wr, int wc, int fr, int fq) const {
        const int row0 = u.pm * BM + wr * 64 + fr, pn = u.pn;
        bf16_t* base; int ldc, colt, mode;
        if (pn < 13) { base = za; ldc = NZA; colt = pn * 256; mode = (pn < 4 || pn == 6 || pn == 7) ? 1 : 0; }
        else { base = zg; ldc = NZG; colt = (pn - 13) * 256; mode = 2; }
        const int col0 = colt + wc * 32 + 8 * fq;
        f32x4 bv[2][2];
#pragma unroll
        for (int bj = 0; bj < 2; ++bj)
#pragma unroll
            for (int n = 0; n < 2; ++n) bv[bj][n] = (mode == 2) ? *(const f32x4*)(bgate + col0 + bj * HALF + 4 * n) : (f32x4){0.f, 0.f, 0.f, 0.f};
#pragma unroll
        for (int ai = 0; ai < 2; ++ai) {
            float rsm[4];
#pragma unroll
            for (int m = 0; m < 4; ++m) rsm[m] = row_rstd(ssq, row0 + ai * HALF + m * 16);
            asm volatile("" ::: "memory");
#pragma unroll
            for (int m = 0; m < 4; ++m) {
                const int row = row0 + ai * HALF + m * 16; const float rs = rsm[m];
                bf16_t* rowp = base + (size_t)row * ldc + col0;
#pragma unroll
                for (int bj = 0; bj < 2; ++bj) {
                    f32x4 v0 = acc[ai][bj][m][0] * rs, v1 = acc[ai][bj][m][1] * rs;
                    if (mode == 1) {
#pragma unroll
                        for (int e = 0; e < 4; ++e) { v0[e] = gelu_t(v0[e]); v1[e] = gelu_t(v1[e]); }
                    } else if (mode == 2) {
                        v0 = v0 + bv[bj][0]; v1 = v1 + bv[bj][1];
#pragma unroll
                        for (int e = 0; e < 4; ++e) { v0[e] = sigmoid_f(v0[e]); v1[e] = sigmoid_f(v1[e]); }
                    }
                    u32x4 w; w.x = cvt_pk_bf16(v0[0], v0[1]); w.y = cvt_pk_bf16(v0[2], v0[3]); w.z = cvt_pk_bf16(v1[0], v1[1]); w.w = cvt_pk_bf16(v1[2], v1[3]);
                    *(u32x4*)(rowp + bj * HALF) = w;
                }
            }
            asm volatile("" ::: "memory");
        }
    }
};
struct EpiFF1 {
    static constexpr bool PERM = true, KEEPS = false;
    bf16_t* f; const float* ssq;
    __device__ __forceinline__ void operator()(const f32x4 (&acc)[2][2][4][2], const Unit& u, int wr, int wc, int fr, int fq) const {
        const int row0 = u.pm * BM + wr * 64 + fr, col0 = u.pn * BM + wc * 32 + 8 * fq;
#pragma unroll
        for (int ai = 0; ai < 2; ++ai) {
            float rsm[4];
#pragma unroll
            for (int m = 0; m < 4; ++m) rsm[m] = row_rstd(ssq, row0 + ai * HALF + m * 16);
            asm volatile("" ::: "memory");
#pragma unroll
            for (int m = 0; m < 4; ++m) {
                const int row = row0 + ai * HALF + m * 16; const float rs = rsm[m];
                bf16_t* rowp = f + (size_t)row * FF + col0;
#pragma unroll
                for (int bj = 0; bj < 2; ++bj) {
                    f32x4 v0 = acc[ai][bj][m][0] * rs, v1 = acc[ai][bj][m][1] * rs;
#pragma unroll
                    for (int e = 0; e < 4; ++e) { const float a = fmaxf(v0[e], 0.f), b = fmaxf(v1[e], 0.f); v0[e] = a * a; v1[e] = b * b; }
                    u32x4 w; w.x = cvt_pk_bf16(v0[0], v0[1]); w.y = cvt_pk_bf16(v0[2], v0[3]); w.z = cvt_pk_bf16(v1[0], v1[1]); w.w = cvt_pk_bf16(v1[2], v1[3]);
                    *(u32x4*)(rowp + bj * HALF) = w;
                }
            }
            asm volatile("" ::: "memory");
        }
    }
};
struct EpiRes {
    static constexpr bool PERM = true, KEEPS = false;
    const float* x; float* xo_; bf16_t* xb; float* ssq;
    __device__ __forceinline__ void operator()(const f32x4 (&acc)[2][2][4][2], const Unit& u, int wr, int wc, int fr, int fq) const {
        const int row0 = u.pm * BM + wr * 64 + fr, col0 = u.pn * BM + wc * 32 + 8 * fq;
#pragma unroll
        for (int ai = 0; ai < 2; ++ai) {
            f32x4 xo[4][2][2];
#pragma unroll
            for (int m = 0; m < 4; ++m)
#pragma unroll
                for (int bj = 0; bj < 2; ++bj) { const float* xp = x + (size_t)(row0 + ai * HALF + m * 16) * D + col0 + bj * HALF; xo[m][bj][0] = *(const f32x4*)xp; xo[m][bj][1] = *(const f32x4*)(xp + 4); }
            asm volatile("" ::: "memory");
#pragma unroll
            for (int m = 0; m < 4; ++m) {
                const int row = row0 + ai * HALF + m * 16; float ss = 0.f;
#pragma unroll
                for (int bj = 0; bj < 2; ++bj) {
                    float* xp = xo_ + (size_t)row * D + col0 + bj * HALF;
                    const f32x4 v0 = xo[m][bj][0] + acc[ai][bj][m][0], v1 = xo[m][bj][1] + acc[ai][bj][m][1];
                    *(f32x4*)xp = v0; *(f32x4*)(xp + 4) = v1;
                    ss += (v0[0] * v0[0] + v0[1] * v0[1]) + (v0[2] * v0[2] + v0[3] * v0[3]) + (v1[0] * v1[0] + v1[1] * v1[1]) + (v1[2] * v1[2] + v1[3] * v1[3]);
                    u32x4 w; w.x = cvt_pk_bf16(v0[0], v0[1]); w.y = cvt_pk_bf16(v0[2], v0[3]); w.z = cvt_pk_bf16(v1[0], v1[1]); w.w = cvt_pk_bf16(v1[2], v1[3]);
                    *(u32x4*)(xb + (size_t)row * D + col0 + bj * HALF) = w;
                }
                ss += __shfl_xor(ss, 16); ss += __shfl_xor(ss, 32);
                if (fq == 0) ssq[(size_t)row * 16 + u.pn * 4 + wc] = ss;
            }
            asm volatile("" ::: "memory");
        }
    }
};
struct EpiMerge {
    static constexpr bool PERM = true, KEEPS = true;
    const bf16_t* zg; bf16_t* mb;
    __device__ __forceinline__ bool merge(f32x4 (&acc)[2][2][4][2], const Unit& u, int wr, int wc, int fr, int fq) const {
        const int row0 = u.pm * BM + wr * 64 + fr, col0 = u.pn * BM + wc * 32 + 8 * fq, b = u.b, bn = b < 3 ? b + 1 : b;
#pragma unroll
        for (int ai = 0; ai < 2; ++ai) {
            u32x4 ga[4][2], gb[4][2];
#pragma unroll
            for (int m = 0; m < 4; ++m)
#pragma unroll
                for (int bj = 0; bj < 2; ++bj) { const bf16_t* gp = zg + (size_t)(row0 + ai * HALF + m * 16) * NZG + col0 + bj * HALF; ga[m][bj] = *(const u32x4*)(gp + b * 1024); gb[m][bj] = *(const u32x4*)(gp + bn * 1024); }
            asm volatile("" ::: "memory");
#pragma unroll
            for (int m = 0; m < 4; ++m) {
                const int row = row0 + ai * HALF + m * 16;
#pragma unroll
                for (int bj = 0; bj < 2; ++bj) {
                    const int col = col0 + bj * HALF;
                    float g[8]; UNPACK8(ga[m][bj], g, 0);
#pragma unroll
                    for (int e = 0; e < 8; ++e) g[e] = fmaxf(g[e], 1e-20f);
                    if (b < 3) {
                        float h[8]; UNPACK8(gb[m][bj], h, 0);
#pragma unroll
                        for (int e = 0; e < 8; ++e) g[e] *= __builtin_amdgcn_rcpf(fmaxf(h[e], 1e-20f));
                    }
#pragma unroll
                    for (int e = 0; e < 4; ++e) { acc[ai][bj][m][0][e] *= g[e]; acc[ai][bj][m][1][e] *= g[4 + e]; }
                    if (b == 3) { const f32x4 v0 = acc[ai][bj][m][0], v1 = acc[ai][bj][m][1];
                        u32x4 w; w.x = cvt_pk_bf16(v0[0], v0[1]); w.y = cvt_pk_bf16(v0[2], v0[3]); w.z = cvt_pk_bf16(v1[0], v1[1]); w.w = cvt_pk_bf16(v1[2], v1[3]);
                        *(u32x4*)(mb + (size_t)row * D + col) = w; }
                }
            }
            asm volatile("" ::: "memory");
        }
        return b < 3;
    }
};
struct EpiKV {
    static constexpr bool PERM = true, KEEPS = false;
    bf16_t* out;
    __device__ __forceinline__ void operator()(const f32x4 (&acc)[2][2][4][2], const Unit& u, int wr, int wc, int fr, int fq) const {
        const int row0 = u.pm * BM + wr * 64 + fr, col0 = u.pn * BM + wc * 32 + 8 * fq;
        bf16_t* base = out + (size_t)u.b * 512 * 1024;
#pragma unroll
        for (int ai = 0; ai < 2; ++ai)
#pragma unroll
            for (int m = 0; m < 4; ++m) {
                const int row = row0 + ai * HALF + m * 16;
#pragma unroll
                for (int bj = 0; bj < 2; ++bj) {
                    const f32x4 v0 = acc[ai][bj][m][0], v1 = acc[ai][bj][m][1];
                    u32x4 w; w.x = cvt_pk_bf16(v0[0], v0[1]); w.y = cvt_pk_bf16(v0[2], v0[3]); w.z = cvt_pk_bf16(v1[0], v1[1]); w.w = cvt_pk_bf16(v1[2], v1[3]);
                    *(u32x4*)(base + (size_t)row * 1024 + col0 + bj * HALF) = w;
                }
            }
    }
};

template <class Epi, class Sched, bool ALIGN_EPI, int LDA, int LDB, int KK>
__device__ __forceinline__ void gemm_phase(LAS unsigned char* lds, const Gemm g, const Sched& S, const Epi& E) {
    const int tid = opaque_tid(), wid = __builtin_amdgcn_readfirstlane(tid >> 6), lane = tid & 63, wr = wid >> 2, wc = wid & 3, fr = lane & 15, fq = lane >> 4;
    constexpr int nt = KK / BK;
    unsigned voffA[2], voffB[2];
#pragma unroll
    for (int i = 0; i < 2; ++i) { int R, C; stage_rc(tid * 16 + i * 8192, R, C); const int Rb = Epi::PERM ? ((R & ~31) + perm32(R & 31)) : R;
        voffA[i] = (unsigned)(R * LDA + C) * 2u; voffB[i] = (unsigned)(Rb * LDB + C) * 2u; }
    constexpr size_t kstep = (size_t)(BK * 2);
    constexpr size_t hstepA = (size_t)HALF * LDA * 2, hstepB = (size_t)HALF * LDB * 2;
    const unsigned ldsw = (unsigned)wid * 1024u;
    const int aoff = lds_byte(wr * 64 + fr, fq * 8), boff = lds_byte(wc * 32 + fr, fq * 8);
#define PG8_SA(b, h) (((b) * 2 + (h)) * HTB)
#define PG8_SB(b, h) ((4 + (b) * 2 + (h)) * HTB)
#define PG8_STAGE(bufoff, gbase, voff) do { _Pragma("unroll") for (int _i = 0; _i < 2; ++_i) \
        __builtin_amdgcn_global_load_lds((const unsigned*)((const char*)(gbase) + (voff)[_i]), (LAS unsigned*)(lds + (bufoff) + ldsw + _i * 8192), 16, 0, 0); } while (0)
#define PG8_LDA(dst, b, h) do { _Pragma("unroll") for (int m = 0; m < 4; ++m) _Pragma("unroll") for (int k = 0; k < 2; ++k) dst[m][k] = *(const LAS bf16x8*)(lds + PG8_SA(b, h) + aoff + m * 2048 + k * 1024); } while (0)
#define PG8_LDB(dst, b, h) do { _Pragma("unroll") for (int n = 0; n < 2; ++n) _Pragma("unroll") for (int k = 0; k < 2; ++k) dst[n][k] = *(const LAS bf16x8*)(lds + PG8_SB(b, h) + boff + n * 2048 + k * 1024); } while (0)
#define PG8_MMA(ai, bj, At, Bt) do { __builtin_amdgcn_s_setprio(1); _Pragma("unroll") for (int m = 0; m < 4; ++m) _Pragma("unroll") for (int n = 0; n < 2; ++n) _Pragma("unroll") for (int k = 0; k < 2; ++k) \
        acc[ai][bj][m][n] = __builtin_amdgcn_mfma_f32_16x16x32_bf16(Bt[n][k], At[m][k], acc[ai][bj][m][n], 0, 0, 0); __builtin_amdgcn_s_setprio(0); } while (0)
#define PG8_WAIT_V(n) asm volatile("s_waitcnt vmcnt(" #n ")" ::: "memory")
#define PG8_WAIT_L(n) asm volatile("s_waitcnt lgkmcnt(" #n ")" ::: "memory")
#define PG8_BAR __builtin_amdgcn_s_barrier()
#define PG8_SCHED __builtin_amdgcn_sched_barrier(0)
    Unit cur, nxt; int ui = 0;
    if (!S.next(0, cur)) return;
    f32x4 acc[2][2][4][2];
#pragma unroll
    for (int a = 0; a < 2; ++a)
#pragma unroll
        for (int b = 0; b < 2; ++b)
#pragma unroll
            for (int m = 0; m < 4; ++m)
#pragma unroll
                for (int n = 0; n < 2; ++n) acc[a][b][m][n] = (f32x4){0.f, 0.f, 0.f, 0.f};
    bf16x8 At[4][2], B0[2][2], B1[2][2];
    const char* gA = (const char*)g.A; const char* gB = (const char*)g.Bt;
    asm volatile("" : "+s"(gA), "+s"(gB));
    const char* cA = gA + S.aoff(cur); const char* cB = gB + S.boff(cur);
    PG8_STAGE(PG8_SB(0, 0), cB, voffB); PG8_STAGE(PG8_SB(0, 1), cB + hstepB, voffB); PG8_STAGE(PG8_SA(0, 0), cA, voffA); PG8_STAGE(PG8_SA(0, 1), cA + hstepA, voffA);
    if (wr == 1) PG8_BAR;
    PG8_WAIT_V(2); PG8_BAR;
    PG8_STAGE(PG8_SB(1, 0), cB + kstep, voffB); PG8_STAGE(PG8_SA(1, 0), cA + kstep, voffA); PG8_STAGE(PG8_SB(1, 1), cB + hstepB + kstep, voffB);
    PG8_WAIT_V(6); PG8_BAR;
    for (;;) {
        const bool has_next = S.next(ui + 1, nxt);
        const char* nA = has_next ? gA + S.aoff(nxt) : cA; const char* nB = has_next ? gB + S.boff(nxt) : cB;
        for (int t = 0; t < nt; t += 2) {
            const bool last = (t == nt - 2);
            const char* a1 = cA + (size_t)(t + 1) * kstep;
            const char* a2 = last ? nA : cA + (size_t)(t + 2) * kstep; const char* b2 = last ? nB : cB + (size_t)(t + 2) * kstep;
            const char* a3 = a2 + kstep; const char* b3 = b2 + kstep;
            PG8_LDB(B0, 0, 0); PG8_LDB(B1, 0, 1); PG8_SCHED; PG8_LDA(At, 0, 0); PG8_STAGE(PG8_SA(1, 1), a1 + hstepA, voffA);
            PG8_WAIT_V(8); PG8_WAIT_L(0); PG8_BAR; PG8_MMA(0, 0, At, B0); PG8_MMA(0, 1, At, B1); PG8_BAR; PG8_SCHED;
            PG8_LDA(At, 0, 1); PG8_STAGE(PG8_SB(0, 0), b2, voffB); PG8_STAGE(PG8_SB(0, 1), b2 + hstepB, voffB); PG8_STAGE(PG8_SA(0, 0), a2, voffA);
            PG8_WAIT_V(8); PG8_WAIT_L(0); PG8_BAR; PG8_MMA(1, 0, At, B0); PG8_MMA(1, 1, At, B1); PG8_BAR; PG8_SCHED;
            PG8_LDB(B0, 1, 0); PG8_LDB(B1, 1, 1); PG8_SCHED; PG8_LDA(At, 1, 0); PG8_STAGE(PG8_SA(0, 1), a2 + hstepA, voffA);
            PG8_WAIT_V(8); PG8_WAIT_L(0); PG8_BAR; PG8_MMA(0, 0, At, B0); PG8_MMA(0, 1, At, B1); PG8_BAR; PG8_SCHED;
            PG8_LDA(At, 1, 1); PG8_STAGE(PG8_SB(1, 0), b3, voffB); PG8_STAGE(PG8_SB(1, 1), b3 + hstepB, voffB); PG8_STAGE(PG8_SA(1, 0), a3, voffA);
            PG8_WAIT_V(8); PG8_WAIT_L(0); PG8_BAR; PG8_MMA(1, 0, At, B0); PG8_MMA(1, 1, At, B1); PG8_BAR; PG8_SCHED;
        }
        if constexpr (ALIGN_EPI) { if (wr == 0) PG8_BAR; }
        bool keep = false;
        if constexpr (Epi::KEEPS) keep = E.merge(acc, cur, wr, wc, fr, fq); else E(acc, cur, wr, wc, fr, fq);
        if (!has_next) break;
        if (!keep)
#pragma unroll
        for (int a = 0; a < 2; ++a)
#pragma unroll
            for (int b = 0; b < 2; ++b)
#pragma unroll
                for (int m = 0; m < 4; ++m)
#pragma unroll
                    for (int n = 0; n < 2; ++n) acc[a][b][m][n] = (f32x4){0.f, 0.f, 0.f, 0.f};
        cur = nxt; cA = nA; cB = nB; ++ui;
        if constexpr (ALIGN_EPI) { if (wr == 1) PG8_BAR; }
    }
    PG8_WAIT_V(0);
    if constexpr (!ALIGN_EPI) { if (wr == 0) PG8_BAR; }
    PG8_BAR;
#undef PG8_SA
#undef PG8_SB
#undef PG8_STAGE
#undef PG8_LDA
#undef PG8_LDB
#undef PG8_MMA
#undef PG8_WAIT_V
#undef PG8_WAIT_L
#undef PG8_BAR
#undef PG8_SCHED
}
}

#define XB_TMO      128
#define XB_XCNT(j)  (256  + 64 * (j))
#define XB_XSUB(j)  (1280 + 64 * (j))
#define XB_XGEN(j)  (2304 + 64 * (j))
#define XB_TOP      3328
#define XB_TOPGEN   3392
#define XCD_BAR_WORDS 3456
#define XB_SPIN_CAP (1u << 23)
__device__ __forceinline__ unsigned xb_ld(unsigned* p)              { return __hip_atomic_load(p, __ATOMIC_RELAXED, __HIP_MEMORY_SCOPE_AGENT); }
__device__ __forceinline__ unsigned xb_add(unsigned* p, unsigned v) { return __hip_atomic_fetch_add(p, v, __ATOMIC_RELAXED, __HIP_MEMORY_SCOPE_AGENT); }
__device__ __forceinline__ unsigned xb_xcc_id() { return (unsigned)__builtin_amdgcn_s_getreg((3 << 11) | 20) & 0xFu; }
#define XB_SPIN(cond, bar) do { unsigned _sp = 0; while (cond) { __builtin_amdgcn_s_sleep(1); \
    if ((++_sp & 255u) == 0u) { if (xb_ld(&(bar)[XB_TMO])) break; if (_sp > XB_SPIN_CAP) { atomicAdd(&(bar)[XB_TMO], 1u); break; } } } } while (0)
struct XcdBarrier { unsigned* bar; unsigned x; volatile LAS unsigned* st; };
__device__ __forceinline__ XcdBarrier xcd_barrier_post(unsigned* bar, volatile LAS unsigned* st) {
    XcdBarrier b; b.bar = bar; b.x = xb_xcc_id(); b.st = st;
    if (threadIdx.x == 0) (void)xb_add(&bar[XB_XCNT(b.x)], 1u);
    return b;
}
__device__ __forceinline__ void xcd_barrier_complete(unsigned* bar, unsigned x, unsigned& nloc, unsigned& nx) {
    const unsigned G = gridDim.x * gridDim.y * gridDim.z;
    unsigned sum, cnt, mine, sp = 0u;
    for (;;) {
        sum = 0u; cnt = 0u; mine = 0u;
#pragma unroll
        for (unsigned j = 0; j < 16; ++j) { const unsigned c = xb_ld(&bar[XB_XCNT(j)]); sum += c; cnt += (c > 0u) ? 1u : 0u; mine = (j == x) ? c : mine; }
        if (sum == G) break;
        __builtin_amdgcn_s_sleep(1);
        if ((++sp & 255u) == 0u) { if (xb_ld(&bar[XB_TMO])) break; if (sp > XB_SPIN_CAP) { atomicAdd(&bar[XB_TMO], 1u); break; } }
    }
    nloc = mine > 0u ? mine : 1u; nx = cnt > 0u ? cnt : 1u;
}
__device__ __forceinline__ void xcd_barrier(const XcdBarrier& b) {
    asm volatile("s_waitcnt vmcnt(0)" ::: "memory");
    __syncthreads();
    if (threadIdx.x == 0) {
        unsigned* bar = b.bar;
        asm volatile("" : "+s"(bar));
        __builtin_amdgcn_s_waitcnt(0);
        unsigned nloc = b.st[0], nx = b.st[1];
        const unsigned bxcc = xb_xcc_id();
        if (nloc == 0u) { xcd_barrier_complete(bar, bxcc, nloc, nx); b.st[0] = nloc; b.st[1] = nx; }
        const unsigned old = xb_add(&bar[XB_XSUB(bxcc)], 1u);
        const unsigned gen = old / nloc;
        if (old + 1u == (gen + 1u) * nloc) {
            __builtin_amdgcn_fence(__ATOMIC_RELEASE, "agent");
            asm volatile("s_waitcnt vmcnt(0)" ::: "memory");
            const unsigned og = xb_add(&bar[XB_TOP], 1u);
            const unsigned tg = og / nx;
            if (og + 1u == (tg + 1u) * nx) xb_add(&bar[XB_TOPGEN], 1u);
            else XB_SPIN(xb_ld(&bar[XB_TOPGEN]) == tg, bar);
            __builtin_amdgcn_fence(__ATOMIC_ACQUIRE, "agent");
            xb_add(&bar[XB_XGEN(bxcc)], 1u);
            asm volatile("s_waitcnt vmcnt(0)" ::: "memory");
        } else {
            XB_SPIN(xb_ld(&bar[XB_XGEN(bxcc)]) == gen, bar);
            __builtin_amdgcn_fence(__ATOMIC_ACQUIRE, "agent");
            asm volatile("s_waitcnt vmcnt(0)" ::: "memory");
        }
    }
    __syncthreads();
}

struct Args { const float* in[27]; float* out; unsigned char* ws; };
enum { I_X = 0, I_MEM, I_NMIX, I_NMEM, I_NMLP, I_WIN, I_BGATE, I_GMVG, I_GMWS, I_GMBS, I_CONVW, I_CONVB, I_WR, I_BR, I_WI, I_BI, I_LAM, I_SQG, I_SKG, I_SINK, I_WKV, I_XQG, I_XKG, I_WBR, I_WOUT, I_WFF1, I_WFF2 };
struct Ctx {
    const float* const* in; float* x;
    bf16_t *wt_in, *wt_br, *wt_out, *wt_ff1, *wt_ff2, *wt_kv, *memn, *memkv, *xb, *za, *zg, *mb, *o;
    float *ssq, *carryA, *carryH, *S, *ly, *lp;
    bf16_t *memK, *memVt;
    float* spl;
    unsigned long long *agg, *inc;
};

__device__ __forceinline__ void transpose_item(const float* W, int N, bf16_t* WT, int ldk, int koff, const float* gain, LAS float* scr, int item, int lane) {
    const int nblk = N / 32, kb = item / nblk, nb = item % nblk, k0 = 64 * kb, n0 = 32 * nb;
#pragma unroll 8
    for (int i = 0; i < 32; ++i) { const int kk = 2 * i + (lane >> 5); float v = W[(size_t)(k0 + kk) * N + n0 + (lane & 31)]; if (gain) v *= gain[k0 + kk]; scr[kk * 33 + (lane & 31)] = v; }
    LDS_WAIT(); asm volatile("" ::: "memory");
    const int c = lane & 7;
#pragma unroll
    for (int j = 0; j < 4; ++j) { const int n = (lane >> 3) + 8 * j; const LAS float* s = scr + (8 * c) * 33 + n;
        u32x4 o; o.x = pk2(s[0 * 33], s[1 * 33]); o.y = pk2(s[2 * 33], s[3 * 33]); o.z = pk2(s[4 * 33], s[5 * 33]); o.w = pk2(s[6 * 33], s[7 * 33]);
        *(u32x4*)(WT + (size_t)(n0 + n) * ldk + koff + k0 + 8 * c) = o; }
    LDS_WAIT(); asm volatile("" ::: "memory");
}
__device__ __forceinline__ float wave_sum(float v) {
#pragma unroll
    for (int o = 1; o < 64; o <<= 1) v += __shfl_xor(v, o);
    return v;
}
__device__ __forceinline__ void conv_w(const Ctx& C, int which, int l, int item, LAS float* scr, int lane) {
    if (which == 0) transpose_item(C.in[I_WIN] + (size_t)l * D * DIN, DIN, C.wt_in, D, 0, C.in[I_NMIX] + l * D, scr, item, lane);
    else if (which == 1) { const int b = item >> 8; transpose_item(C.in[I_WBR] + (size_t)(l * 4 + b) * 512 * D, D, C.wt_br, 2048, b * 512, nullptr, scr, item & 255, lane); }
    else if (which == 2) transpose_item(C.in[I_WOUT] + (size_t)l * D * D, D, C.wt_out, D, 0, nullptr, scr, item, lane);
    else if (which == 3) transpose_item(C.in[I_WFF1] + (size_t)l * D * FF, FF, C.wt_ff1, D, 0, C.in[I_NMLP] + l * D, scr, item, lane);
    else if (which == 4) transpose_item(C.in[I_WFF2] + (size_t)l * FF * D, D, C.wt_ff2, FF, 0, nullptr, scr, item, lane);
    else transpose_item(C.in[I_WKV] + (size_t)l * D * D, D, C.wt_kv + (size_t)l * D * D, D, 0, C.in[I_NMEM] + l * D, scr, item, lane);
}
constexpr int IT_WIN = 16 * 232, IT_WBR = 1024, IT_WOUT = 512, IT_WFF1 = 2048, IT_WFF2 = 2048, IT_WKV = 512;

#ifndef REP_SWA
#define REP_SWA 1
#endif
#ifndef REP_XA
#define REP_XA 1
#endif
#ifndef REP_GM
#define REP_GM 1
#endif
#ifndef REP_LRU
#define REP_LRU 1
#endif
#ifndef REP_CONV
#define REP_CONV 1
#endif
#ifndef REP_FIX
#define REP_FIX 1
#endif
#ifndef REP_G1
#define REP_G1 1
#endif
#ifndef REP_G2
#define REP_G2 1
#endif
#ifndef REP_G4
#define REP_G4 1
#endif
#ifndef REP_G3
#define REP_G3 1
#endif
#ifndef REP_G5
#define REP_G5 1
#endif
#ifndef REP_MIX
#define REP_MIX 1
#endif
#ifndef REP_BAR
#define REP_BAR 1
#endif
#ifndef USE_MFMA_SWA
#define USE_MFMA_SWA 1
#endif
#ifndef USE_MFMA_XA
#define USE_MFMA_XA 1
#endif
#ifndef USE_MFMA_GM
#define USE_MFMA_GM 1
#endif
#ifndef USE_MFMA_LRU
#define USE_MFMA_LRU 1
#endif
#define ROPE_INV(i) ((i) == 0 ? 1.0f : (i) == 1 ? 0.19392274474868576f : (i) == 2 ? 0.03760603093086393f : (i) == 3 ? 0.007292664737217109f : (i) == 4 ? 0.001414213562373095f : (i) == 5 ? 0.0002742481756762073f : (i) == 6 ? 5.318295896944988e-05f : 1.031338537721246e-05f)
#define ROPE16(f, pos) do { _Pragma("unroll") for (int _i = 0; _i < 8; ++_i) { float _s, _c; sincosf((pos) * ROPE_INV(_i), &_s, &_c); const float _x1 = (f)[_i], _x2 = (f)[_i + 8]; (f)[_i] = _x1 * _c - _x2 * _s; (f)[_i + 8] = _x2 * _c + _x1 * _s; } } while (0)

__device__ __forceinline__ void swa_item(LAS unsigned char* lds, const Ctx& C, int l, int tile, int h) {
    const int tid = opaque_tid();
    LAS bf16_t* Ks = (LAS bf16_t*)lds;
    LAS bf16_t* Vs = Ks + 256 * 72;
    const int kvh = h >> 2, nb = tile & 63, row0 = tile * 128;
    {
        const int key = tid >> 1, half = tid & 1;
        const bool ok = (nb > 0) || (key >= 128);
        const size_t grow = (size_t)(ok ? row0 - 128 + key : row0);
        const u32x4* kp = (const u32x4*)(C.za + grow * NZA + 2560 + kvh * 64 + half * 32);
        const u32x4* vp = (const u32x4*)(C.za + grow * NZA + 2688 + kvh * 64 + half * 32);
        float kf[32]; float ss = 0.f;
#pragma unroll
        for (int i = 0; i < 4; ++i) { const u32x4 w = kp[i]; UNPACK8(w, kf, 8 * i); }
#pragma unroll
        for (int i = 0; i < 32; ++i) ss += kf[i] * kf[i];
        ss += __shfl_xor(ss, 1);
        const float rs = rsqrtf(ss * (1.f / 64.f) + EPS);
        const float* kg = C.in[I_SKG] + l * 64 + half * 32;
#pragma unroll
        for (int i = 0; i < 32; ++i) kf[i] *= rs * kg[i];
        if (half == 0) { const float pos = (float)(nb * 128 - 128 + key); ROPE16(kf, pos); }
#pragma unroll
        for (int i = 0; i < 4; ++i) { *(LAS u32x4*)(Ks + key * 72 + half * 32 + 8 * i) = PACK8(kf, 8 * i); *(LAS u32x4*)(Vs + key * 72 + half * 32 + 8 * i) = vp[i]; }
    }
    const int q = tid >> 2, sub = tid & 3;
    float qf[16];
    {
        const u32x4* qp = (const u32x4*)(C.za + (size_t)(row0 + q) * NZA + 2048 + h * 64 + sub * 16);
        const u32x4 w0 = qp[0], w1 = qp[1]; UNPACK8(w0, qf, 0); UNPACK8(w1, qf, 8);
        float ss = 0.f;
#pragma unroll
        for (int i = 0; i < 16; ++i) ss += qf[i] * qf[i];
        ss += __shfl_xor(ss, 1); ss += __shfl_xor(ss, 2);
        const float rs = rsqrtf(ss * (1.f / 64.f) + EPS);
        const float* qg = C.in[I_SQG] + l * 64 + sub * 16;
#pragma unroll
        for (int i = 0; i < 16; ++i) qf[i] *= rs * qg[i];
        if (sub == 0) { const float pos = (float)(nb * 128 + q); ROPE16(qf, pos); }
#pragma unroll
        for (int i = 0; i < 16; ++i) qf[i] *= 0.125f;
    }
    __syncthreads();
    const float sink = C.in[I_SINK][l * 8 + h];
    float mx = sink;
    for (int j = 0; j < 128; ++j) {
        const int kj = q + 1 + j; const bool valid = (nb > 0) || (kj >= 128);
        const LAS u32x4* kr = (const LAS u32x4*)(Ks + kj * 72 + sub * 16);
        float kf[16]; const u32x4 w0 = kr[0], w1 = kr[1]; UNPACK8(w0, kf, 0); UNPACK8(w1, kf, 8);
        float s = 0.f;
#pragma unroll
        for (int i = 0; i < 16; ++i) s += qf[i] * kf[i];
        s += __shfl_xor(s, 1); s += __shfl_xor(s, 2);
        if (valid) mx = fmaxf(mx, s);
    }
    float lsum = __expf(sink - mx); float o[16];
#pragma unroll
    for (int i = 0; i < 16; ++i) o[i] = 0.f;
    for (int j = 0; j < 128; ++j) {
        const int kj = q + 1 + j; const bool valid = (nb > 0) || (kj >= 128);
        const LAS u32x4* kr = (const LAS u32x4*)(Ks + kj * 72 + sub * 16);
        float kf[16]; { const u32x4 w0 = kr[0], w1 = kr[1]; UNPACK8(w0, kf, 0); UNPACK8(w1, kf, 8); }
        float s = 0.f;
#pragma unroll
        for (int i = 0; i < 16; ++i) s += qf[i] * kf[i];
        s += __shfl_xor(s, 1); s += __shfl_xor(s, 2);
        const float p = valid ? __expf(s - mx) : 0.f;
        lsum += p;
        const LAS u32x4* vr = (const LAS u32x4*)(Vs + kj * 72 + sub * 16);
        float vf[16]; { const u32x4 w0 = vr[0], w1 = vr[1]; UNPACK8(w0, vf, 0); UNPACK8(w1, vf, 8); }
#pragma unroll
        for (int i = 0; i < 16; ++i) o[i] += p * vf[i];
    }
    const float inv = 1.f / lsum;
#pragma unroll
    for (int i = 0; i < 16; ++i) o[i] *= inv;
    u32x4* op = (u32x4*)(C.o + (size_t)(row0 + q) * NO + 1024 + h * 64 + sub * 16);
    op[0] = PACK8(o, 0); op[1] = PACK8(o, 8);
    __syncthreads();
}

__device__ __forceinline__ void xa_item(LAS unsigned char* lds, const Ctx& C, int l, int tile, int h) {
    const int tid = opaque_tid();
    LAS bf16_t* Ks = (LAS bf16_t*)lds;
    LAS bf16_t* Vs = Ks + 256 * 136;
    const int b = tile >> 6, row0 = tile * 128;
    {
        const int key = tid >> 1, half = tid & 1;
        const bf16_t* src = C.memkv + ((size_t)(l * 512 + b * 256 + key)) * 1024 + h * 128 + half * 64;
        const u32x4* kp = (const u32x4*)src; const u32x4* vp = (const u32x4*)(src + 512);
        float kf[64]; float ss = 0.f;
#pragma unroll
        for (int i = 0; i < 8; ++i) { const u32x4 w = kp[i]; UNPACK8(w, kf, 8 * i); }
#pragma unroll
        for (int i = 0; i < 64; ++i) ss += kf[i] * kf[i];
        ss += __shfl_xor(ss, 1);
        const float rs = rsqrtf(ss * (1.f / 128.f) + EPS);
        const float* kg = C.in[I_XKG] + l * 128 + half * 64;
#pragma unroll
        for (int i = 0; i < 64; ++i) kf[i] *= rs * kg[i];
#pragma unroll
        for (int i = 0; i < 8; ++i) { *(LAS u32x4*)(Ks + key * 136 + half * 64 + 8 * i) = PACK8(kf, 8 * i); *(LAS u32x4*)(Vs + key * 136 + half * 64 + 8 * i) = vp[i]; }
    }
    const int q = tid >> 2, sub = tid & 3;
    float qf[32];
    {
        const u32x4* qp = (const u32x4*)(C.za + (size_t)(row0 + q) * NZA + 2816 + h * 128 + sub * 32);
#pragma unroll
        for (int i = 0; i < 4; ++i) { const u32x4 w = qp[i]; UNPACK8(w, qf, 8 * i); }
        float ss = 0.f;
#pragma unroll
        for (int i = 0; i < 32; ++i) ss += qf[i] * qf[i];
        ss += __shfl_xor(ss, 1); ss += __shfl_xor(ss, 2);
        const float rs = rsqrtf(ss * (1.f / 128.f) + EPS) * 0.08838834764831845f;
        const float* qg = C.in[I_XQG] + l * 128 + sub * 32;
#pragma unroll
        for (int i = 0; i < 32; ++i) qf[i] *= rs * qg[i];
    }
    __syncthreads();
    float mx = -3.0e38f;
    for (int key = 0; key < 256; ++key) {
        const LAS u32x4* kr = (const LAS u32x4*)(Ks + key * 136 + sub * 32);
        float s = 0.f;
#pragma unroll
        for (int c = 0; c < 4; ++c) { float kf[8]; const u32x4 w = kr[c]; UNPACK8(w, kf, 0);
#pragma unroll
            for (int i = 0; i < 8; ++i) s += qf[8 * c + i] * kf[i]; }
        s += __shfl_xor(s, 1); s += __shfl_xor(s, 2);
        mx = fmaxf(mx, s);
    }
    float lsum = 0.f; float o[32];
#pragma unroll
    for (int i = 0; i < 32; ++i) o[i] = 0.f;
    for (int key = 0; key < 256; ++key) {
        const LAS u32x4* kr = (const LAS u32x4*)(Ks + key * 136 + sub * 32);
        float s = 0.f;
#pragma unroll
        for (int c = 0; c < 4; ++c) { float kf[8]; const u32x4 w = kr[c]; UNPACK8(w, kf, 0);
#pragma unroll
            for (int i = 0; i < 8; ++i) s += qf[8 * c + i] * kf[i]; }
        s += __shfl_xor(s, 1); s += __shfl_xor(s, 2);
        const float p = __expf(s - mx);
        lsum += p;
        const LAS u32x4* vr = (const LAS u32x4*)(Vs + key * 136 + sub * 32);
#pragma unroll
        for (int c = 0; c < 4; ++c) { float vf[8]; const u32x4 w = vr[c]; UNPACK8(w, vf, 0);
#pragma unroll
            for (int i = 0; i < 8; ++i) o[8 * c + i] += p * vf[i]; }
    }
    const float inv = 1.f / lsum;
#pragma unroll
    for (int i = 0; i < 32; ++i) o[i] *= inv;
    u32x4* op = (u32x4*)(C.o + (size_t)(row0 + q) * NO + 1536 + h * 128 + sub * 32);
#pragma unroll
    for (int c = 0; c < 4; ++c) op[c] = PACK8(o, 8 * c);
    __syncthreads();
}

__device__ __forceinline__ void gm_item(LAS unsigned char* lds, const Ctx& C, int l, int tile, int g) {
    const int tid = opaque_tid();
    LAS float* vn = (LAS float*)lds;
    LAS float* Wl = vn + 128 * 128;
    LAS float* rsv = Wl + 128 * 128;
    const int row0 = tile * 128;
    {
        const int tok = tid >> 2, sub = tid & 3;
        const u32x4* vp = (const u32x4*)(C.za + (size_t)(row0 + tok) * NZA + 512 + sub * 128);
        float ss = 0.f;
#pragma unroll
        for (int i = 0; i < 16; ++i) { float f[8]; const u32x4 w = vp[i]; UNPACK8(w, f, 0);
#pragma unroll
            for (int e = 0; e < 8; ++e) ss += f[e] * f[e]; }
        ss += __shfl_xor(ss, 1); ss += __shfl_xor(ss, 2);
        if (sub == 0) rsv[tok] = rsqrtf(ss * (1.f / 512.f) + EPS);
        const f32x4* wp = (const f32x4*)(C.in[I_GMWS] + (size_t)(l * 4 + g) * 128 * 128);
#pragma unroll
        for (int i = 0; i < 8; ++i) *(LAS f32x4*)(Wl + (i * 512 + tid) * 4) = wp[i * 512 + tid];
    }
    __syncthreads();
    {
        const int s = tid >> 2, c0 = (tid & 3) * 32;
        const u32x4* vp = (const u32x4*)(C.za + (size_t)(row0 + s) * NZA + 512 + g * 128 + c0);
        const float rs = rsv[s]; const float* vg = C.in[I_GMVG] + l * 512 + g * 128 + c0;
#pragma unroll
        for (int i = 0; i < 4; ++i) { float f[8]; const u32x4 w = vp[i]; UNPACK8(w, f, 0);
#pragma unroll
            for (int e = 0; e < 8; ++e) f[e] *= rs * vg[8 * i + e];
            *(LAS f32x4*)(vn + s * 128 + c0 + 8 * i) = (f32x4){f[0], f[1], f[2], f[3]}; *(LAS f32x4*)(vn + s * 128 + c0 + 8 * i + 4) = (f32x4){f[4], f[5], f[6], f[7]}; }
    }
    __syncthreads();
    {
        const int c = tid & 127, tq = tid >> 7;
        const float* bs = C.in[I_GMBS] + (size_t)(l * 4 + g) * 128;
        for (int k = 0; k < 32; ++k) {
            const int t = tq * 32 + k; float acc = 0.f;
            for (int s = 0; s <= t; ++s) acc += Wl[t * 128 + s] * vn[s * 128 + c];
            const float sval = acc + bs[t];
            const float u = bf2f(C.za[(size_t)(row0 + t) * NZA + g * 128 + c]);
            C.o[(size_t)(row0 + t) * NO + g * 128 + c] = (bf16_t)f2bf(u * sval);
        }
    }
    __syncthreads();
}

__device__ __forceinline__ void lru_item(LAS unsigned char* lds, const Ctx& C, int l, int tile, int hb) {
    const int tid = opaque_tid();
    LAS float* xc = (LAS float*)lds;
    LAS float* wr = xc + 8192;
    LAS float* wi = wr + 4096;
    LAS float* aa = wi + 4096;
    LAS float* bb = aa + 8192;
    const int nb = tile & 63, row0 = tile * 128;
    {
        const int t = tid >> 2, c0 = (tid & 3) * 16, ch = hb * 64 + c0;
        float acc[16];
#pragma unroll
        for (int i = 0; i < 16; ++i) acc[i] = C.in[I_CONVB][l * 512 + ch + i];
#pragma unroll
        for (int k = 0; k < 4; ++k) {
            const int tt = t - 3 + k;
            if (nb * 128 + tt >= 0) {
                const u32x4* xp = (const u32x4*)(C.za + (size_t)(row0 + tt) * NZA + 1024 + ch);
                float f[16]; const u32x4 w0 = xp[0], w1 = xp[1]; UNPACK8(w0, f, 0); UNPACK8(w1, f, 8);
                const float* cw = C.in[I_CONVW] + (size_t)(l * 4 + k) * 512 + ch;
#pragma unroll
                for (int i = 0; i < 16; ++i) acc[i] += cw[i] * f[i];
            }
        }
#pragma unroll
        for (int i = 0; i < 4; ++i) *(LAS f32x4*)(xc + t * 64 + c0 + 4 * i) = (f32x4){acc[4 * i], acc[4 * i + 1], acc[4 * i + 2], acc[4 * i + 3]};
        const f32x4* wrp = (const f32x4*)(C.in[I_WR] + (size_t)(l * 8 + hb) * 4096); const f32x4* wip = (const f32x4*)(C.in[I_WI] + (size_t)(l * 8 + hb) * 4096);
#pragma unroll
        for (int i = 0; i < 2; ++i) { *(LAS f32x4*)(wr + (i * 512 + tid) * 4) = wrp[i * 512 + tid]; *(LAS f32x4*)(wi + (i * 512 + tid) * 4) = wip[i * 512 + tid]; }
    }
    __syncthreads();
    const int j = tid & 63, tg = tid >> 6, chj = hb * 64 + j;
    {
        const float br = C.in[I_BR][l * 512 + chj], bi = C.in[I_BI][l * 512 + chj];
        const float lam = C.in[I_LAM][l * 512 + chj];
        const float sp = log1pf(expf(-lam));
        for (int k = 0; k < 16; ++k) {
            const int t = tg * 16 + k; float r = br, ig = bi;
            for (int i = 0; i < 64; ++i) { const float xv = xc[t * 64 + i]; r += xv * wr[i * 64 + j]; ig += xv * wi[i * 64 + j]; }
            r = sigmoid_f(r); ig = sigmoid_f(ig);
            const float loga = -8.f * r * sp; const float a = expf(loga); const float mult = sqrtf(-expm1f(2.f * loga));
            aa[t * 64 + j] = a; bb[t * 64 + j] = xc[t * 64 + j] * ig * mult;
        }
    }
    __syncthreads();
    if (tid < 64) {
        float hh = 0.f, P = 1.f;
        for (int t = 0; t < 128; ++t) { const float a = aa[t * 64 + tid]; hh = a * hh + bb[t * 64 + tid]; P *= a; aa[t * 64 + tid] = P; bb[t * 64 + tid] = hh; }
        C.carryA[(size_t)tile * 512 + hb * 64 + tid] = P; C.carryH[(size_t)tile * 512 + hb * 64 + tid] = hh;
    }
    __syncthreads();
    for (int k = 0; k < 16; ++k) {
        const int t = tg * 16 + k;
        const float G = bf2f(C.za[(size_t)(row0 + t) * NZA + 1536 + chj]);
        C.ly[(size_t)(row0 + t) * 512 + chj] = G * bb[t * 64 + j]; C.lp[(size_t)(row0 + t) * 512 + chj] = G * aa[t * 64 + j];
    }
    __syncthreads();
}

__device__ __forceinline__ int vperm_pos(int key) { const int w = key & 31; return (key & ~31) + ((w >> 2) & 3) * 8 + (w >> 4) * 4 + (w & 3); }
#define MFMA16(X, Y, ACC) __builtin_amdgcn_mfma_f32_16x16x32_bf16((X), (Y), (ACC), 0, 0, 0)
__device__ __forceinline__ bf16x8 pack_bf16x8(const float* f) { u32x4 w; w[0] = cvt_pk_bf16(f[0], f[1]); w[1] = cvt_pk_bf16(f[2], f[3]); w[2] = cvt_pk_bf16(f[4], f[5]); w[3] = cvt_pk_bf16(f[6], f[7]); return __builtin_bit_cast(bf16x8, w); }

__device__ __forceinline__ void kvprep_phase(const Ctx& C, int gw, int NGW, int lane) {
    for (int r = gw; r < 32 * 256; r += NGW) {
        const int combo = r >> 8, key = r & 255, l = combo >> 3, b = (combo >> 2) & 1, h = combo & 3;
        const unsigned w = *(const unsigned*)(C.memkv + ((size_t)(l * 512 + b * 256 + key)) * 1024 + h * 128 + 2 * lane);
        float f0 = __uint_as_float(w << 16), f1 = __uint_as_float(w & 0xffff0000u);
        const float ss = wave_sum(f0 * f0 + f1 * f1); const float rs = rsqrtf(ss * (1.f / 128.f) + EPS);
        const float* kg = C.in[I_XKG] + l * 128 + 2 * lane;
        *(unsigned*)(C.memK + (size_t)r * 128 + 2 * lane) = pk2(f0 * rs * kg[0], f1 * rs * kg[1]);
    }
    const int gt = gw * 64 + lane, NGT = NGW * 64;
    for (int t = gt; t < 32 * 32 * 128; t += NGT) {
        const int d = t & 127, pg = (t >> 7) & 31, combo = t >> 12, l = combo >> 3, b = (combo >> 2) & 1, h = combo & 3;
        const int kbase = (pg >> 2) * 32 + (pg & 3) * 4;
        const bf16_t* src = C.memkv + ((size_t)(l * 512 + b * 256)) * 1024 + 512 + h * 128 + d;
        unsigned short v[8];
#pragma unroll
        for (int e = 0; e < 4; ++e) { v[e] = src[(size_t)(kbase + e) * 1024]; v[4 + e] = src[(size_t)(kbase + 16 + e) * 1024]; }
        u32x4 o; o[0] = v[0] | ((unsigned)v[1] << 16); o[1] = v[2] | ((unsigned)v[3] << 16); o[2] = v[4] | ((unsigned)v[5] << 16); o[3] = v[6] | ((unsigned)v[7] << 16);
        *(u32x4*)(C.memVt + ((size_t)combo * 128 + d) * 256 + pg * 8) = o;
    }
}

__device__ __forceinline__ void xa_pair_mfma(LAS unsigned char* lds, const Ctx& C, int l, int pairidx) {
    const int tid = opaque_tid(), lane = tid & 63, w = __builtin_amdgcn_readfirstlane(tid >> 6), fr = lane & 15, fq = lane >> 4;
    LAS bf16_t* Ks = (LAS bf16_t*)lds;
    LAS bf16_t* Vt = Ks + 256 * 144;
    const int idx0 = pairidx * 2, bh = idx0 >> 6, b = bh >> 2, h = bh & 3, nb0 = idx0 & 63;
    {
        const u32x4* ksrc = (const u32x4*)(C.memK + ((size_t)(l * 8 + bh)) * 256 * 128);
        const u32x4* vsrc = (const u32x4*)(C.memVt + ((size_t)(l * 8 + bh)) * 128 * 256);
#pragma unroll
        for (int i = 0; i < 8; ++i) { const int ch = i * 512 + tid;
            *(LAS u32x4*)(Ks + (ch >> 4) * 144 + (ch & 15) * 8) = ksrc[ch];
            *(LAS u32x4*)(Vt + (ch >> 5) * 272 + (ch & 31) * 8) = vsrc[ch]; }
    }
    __syncthreads();
    const float* qg = C.in[I_XQG] + l * 128;
    for (int tt = 0; tt < 2; ++tt) {
        const size_t row = (size_t)((b * 64 + nb0 + tt) * 128 + w * 16 + fr);
        bf16x8 qf[4];
        {
            float f[32]; const bf16_t* qp = C.za + row * NZA + 2816 + h * 128 + 8 * fq;
#pragma unroll
            for (int ks = 0; ks < 4; ++ks) { const u32x4 wv = *(const u32x4*)(qp + 32 * ks); UNPACK8(wv, f, 8 * ks); }
            float ss = 0.f;
#pragma unroll
            for (int i = 0; i < 32; ++i) ss += f[i] * f[i];
            ss += __shfl_xor(ss, 16); ss += __shfl_xor(ss, 32);
            const float rs = rsqrtf(ss * (1.f / 128.f) + EPS) * 0.08838834764831845f;
#pragma unroll
            for (int ks = 0; ks < 4; ++ks) {
#pragma unroll
                for (int i = 0; i < 8; ++i) f[8 * ks + i] *= rs * qg[32 * ks + 8 * fq + i];
                qf[ks] = pack_bf16x8(f + 8 * ks); }
        }
        f32x4 acc[16];
#pragma unroll
        for (int kb = 0; kb < 16; ++kb) { acc[kb] = (f32x4){0.f, 0.f, 0.f, 0.f};
#pragma unroll
            for (int ks = 0; ks < 4; ++ks) { const bf16x8 kf = *(const LAS bf16x8*)(Ks + (kb * 16 + fr) * 144 + 32 * ks + 8 * fq); acc[kb] = MFMA16(kf, qf[ks], acc[kb]); } }
        float mx = -3.0e38f;
#pragma unroll
        for (int kb = 0; kb < 16; ++kb) mx = fmaxf(fmaxf(fmaxf(acc[kb][0], acc[kb][1]), fmaxf(acc[kb][2], acc[kb][3])), mx);
        mx = fmaxf(mx, __shfl_xor(mx, 16)); mx = fmaxf(mx, __shfl_xor(mx, 32));
        float lsum = 0.f;
#pragma unroll
        for (int kb = 0; kb < 16; ++kb)
#pragma unroll
            for (int e = 0; e < 4; ++e) { const float pv = __expf(acc[kb][e] - mx); acc[kb][e] = pv; lsum += pv; }
        lsum += __shfl_xor(lsum, 16); lsum += __shfl_xor(lsum, 32);
        const float inv = 1.f / lsum;
        bf16x8 pf[8];
#pragma unroll
        for (int j = 0; j < 8; ++j) { u32x4 wv; wv[0] = cvt_pk_bf16(acc[2 * j][0], acc[2 * j][1]); wv[1] = cvt_pk_bf16(acc[2 * j][2], acc[2 * j][3]); wv[2] = cvt_pk_bf16(acc[2 * j + 1][0], acc[2 * j + 1][1]); wv[3] = cvt_pk_bf16(acc[2 * j + 1][2], acc[2 * j + 1][3]); pf[j] = __builtin_bit_cast(bf16x8, wv); }
        bf16_t* op = C.o + row * NO + 1536 + h * 128 + 4 * fq;
#pragma unroll
        for (int db = 0; db < 8; ++db) {
            f32x4 o = (f32x4){0.f, 0.f, 0.f, 0.f};
#pragma unroll
            for (int j = 0; j < 8; ++j) { const bf16x8 vf = *(const LAS bf16x8*)(Vt + (db * 16 + fr) * 272 + 32 * j + 8 * fq); o = MFMA16(vf, pf[j], o); }
            *(u32x2*)(op + db * 16) = (u32x2){cvt_pk_bf16(o[0] * inv, o[1] * inv), cvt_pk_bf16(o[2] * inv, o[3] * inv)};
        }
    }
    __syncthreads();
}

__device__ __forceinline__ void swa_item_mfma(LAS unsigned char* lds, const Ctx& C, int l, int tile, int kvh) {
    const int tid = opaque_tid(), lane = tid & 63, w = __builtin_amdgcn_readfirstlane(tid >> 6), fr = lane & 15, fq = lane >> 4;
    LAS bf16_t* Ks = (LAS bf16_t*)lds;
    LAS bf16_t* Vt = Ks + 256 * 80;
    const int nb = tile & 63, row0 = tile * 128;
    {
        const int key = tid >> 1, half = tid & 1;
        const bool ok = (nb > 0) || (key >= 128);
        const size_t grow = (size_t)(ok ? row0 - 128 + key : row0);
        const u32x4* kp = (const u32x4*)(C.za + grow * NZA + 2560 + kvh * 64 + half * 32);
        const u32x4* vp = (const u32x4*)(C.za + grow * NZA + 2688 + kvh * 64 + half * 32);
        float kf[32]; float ss = 0.f;
#pragma unroll
        for (int i = 0; i < 4; ++i) { const u32x4 wv = kp[i]; UNPACK8(wv, kf, 8 * i); }
#pragma unroll
        for (int i = 0; i < 32; ++i) ss += kf[i] * kf[i];
        ss += __shfl_xor(ss, 1);
        const float rs = rsqrtf(ss * (1.f / 64.f) + EPS);
        const float* kg = C.in[I_SKG] + l * 64 + half * 32;
#pragma unroll
        for (int i = 0; i < 32; ++i) kf[i] *= rs * kg[i];
        if (half == 0) { const float pos = (float)(nb * 128 - 128 + key); ROPE16(kf, pos); }
#pragma unroll
        for (int i = 0; i < 4; ++i) *(LAS u32x4*)(Ks + key * 80 + half * 32 + 8 * i) = PACK8(kf, 8 * i);
        const int pp = vperm_pos(key);
#pragma unroll
        for (int i = 0; i < 4; ++i) { u32x4 wv = vp[i]; if (!ok) wv = (u32x4){0u, 0u, 0u, 0u};
#pragma unroll
            for (int e = 0; e < 4; ++e) { Vt[(half * 32 + 8 * i + 2 * e) * 272 + pp] = (bf16_t)(wv[e] & 0xffffu); Vt[(half * 32 + 8 * i + 2 * e + 1) * 272 + pp] = (bf16_t)(wv[e] >> 16); } }
    }
    __syncthreads();
    const int i0 = 16 * w, ws2 = w & ~1, qi = i0 + fr;
    float rc[8], rsn[8];
    { const float pos = (float)(nb * 128 + qi);
#pragma unroll
      for (int i = 0; i < 8; ++i) { const float ang = pos * ROPE_INV(i); rc[i] = cosf(ang); rsn[i] = sinf(ang); } }
    const size_t row = (size_t)(row0 + qi);
    for (int hh = 0; hh < 4; ++hh) {
        const int h = kvh * 4 + hh;
        bf16x8 qf[2];
        {
            float f[16]; const bf16_t* qp = C.za + row * NZA + 2048 + h * 64 + 8 * fq;
            { const u32x4 w0 = *(const u32x4*)qp, w1 = *(const u32x4*)(qp + 32); UNPACK8(w0, f, 0); UNPACK8(w1, f, 8); }
            float ss = 0.f;
#pragma unroll
            for (int i = 0; i < 16; ++i) ss += f[i] * f[i];
            ss += __shfl_xor(ss, 16); ss += __shfl_xor(ss, 32);
            const float rs = rsqrtf(ss * (1.f / 64.f) + EPS);
            const float* qg = C.in[I_SQG] + l * 64 + 8 * fq;
#pragma unroll
            for (int i = 0; i < 8; ++i) { f[i] *= rs * qg[i]; f[8 + i] *= rs * qg[32 + i]; }
#pragma unroll
            for (int i = 0; i < 8; ++i) { const float other = __shfl_xor(f[i], 16);
                const float r0 = f[i] * rc[i] - other * rsn[i], r1 = f[i] * rc[i] + other * rsn[i];
                f[i] = (fq == 0) ? r0 : (fq == 1) ? r1 : f[i]; }
#pragma unroll
            for (int i = 0; i < 16; ++i) f[i] *= 0.125f;
            qf[0] = pack_bf16x8(f); qf[1] = pack_bf16x8(f + 8);
        }
        f32x4 acc[10];
#pragma unroll
        for (int kk = 0; kk < 10; ++kk) { acc[kk] = (f32x4){0.f, 0.f, 0.f, 0.f};
#pragma unroll
            for (int ks = 0; ks < 2; ++ks) { const bf16x8 kf = *(const LAS bf16x8*)(Ks + ((ws2 + kk) * 16 + fr) * 80 + 32 * ks + 8 * fq); acc[kk] = MFMA16(kf, qf[ks], acc[kk]); } }
        const float sink = C.in[I_SINK][l * 8 + h];
        float mx = sink;
#pragma unroll
        for (int kk = 0; kk < 10; ++kk)
#pragma unroll
            for (int e = 0; e < 4; ++e) { const int kj = (ws2 + kk) * 16 + 4 * fq + e, dd = kj - qi; const bool valid = (dd >= 1) && (dd <= 128) && ((nb > 0) || (kj >= 128));
                const float sv = valid ? acc[kk][e] : -INFINITY; acc[kk][e] = sv; mx = fmaxf(mx, sv); }
        mx = fmaxf(mx, __shfl_xor(mx, 16)); mx = fmaxf(mx, __shfl_xor(mx, 32));
        float lsum = 0.f;
#pragma unroll
        for (int kk = 0; kk < 10; ++kk)
#pragma unroll
            for (int e = 0; e < 4; ++e) { const float pv = __expf(acc[kk][e] - mx); acc[kk][e] = pv; lsum += pv; }
        lsum += __shfl_xor(lsum, 16); lsum += __shfl_xor(lsum, 32);
        lsum += __expf(sink - mx);
        const float inv = 1.f / lsum;
        bf16x8 pf[5];
#pragma unroll
        for (int j = 0; j < 5; ++j) { u32x4 wv; wv[0] = cvt_pk_bf16(acc[2 * j][0], acc[2 * j][1]); wv[1] = cvt_pk_bf16(acc[2 * j][2], acc[2 * j][3]); wv[2] = cvt_pk_bf16(acc[2 * j + 1][0], acc[2 * j + 1][1]); wv[3] = cvt_pk_bf16(acc[2 * j + 1][2], acc[2 * j + 1][3]); pf[j] = __builtin_bit_cast(bf16x8, wv); }
        bf16_t* op = C.o + row * NO + 1024 + h * 64 + 4 * fq;
#pragma unroll
        for (int db = 0; db < 4; ++db) {
            f32x4 o = (f32x4){0.f, 0.f, 0.f, 0.f};
#pragma unroll
            for (int j = 0; j < 5; ++j) { const bf16x8 vf = *(const LAS bf16x8*)(Vt + (db * 16 + fr) * 272 + (ws2 + 2 * j) * 16 + 8 * fq); o = MFMA16(vf, pf[j], o); }
            *(u32x2*)(op + db * 16) = (u32x2){cvt_pk_bf16(o[0] * inv, o[1] * inv), cvt_pk_bf16(o[2] * inv, o[3] * inv)};
        }
    }
    __syncthreads();
}

__device__ __forceinline__ void gm_item_mfma(LAS unsigned char* lds, const Ctx& C, int l, int tile, int g) {
    const int tid = opaque_tid(), lane = tid & 63, w = __builtin_amdgcn_readfirstlane(tid >> 6), fr = lane & 15, fq = lane >> 4;
    LAS bf16_t* Wl = (LAS bf16_t*)lds;
    LAS bf16_t* vT = Wl + 128 * 144;
    LAS float* rsv = (LAS float*)(vT + 128 * 144);
    const int row0 = tile * 128;
    {
        const int tok = tid >> 2, sub = tid & 3;
        const u32x4* vp = (const u32x4*)(C.za + (size_t)(row0 + tok) * NZA + 512 + sub * 128);
        float ss = 0.f;
#pragma unroll
        for (int i = 0; i < 16; ++i) { float f[8]; const u32x4 wv = vp[i]; UNPACK8(wv, f, 0);
#pragma unroll
            for (int e = 0; e < 8; ++e) ss += f[e] * f[e]; }
        ss += __shfl_xor(ss, 1); ss += __shfl_xor(ss, 2);
        if (sub == 0) rsv[tok] = rsqrtf(ss * (1.f / 512.f) + EPS);
        const u32x4* gp = (const u32x4*)(C.za + (size_t)(row0 + tok) * NZA + 512 + g * 128 + sub * 32);
#pragma unroll
        for (int i = 0; i < 4; ++i) { const u32x4 wv = gp[i];
#pragma unroll
            for (int e = 0; e < 4; ++e) { vT[(sub * 32 + 8 * i + 2 * e) * 144 + tok] = (bf16_t)(wv[e] & 0xffffu); vT[(sub * 32 + 8 * i + 2 * e + 1) * 144 + tok] = (bf16_t)(wv[e] >> 16); } }
    }
    __syncthreads();
    {
        const int t = tid >> 2, s0 = (tid & 3) * 32;
        const f32x4* wp = (const f32x4*)(C.in[I_GMWS] + ((size_t)(l * 4 + g) * 128 + t) * 128 + s0);
#pragma unroll
        for (int i = 0; i < 4; ++i) { const f32x4 a = wp[2 * i], b2 = wp[2 * i + 1]; float f[8] = {a[0], a[1], a[2], a[3], b2[0], b2[1], b2[2], b2[3]};
#pragma unroll
            for (int e = 0; e < 8; ++e) { const int sidx = s0 + 8 * i + e; f[e] = (sidx <= t) ? f[e] * rsv[sidx] : 0.f; }
            *(LAS u32x4*)(Wl + t * 144 + s0 + 8 * i) = PACK8(f, 0); }
    }
    __syncthreads();
    {
        const int nks = (w + 2) >> 1;
        f32x4 acc[8];
#pragma unroll
        for (int cb = 0; cb < 8; ++cb) acc[cb] = (f32x4){0.f, 0.f, 0.f, 0.f};
        for (int ks = 0; ks < nks; ++ks) {
            const bf16x8 wf = *(const LAS bf16x8*)(Wl + (16 * w + fr) * 144 + 32 * ks + 8 * fq);
#pragma unroll
            for (int cb = 0; cb < 8; ++cb) { const bf16x8 vf = *(const LAS bf16x8*)(vT + (cb * 16 + fr) * 144 + 32 * ks + 8 * fq); acc[cb] = MFMA16(wf, vf, acc[cb]); }
        }
        const float* bs = C.in[I_GMBS] + (size_t)(l * 4 + g) * 128 + 16 * w + 4 * fq;
        const float* vg = C.in[I_GMVG] + l * 512 + g * 128;
#pragma unroll
        for (int cb = 0; cb < 8; ++cb) { const int c = cb * 16 + fr; const float gn = vg[c];
#pragma unroll
            for (int e = 0; e < 4; ++e) { const size_t r = (size_t)(row0 + 16 * w + 4 * fq + e);
                const float u = bf2f(C.za[r * NZA + g * 128 + c]);
                C.o[r * NO + g * 128 + c] = (bf16_t)f2bf(u * (gn * acc[cb][e] + bs[e])); } }
    }
    __syncthreads();
}

__device__ __forceinline__ void lru_item_mfma(LAS unsigned char* lds, const Ctx& C, int l, int tile, int hb) {
    const int tid = opaque_tid(), lane = tid & 63, w = __builtin_amdgcn_readfirstlane(tid >> 6), fr = lane & 15, fq = lane >> 4;
    LAS bf16_t* xcb = (LAS bf16_t*)lds;
    LAS bf16_t* wrT = xcb + 128 * 80;
    LAS bf16_t* wiT = wrT + 64 * 80;
    LAS float* xcf = (LAS float*)(lds + 40960);
    LAS float* aa = xcf + 8192;
    LAS float* bb = aa + 8192;
    LAS float* segA = bb + 8192;
    LAS float* segH = segA + 512;
    const int nb = tile & 63, row0 = tile * 128;
    {
        const int t = tid >> 2, c0 = (tid & 3) * 16, ch = hb * 64 + c0;
        float acc[16];
#pragma unroll
        for (int i = 0; i < 16; ++i) acc[i] = C.in[I_CONVB][l * 512 + ch + i];
#pragma unroll
        for (int k = 0; k < 4; ++k) {
            const int tt = t - 3 + k;
            if (nb * 128 + tt >= 0) {
                const u32x4* xp = (const u32x4*)(C.za + (size_t)(row0 + tt) * NZA + 1024 + ch);
                float f[16]; const u32x4 w0 = xp[0], w1 = xp[1]; UNPACK8(w0, f, 0); UNPACK8(w1, f, 8);
                const float* cw = C.in[I_CONVW] + (size_t)(l * 4 + k) * 512 + ch;
#pragma unroll
                for (int i = 0; i < 16; ++i) acc[i] += cw[i] * f[i];
            }
        }
#pragma unroll
        for (int i = 0; i < 4; ++i) *(LAS f32x4*)(xcf + t * 64 + c0 + 4 * i) = (f32x4){acc[4 * i], acc[4 * i + 1], acc[4 * i + 2], acc[4 * i + 3]};
        *(LAS u32x4*)(xcb + t * 80 + c0) = PACK8(acc, 0); *(LAS u32x4*)(xcb + t * 80 + c0 + 8) = PACK8(acc, 8);
        const int wi_ = tid >> 3, j0 = (tid & 7) * 8;
        const f32x4* wrp = (const f32x4*)(C.in[I_WR] + (size_t)(l * 8 + hb) * 4096 + wi_ * 64 + j0); const f32x4* wip = (const f32x4*)(C.in[I_WI] + (size_t)(l * 8 + hb) * 4096 + wi_ * 64 + j0);
        const f32x4 r0 = wrp[0], r1 = wrp[1], q0 = wip[0], q1 = wip[1];
#pragma unroll
        for (int e = 0; e < 4; ++e) { wrT[(j0 + e) * 80 + wi_] = (bf16_t)f2bf(r0[e]); wrT[(j0 + 4 + e) * 80 + wi_] = (bf16_t)f2bf(r1[e]); wiT[(j0 + e) * 80 + wi_] = (bf16_t)f2bf(q0[e]); wiT[(j0 + 4 + e) * 80 + wi_] = (bf16_t)f2bf(q1[e]); }
    }
    __syncthreads();
    {
        bf16x8 xf[2];
#pragma unroll
        for (int ks = 0; ks < 2; ++ks) xf[ks] = *(const LAS bf16x8*)(xcb + (16 * w + fr) * 80 + 32 * ks + 8 * fq);
#pragma unroll
        for (int jb = 0; jb < 4; ++jb) {
            f32x4 ar = (f32x4){0.f, 0.f, 0.f, 0.f}, ai = (f32x4){0.f, 0.f, 0.f, 0.f};
#pragma unroll
            for (int ks = 0; ks < 2; ++ks) { const bf16x8 wf = *(const LAS bf16x8*)(wrT + (jb * 16 + fr) * 80 + 32 * ks + 8 * fq); ar = MFMA16(xf[ks], wf, ar);
                const bf16x8 wf2 = *(const LAS bf16x8*)(wiT + (jb * 16 + fr) * 80 + 32 * ks + 8 * fq); ai = MFMA16(xf[ks], wf2, ai); }
            const int j = jb * 16 + fr, chj = l * 512 + hb * 64 + j;
            const float br = C.in[I_BR][chj], bi = C.in[I_BI][chj], sp8 = -8.f * C.spl[chj];
#pragma unroll
            for (int e = 0; e < 4; ++e) { const int t = 16 * w + 4 * fq + e;
                const float r = sigmoid_f(ar[e] + br), ig = sigmoid_f(ai[e] + bi);
                const float a = __expf(r * sp8); const float mult = __builtin_amdgcn_sqrtf(fmaxf(1.f - a * a, 0.f));
                aa[t * 64 + j] = a; bb[t * 64 + j] = xcf[t * 64 + j] * ig * mult; }
        }
    }
    __syncthreads();
    const int j = tid & 63, sg = tid >> 6;
    {
        float hh = 0.f, P = 1.f;
#pragma unroll 4
        for (int k = 0; k < 16; ++k) { const int t = sg * 16 + k; const float a = aa[t * 64 + j]; hh = a * hh + bb[t * 64 + j]; P *= a; aa[t * 64 + j] = P; bb[t * 64 + j] = hh; }
        segA[sg * 64 + j] = P; segH[sg * 64 + j] = hh;
    }
    __syncthreads();
    LAS float* cin = segH + 512;
    float Hc = 0.f, Pc = 1.f;
    for (int s2 = 0; s2 < sg; ++s2) { const float a = segA[s2 * 64 + j]; Hc = a * Hc + segH[s2 * 64 + j]; Pc *= a; }
    const int chj = hb * 64 + j, bt = tile >> 6;
    const size_t wbase = (size_t)l * 128 * 512 + chj;
    if (sg == 7) {
        const float At = Pc * segA[7 * 64 + j], Hl = segA[7 * 64 + j] * Hc + segH[7 * 64 + j];
        __hip_atomic_store(C.agg + wbase + (size_t)tile * 512, ((unsigned long long)__float_as_uint(Hl) << 32) | (unsigned long long)(__float_as_uint(At) | 1u), __ATOMIC_RELAXED, __HIP_MEMORY_SCOPE_AGENT);
    }
    if (sg == 0) {
        const int r0 = nb & ~15;
        unsigned long long wv[16]; unsigned spins = 0;
        for (;;) {
            bool ok = true;
#pragma unroll
            for (int i = 0; i < 16; ++i) {
                const int n = r0 - 1 + i; const bool need = (i == 0) ? (r0 > 0) : (n < nb);
                const unsigned long long* pw = (i == 0 ? C.inc : C.agg) + wbase + (size_t)(bt * 64 + (need ? n : 0)) * 512;
                wv[i] = need ? __hip_atomic_load(pw, __ATOMIC_RELAXED, __HIP_MEMORY_SCOPE_AGENT) : 1ull;
                ok = ok && (wv[i] != 0ull);
            }
            if (ok || ++spins > (1u << 20)) break;
            __builtin_amdgcn_s_sleep(2);
        }
        float Hin = (r0 > 0) ? __uint_as_float((unsigned)(wv[0] >> 32)) : 0.f;
#pragma unroll
        for (int i = 1; i < 16; ++i) if (r0 - 1 + i < nb) Hin = __uint_as_float((unsigned)wv[i]) * Hin + __uint_as_float((unsigned)(wv[i] >> 32));
        cin[j] = Hin;
    }
    __syncthreads();
    {
        const float Hs = Hc + Pc * cin[j];
        float hl = 0.f;
#pragma unroll 4
        for (int k = 0; k < 16; ++k) { const int t = sg * 16 + k; hl = bb[t * 64 + j] + aa[t * 64 + j] * Hs;
            const float G = bf2f(C.za[(size_t)(row0 + t) * NZA + 1536 + chj]);
            C.o[(size_t)(row0 + t) * NO + 512 + chj] = (bf16_t)f2bf(G * hl); }
        if (sg == 7) __hip_atomic_store(C.inc + wbase + (size_t)tile * 512, ((unsigned long long)__float_as_uint(hl) << 32) | 1ull, __ATOMIC_RELAXED, __HIP_MEMORY_SCOPE_AGENT);
    }
    __syncthreads();
}

__device__ __forceinline__ void fix_item(const Ctx& C, int tile, int half) {
    const int c = opaque_tid(), b = tile >> 6, nb = tile & 63, row0 = tile * 128 + half * 64;
    float H = 0.f;
    for (int jn = 0; jn < nb; ++jn) { const size_t idx = (size_t)(b * 64 + jn) * 512 + c; H = C.carryA[idx] * H + C.carryH[idx]; }
    for (int t = 0; t < 64; ++t) { const size_t r = (size_t)(row0 + t); C.o[r * NO + 512 + c] = (bf16_t)f2bf(C.ly[r * 512 + c] + C.lp[r * 512 + c] * H); }
}

__global__ void __launch_bounds__(512, 2) fwd_megakernel(Args args) {
    extern __shared__ __attribute__((aligned(16))) unsigned char lds_raw[];
    LAS unsigned char* lds = (LAS unsigned char*)lds_raw;
    volatile LAS unsigned* MISC = (volatile LAS unsigned*)(lds + MISC_OFF);
    const int tid = threadIdx.x, lane = tid & 63, wave = __builtin_amdgcn_readfirstlane(tid >> 6);
    const int G = gridDim.x, bx = blockIdx.x;
    unsigned char* ws = args.ws;
    Ctx C;
    C.in = args.in; C.x = args.out;
    C.wt_in = (bf16_t*)(ws + WS_WIN); C.wt_br = (bf16_t*)(ws + WS_WBR); C.wt_out = (bf16_t*)(ws + WS_WOUT); C.wt_ff1 = (bf16_t*)(ws + WS_WFF1); C.wt_ff2 = (bf16_t*)(ws + WS_WFF2); C.wt_kv = (bf16_t*)(ws + WS_WKV);
    C.memn = (bf16_t*)(ws + WS_MEMN); C.memkv = (bf16_t*)(ws + WS_MEMKV); C.xb = (bf16_t*)(ws + WS_XB); C.za = (bf16_t*)(ws + WS_ZA); C.zg = (bf16_t*)(ws + WS_ZG); C.mb = (bf16_t*)(ws + WS_MB); C.o = (bf16_t*)(ws + WS_O);
    C.ssq = (float*)(ws + WS_SSQ); C.carryA = (float*)(ws + WS_CARRY); C.carryH = C.carryA + 128 * 512; C.S = (float*)(ws + WS_S); C.ly = (float*)(ws + WS_LY); C.lp = (float*)(ws + WS_LP); C.memK = (bf16_t*)(ws + WS_MEMK); C.memVt = (bf16_t*)(ws + WS_MEMVT); C.spl = (float*)(ws + WS_SPL); C.agg = (unsigned long long*)(ws + WS_AGG); C.inc = (unsigned long long*)(ws + WS_INC);

    if (tid < 64) MISC[tid] = 0u;
    __syncthreads();
    XcdBarrier bar = xcd_barrier_post((unsigned*)(ws + WS_CTL), MISC + 8);
    const int gw = bx * 8 + wave, NGW = G * 8;
    LAS float* scr = (LAS float*)(lds + wave * 16384);

    for (int it = gw; it < IT_WIN + 4 * IT_WKV; it += NGW) {
        if (it < IT_WIN) conv_w(C, 0, 0, it, scr, lane);
        else { const int r = it - IT_WIN; conv_w(C, 5, r / IT_WKV, r % IT_WKV, scr, lane); }
    }
    for (int m = gw; m < M + 512; m += NGW) {
        if (m < M) {
            const f32x4* xr = (const f32x4*)(C.in[I_X] + (size_t)m * D) + lane; f32x4 v[4]; float s = 0.f;
#pragma unroll
            for (int jj = 0; jj < 4; ++jj) { v[jj] = xr[64 * jj]; s += (v[jj].x * v[jj].x + v[jj].y * v[jj].y) + (v[jj].z * v[jj].z + v[jj].w * v[jj].w); }
            s = wave_sum(s);
            f32x4* xo = (f32x4*)(C.x + (size_t)m * D) + lane; u32x2* bo = (u32x2*)(C.xb + (size_t)m * D) + lane;
#pragma unroll
            for (int jj = 0; jj < 4; ++jj) { xo[64 * jj] = v[jj]; bo[64 * jj] = (u32x2){pk2(v[jj].x, v[jj].y), pk2(v[jj].z, v[jj].w)}; }
            if (lane < 16) C.ssq[(size_t)m * 16 + lane] = (lane == 0) ? s : 0.f;
        } else {
            const int r = m - M;
            const f32x4* xr = (const f32x4*)(C.in[I_MEM] + (size_t)r * D) + lane; f32x4 v[4]; float s = 0.f;
#pragma unroll
            for (int jj = 0; jj < 4; ++jj) { v[jj] = xr[64 * jj]; s += (v[jj].x * v[jj].x + v[jj].y * v[jj].y) + (v[jj].z * v[jj].z + v[jj].w * v[jj].w); }
            s = wave_sum(s); const float rs = rsqrtf(s * (1.f / 1024.f) + EPS);
            u32x2* bo = (u32x2*)(C.memn + (size_t)r * D) + lane;
#pragma unroll
            for (int jj = 0; jj < 4; ++jj) bo[64 * jj] = (u32x2){pk2(v[jj].x * rs, v[jj].y * rs), pk2(v[jj].z * rs, v[jj].w * rs)};
        }
    }
    { const int gt = bx * 512 + tid; if (gt < DEPTH * 512) C.spl[gt] = log1pf(expf(-C.in[I_LAM][gt])); }
    { u32x4* zp = (u32x4*)(ws + WS_AGG); for (int i = bx * 512 + tid; i < (int)((WS_END - WS_AGG) / 16); i += G * 512) zp[i] = (u32x4){0u, 0u, 0u, 0u}; }
    __syncthreads();
    if (args.ws == nullptr) cg::this_grid().sync();
    xcd_barrier(bar);

    for (int l = 0; l < DEPTH; ++l) {
        if (l == 0 && bx >= 64 && bx < 96) {
            pg8::Gemm g{C.memn, C.wt_kv}; pg8::SchedKV S{bx - 64}; pg8::EpiKV E{C.memkv};
            pg8::gemm_phase<pg8::EpiKV, pg8::SchedKV, true, D, D, D>(lds, g, S, E);
        }
        {
#ifndef SKIP_G1
            pg8::Gemm g{C.xb, C.wt_in}; pg8::SchedStd S; S.init(M, DIN, G, bx, D, D);
            pg8::EpiZ E{C.za, C.zg, C.ssq, C.in[I_BGATE] + (size_t)l * 4 * D};
            for (int rep = 0; rep < REP_G1; ++rep) pg8::gemm_phase<pg8::EpiZ, pg8::SchedStd, true, D, D, D>(lds, g, S, E);
#endif

        }
        const int cfirst = (l == 0) ? 96 : 64;
        if (G == 256 && bx >= cfirst) {
            const int lane_c = opaque_tid() & 63;
            const int cw = (bx - cfirst) * 8 + wave, NCW = (G - cfirst) * 8;
            for (int it = cw; it < IT_WBR + IT_WOUT + IT_WFF1 + IT_WFF2; it += NCW) {
                int r = it;
                if (r < IT_WBR) { conv_w(C, 1, l, r, scr, lane_c); continue; } r -= IT_WBR;
                if (r < IT_WOUT) { conv_w(C, 2, l, r, scr, lane_c); continue; } r -= IT_WOUT;
                if (r < IT_WFF1) { conv_w(C, 3, l, r, scr, lane_c); continue; } r -= IT_WFF1;
                conv_w(C, 4, l, r, scr, lane_c);
            }
        }
        xcd_barrier(bar);
        {
            if (l == 0) { kvprep_phase(C, gw, NGW, opaque_tid() & 63); xcd_barrier(bar); }
            for (int rmix = 0; rmix < REP_MIX; ++rmix) {
#if USE_MFMA_SWA
            for (int rep = 0; rep < REP_SWA; ++rep) for (int it = bx; it < 256; it += G) swa_item_mfma(lds, C, l, it >> 1, it & 1);
#else
            for (int it = bx; it < 1024; it += G) swa_item(lds, C, l, it >> 3, it & 7);
#endif
#if USE_MFMA_XA
            for (int rep = 0; rep < REP_XA; ++rep) for (int it = bx; it < 256; it += G) xa_pair_mfma(lds, C, l, it);
#else
            for (int it = bx; it < 512; it += G) xa_item(lds, C, l, it >> 2, it & 3);
#endif
#if USE_MFMA_GM
            for (int rep = 0; rep < REP_GM; ++rep) for (int it = bx; it < 512; it += G) gm_item_mfma(lds, C, l, it >> 2, it & 3);
#else
            for (int it = bx; it < 512; it += G) gm_item(lds, C, l, it >> 2, it & 3);
#endif
#if USE_MFMA_LRU
            for (int it = bx; it < 1024; it += G) lru_item_mfma(lds, C, l, ((it >> 3) & 1) * 64 + (it >> 4), it & 7);
#else
            for (int it = bx; it < 1024; it += G) lru_item(lds, C, l, it >> 3, it & 7);
#endif
            }
            const int lane_c = opaque_tid() & 63;
            const int NC0 = (G == 256) ? 0 : IT_WBR + IT_WOUT + IT_WFF1 + IT_WFF2;
            const int NC = IT_WBR + IT_WOUT + IT_WFF1 + IT_WFF2 + (l + 1 < DEPTH ? IT_WIN : 0);
            for (int rep = 0; rep < REP_CONV; ++rep) for (int it = gw + (IT_WBR + IT_WOUT + IT_WFF1 + IT_WFF2 - NC0); it < NC; it += NGW) {
                int r = it;
                if (r < IT_WBR) { conv_w(C, 1, l, r, scr, lane_c); continue; } r -= IT_WBR;
                if (r < IT_WOUT) { conv_w(C, 2, l, r, scr, lane_c); continue; } r -= IT_WOUT;
                if (r < IT_WFF1) { conv_w(C, 3, l, r, scr, lane_c); continue; } r -= IT_WFF1;
                if (r < IT_WFF2) { conv_w(C, 4, l, r, scr, lane_c); continue; } r -= IT_WFF2;
                conv_w(C, 0, l + 1, r, scr, lane_c);
            }
            __syncthreads();
        }
        xcd_barrier(bar);
        {
#ifndef SKIP_G2
            pg8::Gemm g{C.o, C.wt_br}; pg8::SchedMerge S; S.t.init(M, D, G, bx, NO, NO);
            pg8::EpiMerge E{C.zg, C.mb};
            for (int rep = 0; rep < REP_G2; ++rep) pg8::gemm_phase<pg8::EpiMerge, pg8::SchedMerge, true, NO, NO, 512>(lds, g, S, E);
#endif

        }
        xcd_barrier(bar);
        {
#ifndef SKIP_G3
            pg8::Gemm g{C.mb, C.wt_out}; pg8::SchedStd S; S.init(M, D, G, bx, D, D);
            for (int rep = 1; rep < REP_G3; ++rep) { pg8::EpiRes E0{C.x, C.ly, C.o, C.S}; pg8::gemm_phase<pg8::EpiRes, pg8::SchedStd, true, D, D, D>(lds, g, S, E0); }
            pg8::EpiRes E{C.x, C.x, C.xb, C.ssq};
            pg8::gemm_phase<pg8::EpiRes, pg8::SchedStd, true, D, D, D>(lds, g, S, E);
#endif

        }
        xcd_barrier(bar);
        {
#ifndef SKIP_G4
            pg8::Gemm g{C.xb, C.wt_ff1}; pg8::SchedStd S; S.init(M, FF, G, bx, D, D);
            pg8::EpiFF1 E{C.zg, C.ssq};
            for (int rep = 0; rep < REP_G4; ++rep) pg8::gemm_phase<pg8::EpiFF1, pg8::SchedStd, true, D, D, D>(lds, g, S, E);
#endif

        }
        xcd_barrier(bar);
        {
#ifndef SKIP_G5
            pg8::Gemm g{C.zg, C.wt_ff2}; pg8::SchedStd S; S.init(M, D, G, bx, FF, FF);
            for (int rep = 1; rep < REP_G5; ++rep) { pg8::EpiRes E0{C.x, C.ly, C.o, C.S}; pg8::gemm_phase<pg8::EpiRes, pg8::SchedStd, true, FF, FF, FF>(lds, g, S, E0); }
            pg8::EpiRes E{C.x, C.x, C.xb, C.ssq};
            pg8::gemm_phase<pg8::EpiRes, pg8::SchedStd, true, FF, FF, FF>(lds, g, S, E);
#endif

        }
        if (l + 1 < DEPTH) xcd_barrier(bar);
    }
}

extern "C" void kernel_launch(void* const* d_in, const int* in_sizes, int n_in, void* d_out, int out_size, void* d_ws, size_t ws_size, hipStream_t stream) {
    static int grid = 0;
    if (grid == 0) {
        if (n_in != 27 || out_size != M * D || ws_size < WS_END) { fprintf(stderr, "kernel_launch: unexpected shapes: n_in %d out %d ws %zu (need %zu)\n", n_in, out_size, ws_size, (size_t)WS_END); grid = -1; return; }
        int dev = 0, cus = 0, per_cu = 0;
        hipGetDevice(&dev); hipDeviceGetAttribute(&cus, hipDeviceAttributeMultiprocessorCount, dev);
        if (hipFuncSetAttribute((const void*)fwd_megakernel, hipFuncAttributeMaxDynamicSharedMemorySize, LDS_BYTES) != hipSuccess) { fprintf(stderr, "kernel_launch: hipFuncSetAttribute failed\n"); grid = -1; return; }
        if (hipOccupancyMaxActiveBlocksPerMultiprocessor(&per_cu, (const void*)fwd_megakernel, 512, LDS_BYTES) != hipSuccess || per_cu < 1) { fprintf(stderr, "kernel_launch: occupancy query says %d\n", per_cu); per_cu = 1; }
        (void)hipGetLastError();
        grid = cus;
        if (grid != 256) fprintf(stderr, "kernel_launch: note: %d CUs\n", grid);
    }
    if (grid < 0) return;
    hipMemsetAsync((char*)d_ws + WS_CTL, 0, CTL_ZERO_BYTES, stream);
    Args a{};
    for (int i = 0; i < 27; ++i) a.in[i] = (const float*)d_in[i];
    a.out = (float*)d_out; a.ws = (unsigned char*)d_ws;
    void* kargs[] = {&a};
    hipError_t e = hipLaunchCooperativeKernel((const void*)fwd_megakernel, dim3(grid), dim3(512), kargs, LDS_BYTES, stream);
    if (e != hipSuccess) fprintf(stderr, "kernel_launch: cooperative launch failed: %s\n", hipGetErrorString(e));
}
```

```cpp
#include <hip/hip_runtime.h>
#include <hip/hip_cooperative_groups.h>
#include <cstdio>
#include <cstdint>
namespace cg = cooperative_groups;

#define LAS __attribute__((address_space(3)))
#define GAS __attribute__((address_space(1)))
typedef unsigned short bf16_t;
typedef short bf16x8 __attribute__((ext_vector_type(8)));
typedef float f32x4 __attribute__((ext_vector_type(4)));
typedef unsigned u32x4 __attribute__((ext_vector_type(4)));
typedef unsigned u32x2 __attribute__((ext_vector_type(2)));

constexpr int M = 16384, D = 1024, DIN = 7424, NZA = 3328, NZG = 4096, FF = 4096, DEPTH = 4, NO = 2048;
constexpr float EPS = 1e-6f;
constexpr size_t MiB = 1u << 20;
constexpr size_t WS_CTL = 0, CTL_ZERO_BYTES = 64 * 1024;
constexpr size_t WS_WIN = 2 * MiB, WS_WBR = 17 * MiB, WS_WOUT = 21 * MiB, WS_WFF1 = 23 * MiB, WS_WFF2 = 31 * MiB, WS_WKV = 39 * MiB;
constexpr size_t WS_MEMN = 47 * MiB, WS_MEMKV = 48 * MiB, WS_SSQ = 52 * MiB, WS_CARRY = 53 * MiB, WS_XB = 54 * MiB;
constexpr size_t WS_ZA = 86 * MiB, WS_S = 86 * MiB, WS_MB = 150 * MiB, WS_ZG = 190 * MiB, WS_O = 318 * MiB, WS_LY = 382 * MiB, WS_LP = 414 * MiB, WS_MEMK = 446 * MiB, WS_MEMVT = 448 * MiB, WS_SPL = 450 * MiB, WS_AGG = 451 * MiB, WS_INC = 453 * MiB, WS_SSV = 455 * MiB, WS_WGT = 456 * MiB, WS_END = 457 * MiB;
static_assert(WS_ZA + (size_t)M * NZA * 2 <= WS_ZG && WS_MB + (size_t)M * D * 2 <= WS_ZG && WS_WIN + (size_t)DIN * D * 2 <= WS_WBR, "ws map");

constexpr int LDS_BYTES = 147456, MISC_OFF = LDS_BYTES - 256;

__device__ __forceinline__ float bf2f(bf16_t h) { return __uint_as_float((unsigned)h << 16); }
__device__ __forceinline__ unsigned f2bf(float f) { unsigned u = __float_as_uint(f); return (u + 0x7fffu + ((u >> 16) & 1u)) >> 16; }
__device__ __forceinline__ unsigned pk2(float lo, float hi) { return f2bf(lo) | (f2bf(hi) << 16); }
__device__ __forceinline__ unsigned cvt_pk_bf16(float lo, float hi) { unsigned r; asm volatile("v_cvt_pk_bf16_f32 %0, %1, %2" : "=v"(r) : "v"(lo), "v"(hi)); return r; }
#define UNPACK8(VV, f, o) do { (f)[(o) + 0] = __uint_as_float((VV)[0] << 16); (f)[(o) + 1] = __uint_as_float((VV)[0] & 0xffff0000u); (f)[(o) + 2] = __uint_as_float((VV)[1] << 16); (f)[(o) + 3] = __uint_as_float((VV)[1] & 0xffff0000u); \
    (f)[(o) + 4] = __uint_as_float((VV)[2] << 16); (f)[(o) + 5] = __uint_as_float((VV)[2] & 0xffff0000u); (f)[(o) + 6] = __uint_as_float((VV)[3] << 16); (f)[(o) + 7] = __uint_as_float((VV)[3] & 0xffff0000u); } while (0)
#define PACK8(f, o) ((u32x4){pk2((f)[(o) + 0], (f)[(o) + 1]), pk2((f)[(o) + 2], (f)[(o) + 3]), pk2((f)[(o) + 4], (f)[(o) + 5]), pk2((f)[(o) + 6], (f)[(o) + 7])})
__device__ __forceinline__ float gelu_t(float x) { const float u = 0.7978845608028654f * (x + 0.044715f * x * x * x); return x * __builtin_amdgcn_rcpf(1.f + __expf(-2.f * u)); }
__device__ __forceinline__ float sigmoid_f(float x) { return __builtin_amdgcn_rcpf(1.f + __expf(-x)); }
__device__ __forceinline__ float row_rstd(const float* ssq, int row) {
    const f32x4* p = (const f32x4*)(ssq + (size_t)row * 16);
    const f32x4 a = p[0], b = p[1], c = p[2], d = p[3];
    const float s = (((a.x + a.y) + (a.z + a.w)) + ((b.x + b.y) + (b.z + b.w))) + (((c.x + c.y) + (c.z + c.w)) + ((d.x + d.y) + (d.z + d.w)));
    return rsqrtf(s * (1.f / 1024.f) + EPS);
}
#define LDS_WAIT() asm volatile("s_waitcnt lgkmcnt(0)" ::: "memory")
__device__ __forceinline__ int opaque_tid() { int t = threadIdx.x; asm volatile("" : "+v"(t)); return t; }

namespace pg8 {
constexpr int BM = 256, BK = 64, HALF = 128, HTB = HALF * BK * 2, STAGE_BYTES = 8 * HTB, NXCD = 8, WGM = 8;
__host__ __device__ __forceinline__ int lds_byte(int r, int c) { const int st = (r >> 4) * 2 + (c >> 5), rr = r & 15, cc = c & 31, ob = rr * 64 + cc * 2; return st * 1024 + (ob ^ (((ob >> 9) & 1) << 5)); }
__host__ __device__ __forceinline__ void stage_rc(int b, int& R, int& C) { const int st = b / 1024, sb = b % 1024, swz = sb ^ (((sb >> 9) & 1) << 5); R = (st >> 1) * 16 + swz / 64; C = (st & 1) * 32 + (swz % 64) / 2; }
__host__ __device__ __forceinline__ int perm32(int rho) { const int n = rho >> 4, i = rho & 15; return 8 * (i >> 2) + 4 * n + (i & 3); }

struct Unit { int pm, pn, b; };
struct Gemm { const bf16_t* A; const bf16_t* Bt; };

struct SchedStd {
    int nM, nN, nwg, G, c; size_t as, bs;
    __device__ void init(int M_, int N_, int G_, int c_, int lda, int ldb) { nM = M_ / BM; nN = N_ / BM; nwg = nM * nN; G = G_; c = c_; as = (size_t)BM * lda * 2; bs = (size_t)BM * ldb * 2; }
    __device__ bool tile(long L, Unit& u) const {
        if (L >= nwg) return false;
        int wgid = (int)L; { const int q = nwg / NXCD, r = nwg % NXCD, xcd = wgid % NXCD, off = wgid / NXCD; wgid = (xcd < r ? xcd * (q + 1) : r * (q + 1) + (xcd - r) * q) + off; }
        const int nig = WGM * nN, gid = wgid / nig, fm = gid * WGM, gsz = (nM - fm) < WGM ? (nM - fm) : WGM;
        u.pm = fm + ((wgid % nig) % gsz); u.pn = (wgid % nig) / gsz; u.b = 0; return true;
    }
    __device__ bool next(int i, Unit& u) const { return tile((long)i * G + c, u); }
    __device__ size_t aoff(const Unit& u) const { return (size_t)u.pm * as; }
    __device__ size_t boff(const Unit& u) const { return (size_t)u.pn * bs; }
};
struct SchedMerge {
    SchedStd t;
    __device__ bool next(int i, Unit& u) const { if (!t.tile((long)(i >> 2) * t.G + t.c, u)) return false; u.b = i & 3; return true; }
    __device__ size_t aoff(const Unit& u) const { return (size_t)u.pm * t.as + (size_t)u.b * 1024; }
    __device__ size_t boff(const Unit& u) const { return (size_t)u.pn * t.bs + (size_t)u.b * 1024; }
};
struct SchedKV {
    int c;
    __device__ bool next(int i, Unit& u) const { if (i > 0 || c >= 32) return false; u.b = c >> 3; u.pm = (c & 7) >> 2; u.pn = c & 3; return true; }
    __device__ size_t aoff(const Unit& u) const { return (size_t)u.pm * 256 * 1024 * 2; }
    __device__ size_t boff(const Unit& u) const { return ((size_t)u.b * 1024 + (size_t)u.pn * 256) * 1024 * 2; }
};

struct EpiZ {
    static constexpr bool PERM = true, KEEPS = false;
    bf16_t* za; bf16_t* zg; const float* ssq; const float* bgate; float* ssv;
    __device__ __forceinline__ void operator()(const f32x4 (&acc)[2][2][4][2], const Unit& u, int wr, int wc, int fr, int fq) const {
        const int row0 = u.pm * BM + wr * 64 + fr, pn = u.pn;
        bf16_t* base; int ldc, colt, mode;
        if (pn < 13) { base = za; ldc = NZA; colt = pn * 256; mode = (pn < 4 || pn == 6 || pn == 7) ? 1 : 0; }
        else { base = zg; ldc = NZG; colt = (pn - 13) * 256; mode = 2; }
        const int col0 = colt + wc * 32 + 8 * fq;
        f32x4 bv[2][2];
#pragma unroll
        for (int bj = 0; bj < 2; ++bj)
#pragma unroll
            for (int n = 0; n < 2; ++n) bv[bj][n] = (mode == 2) ? *(const f32x4*)(bgate + col0 + bj * HALF + 4 * n) : (f32x4){0.f, 0.f, 0.f, 0.f};
#pragma unroll
        for (int ai = 0; ai < 2; ++ai) {
            float rsm[4];
#pragma unroll
            for (int m = 0; m < 4; ++m) rsm[m] = row_rstd(ssq, row0 + ai * HALF + m * 16);
            asm volatile("" ::: "memory");
#pragma unroll
            for (int m = 0; m < 4; ++m) {
                const int row = row0 + ai * HALF + m * 16; const float rs = rsm[m]; float vss = 0.f;
                bf16_t* rowp = base + (size_t)row * ldc + col0;
#pragma unroll
                for (int bj = 0; bj < 2; ++bj) {
                    f32x4 v0 = acc[ai][bj][m][0] * rs, v1 = acc[ai][bj][m][1] * rs;
                    if (mode == 1) {
#pragma unroll
                        for (int e = 0; e < 4; ++e) { v0[e] = gelu_t(v0[e]); v1[e] = gelu_t(v1[e]); }
                    } else if (mode == 2) {
                        v0 = v0 + bv[bj][0]; v1 = v1 + bv[bj][1];
#pragma unroll
                        for (int e = 0; e < 4; ++e) { v0[e] = sigmoid_f(v0[e]); v1[e] = sigmoid_f(v1[e]); }
                    }
                    u32x4 w; w.x = cvt_pk_bf16(v0[0], v0[1]); w.y = cvt_pk_bf16(v0[2], v0[3]); w.z = cvt_pk_bf16(v1[0], v1[1]); w.w = cvt_pk_bf16(v1[2], v1[3]);
                    *(u32x4*)(rowp + bj * HALF) = w;
                    vss += (v0[0] * v0[0] + v0[1] * v0[1]) + (v0[2] * v0[2] + v0[3] * v0[3]) + (v1[0] * v1[0] + v1[1] * v1[1]) + (v1[2] * v1[2] + v1[3] * v1[3]);
                }
                if (pn == 2 || pn == 3) { vss += __shfl_xor(vss, 16); vss += __shfl_xor(vss, 32); if (fq == 0) ssv[(size_t)row * 8 + (pn - 2) * 4 + wc] = vss; }
            }
            asm volatile("" ::: "memory");
        }
    }
};
struct EpiFF1 {
    static constexpr bool PERM = true, KEEPS = false;
    bf16_t* f; const float* ssq;
    __device__ __forceinline__ void operator()(const f32x4 (&acc)[2][2][4][2], const Unit& u, int wr, int wc, int fr, int fq) const {
        const int row0 = u.pm * BM + wr * 64 + fr, col0 = u.pn * BM + wc * 32 + 8 * fq;
#pragma unroll
        for (int ai = 0; ai < 2; ++ai) {
            float rsm[4];
#pragma unroll
            for (int m = 0; m < 4; ++m) rsm[m] = row_rstd(ssq, row0 + ai * HALF + m * 16);
            asm volatile("" ::: "memory");
#pragma unroll
            for (int m = 0; m < 4; ++m) {
                const int row = row0 + ai * HALF + m * 16; const float rs = rsm[m];
                bf16_t* rowp = f + (size_t)row * FF + col0;
#pragma unroll
                for (int bj = 0; bj < 2; ++bj) {
                    f32x4 v0 = acc[ai][bj][m][0] * rs, v1 = acc[ai][bj][m][1] * rs;
#pragma unroll
                    for (int e = 0; e < 4; ++e) { const float a = fmaxf(v0[e], 0.f), b = fmaxf(v1[e], 0.f); v0[e] = a * a; v1[e] = b * b; }
                    u32x4 w; w.x = cvt_pk_bf16(v0[0], v0[1]); w.y = cvt_pk_bf16(v0[2], v0[3]); w.z = cvt_pk_bf16(v1[0], v1[1]); w.w = cvt_pk_bf16(v1[2], v1[3]);
                    *(u32x4*)(rowp + bj * HALF) = w;
                }
            }
            asm volatile("" ::: "memory");
        }
    }
};
struct EpiRes {
    static constexpr bool PERM = true, KEEPS = false;
    const float* x; float* xo_; bf16_t* xb; float* ssq;
    __device__ __forceinline__ void operator()(const f32x4 (&acc)[2][2][4][2], const Unit& u, int wr, int wc, int fr, int fq) const {
        const int row0 = u.pm * BM + wr * 64 + fr, col0 = u.pn * BM + wc * 32 + 8 * fq;
#pragma unroll
        for (int ai = 0; ai < 2; ++ai) {
            f32x4 xo[4][2][2];
#pragma unroll
            for (int m = 0; m < 4; ++m)
#pragma unroll
                for (int bj = 0; bj < 2; ++bj) { const float* xp = x + (size_t)(row0 + ai * HALF + m * 16) * D + col0 + bj * HALF; xo[m][bj][0] = *(const f32x4*)xp; xo[m][bj][1] = *(const f32x4*)(xp + 4); }
            asm volatile("" ::: "memory");
#pragma unroll
            for (int m = 0; m < 4; ++m) {
                const int row = row0 + ai * HALF + m * 16; float ss = 0.f;
#pragma unroll
                for (int bj = 0; bj < 2; ++bj) {
                    float* xp = xo_ + (size_t)row * D + col0 + bj * HALF;
                    const f32x4 v0 = xo[m][bj][0] + acc[ai][bj][m][0], v1 = xo[m][bj][1] + acc[ai][bj][m][1];
                    *(f32x4*)xp = v0; *(f32x4*)(xp + 4) = v1;
                    ss += (v0[0] * v0[0] + v0[1] * v0[1]) + (v0[2] * v0[2] + v0[3] * v0[3]) + (v1[0] * v1[0] + v1[1] * v1[1]) + (v1[2] * v1[2] + v1[3] * v1[3]);
                    u32x4 w; w.x = cvt_pk_bf16(v0[0], v0[1]); w.y = cvt_pk_bf16(v0[2], v0[3]); w.z = cvt_pk_bf16(v1[0], v1[1]); w.w = cvt_pk_bf16(v1[2], v1[3]);
                    *(u32x4*)(xb + (size_t)row * D + col0 + bj * HALF) = w;
                }
                ss += __shfl_xor(ss, 16); ss += __shfl_xor(ss, 32);
                if (fq == 0) ssq[(size_t)row * 16 + u.pn * 4 + wc] = ss;
            }
            asm volatile("" ::: "memory");
        }
    }
};
struct EpiMerge {
    static constexpr bool PERM = true, KEEPS = true;
    const bf16_t* zg; bf16_t* mb;
    __device__ __forceinline__ bool merge(f32x4 (&acc)[2][2][4][2], const Unit& u, int wr, int wc, int fr, int fq) const {
        const int row0 = u.pm * BM + wr * 64 + fr, col0 = u.pn * BM + wc * 32 + 8 * fq, b = u.b, bn = b < 3 ? b + 1 : b;
#pragma unroll
        for (int ai = 0; ai < 2; ++ai) {
            u32x4 ga[4][2], gb[4][2];
#pragma unroll
            for (int m = 0; m < 4; ++m)
#pragma unroll
                for (int bj = 0; bj < 2; ++bj) { const bf16_t* gp = zg + (size_t)(row0 + ai * HALF + m * 16) * NZG + col0 + bj * HALF; ga[m][bj] = *(const u32x4*)(gp + b * 1024); gb[m][bj] = *(const u32x4*)(gp + bn * 1024); }
            asm volatile("" ::: "memory");
#pragma unroll
            for (int m = 0; m < 4; ++m) {
                const int row = row0 + ai * HALF + m * 16;
#pragma unroll
                for (int bj = 0; bj < 2; ++bj) {
                    const int col = col0 + bj * HALF;
                    float g[8]; UNPACK8(ga[m][bj], g, 0);
#pragma unroll
                    for (int e = 0; e < 8; ++e) g[e] = fmaxf(g[e], 1e-20f);
                    if (b < 3) {
                        float h[8]; UNPACK8(gb[m][bj], h, 0);
#pragma unroll
                        for (int e = 0; e < 8; ++e) g[e] *= __builtin_amdgcn_rcpf(fmaxf(h[e], 1e-20f));
                    }
#pragma unroll
                    for (int e = 0; e < 4; ++e) { acc[ai][bj][m][0][e] *= g[e]; acc[ai][bj][m][1][e] *= g[4 + e]; }
                    if (b == 3) { const f32x4 v0 = acc[ai][bj][m][0], v1 = acc[ai][bj][m][1];
                        u32x4 w; w.x = cvt_pk_bf16(v0[0], v0[1]); w.y = cvt_pk_bf16(v0[2], v0[3]); w.z = cvt_pk_bf16(v1[0], v1[1]); w.w = cvt_pk_bf16(v1[2], v1[3]);
                        *(u32x4*)(mb + (size_t)row * D + col) = w; }
                }
            }
            asm volatile("" ::: "memory");
        }
        return b < 3;
    }
};
struct EpiKV {
    static constexpr bool PERM = true, KEEPS = false;
    bf16_t* out;
    __device__ __forceinline__ void operator()(const f32x4 (&acc)[2][2][4][2], const Unit& u, int wr, int wc, int fr, int fq) const {
        const int row0 = u.pm * BM + wr * 64 + fr, col0 = u.pn * BM + wc * 32 + 8 * fq;
        bf16_t* base = out + (size_t)u.b * 512 * 1024;
#pragma unroll
        for (int ai = 0; ai < 2; ++ai)
#pragma unroll
            for (int m = 0; m < 4; ++m) {
                const int row = row0 + ai * HALF + m * 16;
#pragma unroll
                for (int bj = 0; bj < 2; ++bj) {
                    const f32x4 v0 = acc[ai][bj][m][0], v1 = acc[ai][bj][m][1];
                    u32x4 w; w.x = cvt_pk_bf16(v0[0], v0[1]); w.y = cvt_pk_bf16(v0[2], v0[3]); w.z = cvt_pk_bf16(v1[0], v1[1]); w.w = cvt_pk_bf16(v1[2], v1[3]);
                    *(u32x4*)(base + (size_t)row * 1024 + col0 + bj * HALF) = w;
                }
            }
    }
};

template <class Epi, class Sched, bool ALIGN_EPI, int LDA, int LDB, int KK>
__device__ __forceinline__ void gemm_phase(LAS unsigned char* lds, const Gemm g, const Sched& S, const Epi& E) {
    const int tid = opaque_tid(), wid = __builtin_amdgcn_readfirstlane(tid >> 6), lane = tid & 63, wr = wid >> 2, wc = wid & 3, fr = lane & 15, fq = lane >> 4;
    constexpr int nt = KK / BK;
    unsigned voffA[2], voffB[2];
#pragma unroll
    for (int i = 0; i < 2; ++i) { int R, C; stage_rc(tid * 16 + i * 8192, R, C); const int Rb = Epi::PERM ? ((R & ~31) + perm32(R & 31)) : R;
        voffA[i] = (unsigned)(R * LDA + C) * 2u; voffB[i] = (unsigned)(Rb * LDB + C) * 2u; }
    constexpr size_t kstep = (size_t)(BK * 2);
    constexpr size_t hstepA = (size_t)HALF * LDA * 2, hstepB = (size_t)HALF * LDB * 2;
    const unsigned ldsw = (unsigned)wid * 1024u;
    const int aoff = lds_byte(wr * 64 + fr, fq * 8), boff = lds_byte(wc * 32 + fr, fq * 8);
#define PG8_SA(b, h) (((b) * 2 + (h)) * HTB)
#define PG8_SB(b, h) ((4 + (b) * 2 + (h)) * HTB)
#define PG8_STAGE(bufoff, gbase, voff) do { _Pragma("unroll") for (int _i = 0; _i < 2; ++_i) \
        __builtin_amdgcn_global_load_lds((const unsigned*)((const char*)(gbase) + (voff)[_i]), (LAS unsigned*)(lds + (bufoff) + ldsw + _i * 8192), 16, 0, 0); } while (0)
#define PG8_LDA(dst, b, h) do { _Pragma("unroll") for (int m = 0; m < 4; ++m) _Pragma("unroll") for (int k = 0; k < 2; ++k) dst[m][k] = *(const LAS bf16x8*)(lds + PG8_SA(b, h) + aoff + m * 2048 + k * 1024); } while (0)
#define PG8_LDB(dst, b, h) do { _Pragma("unroll") for (int n = 0; n < 2; ++n) _Pragma("unroll") for (int k = 0; k < 2; ++k) dst[n][k] = *(const LAS bf16x8*)(lds + PG8_SB(b, h) + boff + n * 2048 + k * 1024); } while (0)
#define PG8_MMA(ai, bj, At, Bt) do { __builtin_amdgcn_s_setprio(1); _Pragma("unroll") for (int m = 0; m < 4; ++m) _Pragma("unroll") for (int n = 0; n < 2; ++n) _Pragma("unroll") for (int k = 0; k < 2; ++k) \
        acc[ai][bj][m][n] = __builtin_amdgcn_mfma_f32_16x16x32_bf16(Bt[n][k], At[m][k], acc[ai][bj][m][n], 0, 0, 0); __builtin_amdgcn_s_setprio(0); } while (0)
#define PG8_WAIT_V(n) asm volatile("s_waitcnt vmcnt(" #n ")" ::: "memory")
#define PG8_WAIT_L(n) asm volatile("s_waitcnt lgkmcnt(" #n ")" ::: "memory")
#define PG8_BAR __builtin_amdgcn_s_barrier()
#define PG8_SCHED __builtin_amdgcn_sched_barrier(0)
    Unit cur, nxt; int ui = 0;
    if (!S.next(0, cur)) return;
    f32x4 acc[2][2][4][2];
#pragma unroll
    for (int a = 0; a < 2; ++a)
#pragma unroll
        for (int b = 0; b < 2; ++b)
#pragma unroll
            for (int m = 0; m < 4; ++m)
#pragma unroll
                for (int n = 0; n < 2; ++n) acc[a][b][m][n] = (f32x4){0.f, 0.f, 0.f, 0.f};
    bf16x8 At[4][2], B0[2][2], B1[2][2];
    const char* gA = (const char*)g.A; const char* gB = (const char*)g.Bt;
    asm volatile("" : "+s"(gA), "+s"(gB));
    const char* cA = gA + S.aoff(cur); const char* cB = gB + S.boff(cur);
    PG8_STAGE(PG8_SB(0, 0), cB, voffB); PG8_STAGE(PG8_SB(0, 1), cB + hstepB, voffB); PG8_STAGE(PG8_SA(0, 0), cA, voffA); PG8_STAGE(PG8_SA(0, 1), cA + hstepA, voffA);
    if (wr == 1) PG8_BAR;
    PG8_WAIT_V(2); PG8_BAR;
    PG8_STAGE(PG8_SB(1, 0), cB + kstep, voffB); PG8_STAGE(PG8_SA(1, 0), cA + kstep, voffA); PG8_STAGE(PG8_SB(1, 1), cB + hstepB + kstep, voffB);
    PG8_WAIT_V(6); PG8_BAR;
    for (;;) {
        const bool has_next = S.next(ui + 1, nxt);
        const char* nA = has_next ? gA + S.aoff(nxt) : cA; const char* nB = has_next ? gB + S.boff(nxt) : cB;
        for (int t = 0; t < nt; t += 2) {
            const bool last = (t == nt - 2);
            const char* a1 = cA + (size_t)(t + 1) * kstep;
            const char* a2 = last ? nA : cA + (size_t)(t + 2) * kstep; const char* b2 = last ? nB : cB + (size_t)(t + 2) * kstep;
            const char* a3 = a2 + kstep; const char* b3 = b2 + kstep;
            PG8_LDB(B0, 0, 0); PG8_LDB(B1, 0, 1); PG8_SCHED; PG8_LDA(At, 0, 0); PG8_STAGE(PG8_SA(1, 1), a1 + hstepA, voffA);
            PG8_WAIT_V(8); PG8_WAIT_L(0); PG8_BAR; PG8_MMA(0, 0, At, B0); PG8_MMA(0, 1, At, B1); PG8_BAR; PG8_SCHED;
            PG8_LDA(At, 0, 1); PG8_STAGE(PG8_SB(0, 0), b2, voffB); PG8_STAGE(PG8_SB(0, 1), b2 + hstepB, voffB); PG8_STAGE(PG8_SA(0, 0), a2, voffA);
            PG8_WAIT_V(8); PG8_WAIT_L(0); PG8_BAR; PG8_MMA(1, 0, At, B0); PG8_MMA(1, 1, At, B1); PG8_BAR; PG8_SCHED;
            PG8_LDB(B0, 1, 0); PG8_LDB(B1, 1, 1); PG8_SCHED; PG8_LDA(At, 1, 0); PG8_STAGE(PG8_SA(0, 1), a2 + hstepA, voffA);
            PG8_WAIT_V(8); PG8_WAIT_L(0); PG8_BAR; PG8_MMA(0, 0, At, B0); PG8_MMA(0, 1, At, B1); PG8_BAR; PG8_SCHED;
            PG8_LDA(At, 1, 1); PG8_STAGE(PG8_SB(1, 0), b3, voffB); PG8_STAGE(PG8_SB(1, 1), b3 + hstepB, voffB); PG8_STAGE(PG8_SA(1, 0), a3, voffA);
            PG8_WAIT_V(8); PG8_WAIT_L(0); PG8_BAR; PG8_MMA(1, 0, At, B0); PG8_MMA(1, 1, At, B1); PG8_BAR; PG8_SCHED;
        }
        if constexpr (ALIGN_EPI) { if (wr == 0) PG8_BAR; }
        bool keep = false;
        if constexpr (Epi::KEEPS) keep = E.merge(acc, cur, wr, wc, fr, fq); else E(acc, cur, wr, wc, fr, fq);
        if (!has_next) break;
        if (!keep)
#pragma unroll
        for (int a = 0; a < 2; ++a)
#pragma unroll
            for (int b = 0; b < 2; ++b)
#pragma unroll
                for (int m = 0; m < 4; ++m)
#pragma unroll
                    for (int n = 0; n < 2; ++n) acc[a][b][m][n] = (f32x4){0.f, 0.f, 0.f, 0.f};
        cur = nxt; cA = nA; cB = nB; ++ui;
        if constexpr (ALIGN_EPI) { if (wr == 1) PG8_BAR; }
    }
    PG8_WAIT_V(0);
    if constexpr (!ALIGN_EPI) { if (wr == 0) PG8_BAR; }
    PG8_BAR;
#undef PG8_SA
#undef PG8_SB
#undef PG8_STAGE
#undef PG8_LDA
#undef PG8_LDB
#undef PG8_MMA
#undef PG8_WAIT_V
#undef PG8_WAIT_L
#undef PG8_BAR
#undef PG8_SCHED
}
}

#define XB_TMO      128
#define XB_XCNT(j)  (256  + 64 * (j))
#define XB_XSUB(j)  (1280 + 64 * (j))
#define XB_XGEN(j)  (2304 + 64 * (j))
#define XB_TOP      3328
#define XB_TOPGEN   3392
#define XCD_BAR_WORDS 3456
#define XB_SPIN_CAP (1u << 23)
__device__ __forceinline__ unsigned xb_ld(unsigned* p)              { return __hip_atomic_load(p, __ATOMIC_RELAXED, __HIP_MEMORY_SCOPE_AGENT); }
__device__ __forceinline__ unsigned xb_add(unsigned* p, unsigned v) { return __hip_atomic_fetch_add(p, v, __ATOMIC_RELAXED, __HIP_MEMORY_SCOPE_AGENT); }
__device__ __forceinline__ unsigned xb_xcc_id() { return (unsigned)__builtin_amdgcn_s_getreg((3 << 11) | 20) & 0xFu; }
#define XB_SPIN(cond, bar) do { unsigned _sp = 0; while (cond) { __builtin_amdgcn_s_sleep(1); \
    if ((++_sp & 255u) == 0u) { if (xb_ld(&(bar)[XB_TMO])) break; if (_sp > XB_SPIN_CAP) { atomicAdd(&(bar)[XB_TMO], 1u); break; } } } } while (0)
struct XcdBarrier { unsigned* bar; unsigned x; volatile LAS unsigned* st; };
__device__ __forceinline__ XcdBarrier xcd_barrier_post(unsigned* bar, volatile LAS unsigned* st) {
    XcdBarrier b; b.bar = bar; b.x = xb_xcc_id(); b.st = st;
    if (threadIdx.x == 0) (void)xb_add(&bar[XB_XCNT(b.x)], 1u);
    return b;
}
__device__ __forceinline__ void xcd_barrier_complete(unsigned* bar, unsigned x, unsigned& nloc, unsigned& nx) {
    const unsigned G = gridDim.x * gridDim.y * gridDim.z;
    unsigned sum, cnt, mine, sp = 0u;
    for (;;) {
        sum = 0u; cnt = 0u; mine = 0u;
#pragma unroll
        for (unsigned j = 0; j < 16; ++j) { const unsigned c = xb_ld(&bar[XB_XCNT(j)]); sum += c; cnt += (c > 0u) ? 1u : 0u; mine = (j == x) ? c : mine; }
        if (sum == G) break;
        __builtin_amdgcn_s_sleep(1);
        if ((++sp & 255u) == 0u) { if (xb_ld(&bar[XB_TMO])) break; if (sp > XB_SPIN_CAP) { atomicAdd(&bar[XB_TMO], 1u); break; } }
    }
    nloc = mine > 0u ? mine : 1u; nx = cnt > 0u ? cnt : 1u;
}
__device__ __forceinline__ void xcd_barrier(const XcdBarrier& b) {
    asm volatile("s_waitcnt vmcnt(0)" ::: "memory");
    __syncthreads();
    if (threadIdx.x == 0) {
        unsigned* bar = b.bar;
        asm volatile("" : "+s"(bar));
        __builtin_amdgcn_s_waitcnt(0);
        unsigned nloc = b.st[0], nx = b.st[1];
        const unsigned bxcc = xb_xcc_id();
        if (nloc == 0u) { xcd_barrier_complete(bar, bxcc, nloc, nx); b.st[0] = nloc; b.st[1] = nx; }
        const unsigned old = xb_add(&bar[XB_XSUB(bxcc)], 1u);
        const unsigned gen = old / nloc;
        if (old + 1u == (gen + 1u) * nloc) {
            __builtin_amdgcn_fence(__ATOMIC_RELEASE, "agent");
            asm volatile("s_waitcnt vmcnt(0)" ::: "memory");
            const unsigned og = xb_add(&bar[XB_TOP], 1u);
            const unsigned tg = og / nx;
            if (og + 1u == (tg + 1u) * nx) xb_add(&bar[XB_TOPGEN], 1u);
            else XB_SPIN(xb_ld(&bar[XB_TOPGEN]) == tg, bar);
            __builtin_amdgcn_fence(__ATOMIC_ACQUIRE, "agent");
            xb_add(&bar[XB_XGEN(bxcc)], 1u);
            asm volatile("s_waitcnt vmcnt(0)" ::: "memory");
        } else {
            XB_SPIN(xb_ld(&bar[XB_XGEN(bxcc)]) == gen, bar);
            __builtin_amdgcn_fence(__ATOMIC_ACQUIRE, "agent");
            asm volatile("s_waitcnt vmcnt(0)" ::: "memory");
        }
    }
    __syncthreads();
}

struct Args { const float* in[27]; float* out; unsigned char* ws; };
enum { I_X = 0, I_MEM, I_NMIX, I_NMEM, I_NMLP, I_WIN, I_BGATE, I_GMVG, I_GMWS, I_GMBS, I_CONVW, I_CONVB, I_WR, I_BR, I_WI, I_BI, I_LAM, I_SQG, I_SKG, I_SINK, I_WKV, I_XQG, I_XKG, I_WBR, I_WOUT, I_WFF1, I_WFF2 };
struct Ctx {
    const float* const* in; float* x;
    bf16_t *wt_in, *wt_br, *wt_out, *wt_ff1, *wt_ff2, *wt_kv, *memn, *memkv, *xb, *za, *zg, *mb, *o;
    float *ssq, *carryA, *carryH, *S, *ly, *lp;
    bf16_t *memK, *memVt;
    float* spl;
    float* ssv;
    bf16_t* wgT;
    unsigned long long *agg, *inc;
};

__device__ __forceinline__ void transpose_item(const float* W, int N, bf16_t* WT, int ldk, int koff, const float* gain, LAS float* scr, int item, int lane) {
    const int nblk = N / 32, kb = item / nblk, nb = item % nblk, k0 = 64 * kb, n0 = 32 * nb;
#pragma unroll 8
    for (int i = 0; i < 32; ++i) { const int kk = 2 * i + (lane >> 5); float v = W[(size_t)(k0 + kk) * N + n0 + (lane & 31)]; if (gain) v *= gain[k0 + kk]; scr[kk * 33 + (lane & 31)] = v; }
    LDS_WAIT(); asm volatile("" ::: "memory");
    const int c = lane & 7;
#pragma unroll
    for (int j = 0; j < 4; ++j) { const int n = (lane >> 3) + 8 * j; const LAS float* s = scr + (8 * c) * 33 + n;
        u32x4 o; o.x = pk2(s[0 * 33], s[1 * 33]); o.y = pk2(s[2 * 33], s[3 * 33]); o.z = pk2(s[4 * 33], s[5 * 33]); o.w = pk2(s[6 * 33], s[7 * 33]);
        *(u32x4*)(WT + (size_t)(n0 + n) * ldk + koff + k0 + 8 * c) = o; }
    LDS_WAIT(); asm volatile("" ::: "memory");
}
__device__ __forceinline__ float wave_sum(float v) {
#pragma unroll
    for (int o = 1; o < 64; o <<= 1) v += __shfl_xor(v, o);
    return v;
}
__device__ __forceinline__ void conv_w(const Ctx& C, int which, int l, int item, LAS float* scr, int lane) {
    if (which == 0) transpose_item(C.in[I_WIN] + (size_t)l * D * DIN, DIN, C.wt_in, D, 0, C.in[I_NMIX] + l * D, scr, item, lane);
    else if (which == 1) { const int b = item >> 8; transpose_item(C.in[I_WBR] + (size_t)(l * 4 + b) * 512 * D, D, C.wt_br, 2048, b * 512, nullptr, scr, item & 255, lane); }
    else if (which == 2) transpose_item(C.in[I_WOUT] + (size_t)l * D * D, D, C.wt_out, D, 0, nullptr, scr, item, lane);
    else if (which == 3) transpose_item(C.in[I_WFF1] + (size_t)l * D * FF, FF, C.wt_ff1, D, 0, C.in[I_NMLP] + l * D, scr, item, lane);
    else if (which == 4) transpose_item(C.in[I_WFF2] + (size_t)l * FF * D, D, C.wt_ff2, FF, 0, nullptr, scr, item, lane);
    else transpose_item(C.in[I_WKV] + (size_t)l * D * D, D, C.wt_kv + (size_t)l * D * D, D, 0, C.in[I_NMEM] + l * D, scr, item, lane);
}
constexpr int IT_WIN = 16 * 232, IT_WBR = 1024, IT_WOUT = 512, IT_WFF1 = 2048, IT_WFF2 = 2048, IT_WKV = 512;

#ifndef REP_SWA
#define REP_SWA 1
#endif
#ifndef REP_XA
#define REP_XA 1
#endif
#ifndef REP_GM
#define REP_GM 1
#endif
#ifndef REP_LRU
#define REP_LRU 1
#endif
#ifndef REP_CONV
#define REP_CONV 1
#endif
#ifndef REP_FIX
#define REP_FIX 1
#endif
#ifndef REP_G1
#define REP_G1 1
#endif
#ifndef REP_G2
#define REP_G2 1
#endif
#ifndef REP_G4
#define REP_G4 1
#endif
#ifndef REP_G3
#define REP_G3 1
#endif
#ifndef REP_G5
#define REP_G5 1
#endif
#ifndef REP_MIX
#define REP_MIX 1
#endif
#ifndef REP_BAR
#define REP_BAR 1
#endif
#ifndef USE_MFMA_SWA
#define USE_MFMA_SWA 1
#endif
#ifndef USE_MFMA_XA
#define USE_MFMA_XA 1
#endif
#ifndef USE_MFMA_GM
#define USE_MFMA_GM 1
#endif
#ifndef USE_MFMA_LRU
#define USE_MFMA_LRU 1
#endif
#define ROPE_INV(i) ((i) == 0 ? 1.0f : (i) == 1 ? 0.19392274474868576f : (i) == 2 ? 0.03760603093086393f : (i) == 3 ? 0.007292664737217109f : (i) == 4 ? 0.001414213562373095f : (i) == 5 ? 0.0002742481756762073f : (i) == 6 ? 5.318295896944988e-05f : 1.031338537721246e-05f)
#define ROPE16(f, pos) do { _Pragma("unroll") for (int _i = 0; _i < 8; ++_i) { float _s, _c; sincosf((pos) * ROPE_INV(_i), &_s, &_c); const float _x1 = (f)[_i], _x2 = (f)[_i + 8]; (f)[_i] = _x1 * _c - _x2 * _s; (f)[_i + 8] = _x2 * _c + _x1 * _s; } } while (0)

__device__ __forceinline__ void swa_item(LAS unsigned char* lds, const Ctx& C, int l, int tile, int h) {
    const int tid = opaque_tid();
    LAS bf16_t* Ks = (LAS bf16_t*)lds;
    LAS bf16_t* Vs = Ks + 256 * 72;
    const int kvh = h >> 2, nb = tile & 63, row0 = tile * 128;
    {
        const int key = tid >> 1, half = tid & 1;
        const bool ok = (nb > 0) || (key >= 128);
        const size_t grow = (size_t)(ok ? row0 - 128 + key : row0);
        const u32x4* kp = (const u32x4*)(C.za + grow * NZA + 2560 + kvh * 64 + half * 32);
        const u32x4* vp = (const u32x4*)(C.za + grow * NZA + 2688 + kvh * 64 + half * 32);
        float kf[32]; float ss = 0.f;
#pragma unroll
        for (int i = 0; i < 4; ++i) { const u32x4 w = kp[i]; UNPACK8(w, kf, 8 * i); }
#pragma unroll
        for (int i = 0; i < 32; ++i) ss += kf[i] * kf[i];
        ss += __shfl_xor(ss, 1);
        const float rs = rsqrtf(ss * (1.f / 64.f) + EPS);
        const float* kg = C.in[I_SKG] + l * 64 + half * 32;
#pragma unroll
        for (int i = 0; i < 32; ++i) kf[i] *= rs * kg[i];
        if (half == 0) { const float pos = (float)(nb * 128 - 128 + key); ROPE16(kf, pos); }
#pragma unroll
        for (int i = 0; i < 4; ++i) { *(LAS u32x4*)(Ks + key * 72 + half * 32 + 8 * i) = PACK8(kf, 8 * i); *(LAS u32x4*)(Vs + key * 72 + half * 32 + 8 * i) = vp[i]; }
    }
    const int q = tid >> 2, sub = tid & 3;
    float qf[16];
    {
        const u32x4* qp = (const u32x4*)(C.za + (size_t)(row0 + q) * NZA + 2048 + h * 64 + sub * 16);
        const u32x4 w0 = qp[0], w1 = qp[1]; UNPACK8(w0, qf, 0); UNPACK8(w1, qf, 8);
        float ss = 0.f;
#pragma unroll
        for (int i = 0; i < 16; ++i) ss += qf[i] * qf[i];
        ss += __shfl_xor(ss, 1); ss += __shfl_xor(ss, 2);
        const float rs = rsqrtf(ss * (1.f / 64.f) + EPS);
        const float* qg = C.in[I_SQG] + l * 64 + sub * 16;
#pragma unroll
        for (int i = 0; i < 16; ++i) qf[i] *= rs * qg[i];
        if (sub == 0) { const float pos = (float)(nb * 128 + q); ROPE16(qf, pos); }
#pragma unroll
        for (int i = 0; i < 16; ++i) qf[i] *= 0.125f;
    }
    __syncthreads();
    const float sink = C.in[I_SINK][l * 8 + h];
    float mx = sink;
    for (int j = 0; j < 128; ++j) {
        const int kj = q + 1 + j; const bool valid = (nb > 0) || (kj >= 128);
        const LAS u32x4* kr = (const LAS u32x4*)(Ks + kj * 72 + sub * 16);
        float kf[16]; const u32x4 w0 = kr[0], w1 = kr[1]; UNPACK8(w0, kf, 0); UNPACK8(w1, kf, 8);
        float s = 0.f;
#pragma unroll
        for (int i = 0; i < 16; ++i) s += qf[i] * kf[i];
        s += __shfl_xor(s, 1); s += __shfl_xor(s, 2);
        if (valid) mx = fmaxf(mx, s);
    }
    float lsum = __expf(sink - mx); float o[16];
#pragma unroll
    for (int i = 0; i < 16; ++i) o[i] = 0.f;
    for (int j = 0; j < 128; ++j) {
        const int kj = q + 1 + j; const bool valid = (nb > 0) || (kj >= 128);
        const LAS u32x4* kr = (const LAS u32x4*)(Ks + kj * 72 + sub * 16);
        float kf[16]; { const u32x4 w0 = kr[0], w1 = kr[1]; UNPACK8(w0, kf, 0); UNPACK8(w1, kf, 8); }
        float s = 0.f;
#pragma unroll
        for (int i = 0; i < 16; ++i) s += qf[i] * kf[i];
        s += __shfl_xor(s, 1); s += __shfl_xor(s, 2);
        const float p = valid ? __expf(s - mx) : 0.f;
        lsum += p;
        const LAS u32x4* vr = (const LAS u32x4*)(Vs + kj * 72 + sub * 16);
        float vf[16]; { const u32x4 w0 = vr[0], w1 = vr[1]; UNPACK8(w0, vf, 0); UNPACK8(w1, vf, 8); }
#pragma unroll
        for (int i = 0; i < 16; ++i) o[i] += p * vf[i];
    }
    const float inv = 1.f / lsum;
#pragma unroll
    for (int i = 0; i < 16; ++i) o[i] *= inv;
    u32x4* op = (u32x4*)(C.o + (size_t)(row0 + q) * NO + 1024 + h * 64 + sub * 16);
    op[0] = PACK8(o, 0); op[1] = PACK8(o, 8);
    __syncthreads();
}

__device__ __forceinline__ void xa_item(LAS unsigned char* lds, const Ctx& C, int l, int tile, int h) {
    const int tid = opaque_tid();
    LAS bf16_t* Ks = (LAS bf16_t*)lds;
    LAS bf16_t* Vs = Ks + 256 * 136;
    const int b = tile >> 6, row0 = tile * 128;
    {
        const int key = tid >> 1, half = tid & 1;
        const bf16_t* src = C.memkv + ((size_t)(l * 512 + b * 256 + key)) * 1024 + h * 128 + half * 64;
        const u32x4* kp = (const u32x4*)src; const u32x4* vp = (const u32x4*)(src + 512);
        float kf[64]; float ss = 0.f;
#pragma unroll
        for (int i = 0; i < 8; ++i) { const u32x4 w = kp[i]; UNPACK8(w, kf, 8 * i); }
#pragma unroll
        for (int i = 0; i < 64; ++i) ss += kf[i] * kf[i];
        ss += __shfl_xor(ss, 1);
        const float rs = rsqrtf(ss * (1.f / 128.f) + EPS);
        const float* kg = C.in[I_XKG] + l * 128 + half * 64;
#pragma unroll
        for (int i = 0; i < 64; ++i) kf[i] *= rs * kg[i];
#pragma unroll
        for (int i = 0; i < 8; ++i) { *(LAS u32x4*)(Ks + key * 136 + half * 64 + 8 * i) = PACK8(kf, 8 * i); *(LAS u32x4*)(Vs + key * 136 + half * 64 + 8 * i) = vp[i]; }
    }
    const int q = tid >> 2, sub = tid & 3;
    float qf[32];
    {
        const u32x4* qp = (const u32x4*)(C.za + (size_t)(row0 + q) * NZA + 2816 + h * 128 + sub * 32);
#pragma unroll
        for (int i = 0; i < 4; ++i) { const u32x4 w = qp[i]; UNPACK8(w, qf, 8 * i); }
        float ss = 0.f;
#pragma unroll
        for (int i = 0; i < 32; ++i) ss += qf[i] * qf[i];
        ss += __shfl_xor(ss, 1); ss += __shfl_xor(ss, 2);
        const float rs = rsqrtf(ss * (1.f / 128.f) + EPS) * 0.08838834764831845f;
        const float* qg = C.in[I_XQG] + l * 128 + sub * 32;
#pragma unroll
        for (int i = 0; i < 32; ++i) qf[i] *= rs * qg[i];
    }
    __syncthreads();
    float mx = -3.0e38f;
    for (int key = 0; key < 256; ++key) {
        const LAS u32x4* kr = (const LAS u32x4*)(Ks + key * 136 + sub * 32);
        float s = 0.f;
#pragma unroll
        for (int c = 0; c < 4; ++c) { float kf[8]; const u32x4 w = kr[c]; UNPACK8(w, kf, 0);
#pragma unroll
            for (int i = 0; i < 8; ++i) s += qf[8 * c + i] * kf[i]; }
        s += __shfl_xor(s, 1); s += __shfl_xor(s, 2);
        mx = fmaxf(mx, s);
    }
    float lsum = 0.f; float o[32];
#pragma unroll
    for (int i = 0; i < 32; ++i) o[i] = 0.f;
    for (int key = 0; key < 256; ++key) {
        const LAS u32x4* kr = (const LAS u32x4*)(Ks + key * 136 + sub * 32);
        float s = 0.f;
#pragma unroll
        for (int c = 0; c < 4; ++c) { float kf[8]; const u32x4 w = kr[c]; UNPACK8(w, kf, 0);
#pragma unroll
            for (int i = 0; i < 8; ++i) s += qf[8 * c + i] * kf[i]; }
        s += __shfl_xor(s, 1); s += __shfl_xor(s, 2);
        const float p = __expf(s - mx);
        lsum += p;
        const LAS u32x4* vr = (const LAS u32x4*)(Vs + key * 136 + sub * 32);
#pragma unroll
        for (int c = 0; c < 4; ++c) { float vf[8]; const u32x4 w = vr[c]; UNPACK8(w, vf, 0);
#pragma unroll
            for (int i = 0; i < 8; ++i) o[8 * c + i] += p * vf[i]; }
    }
    const float inv = 1.f / lsum;
#pragma unroll
    for (int i = 0; i < 32; ++i) o[i] *= inv;
    u32x4* op = (u32x4*)(C.o + (size_t)(row0 + q) * NO + 1536 + h * 128 + sub * 32);
#pragma unroll
    for (int c = 0; c < 4; ++c) op[c] = PACK8(o, 8 * c);
    __syncthreads();
}

__device__ __forceinline__ void gm_item(LAS unsigned char* lds, const Ctx& C, int l, int tile, int g) {
    const int tid = opaque_tid();
    LAS float* vn = (LAS float*)lds;
    LAS float* Wl = vn + 128 * 128;
    LAS float* rsv = Wl + 128 * 128;
    const int row0 = tile * 128;
    {
        const int tok = tid >> 2, sub = tid & 3;
        const u32x4* vp = (const u32x4*)(C.za + (size_t)(row0 + tok) * NZA + 512 + sub * 128);
        float ss = 0.f;
#pragma unroll
        for (int i = 0; i < 16; ++i) { float f[8]; const u32x4 w = vp[i]; UNPACK8(w, f, 0);
#pragma unroll
            for (int e = 0; e < 8; ++e) ss += f[e] * f[e]; }
        ss += __shfl_xor(ss, 1); ss += __shfl_xor(ss, 2);
        if (sub == 0) rsv[tok] = rsqrtf(ss * (1.f / 512.f) + EPS);
        const f32x4* wp = (const f32x4*)(C.in[I_GMWS] + (size_t)(l * 4 + g) * 128 * 128);
#pragma unroll
        for (int i = 0; i < 8; ++i) *(LAS f32x4*)(Wl + (i * 512 + tid) * 4) = wp[i * 512 + tid];
    }
    __syncthreads();
    {
        const int s = tid >> 2, c0 = (tid & 3) * 32;
        const u32x4* vp = (const u32x4*)(C.za + (size_t)(row0 + s) * NZA + 512 + g * 128 + c0);
        const float rs = rsv[s]; const float* vg = C.in[I_GMVG] + l * 512 + g * 128 + c0;
#pragma unroll
        for (int i = 0; i < 4; ++i) { float f[8]; const u32x4 w = vp[i]; UNPACK8(w, f, 0);
#pragma unroll
            for (int e = 0; e < 8; ++e) f[e] *= rs * vg[8 * i + e];
            *(LAS f32x4*)(vn + s * 128 + c0 + 8 * i) = (f32x4){f[0], f[1], f[2], f[3]}; *(LAS f32x4*)(vn + s * 128 + c0 + 8 * i + 4) = (f32x4){f[4], f[5], f[6], f[7]}; }
    }
    __syncthreads();
    {
        const int c = tid & 127, tq = tid >> 7;
        const float* bs = C.in[I_GMBS] + (size_t)(l * 4 + g) * 128;
        for (int k = 0; k < 32; ++k) {
            const int t = tq * 32 + k; float acc = 0.f;
            for (int s = 0; s <= t; ++s) acc += Wl[t * 128 + s] * vn[s * 128 + c];
            const float sval = acc + bs[t];
            const float u = bf2f(C.za[(size_t)(row0 + t) * NZA + g * 128 + c]);
            C.o[(size_t)(row0 + t) * NO + g * 128 + c] = (bf16_t)f2bf(u * sval);
        }
    }
    __syncthreads();
}

__device__ __forceinline__ void lru_item(LAS unsigned char* lds, const Ctx& C, int l, int tile, int hb) {
    const int tid = opaque_tid();
    LAS float* xc = (LAS float*)lds;
    LAS float* wr = xc + 8192;
    LAS float* wi = wr + 4096;
    LAS float* aa = wi + 4096;
    LAS float* bb = aa + 8192;
    const int nb = tile & 63, row0 = tile * 128;
    {
        const int t = tid >> 2, c0 = (tid & 3) * 16, ch = hb * 64 + c0;
        float acc[16];
#pragma unroll
        for (int i = 0; i < 16; ++i) acc[i] = C.in[I_CONVB][l * 512 + ch + i];
#pragma unroll
        for (int k = 0; k < 4; ++k) {
            const int tt = t - 3 + k;
            if (nb * 128 + tt >= 0) {
                const u32x4* xp = (const u32x4*)(C.za + (size_t)(row0 + tt) * NZA + 1024 + ch);
                float f[16]; const u32x4 w0 = xp[0], w1 = xp[1]; UNPACK8(w0, f, 0); UNPACK8(w1, f, 8);
                const float* cw = C.in[I_CONVW] + (size_t)(l * 4 + k) * 512 + ch;
#pragma unroll
                for (int i = 0; i < 16; ++i) acc[i] += cw[i] * f[i];
            }
        }
#pragma unroll
        for (int i = 0; i < 4; ++i) *(LAS f32x4*)(xc + t * 64 + c0 + 4 * i) = (f32x4){acc[4 * i], acc[4 * i + 1], acc[4 * i + 2], acc[4 * i + 3]};
        const f32x4* wrp = (const f32x4*)(C.in[I_WR] + (size_t)(l * 8 + hb) * 4096); const f32x4* wip = (const f32x4*)(C.in[I_WI] + (size_t)(l * 8 + hb) * 4096);
#pragma unroll
        for (int i = 0; i < 2; ++i) { *(LAS f32x4*)(wr + (i * 512 + tid) * 4) = wrp[i * 512 + tid]; *(LAS f32x4*)(wi + (i * 512 + tid) * 4) = wip[i * 512 + tid]; }
    }
    __syncthreads();
    const int j = tid & 63, tg = tid >> 6, chj = hb * 64 + j;
    {
        const float br = C.in[I_BR][l * 512 + chj], bi = C.in[I_BI][l * 512 + chj];
        const float lam = C.in[I_LAM][l * 512 + chj];
        const float sp = log1pf(expf(-lam));
        for (int k = 0; k < 16; ++k) {
            const int t = tg * 16 + k; float r = br, ig = bi;
            for (int i = 0; i < 64; ++i) { const float xv = xc[t * 64 + i]; r += xv * wr[i * 64 + j]; ig += xv * wi[i * 64 + j]; }
            r = sigmoid_f(r); ig = sigmoid_f(ig);
            const float loga = -8.f * r * sp; const float a = expf(loga); const float mult = sqrtf(-expm1f(2.f * loga));
            aa[t * 64 + j] = a; bb[t * 64 + j] = xc[t * 64 + j] * ig * mult;
        }
    }
    __syncthreads();
    if (tid < 64) {
        float hh = 0.f, P = 1.f;
        for (int t = 0; t < 128; ++t) { const float a = aa[t * 64 + tid]; hh = a * hh + bb[t * 64 + tid]; P *= a; aa[t * 64 + tid] = P; bb[t * 64 + tid] = hh; }
        C.carryA[(size_t)tile * 512 + hb * 64 + tid] = P; C.carryH[(size_t)tile * 512 + hb * 64 + tid] = hh;
    }
    __syncthreads();
    for (int k = 0; k < 16; ++k) {
        const int t = tg * 16 + k;
        const float G = bf2f(C.za[(size_t)(row0 + t) * NZA + 1536 + chj]);
        C.ly[(size_t)(row0 + t) * 512 + chj] = G * bb[t * 64 + j]; C.lp[(size_t)(row0 + t) * 512 + chj] = G * aa[t * 64 + j];
    }
    __syncthreads();
}

__device__ __forceinline__ int vperm_pos(int key) { const int w = key & 31; return (key & ~31) + ((w >> 2) & 3) * 8 + (w >> 4) * 4 + (w & 3); }
#define MFMA16(X, Y, ACC) __builtin_amdgcn_mfma_f32_16x16x32_bf16((X), (Y), (ACC), 0, 0, 0)
__device__ __forceinline__ bf16x8 pack_bf16x8(const float* f) { u32x4 w; w[0] = cvt_pk_bf16(f[0], f[1]); w[1] = cvt_pk_bf16(f[2], f[3]); w[2] = cvt_pk_bf16(f[4], f[5]); w[3] = cvt_pk_bf16(f[6], f[7]); return __builtin_bit_cast(bf16x8, w); }

__device__ __forceinline__ void kvprep_phase(const Ctx& C, int gw, int NGW, int lane) {
    for (int r = gw; r < 32 * 256; r += NGW) {
        const int combo = r >> 8, key = r & 255, l = combo >> 3, b = (combo >> 2) & 1, h = combo & 3;
        const unsigned w = *(const unsigned*)(C.memkv + ((size_t)(l * 512 + b * 256 + key)) * 1024 + h * 128 + 2 * lane);
        float f0 = __uint_as_float(w << 16), f1 = __uint_as_float(w & 0xffff0000u);
        const float ss = wave_sum(f0 * f0 + f1 * f1); const float rs = rsqrtf(ss * (1.f / 128.f) + EPS);
        const float* kg = C.in[I_XKG] + l * 128 + 2 * lane;
        *(unsigned*)(C.memK + (size_t)r * 128 + 2 * lane) = pk2(f0 * rs * kg[0], f1 * rs * kg[1]);
    }
    const int gt = gw * 64 + lane, NGT = NGW * 64;
    for (int t = gt; t < 32 * 32 * 128; t += NGT) {
        const int d = t & 127, pg = (t >> 7) & 31, combo = t >> 12, l = combo >> 3, b = (combo >> 2) & 1, h = combo & 3;
        const int kbase = (pg >> 2) * 32 + (pg & 3) * 4;
        const bf16_t* src = C.memkv + ((size_t)(l * 512 + b * 256)) * 1024 + 512 + h * 128 + d;
        unsigned short v[8];
#pragma unroll
        for (int e = 0; e < 4; ++e) { v[e] = src[(size_t)(kbase + e) * 1024]; v[4 + e] = src[(size_t)(kbase + 16 + e) * 1024]; }
        u32x4 o; o[0] = v[0] | ((unsigned)v[1] << 16); o[1] = v[2] | ((unsigned)v[3] << 16); o[2] = v[4] | ((unsigned)v[5] << 16); o[3] = v[6] | ((unsigned)v[7] << 16);
        *(u32x4*)(C.memVt + ((size_t)combo * 128 + d) * 256 + pg * 8) = o;
    }
}

__device__ __forceinline__ void xa_pair_mfma(LAS unsigned char* lds, const Ctx& C, int l, int pairidx) {
    const int tid = opaque_tid(), lane = tid & 63, w = __builtin_amdgcn_readfirstlane(tid >> 6), fr = lane & 15, fq = lane >> 4;
    LAS bf16_t* Ks = (LAS bf16_t*)lds;
    LAS bf16_t* Vt = Ks + 256 * 144;
    const int idx0 = pairidx * 2, bh = idx0 >> 6, b = bh >> 2, h = bh & 3, nb0 = idx0 & 63;
    {
        const u32x4* ksrc = (const u32x4*)(C.memK + ((size_t)(l * 8 + bh)) * 256 * 128);
        const u32x4* vsrc = (const u32x4*)(C.memVt + ((size_t)(l * 8 + bh)) * 128 * 256);
#pragma unroll
        for (int i = 0; i < 8; ++i) { const int ch = i * 512 + tid;
            *(LAS u32x4*)(Ks + (ch >> 4) * 144 + (ch & 15) * 8) = ksrc[ch];
            *(LAS u32x4*)(Vt + (ch >> 5) * 272 + (ch & 31) * 8) = vsrc[ch]; }
    }
    __syncthreads();
    const float* qg = C.in[I_XQG] + l * 128;
    for (int tt = 0; tt < 2; ++tt) {
        const size_t row = (size_t)((b * 64 + nb0 + tt) * 128 + w * 16 + fr);
        bf16x8 qf[4];
        {
            float f[32]; const bf16_t* qp = C.za + row * NZA + 2816 + h * 128 + 8 * fq;
#pragma unroll
            for (int ks = 0; ks < 4; ++ks) { const u32x4 wv = *(const u32x4*)(qp + 32 * ks); UNPACK8(wv, f, 8 * ks); }
            float ss = 0.f;
#pragma unroll
            for (int i = 0; i < 32; ++i) ss += f[i] * f[i];
            ss += __shfl_xor(ss, 16); ss += __shfl_xor(ss, 32);
            const float rs = rsqrtf(ss * (1.f / 128.f) + EPS) * 0.08838834764831845f;
#pragma unroll
            for (int ks = 0; ks < 4; ++ks) {
#pragma unroll
                for (int i = 0; i < 8; ++i) f[8 * ks + i] *= rs * qg[32 * ks + 8 * fq + i];
                qf[ks] = pack_bf16x8(f + 8 * ks); }
        }
        f32x4 acc[16];
#pragma unroll
        for (int kb = 0; kb < 16; ++kb) { acc[kb] = (f32x4){0.f, 0.f, 0.f, 0.f};
#pragma unroll
            for (int ks = 0; ks < 4; ++ks) { const bf16x8 kf = *(const LAS bf16x8*)(Ks + (kb * 16 + fr) * 144 + 32 * ks + 8 * fq); acc[kb] = MFMA16(kf, qf[ks], acc[kb]); } }
        float mx = -3.0e38f;
#pragma unroll
        for (int kb = 0; kb < 16; ++kb) mx = fmaxf(fmaxf(fmaxf(acc[kb][0], acc[kb][1]), fmaxf(acc[kb][2], acc[kb][3])), mx);
        mx = fmaxf(mx, __shfl_xor(mx, 16)); mx = fmaxf(mx, __shfl_xor(mx, 32));
        float lsum = 0.f;
#pragma unroll
        for (int kb = 0; kb < 16; ++kb)
#pragma unroll
            for (int e = 0; e < 4; ++e) { const float pv = __expf(acc[kb][e] - mx); acc[kb][e] = pv; lsum += pv; }
        lsum += __shfl_xor(lsum, 16); lsum += __shfl_xor(lsum, 32);
        const float inv = 1.f / lsum;
        bf16x8 pf[8];
#pragma unroll
        for (int j = 0; j < 8; ++j) { u32x4 wv; wv[0] = cvt_pk_bf16(acc[2 * j][0], acc[2 * j][1]); wv[1] = cvt_pk_bf16(acc[2 * j][2], acc[2 * j][3]); wv[2] = cvt_pk_bf16(acc[2 * j + 1][0], acc[2 * j + 1][1]); wv[3] = cvt_pk_bf16(acc[2 * j + 1][2], acc[2 * j + 1][3]); pf[j] = __builtin_bit_cast(bf16x8, wv); }
        bf16_t* op = C.o + row * NO + 1536 + h * 128 + 4 * fq;
#pragma unroll
        for (int db = 0; db < 8; ++db) {
            f32x4 o = (f32x4){0.f, 0.f, 0.f, 0.f};
#pragma unroll
            for (int j = 0; j < 8; ++j) { const bf16x8 vf = *(const LAS bf16x8*)(Vt + (db * 16 + fr) * 272 + 32 * j + 8 * fq); o = MFMA16(vf, pf[j], o); }
            *(u32x2*)(op + db * 16) = (u32x2){cvt_pk_bf16(o[0] * inv, o[1] * inv), cvt_pk_bf16(o[2] * inv, o[3] * inv)};
        }
    }
    __syncthreads();
}

__device__ __forceinline__ void swa_item_mfma(LAS unsigned char* lds, const Ctx& C, int l, int tile, int kvh) {
    const int tid = opaque_tid(), lane = tid & 63, w = __builtin_amdgcn_readfirstlane(tid >> 6), fr = lane & 15, fq = lane >> 4;
    LAS bf16_t* Ks = (LAS bf16_t*)lds;
    LAS bf16_t* Vt = Ks + 256 * 80;
    const int nb = tile & 63, row0 = tile * 128;
    {
        const int key = tid >> 1, half = tid & 1;
        const bool ok = (nb > 0) || (key >= 128);
        const size_t grow = (size_t)(ok ? row0 - 128 + key : row0);
        const u32x4* kp = (const u32x4*)(C.za + grow * NZA + 2560 + kvh * 64 + half * 32);
        const u32x4* vp = (const u32x4*)(C.za + grow * NZA + 2688 + kvh * 64 + half * 32);
        float kf[32]; float ss = 0.f;
#pragma unroll
        for (int i = 0; i < 4; ++i) { const u32x4 wv = kp[i]; UNPACK8(wv, kf, 8 * i); }
#pragma unroll
        for (int i = 0; i < 32; ++i) ss += kf[i] * kf[i];
        ss += __shfl_xor(ss, 1);
        const float rs = rsqrtf(ss * (1.f / 64.f) + EPS);
        const float* kg = C.in[I_SKG] + l * 64 + half * 32;
#pragma unroll
        for (int i = 0; i < 32; ++i) kf[i] *= rs * kg[i];
        if (half == 0) { const float pos = (float)(nb * 128 - 128 + key); ROPE16(kf, pos); }
#pragma unroll
        for (int i = 0; i < 4; ++i) *(LAS u32x4*)(Ks + key * 80 + half * 32 + 8 * i) = PACK8(kf, 8 * i);
        const int pp = vperm_pos(key);
#pragma unroll
        for (int i = 0; i < 4; ++i) { u32x4 wv = vp[i]; if (!ok) wv = (u32x4){0u, 0u, 0u, 0u};
#pragma unroll
            for (int e = 0; e < 4; ++e) { Vt[(half * 32 + 8 * i + 2 * e) * 272 + pp] = (bf16_t)(wv[e] & 0xffffu); Vt[(half * 32 + 8 * i + 2 * e + 1) * 272 + pp] = (bf16_t)(wv[e] >> 16); } }
    }
    __syncthreads();
    const int i0 = 16 * w, ws2 = w & ~1, qi = i0 + fr;
    float rc[8], rsn[8];
    { const float pos = (float)(nb * 128 + qi);
#pragma unroll
      for (int i = 0; i < 8; ++i) { const float ang = pos * ROPE_INV(i); rc[i] = cosf(ang); rsn[i] = sinf(ang); } }
    const size_t row = (size_t)(row0 + qi);
    for (int hh = 0; hh < 4; ++hh) {
        const int h = kvh * 4 + hh;
        bf16x8 qf[2];
        {
            float f[16]; const bf16_t* qp = C.za + row * NZA + 2048 + h * 64 + 8 * fq;
            { const u32x4 w0 = *(const u32x4*)qp, w1 = *(const u32x4*)(qp + 32); UNPACK8(w0, f, 0); UNPACK8(w1, f, 8); }
            float ss = 0.f;
#pragma unroll
            for (int i = 0; i < 16; ++i) ss += f[i] * f[i];
            ss += __shfl_xor(ss, 16); ss += __shfl_xor(ss, 32);
            const float rs = rsqrtf(ss * (1.f / 64.f) + EPS);
            const float* qg = C.in[I_SQG] + l * 64 + 8 * fq;
#pragma unroll
            for (int i = 0; i < 8; ++i) { f[i] *= rs * qg[i]; f[8 + i] *= rs * qg[32 + i]; }
#pragma unroll
            for (int i = 0; i < 8; ++i) { const float other = __shfl_xor(f[i], 16);
                const float r0 = f[i] * rc[i] - other * rsn[i], r1 = f[i] * rc[i] + other * rsn[i];
                f[i] = (fq == 0) ? r0 : (fq == 1) ? r1 : f[i]; }
#pragma unroll
            for (int i = 0; i < 16; ++i) f[i] *= 0.125f;
            qf[0] = pack_bf16x8(f); qf[1] = pack_bf16x8(f + 8);
        }
        f32x4 acc[10];
#pragma unroll
        for (int kk = 0; kk < 10; ++kk) { acc[kk] = (f32x4){0.f, 0.f, 0.f, 0.f};
#pragma unroll
            for (int ks = 0; ks < 2; ++ks) { const bf16x8 kf = *(const LAS bf16x8*)(Ks + ((ws2 + kk) * 16 + fr) * 80 + 32 * ks + 8 * fq); acc[kk] = MFMA16(kf, qf[ks], acc[kk]); } }
        const float sink = C.in[I_SINK][l * 8 + h];
        float mx = sink;
#pragma unroll
        for (int kk = 0; kk < 10; ++kk)
#pragma unroll
            for (int e = 0; e < 4; ++e) { const int kj = (ws2 + kk) * 16 + 4 * fq + e, dd = kj - qi; const bool valid = (dd >= 1) && (dd <= 128) && ((nb > 0) || (kj >= 128));
                const float sv = valid ? acc[kk][e] : -INFINITY; acc[kk][e] = sv; mx = fmaxf(mx, sv); }
        mx = fmaxf(mx, __shfl_xor(mx, 16)); mx = fmaxf(mx, __shfl_xor(mx, 32));
        float lsum = 0.f;
#pragma unroll
        for (int kk = 0; kk < 10; ++kk)
#pragma unroll
            for (int e = 0; e < 4; ++e) { const float pv = __expf(acc[kk][e] - mx); acc[kk][e] = pv; lsum += pv; }
        lsum += __shfl_xor(lsum, 16); lsum += __shfl_xor(lsum, 32);
        lsum += __expf(sink - mx);
        const float inv = 1.f / lsum;
        bf16x8 pf[5];
#pragma unroll
        for (int j = 0; j < 5; ++j) { u32x4 wv; wv[0] = cvt_pk_bf16(acc[2 * j][0], acc[2 * j][1]); wv[1] = cvt_pk_bf16(acc[2 * j][2], acc[2 * j][3]); wv[2] = cvt_pk_bf16(acc[2 * j + 1][0], acc[2 * j + 1][1]); wv[3] = cvt_pk_bf16(acc[2 * j + 1][2], acc[2 * j + 1][3]); pf[j] = __builtin_bit_cast(bf16x8, wv); }
        bf16_t* op = C.o + row * NO + 1024 + h * 64 + 4 * fq;
#pragma unroll
        for (int db = 0; db < 4; ++db) {
            f32x4 o = (f32x4){0.f, 0.f, 0.f, 0.f};
#pragma unroll
            for (int j = 0; j < 5; ++j) { const bf16x8 vf = *(const LAS bf16x8*)(Vt + (db * 16 + fr) * 272 + (ws2 + 2 * j) * 16 + 8 * fq); o = MFMA16(vf, pf[j], o); }
            *(u32x2*)(op + db * 16) = (u32x2){cvt_pk_bf16(o[0] * inv, o[1] * inv), cvt_pk_bf16(o[2] * inv, o[3] * inv)};
        }
    }
    __syncthreads();
}

__device__ __forceinline__ void gm_item_mfma(LAS unsigned char* lds, const Ctx& C, int l, int tile, int g) {
    const int tid = opaque_tid(), lane = tid & 63, w = __builtin_amdgcn_readfirstlane(tid >> 6), fr = lane & 15, fq = lane >> 4;
    LAS bf16_t* Wl = (LAS bf16_t*)lds;
    LAS bf16_t* vT = Wl + 128 * 144;
    LAS float* rsv = (LAS float*)(vT + 128 * 144);
    const int row0 = tile * 128;
    {
        if (tid < 128) { const f32x4* pp = (const f32x4*)(C.ssv + (size_t)(row0 + tid) * 8); const f32x4 a = pp[0], b2 = pp[1];
            rsv[tid] = rsqrtf((((a[0] + a[1]) + (a[2] + a[3])) + ((b2[0] + b2[1]) + (b2[2] + b2[3]))) * (1.f / 512.f) + EPS); }
        const int tok = tid >> 2, sub = tid & 3;
        const u32x4* gp = (const u32x4*)(C.za + (size_t)(row0 + tok) * NZA + 512 + g * 128 + sub * 32);
#pragma unroll
        for (int i = 0; i < 4; ++i) { const u32x4 wv = gp[i];
#pragma unroll
            for (int e = 0; e < 4; ++e) { vT[(sub * 32 + 8 * i + 2 * e) * 144 + tok] = (bf16_t)(wv[e] & 0xffffu); vT[(sub * 32 + 8 * i + 2 * e + 1) * 144 + tok] = (bf16_t)(wv[e] >> 16); } }
    }
    const int t_ = tid >> 2, s0 = (tid & 3) * 32;
    f32x4 wreg[8];
    { const f32x4* wp = (const f32x4*)(C.in[I_GMWS] + ((size_t)(l * 4 + g) * 128 + t_) * 128 + s0);
#pragma unroll
      for (int i = 0; i < 8; ++i) wreg[i] = wp[i]; }
    __syncthreads();
    {
#pragma unroll
        for (int i = 0; i < 4; ++i) { const f32x4 a = wreg[2 * i], b2 = wreg[2 * i + 1]; float f[8] = {a[0], a[1], a[2], a[3], b2[0], b2[1], b2[2], b2[3]};
#pragma unroll
            for (int e = 0; e < 8; ++e) { const int sidx = s0 + 8 * i + e; f[e] = (sidx <= t_) ? f[e] * rsv[sidx] : 0.f; }
            *(LAS u32x4*)(Wl + t_ * 144 + s0 + 8 * i) = PACK8(f, 0); }
    }
    __syncthreads();
    {
        const int nks = (w + 2) >> 1;
        f32x4 acc[8];
#pragma unroll
        for (int cb = 0; cb < 8; ++cb) acc[cb] = (f32x4){0.f, 0.f, 0.f, 0.f};
        for (int ks = 0; ks < nks; ++ks) {
            const bf16x8 wf = *(const LAS bf16x8*)(Wl + (16 * w + fr) * 144 + 32 * ks + 8 * fq);
#pragma unroll
            for (int cb = 0; cb < 8; ++cb) { const bf16x8 vf = *(const LAS bf16x8*)(vT + (cb * 16 + fr) * 144 + 32 * ks + 8 * fq); acc[cb] = MFMA16(vf, wf, acc[cb]); }
        }
        const int t = 16 * w + fr; const size_t r = (size_t)(row0 + t);
        const float bsv = C.in[I_GMBS][(size_t)(l * 4 + g) * 128 + t];
        const float* vg = C.in[I_GMVG] + l * 512 + g * 128 + 4 * fq;
        const bf16_t* up = C.za + r * NZA + g * 128 + 4 * fq; bf16_t* op = C.o + r * NO + g * 128 + 4 * fq;
#pragma unroll
        for (int cb = 0; cb < 8; ++cb) { const f32x4 gn = *(const f32x4*)(vg + cb * 16); const u32x2 uw = *(const u32x2*)(up + cb * 16);
            const float u0 = __uint_as_float(uw[0] << 16), u1 = __uint_as_float(uw[0] & 0xffff0000u), u2 = __uint_as_float(uw[1] << 16), u3 = __uint_as_float(uw[1] & 0xffff0000u);
            *(u32x2*)(op + cb * 16) = (u32x2){cvt_pk_bf16(u0 * (gn[0] * acc[cb][0] + bsv), u1 * (gn[1] * acc[cb][1] + bsv)), cvt_pk_bf16(u2 * (gn[2] * acc[cb][2] + bsv), u3 * (gn[3] * acc[cb][3] + bsv))}; }
    }
    __syncthreads();
}

__device__ __forceinline__ void lru_item_mfma(LAS unsigned char* lds, const Ctx& C, int l, int tile, int hb) {
    const int tid = opaque_tid(), lane = tid & 63, w = __builtin_amdgcn_readfirstlane(tid >> 6), fr = lane & 15, fq = lane >> 4;
    LAS bf16_t* xcb = (LAS bf16_t*)lds;
    LAS bf16_t* wrT = xcb + 128 * 80;
    LAS bf16_t* wiT = wrT + 64 * 80;
    LAS float* xcf = (LAS float*)(lds + 40960);
    LAS float* aa = xcf + 8192;
    LAS float* bb = aa + 8192;
    LAS float* segA = bb + 8192;
    LAS float* segH = segA + 512;
    const int nb = tile & 63, row0 = tile * 128;
    {
        const int t = tid >> 2, c0 = (tid & 3) * 16, ch = hb * 64 + c0;
        float acc[16];
#pragma unroll
        for (int i = 0; i < 16; ++i) acc[i] = C.in[I_CONVB][l * 512 + ch + i];
#pragma unroll
        for (int k = 0; k < 4; ++k) {
            const int tt = t - 3 + k;
            if (nb * 128 + tt >= 0) {
                const u32x4* xp = (const u32x4*)(C.za + (size_t)(row0 + tt) * NZA + 1024 + ch);
                float f[16]; const u32x4 w0 = xp[0], w1 = xp[1]; UNPACK8(w0, f, 0); UNPACK8(w1, f, 8);
                const float* cw = C.in[I_CONVW] + (size_t)(l * 4 + k) * 512 + ch;
#pragma unroll
                for (int i = 0; i < 16; ++i) acc[i] += cw[i] * f[i];
            }
        }
#pragma unroll
        for (int i = 0; i < 4; ++i) *(LAS f32x4*)(xcf + t * 64 + c0 + 4 * i) = (f32x4){acc[4 * i], acc[4 * i + 1], acc[4 * i + 2], acc[4 * i + 3]};
        *(LAS u32x4*)(xcb + t * 80 + c0) = PACK8(acc, 0); *(LAS u32x4*)(xcb + t * 80 + c0 + 8) = PACK8(acc, 8);
        const u32x4* wsrc = (const u32x4*)(C.wgT + (size_t)(l * 8 + hb) * 2 * 4096);
#pragma unroll
        for (int i = 0; i < 2; ++i) { const int c = i * 512 + tid; *(LAS u32x4*)(wrT + (c >> 3) * 80 + (c & 7) * 8) = wsrc[c]; }
    }
    __syncthreads();
    {
        bf16x8 xf[2];
#pragma unroll
        for (int ks = 0; ks < 2; ++ks) xf[ks] = *(const LAS bf16x8*)(xcb + (16 * w + fr) * 80 + 32 * ks + 8 * fq);
#pragma unroll
        for (int jb = 0; jb < 4; ++jb) {
            f32x4 ar = (f32x4){0.f, 0.f, 0.f, 0.f}, ai = (f32x4){0.f, 0.f, 0.f, 0.f};
#pragma unroll
            for (int ks = 0; ks < 2; ++ks) { const bf16x8 wf = *(const LAS bf16x8*)(wrT + (jb * 16 + fr) * 80 + 32 * ks + 8 * fq); ar = MFMA16(xf[ks], wf, ar);
                const bf16x8 wf2 = *(const LAS bf16x8*)(wiT + (jb * 16 + fr) * 80 + 32 * ks + 8 * fq); ai = MFMA16(xf[ks], wf2, ai); }
            const int j = jb * 16 + fr, chj = l * 512 + hb * 64 + j;
            const float br = C.in[I_BR][chj], bi = C.in[I_BI][chj], sp8 = -8.f * C.spl[chj];
#pragma unroll
            for (int e = 0; e < 4; ++e) { const int t = 16 * w + 4 * fq + e;
                const float r = sigmoid_f(ar[e] + br), ig = sigmoid_f(ai[e] + bi);
                const float a = __expf(r * sp8); const float mult = __builtin_amdgcn_sqrtf(fmaxf(1.f - a * a, 0.f));
                aa[t * 64 + j] = a; bb[t * 64 + j] = xcf[t * 64 + j] * ig * mult; }
        }
    }
    __syncthreads();
    const int j = tid & 63, sg = tid >> 6;
    float av[16], bv[16], Gv[16];
    {
#pragma unroll
        for (int k = 0; k < 16; ++k) { av[k] = aa[(sg * 16 + k) * 64 + j]; bv[k] = bb[(sg * 16 + k) * 64 + j]; }
#pragma unroll
        for (int k = 0; k < 16; ++k) Gv[k] = bf2f(C.za[(size_t)(row0 + sg * 16 + k) * NZA + 1536 + hb * 64 + j]);
        float hh = 0.f, P = 1.f;
#pragma unroll
        for (int k = 0; k < 16; ++k) { hh = av[k] * hh + bv[k]; P *= av[k]; av[k] = P; bv[k] = hh; }
        segA[sg * 64 + j] = P; segH[sg * 64 + j] = hh;
    }
    __syncthreads();
    LAS float* cin = segH + 512;
    float Hc = 0.f, Pc = 1.f;
    for (int s2 = 0; s2 < sg; ++s2) { const float a = segA[s2 * 64 + j]; Hc = a * Hc + segH[s2 * 64 + j]; Pc *= a; }
    const int chj = hb * 64 + j, bt = tile >> 6;
    const size_t wbase = (size_t)l * 128 * 512 + chj;
    if (sg == 7) {
        const float At = Pc * segA[7 * 64 + j], Hl = segA[7 * 64 + j] * Hc + segH[7 * 64 + j];
        __hip_atomic_store(C.agg + wbase + (size_t)tile * 512, ((unsigned long long)__float_as_uint(Hl) << 32) | (unsigned long long)(__float_as_uint(At) | 1u), __ATOMIC_RELAXED, __HIP_MEMORY_SCOPE_AGENT);
    }
    if (sg == 0) {
        const int r0 = nb & ~15;
        unsigned long long wv[16]; unsigned spins = 0;
        for (;;) {
            bool ok = true;
#pragma unroll
            for (int i = 0; i < 16; ++i) {
                const int n = r0 - 1 + i; const bool need = (i == 0) ? (r0 > 0) : (n < nb);
                const unsigned long long* pw = (i == 0 ? C.inc : C.agg) + wbase + (size_t)(bt * 64 + (need ? n : 0)) * 512;
                wv[i] = need ? __hip_atomic_load(pw, __ATOMIC_RELAXED, __HIP_MEMORY_SCOPE_AGENT) : 1ull;
                ok = ok && (wv[i] != 0ull);
            }
            if (ok || ++spins > (1u << 20)) break;
            __builtin_amdgcn_s_sleep(2);
        }
        float Hin = (r0 > 0) ? __uint_as_float((unsigned)(wv[0] >> 32)) : 0.f;
#pragma unroll
        for (int i = 1; i < 16; ++i) if (r0 - 1 + i < nb) Hin = __uint_as_float((unsigned)wv[i]) * Hin + __uint_as_float((unsigned)(wv[i] >> 32));
        cin[j] = Hin;
    }
    __syncthreads();
    {
        const float Hs = Hc + Pc * cin[j];
        float hl = 0.f;
#pragma unroll
        for (int k = 0; k < 16; ++k) { const int t = sg * 16 + k; hl = bv[k] + av[k] * Hs;
            C.o[(size_t)(row0 + t) * NO + 512 + chj] = (bf16_t)f2bf(Gv[k] * hl); }
        if (sg == 7) __hip_atomic_store(C.inc + wbase + (size_t)tile * 512, ((unsigned long long)__float_as_uint(hl) << 32) | 1ull, __ATOMIC_RELAXED, __HIP_MEMORY_SCOPE_AGENT);
    }
    __syncthreads();
}

__device__ __forceinline__ void fix_item(const Ctx& C, int tile, int half) {
    const int c = opaque_tid(), b = tile >> 6, nb = tile & 63, row0 = tile * 128 + half * 64;
    float H = 0.f;
    for (int jn = 0; jn < nb; ++jn) { const size_t idx = (size_t)(b * 64 + jn) * 512 + c; H = C.carryA[idx] * H + C.carryH[idx]; }
    for (int t = 0; t < 64; ++t) { const size_t r = (size_t)(row0 + t); C.o[r * NO + 512 + c] = (bf16_t)f2bf(C.ly[r * 512 + c] + C.lp[r * 512 + c] * H); }
}

__global__ void __launch_bounds__(512, 2) fwd_megakernel(Args args) {
    extern __shared__ __attribute__((aligned(16))) unsigned char lds_raw[];
    LAS unsigned char* lds = (LAS unsigned char*)lds_raw;
    volatile LAS unsigned* MISC = (volatile LAS unsigned*)(lds + MISC_OFF);
    const int tid = threadIdx.x, lane = tid & 63, wave = __builtin_amdgcn_readfirstlane(tid >> 6);
    const int G = gridDim.x, bx = blockIdx.x;
    unsigned char* ws = args.ws;
    Ctx C;
    C.in = args.in; C.x = args.out;
    C.wt_in = (bf16_t*)(ws + WS_WIN); C.wt_br = (bf16_t*)(ws + WS_WBR); C.wt_out = (bf16_t*)(ws + WS_WOUT); C.wt_ff1 = (bf16_t*)(ws + WS_WFF1); C.wt_ff2 = (bf16_t*)(ws + WS_WFF2); C.wt_kv = (bf16_t*)(ws + WS_WKV);
    C.memn = (bf16_t*)(ws + WS_MEMN); C.memkv = (bf16_t*)(ws + WS_MEMKV); C.xb = (bf16_t*)(ws + WS_XB); C.za = (bf16_t*)(ws + WS_ZA); C.zg = (bf16_t*)(ws + WS_ZG); C.mb = (bf16_t*)(ws + WS_MB); C.o = (bf16_t*)(ws + WS_O);
    C.ssq = (float*)(ws + WS_SSQ); C.carryA = (float*)(ws + WS_CARRY); C.carryH = C.carryA + 128 * 512; C.S = (float*)(ws + WS_S); C.ly = (float*)(ws + WS_LY); C.lp = (float*)(ws + WS_LP); C.memK = (bf16_t*)(ws + WS_MEMK); C.memVt = (bf16_t*)(ws + WS_MEMVT); C.spl = (float*)(ws + WS_SPL); C.ssv = (float*)(ws + WS_SSV); C.wgT = (bf16_t*)(ws + WS_WGT); C.agg = (unsigned long long*)(ws + WS_AGG); C.inc = (unsigned long long*)(ws + WS_INC);

    if (tid < 64) MISC[tid] = 0u;
    __syncthreads();
    XcdBarrier bar = xcd_barrier_post((unsigned*)(ws + WS_CTL), MISC + 8);
    const int gw = bx * 8 + wave, NGW = G * 8;
    LAS float* scr = (LAS float*)(lds + wave * 16384);

    for (int it = gw; it < IT_WIN + 4 * IT_WKV; it += NGW) {
        if (it < IT_WIN) conv_w(C, 0, 0, it, scr, lane);
        else { const int r = it - IT_WIN; conv_w(C, 5, r / IT_WKV, r % IT_WKV, scr, lane); }
    }
    for (int m = gw; m < M + 512; m += NGW) {
        if (m < M) {
            const f32x4* xr = (const f32x4*)(C.in[I_X] + (size_t)m * D) + lane; f32x4 v[4]; float s = 0.f;
#pragma unroll
            for (int jj = 0; jj < 4; ++jj) { v[jj] = xr[64 * jj]; s += (v[jj].x * v[jj].x + v[jj].y * v[jj].y) + (v[jj].z * v[jj].z + v[jj].w * v[jj].w); }
            s = wave_sum(s);
            f32x4* xo = (f32x4*)(C.x + (size_t)m * D) + lane; u32x2* bo = (u32x2*)(C.xb + (size_t)m * D) + lane;
#pragma unroll
            for (int jj = 0; jj < 4; ++jj) { xo[64 * jj] = v[jj]; bo[64 * jj] = (u32x2){pk2(v[jj].x, v[jj].y), pk2(v[jj].z, v[jj].w)}; }
            if (lane < 16) C.ssq[(size_t)m * 16 + lane] = (lane == 0) ? s : 0.f;
        } else {
            const int r = m - M;
            const f32x4* xr = (const f32x4*)(C.in[I_MEM] + (size_t)r * D) + lane; f32x4 v[4]; float s = 0.f;
#pragma unroll
            for (int jj = 0; jj < 4; ++jj) { v[jj] = xr[64 * jj]; s += (v[jj].x * v[jj].x + v[jj].y * v[jj].y) + (v[jj].z * v[jj].z + v[jj].w * v[jj].w); }
            s = wave_sum(s); const float rs = rsqrtf(s * (1.f / 1024.f) + EPS);
            u32x2* bo = (u32x2*)(C.memn + (size_t)r * D) + lane;
#pragma unroll
            for (int jj = 0; jj < 4; ++jj) bo[64 * jj] = (u32x2){pk2(v[jj].x * rs, v[jj].y * rs), pk2(v[jj].z * rs, v[jj].w * rs)};
        }
    }
    { const int gt = bx * 512 + tid; if (gt < DEPTH * 512) C.spl[gt] = log1pf(expf(-C.in[I_LAM][gt])); }
    for (int c = bx * 512 + tid; c < DEPTH * 8 * 2 * 64 * 8; c += G * 512) {
        const int c8 = c & 7, jj = (c >> 3) & 63, gt2 = (c >> 9) & 1, lh = c >> 10;
        const float* src = C.in[gt2 ? I_WI : I_WR] + (size_t)lh * 4096 + (size_t)(c8 * 8) * 64 + jj;
        float f[8];
#pragma unroll
        for (int e = 0; e < 8; ++e) f[e] = src[e * 64];
        *(u32x4*)(C.wgT + (size_t)c * 8) = PACK8(f, 0);
    }
    { u32x4* zp = (u32x4*)(ws + WS_AGG); for (int i = bx * 512 + tid; i < (int)((WS_SSV - WS_AGG) / 16); i += G * 512) zp[i] = (u32x4){0u, 0u, 0u, 0u}; }
    __syncthreads();
    if (args.ws == nullptr) cg::this_grid().sync();
    xcd_barrier(bar);

    for (int l = 0; l < DEPTH; ++l) {
        if (l == 0 && bx >= 64 && bx < 96) {
            pg8::Gemm g{C.memn, C.wt_kv}; pg8::SchedKV S{bx - 64}; pg8::EpiKV E{C.memkv};
            pg8::gemm_phase<pg8::EpiKV, pg8::SchedKV, true, D, D, D>(lds, g, S, E);
        }
        {
#ifndef SKIP_G1
            pg8::Gemm g{C.xb, C.wt_in}; pg8::SchedStd S; S.init(M, DIN, G, bx, D, D);
            pg8::EpiZ E{C.za, C.zg, C.ssq, C.in[I_BGATE] + (size_t)l * 4 * D, C.ssv};
            for (int rep = 0; rep < REP_G1; ++rep) pg8::gemm_phase<pg8::EpiZ, pg8::SchedStd, true, D, D, D>(lds, g, S, E);
#endif

        }
        const int cfirst = (l == 0) ? 96 : 64;
        if (G == 256 && bx >= cfirst) {
            const int lane_c = opaque_tid() & 63;
            const int cw = (bx - cfirst) * 8 + wave, NCW = (G - cfirst) * 8;
            for (int it = cw; it < IT_WBR + IT_WOUT + IT_WFF1 + IT_WFF2; it += NCW) {
                int r = it;
                if (r < IT_WBR) { conv_w(C, 1, l, r, scr, lane_c); continue; } r -= IT_WBR;
                if (r < IT_WOUT) { conv_w(C, 2, l, r, scr, lane_c); continue; } r -= IT_WOUT;
                if (r < IT_WFF1) { conv_w(C, 3, l, r, scr, lane_c); continue; } r -= IT_WFF1;
                conv_w(C, 4, l, r, scr, lane_c);
            }
        }
        xcd_barrier(bar);
        {
            if (l == 0) { kvprep_phase(C, gw, NGW, opaque_tid() & 63); xcd_barrier(bar); }
            for (int rmix = 0; rmix < REP_MIX; ++rmix) {
#if USE_MFMA_SWA
            for (int rep = 0; rep < REP_SWA; ++rep) for (int it = bx; it < 256; it += G) swa_item_mfma(lds, C, l, it >> 1, it & 1);
#else
            for (int it = bx; it < 1024; it += G) swa_item(lds, C, l, it >> 3, it & 7);
#endif
#if USE_MFMA_XA
            for (int rep = 0; rep < REP_XA; ++rep) for (int it = bx; it < 256; it += G) xa_pair_mfma(lds, C, l, it);
#else
            for (int it = bx; it < 512; it += G) xa_item(lds, C, l, it >> 2, it & 3);
#endif
#if USE_MFMA_GM
            for (int rep = 0; rep < REP_GM; ++rep) for (int it = bx; it < 512; it += G) gm_item_mfma(lds, C, l, it >> 2, it & 3);
#else
            for (int it = bx; it < 512; it += G) gm_item(lds, C, l, it >> 2, it & 3);
#endif
#if USE_MFMA_LRU
            for (int it = bx; it < 1024; it += G) lru_item_mfma(lds, C, l, ((it >> 3) & 1) * 64 + (it >> 4), it & 7);
#else
            for (int it = bx; it < 1024; it += G) lru_item(lds, C, l, it >> 3, it & 7);
#endif
            }
            const int lane_c = opaque_tid() & 63;
            const int NC0 = (G == 256) ? 0 : IT_WBR + IT_WOUT + IT_WFF1 + IT_WFF2;
            const int NC = IT_WBR + IT_WOUT + IT_WFF1 + IT_WFF2 + (l + 1 < DEPTH ? IT_WIN : 0);
            for (int rep = 0; rep < REP_CONV; ++rep) for (int it = gw + (IT_WBR + IT_WOUT + IT_WFF1 + IT_WFF2 - NC0); it < NC; it += NGW) {
                int r = it;
                if (r < IT_WBR) { conv_w(C, 1, l, r, scr, lane_c); continue; } r -= IT_WBR;
                if (r < IT_WOUT) { conv_w(C, 2, l, r, scr, lane_c); continue; } r -= IT_WOUT;
                if (r < IT_WFF1) { conv_w(C, 3, l, r, scr, lane_c); continue; } r -= IT_WFF1;
                if (r < IT_WFF2) { conv_w(C, 4, l, r, scr, lane_c); continue; } r -= IT_WFF2;
                conv_w(C, 0, l + 1, r, scr, lane_c);
            }
            __syncthreads();
        }
        xcd_barrier(bar);
        {
#ifndef SKIP_G2
            pg8::Gemm g{C.o, C.wt_br}; pg8::SchedMerge S; S.t.init(M, D, G, bx, NO, NO);
            pg8::EpiMerge E{C.zg, C.mb};
            for (int rep = 0; rep < REP_G2; ++rep) pg8::gemm_phase<pg8::EpiMerge, pg8::SchedMerge, true, NO, NO, 512>(lds, g, S, E);
#endif

        }
        xcd_barrier(bar);
        {
#ifndef SKIP_G3
            pg8::Gemm g{C.mb, C.wt_out}; pg8::SchedStd S; S.init(M, D, G, bx, D, D);
            for (int rep = 1; rep < REP_G3; ++rep) { pg8::EpiRes E0{C.x, C.ly, C.o, C.S}; pg8::gemm_phase<pg8::EpiRes, pg8::SchedStd, true, D, D, D>(lds, g, S, E0); }
            pg8::EpiRes E{C.x, C.x, C.xb, C.ssq};
            pg8::gemm_phase<pg8::EpiRes, pg8::SchedStd, true, D, D, D>(lds, g, S, E);
#endif

        }
        xcd_barrier(bar);
        {
#ifndef SKIP_G4
            pg8::Gemm g{C.xb, C.wt_ff1}; pg8::SchedStd S; S.init(M, FF, G, bx, D, D);
            pg8::EpiFF1 E{C.zg, C.ssq};
            for (int rep = 0; rep < REP_G4; ++rep) pg8::gemm_phase<pg8::EpiFF1, pg8::SchedStd, true, D, D, D>(lds, g, S, E);
#endif

        }
        xcd_barrier(bar);
        {
#ifndef SKIP_G5
            pg8::Gemm g{C.zg, C.wt_ff2}; pg8::SchedStd S; S.init(M, D, G, bx, FF, FF);
            for (int rep = 1; rep < REP_G5; ++rep) { pg8::EpiRes E0{C.x, C.ly, C.o, C.S}; pg8::gemm_phase<pg8::EpiRes, pg8::SchedStd, true, FF, FF, FF>(lds, g, S, E0); }
            pg8::EpiRes E{C.x, C.x, C.xb, C.ssq};
            pg8::gemm_phase<pg8::EpiRes, pg8::SchedStd, true, FF, FF, FF>(lds, g, S, E);
#endif

        }
        if (l + 1 < DEPTH) xcd_barrier(bar);
    }
}

extern "C" void kernel_launch(void* const* d_in, const int* in_sizes, int n_in, void* d_out, int out_size, void* d_ws, size_t ws_size, hipStream_t stream) {
    static int grid = 0;
    if (grid == 0) {
        if (n_in != 27 || out_size != M * D || ws_size < WS_END) { fprintf(stderr, "kernel_launch: unexpected shapes: n_in %d out %d ws %zu (need %zu)\n", n_in, out_size, ws_size, (size_t)WS_END); grid = -1; return; }
        int dev = 0, cus = 0, per_cu = 0;
        hipGetDevice(&dev); hipDeviceGetAttribute(&cus, hipDeviceAttributeMultiprocessorCount, dev);
        if (hipFuncSetAttribute((const void*)fwd_megakernel, hipFuncAttributeMaxDynamicSharedMemorySize, LDS_BYTES) != hipSuccess) { fprintf(stderr, "kernel_launch: hipFuncSetAttribute failed\n"); grid = -1; return; }
        if (hipOccupancyMaxActiveBlocksPerMultiprocessor(&per_cu, (const void*)fwd_megakernel, 512, LDS_BYTES) != hipSuccess || per_cu < 1) { fprintf(stderr, "kernel_launch: occupancy query says %d\n", per_cu); per_cu = 1; }
        (void)hipGetLastError();
        grid = cus;
        if (grid != 256) fprintf(stderr, "kernel_launch: note: %d CUs\n", grid);
    }
    if (grid < 0) return;
    hipMemsetAsync((char*)d_ws + WS_CTL, 0, CTL_ZERO_BYTES, stream);
    Args a{};
    for (int i = 0; i < 27; ++i) a.in[i] = (const float*)d_in[i];
    a.out = (float*)d_out; a.ws = (unsigned char*)d_ws;
    void* kargs[] = {&a};
    hipError_t e = hipLaunchCooperativeKernel((const void*)fwd_megakernel, dim3(grid), dim3(512), kargs, LDS_BYTES, stream);
    if (e != hipSuccess) fprintf(stderr, "kernel_launch: cooperative launch failed: %s\n", hipGetErrorString(e));
}
```

```cpp
#include <hip/hip_runtime.h>
#include <hip/hip_cooperative_groups.h>
#include <cstdio>
#include <cstdint>
namespace cg = cooperative_groups;

#define LAS __attribute__((address_space(3)))
#define GAS __attribute__((address_space(1)))
typedef unsigned short bf16_t;
typedef short bf16x8 __attribute__((ext_vector_type(8)));
typedef float f32x4 __attribute__((ext_vector_type(4)));
typedef unsigned u32x4 __attribute__((ext_vector_type(4)));
typedef unsigned u32x2 __attribute__((ext_vector_type(2)));

constexpr int M = 16384, D = 1024, DIN = 7424, NZA = 3328, NZG = 4096, FF = 4096, DEPTH = 4, NO = 2048;
constexpr float EPS = 1e-6f;
constexpr size_t MiB = 1u << 20;
constexpr size_t WS_CTL = 0, CTL_ZERO_BYTES = 64 * 1024;
constexpr size_t WS_WIN = 2 * MiB, WS_WBR = 17 * MiB, WS_WOUT = 21 * MiB, WS_WFF1 = 23 * MiB, WS_WFF2 = 31 * MiB, WS_WKV = 39 * MiB;
constexpr size_t WS_MEMN = 47 * MiB, WS_MEMKV = 48 * MiB, WS_SSQ = 52 * MiB, WS_CARRY = 53 * MiB, WS_XB = 54 * MiB;
constexpr size_t WS_ZA = 86 * MiB, WS_S = 86 * MiB, WS_MB = 150 * MiB, WS_ZG = 190 * MiB, WS_O = 318 * MiB, WS_LY = 382 * MiB, WS_LP = 414 * MiB, WS_MEMK = 446 * MiB, WS_MEMVT = 448 * MiB, WS_SPL = 450 * MiB, WS_AGG = 451 * MiB, WS_INC = 453 * MiB, WS_SSV = 455 * MiB, WS_WGT = 456 * MiB, WS_ROPE = 457 * MiB, WS_END = 458 * MiB;
static_assert(WS_ZA + (size_t)M * NZA * 2 <= WS_ZG && WS_MB + (size_t)M * D * 2 <= WS_ZG && WS_WIN + (size_t)DIN * D * 2 <= WS_WBR, "ws map");

constexpr int LDS_BYTES = 147456, MISC_OFF = LDS_BYTES - 256;

__device__ __forceinline__ float bf2f(bf16_t h) { return __uint_as_float((unsigned)h << 16); }
__device__ __forceinline__ unsigned f2bf(float f) { unsigned u = __float_as_uint(f); return (u + 0x7fffu + ((u >> 16) & 1u)) >> 16; }
__device__ __forceinline__ unsigned pk2(float lo, float hi) { return f2bf(lo) | (f2bf(hi) << 16); }
__device__ __forceinline__ unsigned cvt_pk_bf16(float lo, float hi) { unsigned r; asm volatile("v_cvt_pk_bf16_f32 %0, %1, %2" : "=v"(r) : "v"(lo), "v"(hi)); return r; }
#define UNPACK8(VV, f, o) do { (f)[(o) + 0] = __uint_as_float((VV)[0] << 16); (f)[(o) + 1] = __uint_as_float((VV)[0] & 0xffff0000u); (f)[(o) + 2] = __uint_as_float((VV)[1] << 16); (f)[(o) + 3] = __uint_as_float((VV)[1] & 0xffff0000u); \
    (f)[(o) + 4] = __uint_as_float((VV)[2] << 16); (f)[(o) + 5] = __uint_as_float((VV)[2] & 0xffff0000u); (f)[(o) + 6] = __uint_as_float((VV)[3] << 16); (f)[(o) + 7] = __uint_as_float((VV)[3] & 0xffff0000u); } while (0)
#define PACK8(f, o) ((u32x4){cvt_pk_bf16((f)[(o) + 0], (f)[(o) + 1]), cvt_pk_bf16((f)[(o) + 2], (f)[(o) + 3]), cvt_pk_bf16((f)[(o) + 4], (f)[(o) + 5]), cvt_pk_bf16((f)[(o) + 6], (f)[(o) + 7])})
__device__ __forceinline__ float gelu_t(float x) {
    const float c1 = -2.f * 0.7978845608028654f * 1.4426950408889634f, c2 = c1 * 0.044715f;
    return x * __builtin_amdgcn_rcpf(1.f + __builtin_amdgcn_exp2f(x * (c1 + c2 * (x * x)))); }
__device__ __forceinline__ float sigmoid_f(float x) { return __builtin_amdgcn_rcpf(1.f + __expf(-x)); }
__device__ __forceinline__ float row_rstd(const float* ssq, int row) {
    const f32x4* p = (const f32x4*)(ssq + (size_t)row * 16);
    const f32x4 a = p[0], b = p[1], c = p[2], d = p[3];
    const float s = (((a.x + a.y) + (a.z + a.w)) + ((b.x + b.y) + (b.z + b.w))) + (((c.x + c.y) + (c.z + c.w)) + ((d.x + d.y) + (d.z + d.w)));
    return rsqrtf(s * (1.f / 1024.f) + EPS);
}
__device__ __forceinline__ float row_rstd_coop(const float* ssq, int row, int fq) {
    const f32x4 a = *(const f32x4*)(ssq + (size_t)row * 16 + fq * 4);
    float s = (a.x + a.y) + (a.z + a.w);
    s += __shfl_xor(s, 16); s += __shfl_xor(s, 32);
    return rsqrtf(s * (1.f / 1024.f) + EPS);
}
#define LDS_WAIT() asm volatile("s_waitcnt lgkmcnt(0)" ::: "memory")
__device__ __forceinline__ int opaque_tid() { int t = threadIdx.x; asm volatile("" : "+v"(t)); return t; }

namespace pg8 {
constexpr int BM = 256, BK = 64, HALF = 128, HTB = HALF * BK * 2, STAGE_BYTES = 8 * HTB, NXCD = 8, WGM = 8;
__host__ __device__ __forceinline__ int lds_byte(int r, int c) { const int st = (r >> 4) * 2 + (c >> 5), rr = r & 15, cc = c & 31, ob = rr * 64 + cc * 2; return st * 1024 + (ob ^ (((ob >> 9) & 1) << 5)); }
__host__ __device__ __forceinline__ void stage_rc(int b, int& R, int& C) { const int st = b / 1024, sb = b % 1024, swz = sb ^ (((sb >> 9) & 1) << 5); R = (st >> 1) * 16 + swz / 64; C = (st & 1) * 32 + (swz % 64) / 2; }
__host__ __device__ __forceinline__ int perm32(int rho) { const int n = rho >> 4, i = rho & 15; return 8 * (i >> 2) + 4 * n + (i & 3); }

struct Unit { int pm, pn, b; };
struct Gemm { const bf16_t* A; const bf16_t* Bt; };

struct SchedStd {
    int nM, nN, nwg, G, c; size_t as, bs;
    __device__ void init(int M_, int N_, int G_, int c_, int lda, int ldb) { nM = M_ / BM; nN = N_ / BM; nwg = nM * nN; G = G_; c = c_; as = (size_t)BM * lda * 2; bs = (size_t)BM * ldb * 2; }
    __device__ bool tile(long L, Unit& u) const {
        if (L >= nwg) return false;
        int wgid = (int)L; { const int q = nwg / NXCD, r = nwg % NXCD, xcd = wgid % NXCD, off = wgid / NXCD; wgid = (xcd < r ? xcd * (q + 1) : r * (q + 1) + (xcd - r) * q) + off; }
        const int nig = WGM * nN, gid = wgid / nig, fm = gid * WGM, gsz = (nM - fm) < WGM ? (nM - fm) : WGM;
        u.pm = fm + ((wgid % nig) % gsz); u.pn = (wgid % nig) / gsz; u.b = 0; return true;
    }
    __device__ bool next(int i, Unit& u) const { return tile((long)i * G + c, u); }
    __device__ size_t aoff(const Unit& u) const { return (size_t)u.pm * as; }
    __device__ size_t boff(const Unit& u) const { return (size_t)u.pn * bs; }
};
struct SchedMerge {
    SchedStd t;
    __device__ bool next(int i, Unit& u) const { if (!t.tile((long)(i >> 2) * t.G + t.c, u)) return false; u.b = i & 3; return true; }
    __device__ size_t aoff(const Unit& u) const { return (size_t)u.pm * t.as + (size_t)u.b * 1024; }
    __device__ size_t boff(const Unit& u) const { return (size_t)u.pn * t.bs + (size_t)u.b * 1024; }
};
struct SchedKV {
    int c;
    __device__ bool next(int i, Unit& u) const { if (i > 0 || c >= 32) return false; u.b = c >> 3; u.pm = (c & 7) >> 2; u.pn = c & 3; return true; }
    __device__ size_t aoff(const Unit& u) const { return (size_t)u.pm * 256 * 1024 * 2; }
    __device__ size_t boff(const Unit& u) const { return ((size_t)u.b * 1024 + (size_t)u.pn * 256) * 1024 * 2; }
};

struct EpiZ {
    static constexpr bool PERM = true, KEEPS = false;
    bf16_t* za; bf16_t* zg; const float* ssq; const float* bgate; float* ssv;
    __device__ __forceinline__ void operator()(const f32x4 (&acc)[2][2][4][2], const Unit& u, int wr, int wc, int fr, int fq) const {
        const int row0 = u.pm * BM + wr * 64 + fr, pn = u.pn;
        bf16_t* base; int ldc, colt, mode;
        if (pn < 13) { base = za; ldc = NZA; colt = pn * 256; mode = (pn < 4 || pn == 6 || pn == 7) ? 1 : 0; }
        else { base = zg; ldc = NZG; colt = (pn - 13) * 256; mode = 2; }
        const int col0 = colt + wc * 32 + 8 * fq;
        const int d0 = 64 * (pn - 13) + 16 * wc + 4 * fq;
        f32x4 bv[2][2];
#pragma unroll
        for (int bj = 0; bj < 2; ++bj)
#pragma unroll
            for (int n = 0; n < 2; ++n) bv[bj][n] = (mode == 2) ? *(const f32x4*)(bgate + (2 * bj + n) * 1024 + d0) : (f32x4){0.f, 0.f, 0.f, 0.f};
#pragma unroll
        for (int ai = 0; ai < 2; ++ai) {
            float rsm[4];
#pragma unroll
            for (int m = 0; m < 4; ++m) rsm[m] = row_rstd_coop(ssq, row0 + ai * HALF + m * 16, fq);
            asm volatile("" ::: "memory");
#pragma unroll
            for (int m = 0; m < 4; ++m) {
                const int row = row0 + ai * HALF + m * 16; const float rs = rsm[m]; float vss = 0.f;
                bf16_t* rowp = base + (size_t)row * ldc + col0;
                if (mode == 2) {
                    f32x4 sden[4];
#pragma unroll
                    for (int b2 = 0; b2 < 4; ++b2) { const f32x4 zv = acc[ai][b2 >> 1][m][b2 & 1] * (rs * -1.4426950408889634f) + bv[b2 >> 1][b2 & 1] * -1.4426950408889634f;
#pragma unroll
                        for (int e = 0; e < 4; ++e) sden[b2][e] = 1.f + __builtin_amdgcn_exp2f(fminf(zv[e], 66.f)); }
#pragma unroll
                    for (int b2 = 0; b2 < 4; ++b2) { f32x4 rv;
#pragma unroll
                        for (int e = 0; e < 4; ++e) { const float ig = __builtin_amdgcn_rcpf(sden[b2][e]); rv[e] = (b2 < 3) ? sden[b2 + 1][e] * ig : ig; }
                        *(u32x2*)(zg + (size_t)row * NZG + b2 * 1024 + d0) = (u32x2){cvt_pk_bf16(rv[0], rv[1]), cvt_pk_bf16(rv[2], rv[3])}; }
                    continue;
                }
#pragma unroll
                for (int bj = 0; bj < 2; ++bj) {
                    f32x4 v0 = acc[ai][bj][m][0] * rs, v1 = acc[ai][bj][m][1] * rs;
                    if (mode == 1) {
#pragma unroll
                        for (int e = 0; e < 4; ++e) { v0[e] = gelu_t(v0[e]); v1[e] = gelu_t(v1[e]); }
                    } else if (mode == 2) {
                        v0 = v0 + bv[bj][0]; v1 = v1 + bv[bj][1];
#pragma unroll
                        for (int e = 0; e < 4; ++e) { v0[e] = sigmoid_f(v0[e]); v1[e] = sigmoid_f(v1[e]); }
                    }
                    u32x4 w; w.x = cvt_pk_bf16(v0[0], v0[1]); w.y = cvt_pk_bf16(v0[2], v0[3]); w.z = cvt_pk_bf16(v1[0], v1[1]); w.w = cvt_pk_bf16(v1[2], v1[3]);
                    *(u32x4*)(rowp + bj * HALF) = w;
                    if (pn == 2 || pn == 3) vss += (v0[0] * v0[0] + v0[1] * v0[1]) + (v0[2] * v0[2] + v0[3] * v0[3]) + (v1[0] * v1[0] + v1[1] * v1[1]) + (v1[2] * v1[2] + v1[3] * v1[3]);
                }
                if (pn == 2 || pn == 3) { vss += __shfl_xor(vss, 16); vss += __shfl_xor(vss, 32); if (fq == 0) ssv[(size_t)row * 8 + (pn - 2) * 4 + wc] = vss; }
            }
            asm volatile("" ::: "memory");
        }
    }
};
struct EpiFF1 {
    static constexpr bool PERM = true, KEEPS = false;
    bf16_t* f; const float* ssq;
    __device__ __forceinline__ void operator()(const f32x4 (&acc)[2][2][4][2], const Unit& u, int wr, int wc, int fr, int fq) const {
        const int row0 = u.pm * BM + wr * 64 + fr, col0 = u.pn * BM + wc * 32 + 8 * fq;
#pragma unroll
        for (int ai = 0; ai < 2; ++ai) {
            float rsm[4];
#pragma unroll
            for (int m = 0; m < 4; ++m) rsm[m] = row_rstd_coop(ssq, row0 + ai * HALF + m * 16, fq);
            asm volatile("" ::: "memory");
#pragma unroll
            for (int m = 0; m < 4; ++m) {
                const int row = row0 + ai * HALF + m * 16; const float rs = rsm[m];
                bf16_t* rowp = f + (size_t)row * FF + col0;
#pragma unroll
                for (int bj = 0; bj < 2; ++bj) {
                    f32x4 v0 = acc[ai][bj][m][0] * rs, v1 = acc[ai][bj][m][1] * rs;
#pragma unroll
                    for (int e = 0; e < 4; ++e) { const float a = fmaxf(v0[e], 0.f), b = fmaxf(v1[e], 0.f); v0[e] = a * a; v1[e] = b * b; }
                    u32x4 w; w.x = cvt_pk_bf16(v0[0], v0[1]); w.y = cvt_pk_bf16(v0[2], v0[3]); w.z = cvt_pk_bf16(v1[0], v1[1]); w.w = cvt_pk_bf16(v1[2], v1[3]);
                    *(u32x4*)(rowp + bj * HALF) = w;
                }
            }
            asm volatile("" ::: "memory");
        }
    }
};
struct EpiRes {
    static constexpr bool PERM = true, KEEPS = false;
    const bf16_t* xin; bf16_t* xb; float* ssq; float* xout;
    __device__ __forceinline__ void operator()(const f32x4 (&acc)[2][2][4][2], const Unit& u, int wr, int wc, int fr, int fq) const {
        const int row0 = u.pm * BM + wr * 64 + fr, col0 = u.pn * BM + wc * 32 + 8 * fq;
#pragma unroll
        for (int ai = 0; ai < 2; ++ai) {
            u32x4 xo[4][2];
#pragma unroll
            for (int m = 0; m < 4; ++m)
#pragma unroll
                for (int bj = 0; bj < 2; ++bj) xo[m][bj] = *(const u32x4*)(xin + (size_t)(row0 + ai * HALF + m * 16) * D + col0 + bj * HALF);
            asm volatile("" ::: "memory");
#pragma unroll
            for (int m = 0; m < 4; ++m) {
                const int row = row0 + ai * HALF + m * 16; float ss = 0.f;
#pragma unroll
                for (int bj = 0; bj < 2; ++bj) {
                    float xf[8]; UNPACK8(xo[m][bj], xf, 0);
                    const f32x4 v0 = (f32x4){xf[0], xf[1], xf[2], xf[3]} + acc[ai][bj][m][0], v1 = (f32x4){xf[4], xf[5], xf[6], xf[7]} + acc[ai][bj][m][1];
                    ss += (v0[0] * v0[0] + v0[1] * v0[1]) + (v0[2] * v0[2] + v0[3] * v0[3]) + (v1[0] * v1[0] + v1[1] * v1[1]) + (v1[2] * v1[2] + v1[3] * v1[3]);
                    u32x4 w; w.x = cvt_pk_bf16(v0[0], v0[1]); w.y = cvt_pk_bf16(v0[2], v0[3]); w.z = cvt_pk_bf16(v1[0], v1[1]); w.w = cvt_pk_bf16(v1[2], v1[3]);
                    *(u32x4*)(xb + (size_t)row * D + col0 + bj * HALF) = w;
                    if (xout) { float* xp = xout + (size_t)row * D + col0 + bj * HALF; *(f32x4*)xp = v0; *(f32x4*)(xp + 4) = v1; }
                }
                ss += __shfl_xor(ss, 16); ss += __shfl_xor(ss, 32);
                if (fq == 0) ssq[(size_t)row * 16 + u.pn * 4 + wc] = ss;
            }
            asm volatile("" ::: "memory");
        }
    }
};
struct EpiMerge {
    static constexpr bool PERM = true, KEEPS = true;
    const bf16_t* zg; bf16_t* mb;
    __device__ __forceinline__ bool merge(f32x4 (&acc)[2][2][4][2], const Unit& u, int wr, int wc, int fr, int fq) const {
        const int row0 = u.pm * BM + wr * 64 + fr, col0 = u.pn * BM + wc * 32 + 8 * fq, b = u.b;
        u32x4 ga[2][4][2];
#pragma unroll
        for (int ai = 0; ai < 2; ++ai)
#pragma unroll
            for (int m = 0; m < 4; ++m)
#pragma unroll
                for (int bj = 0; bj < 2; ++bj) ga[ai][m][bj] = *(const u32x4*)(zg + (size_t)(row0 + ai * HALF + m * 16) * NZG + b * 1024 + col0 + bj * HALF);
        asm volatile("" ::: "memory");
#pragma unroll
        for (int ai = 0; ai < 2; ++ai) {
#pragma unroll
            for (int m = 0; m < 4; ++m) {
                const int row = row0 + ai * HALF + m * 16;
#pragma unroll
                for (int bj = 0; bj < 2; ++bj) {
                    const int col = col0 + bj * HALF;
                    float g[8]; UNPACK8(ga[ai][m][bj], g, 0);
#pragma unroll
                    for (int e = 0; e < 4; ++e) { acc[ai][bj][m][0][e] *= g[e]; acc[ai][bj][m][1][e] *= g[4 + e]; }
                    if (b == 3) { const f32x4 v0 = acc[ai][bj][m][0], v1 = acc[ai][bj][m][1];
                        u32x4 w; w.x = cvt_pk_bf16(v0[0], v0[1]); w.y = cvt_pk_bf16(v0[2], v0[3]); w.z = cvt_pk_bf16(v1[0], v1[1]); w.w = cvt_pk_bf16(v1[2], v1[3]);
                        *(u32x4*)(mb + (size_t)row * D + col) = w; }
                }
            }
        }
        asm volatile("" ::: "memory");
        return b < 3;
    }
};
struct EpiKV {
    static constexpr bool PERM = true, KEEPS = false;
    bf16_t* out;
    __device__ __forceinline__ void operator()(const f32x4 (&acc)[2][2][4][2], const Unit& u, int wr, int wc, int fr, int fq) const {
        const int row0 = u.pm * BM + wr * 64 + fr, col0 = u.pn * BM + wc * 32 + 8 * fq;
        bf16_t* base = out + (size_t)u.b * 512 * 1024;
#pragma unroll
        for (int ai = 0; ai < 2; ++ai)
#pragma unroll
            for (int m = 0; m < 4; ++m) {
                const int row = row0 + ai * HALF + m * 16;
#pragma unroll
                for (int bj = 0; bj < 2; ++bj) {
                    const f32x4 v0 = acc[ai][bj][m][0], v1 = acc[ai][bj][m][1];
                    u32x4 w; w.x = cvt_pk_bf16(v0[0], v0[1]); w.y = cvt_pk_bf16(v0[2], v0[3]); w.z = cvt_pk_bf16(v1[0], v1[1]); w.w = cvt_pk_bf16(v1[2], v1[3]);
                    *(u32x4*)(base + (size_t)row * 1024 + col0 + bj * HALF) = w;
                }
            }
    }
};

template <class Epi, class Sched, bool ALIGN_EPI, int LDA, int LDB, int KK>
__device__ __forceinline__ void gemm_phase(LAS unsigned char* lds, const Gemm g, const Sched& S, const Epi& E) {
    const int tid = opaque_tid(), wid = __builtin_amdgcn_readfirstlane(tid >> 6), lane = tid & 63, wr = wid >> 2, wc = wid & 3, fr = lane & 15, fq = lane >> 4;
    constexpr int nt = KK / BK;
    unsigned voffA[2], voffB[2];
#pragma unroll
    for (int i = 0; i < 2; ++i) { int R, C; stage_rc(tid * 16 + i * 8192, R, C); const int Rb = Epi::PERM ? ((R & ~31) + perm32(R & 31)) : R;
        voffA[i] = (unsigned)(R * LDA + C) * 2u; voffB[i] = (unsigned)(Rb * LDB + C) * 2u; }
    constexpr size_t kstep = (size_t)(BK * 2);
    constexpr size_t hstepA = (size_t)HALF * LDA * 2, hstepB = (size_t)HALF * LDB * 2;
    const unsigned ldsw = (unsigned)wid * 1024u;
    const int aoff = lds_byte(wr * 64 + fr, fq * 8), boff = lds_byte(wc * 32 + fr, fq * 8);
#define PG8_SA(b, h) (((b) * 2 + (h)) * HTB)
#define PG8_SB(b, h) ((4 + (b) * 2 + (h)) * HTB)
#define PG8_STAGE(bufoff, gbase, voff) do { _Pragma("unroll") for (int _i = 0; _i < 2; ++_i) \
        __builtin_amdgcn_global_load_lds((const unsigned*)((const char*)(gbase) + (voff)[_i]), (LAS unsigned*)(lds + (bufoff) + ldsw + _i * 8192), 16, 0, 0); } while (0)
#define PG8_LDA(dst, b, h) do { _Pragma("unroll") for (int m = 0; m < 4; ++m) _Pragma("unroll") for (int k = 0; k < 2; ++k) dst[m][k] = *(const LAS bf16x8*)(lds + PG8_SA(b, h) + aoff + m * 2048 + k * 1024); } while (0)
#define PG8_LDB(dst, b, h) do { _Pragma("unroll") for (int n = 0; n < 2; ++n) _Pragma("unroll") for (int k = 0; k < 2; ++k) dst[n][k] = *(const LAS bf16x8*)(lds + PG8_SB(b, h) + boff + n * 2048 + k * 1024); } while (0)
#define PG8_MMA(ai, bj, At, Bt) do { __builtin_amdgcn_s_setprio(1); _Pragma("unroll") for (int m = 0; m < 4; ++m) _Pragma("unroll") for (int n = 0; n < 2; ++n) _Pragma("unroll") for (int k = 0; k < 2; ++k) \
        acc[ai][bj][m][n] = __builtin_amdgcn_mfma_f32_16x16x32_bf16(Bt[n][k], At[m][k], acc[ai][bj][m][n], 0, 0, 0); __builtin_amdgcn_s_setprio(0); } while (0)
#define PG8_WAIT_V(n) asm volatile("s_waitcnt vmcnt(" #n ")" ::: "memory")
#define PG8_WAIT_L(n) asm volatile("s_waitcnt lgkmcnt(" #n ")" ::: "memory")
#define PG8_BAR __builtin_amdgcn_s_barrier()
#define PG8_SCHED __builtin_amdgcn_sched_barrier(0)
    Unit cur, nxt; int ui = 0;
    if (!S.next(0, cur)) return;
    f32x4 acc[2][2][4][2];
#pragma unroll
    for (int a = 0; a < 2; ++a)
#pragma unroll
        for (int b = 0; b < 2; ++b)
#pragma unroll
            for (int m = 0; m < 4; ++m)
#pragma unroll
                for (int n = 0; n < 2; ++n) acc[a][b][m][n] = (f32x4){0.f, 0.f, 0.f, 0.f};
    bf16x8 At[4][2], B0[2][2], B1[2][2];
    const char* gA = (const char*)g.A; const char* gB = (const char*)g.Bt;
    asm volatile("" : "+s"(gA), "+s"(gB));
    const char* cA = gA + S.aoff(cur); const char* cB = gB + S.boff(cur);
    PG8_STAGE(PG8_SB(0, 0), cB, voffB); PG8_STAGE(PG8_SB(0, 1), cB + hstepB, voffB); PG8_STAGE(PG8_SA(0, 0), cA, voffA); PG8_STAGE(PG8_SA(0, 1), cA + hstepA, voffA);
    if (wr == 1) PG8_BAR;
    PG8_WAIT_V(2); PG8_BAR;
    PG8_STAGE(PG8_SB(1, 0), cB + kstep, voffB); PG8_STAGE(PG8_SA(1, 0), cA + kstep, voffA); PG8_STAGE(PG8_SB(1, 1), cB + hstepB + kstep, voffB);
    PG8_WAIT_V(6); PG8_BAR;
    for (;;) {
        const bool has_next = S.next(ui + 1, nxt);
        const char* nA = has_next ? gA + S.aoff(nxt) : cA; const char* nB = has_next ? gB + S.boff(nxt) : cB;
        for (int t = 0; t < nt; t += 2) {
            const bool last = (t == nt - 2);
            const char* a1 = cA + (size_t)(t + 1) * kstep;
            const char* a2 = last ? nA : cA + (size_t)(t + 2) * kstep; const char* b2 = last ? nB : cB + (size_t)(t + 2) * kstep;
            const char* a3 = a2 + kstep; const char* b3 = b2 + kstep;
            PG8_LDB(B0, 0, 0); PG8_LDB(B1, 0, 1); PG8_SCHED; PG8_LDA(At, 0, 0); PG8_STAGE(PG8_SA(1, 1), a1 + hstepA, voffA);
            PG8_WAIT_V(8); PG8_WAIT_L(0); PG8_BAR; PG8_MMA(0, 0, At, B0); PG8_MMA(0, 1, At, B1); PG8_BAR; PG8_SCHED;
            PG8_LDA(At, 0, 1); PG8_STAGE(PG8_SB(0, 0), b2, voffB); PG8_STAGE(PG8_SB(0, 1), b2 + hstepB, voffB); PG8_STAGE(PG8_SA(0, 0), a2, voffA);
            PG8_WAIT_V(8); PG8_WAIT_L(0); PG8_BAR; PG8_MMA(1, 0, At, B0); PG8_MMA(1, 1, At, B1); PG8_BAR; PG8_SCHED;
            PG8_LDB(B0, 1, 0); PG8_LDB(B1, 1, 1); PG8_SCHED; PG8_LDA(At, 1, 0); PG8_STAGE(PG8_SA(0, 1), a2 + hstepA, voffA);
            PG8_WAIT_V(8); PG8_WAIT_L(0); PG8_BAR; PG8_MMA(0, 0, At, B0); PG8_MMA(0, 1, At, B1); PG8_BAR; PG8_SCHED;
            PG8_LDA(At, 1, 1); PG8_STAGE(PG8_SB(1, 0), b3, voffB); PG8_STAGE(PG8_SB(1, 1), b3 + hstepB, voffB); PG8_STAGE(PG8_SA(1, 0), a3, voffA);
            PG8_WAIT_V(8); PG8_WAIT_L(0); PG8_BAR; PG8_MMA(1, 0, At, B0); PG8_MMA(1, 1, At, B1); PG8_BAR; PG8_SCHED;
        }
        if constexpr (ALIGN_EPI) { if (wr == 0) PG8_BAR; }
        bool keep = false;
        if constexpr (Epi::KEEPS) keep = E.merge(acc, cur, wr, wc, fr, fq); else E(acc, cur, wr, wc, fr, fq);
        if (!has_next) break;
        if (!keep)
#pragma unroll
        for (int a = 0; a < 2; ++a)
#pragma unroll
            for (int b = 0; b < 2; ++b)
#pragma unroll
                for (int m = 0; m < 4; ++m)
#pragma unroll
                    for (int n = 0; n < 2; ++n) acc[a][b][m][n] = (f32x4){0.f, 0.f, 0.f, 0.f};
        cur = nxt; cA = nA; cB = nB; ++ui;
        if constexpr (ALIGN_EPI) { if (wr == 1) PG8_BAR; }
    }
    PG8_WAIT_V(0);
    if constexpr (!ALIGN_EPI) { if (wr == 0) PG8_BAR; }
    PG8_BAR;
#undef PG8_SA
#undef PG8_SB
#undef PG8_STAGE
#undef PG8_LDA
#undef PG8_LDB
#undef PG8_MMA
#undef PG8_WAIT_V
#undef PG8_WAIT_L
#undef PG8_BAR
#undef PG8_SCHED
}
}

#define XB_TMO      128
#define XB_XCNT(j)  (256  + 64 * (j))
#define XB_XSUB(j)  (1280 + 64 * (j))
#define XB_XGEN(j)  (2304 + 64 * (j))
#define XB_TOP      3328
#define XB_TOPGEN   3392
#define XCD_BAR_WORDS 3456
#define XB_SPIN_CAP (1u << 23)
__device__ __forceinline__ unsigned xb_ld(unsigned* p)              { return __hip_atomic_load(p, __ATOMIC_RELAXED, __HIP_MEMORY_SCOPE_AGENT); }
__device__ __forceinline__ unsigned xb_add(unsigned* p, unsigned v) { return __hip_atomic_fetch_add(p, v, __ATOMIC_RELAXED, __HIP_MEMORY_SCOPE_AGENT); }
__device__ __forceinline__ unsigned xb_xcc_id() { return (unsigned)__builtin_amdgcn_s_getreg((3 << 11) | 20) & 0xFu; }
#define XB_SPIN(cond, bar) do { unsigned _sp = 0; while (cond) { __builtin_amdgcn_s_sleep(1); \
    if ((++_sp & 255u) == 0u) { if (xb_ld(&(bar)[XB_TMO])) break; if (_sp > XB_SPIN_CAP) { atomicAdd(&(bar)[XB_TMO], 1u); break; } } } } while (0)
struct XcdBarrier { unsigned* bar; unsigned x; volatile LAS unsigned* st; };
__device__ __forceinline__ XcdBarrier xcd_barrier_post(unsigned* bar, volatile LAS unsigned* st) {
    XcdBarrier b; b.bar = bar; b.x = xb_xcc_id(); b.st = st;
    if (threadIdx.x == 0) (void)xb_add(&bar[XB_XCNT(b.x)], 1u);
    return b;
}
__device__ __forceinline__ void xcd_barrier_complete(unsigned* bar, unsigned x, unsigned& nloc, unsigned& nx) {
    const unsigned G = gridDim.x * gridDim.y * gridDim.z;
    unsigned sum, cnt, mine, sp = 0u;
    for (;;) {
        sum = 0u; cnt = 0u; mine = 0u;
#pragma unroll
        for (unsigned j = 0; j < 16; ++j) { const unsigned c = xb_ld(&bar[XB_XCNT(j)]); sum += c; cnt += (c > 0u) ? 1u : 0u; mine = (j == x) ? c : mine; }
        if (sum == G) break;
        __builtin_amdgcn_s_sleep(1);
        if ((++sp & 255u) == 0u) { if (xb_ld(&bar[XB_TMO])) break; if (sp > XB_SPIN_CAP) { atomicAdd(&bar[XB_TMO], 1u); break; } }
    }
    nloc = mine > 0u ? mine : 1u; nx = cnt > 0u ? cnt : 1u;
}
__device__ __forceinline__ void xcd_barrier(const XcdBarrier& b) {
    asm volatile("s_waitcnt vmcnt(0)" ::: "memory");
    __syncthreads();
    if (threadIdx.x == 0) {
        unsigned* bar = b.bar;
        asm volatile("" : "+s"(bar));
        __builtin_amdgcn_s_waitcnt(0);
        unsigned nloc = b.st[0], nx = b.st[1];
        const unsigned bxcc = xb_xcc_id();
        if (nloc == 0u) { xcd_barrier_complete(bar, bxcc, nloc, nx); b.st[0] = nloc; b.st[1] = nx; }
        const unsigned old = xb_add(&bar[XB_XSUB(bxcc)], 1u);
        const unsigned gen = old / nloc;
        if (old + 1u == (gen + 1u) * nloc) {
            __builtin_amdgcn_fence(__ATOMIC_RELEASE, "agent");
            asm volatile("s_waitcnt vmcnt(0)" ::: "memory");
            const unsigned og = xb_add(&bar[XB_TOP], 1u);
            const unsigned tg = og / nx;
            if (og + 1u == (tg + 1u) * nx) xb_add(&bar[XB_TOPGEN], 1u);
            else XB_SPIN(xb_ld(&bar[XB_TOPGEN]) == tg, bar);
            __builtin_amdgcn_fence(__ATOMIC_ACQUIRE, "agent");
            xb_add(&bar[XB_XGEN(bxcc)], 1u);
            asm volatile("s_waitcnt vmcnt(0)" ::: "memory");
        } else {
            XB_SPIN(xb_ld(&bar[XB_XGEN(bxcc)]) == gen, bar);
            __builtin_amdgcn_fence(__ATOMIC_ACQUIRE, "agent");
            asm volatile("s_waitcnt vmcnt(0)" ::: "memory");
        }
    }
    __syncthreads();
}

struct Args { const float* in[27]; float* out; unsigned char* ws; };
enum { I_X = 0, I_MEM, I_NMIX, I_NMEM, I_NMLP, I_WIN, I_BGATE, I_GMVG, I_GMWS, I_GMBS, I_CONVW, I_CONVB, I_WR, I_BR, I_WI, I_BI, I_LAM, I_SQG, I_SKG, I_SINK, I_WKV, I_XQG, I_XKG, I_WBR, I_WOUT, I_WFF1, I_WFF2 };
struct Ctx {
    const float* const* in; float* x;
    bf16_t *wt_in, *wt_br, *wt_out, *wt_ff1, *wt_ff2, *wt_kv, *memn, *memkv, *xb, *za, *zg, *mb, *o;
    float *ssq, *carryA, *carryH, *S, *ly, *lp;
    bf16_t *memK, *memVt;
    float* spl;
    float* rope;
    float* ssv;
    bf16_t* wgT;
    unsigned long long *agg, *inc;
};

__device__ __forceinline__ int win_row(int n) {
    if (n < NZA) return n;
    const int ng = n - NZA, b = ng >> 10, d = ng & 1023, q = d >> 6, dc = d & 63;
    return NZA + q * 256 + 128 * (b >> 1) + 32 * (dc >> 4) + 8 * ((dc >> 2) & 3) + 4 * (b & 1) + (dc & 3);
}
template <bool GATEPERM>
__device__ __forceinline__ void transpose_item(const float* W, int N, bf16_t* WT, int ldk, int koff, const float* gain, LAS float* scr, int item, int lane) {
    const int nblk = N / 32, kb = item / nblk, nb = item % nblk, k0 = 64 * kb, n0 = 32 * nb;
    float v[32];
    const float* wp = W + (size_t)(k0 + (lane >> 5)) * N + n0 + (lane & 31);
#pragma unroll
    for (int i = 0; i < 32; ++i) v[i] = wp[(size_t)(2 * i) * N];
    if (gain) {
#pragma unroll
        for (int i = 0; i < 32; ++i) v[i] *= gain[k0 + 2 * i + (lane >> 5)];
    }
#pragma unroll
    for (int i = 0; i < 32; ++i) scr[(2 * i + (lane >> 5)) * 33 + (lane & 31)] = v[i];
    LDS_WAIT(); asm volatile("" ::: "memory");
    const int c = lane & 7;
#pragma unroll
    for (int j = 0; j < 4; ++j) { const int n = (lane >> 3) + 8 * j; const LAS float* s = scr + (8 * c) * 33 + n;
        u32x4 o; o.x = cvt_pk_bf16(s[0 * 33], s[1 * 33]); o.y = cvt_pk_bf16(s[2 * 33], s[3 * 33]); o.z = cvt_pk_bf16(s[4 * 33], s[5 * 33]); o.w = cvt_pk_bf16(s[6 * 33], s[7 * 33]);
        *(u32x4*)(WT + (size_t)(GATEPERM ? win_row(n0 + n) : n0 + n) * ldk + koff + k0 + 8 * c) = o; }
    LDS_WAIT(); asm volatile("" ::: "memory");
}
__device__ __forceinline__ float wave_sum(float v) {
#pragma unroll
    for (int o = 1; o < 64; o <<= 1) v += __shfl_xor(v, o);
    return v;
}
__device__ __forceinline__ void conv_w(const Ctx& C, int which, int l, int item, LAS float* scr, int lane) {
    if (which == 0) transpose_item<true>(C.in[I_WIN] + (size_t)l * D * DIN, DIN, C.wt_in, D, 0, C.in[I_NMIX] + l * D, scr, item, lane);
    else if (which == 1) { const int b = item >> 8; transpose_item<false>(C.in[I_WBR] + (size_t)(l * 4 + b) * 512 * D, D, C.wt_br, 2048, b * 512, nullptr, scr, item & 255, lane); }
    else if (which == 2) transpose_item<false>(C.in[I_WOUT] + (size_t)l * D * D, D, C.wt_out, D, 0, nullptr, scr, item, lane);
    else if (which == 3) transpose_item<false>(C.in[I_WFF1] + (size_t)l * D * FF, FF, C.wt_ff1, D, 0, C.in[I_NMLP] + l * D, scr, item, lane);
    else if (which == 4) transpose_item<false>(C.in[I_WFF2] + (size_t)l * FF * D, D, C.wt_ff2, FF, 0, nullptr, scr, item, lane);
    else transpose_item<false>(C.in[I_WKV] + (size_t)l * D * D, D, C.wt_kv + (size_t)l * D * D, D, 0, C.in[I_NMEM] + l * D, scr, item, lane);
}
constexpr int IT_WIN = 16 * 232, IT_WBR = 1024, IT_WOUT = 512, IT_WFF1 = 2048, IT_WFF2 = 2048, IT_WKV = 512;

#ifndef REP_SWA
#define REP_SWA 1
#endif
#ifndef REP_XA
#define REP_XA 1
#endif
#ifndef REP_GM
#define REP_GM 1
#endif
#ifndef REP_LRU
#define REP_LRU 1
#endif
#ifndef REP_CONV
#define REP_CONV 1
#endif
#ifndef REP_FIX
#define REP_FIX 1
#endif
#ifndef REP_G1
#define REP_G1 1
#endif
#ifndef REP_G2
#define REP_G2 1
#endif
#ifndef REP_G4
#define REP_G4 1
#endif
#ifndef REP_G3
#define REP_G3 1
#endif
#ifndef REP_G5
#define REP_G5 1
#endif
#ifndef REP_MIX
#define REP_MIX 1
#endif
#ifndef REP_BAR
#define REP_BAR 1
#endif
#ifndef USE_MFMA_SWA
#define USE_MFMA_SWA 1
#endif
#ifndef USE_MFMA_XA
#define USE_MFMA_XA 1
#endif
#ifndef USE_MFMA_GM
#define USE_MFMA_GM 1
#endif
#ifndef USE_MFMA_LRU
#define USE_MFMA_LRU 1
#endif
#define ROPE_INV(i) ((i) == 0 ? 1.0f : (i) == 1 ? 0.19392274474868576f : (i) == 2 ? 0.03760603093086393f : (i) == 3 ? 0.007292664737217109f : (i) == 4 ? 0.001414213562373095f : (i) == 5 ? 0.0002742481756762073f : (i) == 6 ? 5.318295896944988e-05f : 1.031338537721246e-05f)
#define ROPE16T(f, tab) do { _Pragma("unroll") for (int _i = 0; _i < 4; ++_i) { const f32x4 _cs = ((const f32x4*)(tab))[_i]; \
    { const float _x1 = (f)[2 * _i], _x2 = (f)[2 * _i + 8]; (f)[2 * _i] = _x1 * _cs[0] - _x2 * _cs[1]; (f)[2 * _i + 8] = _x2 * _cs[0] + _x1 * _cs[1]; } \
    { const float _x1 = (f)[2 * _i + 1], _x2 = (f)[2 * _i + 9]; (f)[2 * _i + 1] = _x1 * _cs[2] - _x2 * _cs[3]; (f)[2 * _i + 9] = _x2 * _cs[2] + _x1 * _cs[3]; } } } while (0)
#define ROPE16(f, pos) do { _Pragma("unroll") for (int _i = 0; _i < 8; ++_i) { float _s, _c; sincosf((pos) * ROPE_INV(_i), &_s, &_c); const float _x1 = (f)[_i], _x2 = (f)[_i + 8]; (f)[_i] = _x1 * _c - _x2 * _s; (f)[_i + 8] = _x2 * _c + _x1 * _s; } } while (0)

__device__ __forceinline__ void swa_item(LAS unsigned char* lds, const Ctx& C, int l, int tile, int h) {
    const int tid = opaque_tid();
    LAS bf16_t* Ks = (LAS bf16_t*)lds;
    LAS bf16_t* Vs = Ks + 256 * 72;
    const int kvh = h >> 2, nb = tile & 63, row0 = tile * 128;
    {
        const int key = tid >> 1, half = tid & 1;
        const bool ok = (nb > 0) || (key >= 128);
        const size_t grow = (size_t)(ok ? row0 - 128 + key : row0);
        const u32x4* kp = (const u32x4*)(C.za + grow * NZA + 2560 + kvh * 64 + half * 32);
        const u32x4* vp = (const u32x4*)(C.za + grow * NZA + 2688 + kvh * 64 + half * 32);
        float kf[32]; float ss = 0.f;
#pragma unroll
        for (int i = 0; i < 4; ++i) { const u32x4 w = kp[i]; UNPACK8(w, kf, 8 * i); }
#pragma unroll
        for (int i = 0; i < 32; ++i) ss += kf[i] * kf[i];
        ss += __shfl_xor(ss, 1);
        const float rs = rsqrtf(ss * (1.f / 64.f) + EPS);
        const float* kg = C.in[I_SKG] + l * 64 + half * 32;
#pragma unroll
        for (int i = 0; i < 32; ++i) kf[i] *= rs * kg[i];
        if (half == 0) { const float pos = (float)(nb * 128 - 128 + key); ROPE16(kf, pos); }
#pragma unroll
        for (int i = 0; i < 4; ++i) { *(LAS u32x4*)(Ks + key * 72 + half * 32 + 8 * i) = PACK8(kf, 8 * i); *(LAS u32x4*)(Vs + key * 72 + half * 32 + 8 * i) = vp[i]; }
    }
    const int q = tid >> 2, sub = tid & 3;
    float qf[16];
    {
        const u32x4* qp = (const u32x4*)(C.za + (size_t)(row0 + q) * NZA + 2048 + h * 64 + sub * 16);
        const u32x4 w0 = qp[0], w1 = qp[1]; UNPACK8(w0, qf, 0); UNPACK8(w1, qf, 8);
        float ss = 0.f;
#pragma unroll
        for (int i = 0; i < 16; ++i) ss += qf[i] * qf[i];
        ss += __shfl_xor(ss, 1); ss += __shfl_xor(ss, 2);
        const float rs = rsqrtf(ss * (1.f / 64.f) + EPS);
        const float* qg = C.in[I_SQG] + l * 64 + sub * 16;
#pragma unroll
        for (int i = 0; i < 16; ++i) qf[i] *= rs * qg[i];
        if (sub == 0) { const float pos = (float)(nb * 128 + q); ROPE16(qf, pos); }
#pragma unroll
        for (int i = 0; i < 16; ++i) qf[i] *= 0.125f;
    }
    __syncthreads();
    const float sink = C.in[I_SINK][l * 8 + h];
    float mx = sink;
    for (int j = 0; j < 128; ++j) {
        const int kj = q + 1 + j; const bool valid = (nb > 0) || (kj >= 128);
        const LAS u32x4* kr = (const LAS u32x4*)(Ks + kj * 72 + sub * 16);
        float kf[16]; const u32x4 w0 = kr[0], w1 = kr[1]; UNPACK8(w0, kf, 0); UNPACK8(w1, kf, 8);
        float s = 0.f;
#pragma unroll
        for (int i = 0; i < 16; ++i) s += qf[i] * kf[i];
        s += __shfl_xor(s, 1); s += __shfl_xor(s, 2);
        if (valid) mx = fmaxf(mx, s);
    }
    float lsum = __expf(sink - mx); float o[16];
#pragma unroll
    for (int i = 0; i < 16; ++i) o[i] = 0.f;
    for (int j = 0; j < 128; ++j) {
        const int kj = q + 1 + j; const bool valid = (nb > 0) || (kj >= 128);
        const LAS u32x4* kr = (const LAS u32x4*)(Ks + kj * 72 + sub * 16);
        float kf[16]; { const u32x4 w0 = kr[0], w1 = kr[1]; UNPACK8(w0, kf, 0); UNPACK8(w1, kf, 8); }
        float s = 0.f;
#pragma unroll
        for (int i = 0; i < 16; ++i) s += qf[i] * kf[i];
        s += __shfl_xor(s, 1); s += __shfl_xor(s, 2);
        const float p = valid ? __expf(s - mx) : 0.f;
        lsum += p;
        const LAS u32x4* vr = (const LAS u32x4*)(Vs + kj * 72 + sub * 16);
        float vf[16]; { const u32x4 w0 = vr[0], w1 = vr[1]; UNPACK8(w0, vf, 0); UNPACK8(w1, vf, 8); }
#pragma unroll
        for (int i = 0; i < 16; ++i) o[i] += p * vf[i];
    }
    const float inv = 1.f / lsum;
#pragma unroll
    for (int i = 0; i < 16; ++i) o[i] *= inv;
    u32x4* op = (u32x4*)(C.o + (size_t)(row0 + q) * NO + 1024 + h * 64 + sub * 16);
    op[0] = PACK8(o, 0); op[1] = PACK8(o, 8);
    __syncthreads();
}

__device__ __forceinline__ void xa_item(LAS unsigned char* lds, const Ctx& C, int l, int tile, int h) {
    const int tid = opaque_tid();
    LAS bf16_t* Ks = (LAS bf16_t*)lds;
    LAS bf16_t* Vs = Ks + 256 * 136;
    const int b = tile >> 6, row0 = tile * 128;
    {
        const int key = tid >> 1, half = tid & 1;
        const bf16_t* src = C.memkv + ((size_t)(l * 512 + b * 256 + key)) * 1024 + h * 128 + half * 64;
        const u32x4* kp = (const u32x4*)src; const u32x4* vp = (const u32x4*)(src + 512);
        float kf[64]; float ss = 0.f;
#pragma unroll
        for (int i = 0; i < 8; ++i) { const u32x4 w = kp[i]; UNPACK8(w, kf, 8 * i); }
#pragma unroll
        for (int i = 0; i < 64; ++i) ss += kf[i] * kf[i];
        ss += __shfl_xor(ss, 1);
        const float rs = rsqrtf(ss * (1.f / 128.f) + EPS);
        const float* kg = C.in[I_XKG] + l * 128 + half * 64;
#pragma unroll
        for (int i = 0; i < 64; ++i) kf[i] *= rs * kg[i];
#pragma unroll
        for (int i = 0; i < 8; ++i) { *(LAS u32x4*)(Ks + key * 136 + half * 64 + 8 * i) = PACK8(kf, 8 * i); *(LAS u32x4*)(Vs + key * 136 + half * 64 + 8 * i) = vp[i]; }
    }
    const int q = tid >> 2, sub = tid & 3;
    float qf[32];
    {
        const u32x4* qp = (const u32x4*)(C.za + (size_t)(row0 + q) * NZA + 2816 + h * 128 + sub * 32);
#pragma unroll
        for (int i = 0; i < 4; ++i) { const u32x4 w = qp[i]; UNPACK8(w, qf, 8 * i); }
        float ss = 0.f;
#pragma unroll
        for (int i = 0; i < 32; ++i) ss += qf[i] * qf[i];
        ss += __shfl_xor(ss, 1); ss += __shfl_xor(ss, 2);
        const float rs = rsqrtf(ss * (1.f / 128.f) + EPS) * 0.08838834764831845f;
        const float* qg = C.in[I_XQG] + l * 128 + sub * 32;
#pragma unroll
        for (int i = 0; i < 32; ++i) qf[i] *= rs * qg[i];
    }
    __syncthreads();
    float mx = -3.0e38f;
    for (int key = 0; key < 256; ++key) {
        const LAS u32x4* kr = (const LAS u32x4*)(Ks + key * 136 + sub * 32);
        float s = 0.f;
#pragma unroll
        for (int c = 0; c < 4; ++c) { float kf[8]; const u32x4 w = kr[c]; UNPACK8(w, kf, 0);
#pragma unroll
            for (int i = 0; i < 8; ++i) s += qf[8 * c + i] * kf[i]; }
        s += __shfl_xor(s, 1); s += __shfl_xor(s, 2);
        mx = fmaxf(mx, s);
    }
    float lsum = 0.f; float o[32];
#pragma unroll
    for (int i = 0; i < 32; ++i) o[i] = 0.f;
    for (int key = 0; key < 256; ++key) {
        const LAS u32x4* kr = (const LAS u32x4*)(Ks + key * 136 + sub * 32);
        float s = 0.f;
#pragma unroll
        for (int c = 0; c < 4; ++c) { float kf[8]; const u32x4 w = kr[c]; UNPACK8(w, kf, 0);
#pragma unroll
            for (int i = 0; i < 8; ++i) s += qf[8 * c + i] * kf[i]; }
        s += __shfl_xor(s, 1); s += __shfl_xor(s, 2);
        const float p = __expf(s - mx);
        lsum += p;
        const LAS u32x4* vr = (const LAS u32x4*)(Vs + key * 136 + sub * 32);
#pragma unroll
        for (int c = 0; c < 4; ++c) { float vf[8]; const u32x4 w = vr[c]; UNPACK8(w, vf, 0);
#pragma unroll
            for (int i = 0; i < 8; ++i) o[8 * c + i] += p * vf[i]; }
    }
    const float inv = 1.f / lsum;
#pragma unroll
    for (int i = 0; i < 32; ++i) o[i] *= inv;
    u32x4* op = (u32x4*)(C.o + (size_t)(row0 + q) * NO + 1536 + h * 128 + sub * 32);
#pragma unroll
    for (int c = 0; c < 4; ++c) op[c] = PACK8(o, 8 * c);
    __syncthreads();
}

__device__ __forceinline__ void gm_item(LAS unsigned char* lds, const Ctx& C, int l, int tile, int g) {
    const int tid = opaque_tid();
    LAS float* vn = (LAS float*)lds;
    LAS float* Wl = vn + 128 * 128;
    LAS float* rsv = Wl + 128 * 128;
    const int row0 = tile * 128;
    {
        const int tok = tid >> 2, sub = tid & 3;
        const u32x4* vp = (const u32x4*)(C.za + (size_t)(row0 + tok) * NZA + 512 + sub * 128);
        float ss = 0.f;
#pragma unroll
        for (int i = 0; i < 16; ++i) { float f[8]; const u32x4 w = vp[i]; UNPACK8(w, f, 0);
#pragma unroll
            for (int e = 0; e < 8; ++e) ss += f[e] * f[e]; }
        ss += __shfl_xor(ss, 1); ss += __shfl_xor(ss, 2);
        if (sub == 0) rsv[tok] = rsqrtf(ss * (1.f / 512.f) + EPS);
        const f32x4* wp = (const f32x4*)(C.in[I_GMWS] + (size_t)(l * 4 + g) * 128 * 128);
#pragma unroll
        for (int i = 0; i < 8; ++i) *(LAS f32x4*)(Wl + (i * 512 + tid) * 4) = wp[i * 512 + tid];
    }
    __syncthreads();
    {
        const int s = tid >> 2, c0 = (tid & 3) * 32;
        const u32x4* vp = (const u32x4*)(C.za + (size_t)(row0 + s) * NZA + 512 + g * 128 + c0);
        const float rs = rsv[s]; const float* vg = C.in[I_GMVG] + l * 512 + g * 128 + c0;
#pragma unroll
        for (int i = 0; i < 4; ++i) { float f[8]; const u32x4 w = vp[i]; UNPACK8(w, f, 0);
#pragma unroll
            for (int e = 0; e < 8; ++e) f[e] *= rs * vg[8 * i + e];
            *(LAS f32x4*)(vn + s * 128 + c0 + 8 * i) = (f32x4){f[0], f[1], f[2], f[3]}; *(LAS f32x4*)(vn + s * 128 + c0 + 8 * i + 4) = (f32x4){f[4], f[5], f[6], f[7]}; }
    }
    __syncthreads();
    {
        const int c = tid & 127, tq = tid >> 7;
        const float* bs = C.in[I_GMBS] + (size_t)(l * 4 + g) * 128;
        for (int k = 0; k < 32; ++k) {
            const int t = tq * 32 + k; float acc = 0.f;
            for (int s = 0; s <= t; ++s) acc += Wl[t * 128 + s] * vn[s * 128 + c];
            const float sval = acc + bs[t];
            const float u = bf2f(C.za[(size_t)(row0 + t) * NZA + g * 128 + c]);
            C.o[(size_t)(row0 + t) * NO + g * 128 + c] = (bf16_t)f2bf(u * sval);
        }
    }
    __syncthreads();
}

__device__ __forceinline__ void lru_item(LAS unsigned char* lds, const Ctx& C, int l, int tile, int hb) {
    const int tid = opaque_tid();
    LAS float* xc = (LAS float*)lds;
    LAS float* wr = xc + 8192;
    LAS float* wi = wr + 4096;
    LAS float* aa = wi + 4096;
    LAS float* bb = aa + 8192;
    const int nb = tile & 63, row0 = tile * 128;
    {
        const int t = tid >> 2, c0 = (tid & 3) * 16, ch = hb * 64 + c0;
        float acc[16];
#pragma unroll
        for (int i = 0; i < 16; ++i) acc[i] = C.in[I_CONVB][l * 512 + ch + i];
#pragma unroll
        for (int k = 0; k < 4; ++k) {
            const int tt = t - 3 + k;
            if (nb * 128 + tt >= 0) {
                const u32x4* xp = (const u32x4*)(C.za + (size_t)(row0 + tt) * NZA + 1024 + ch);
                float f[16]; const u32x4 w0 = xp[0], w1 = xp[1]; UNPACK8(w0, f, 0); UNPACK8(w1, f, 8);
                const float* cw = C.in[I_CONVW] + (size_t)(l * 4 + k) * 512 + ch;
#pragma unroll
                for (int i = 0; i < 16; ++i) acc[i] += cw[i] * f[i];
            }
        }
#pragma unroll
        for (int i = 0; i < 4; ++i) *(LAS f32x4*)(xc + t * 64 + c0 + 4 * i) = (f32x4){acc[4 * i], acc[4 * i + 1], acc[4 * i + 2], acc[4 * i + 3]};
        const f32x4* wrp = (const f32x4*)(C.in[I_WR] + (size_t)(l * 8 + hb) * 4096); const f32x4* wip = (const f32x4*)(C.in[I_WI] + (size_t)(l * 8 + hb) * 4096);
#pragma unroll
        for (int i = 0; i < 2; ++i) { *(LAS f32x4*)(wr + (i * 512 + tid) * 4) = wrp[i * 512 + tid]; *(LAS f32x4*)(wi + (i * 512 + tid) * 4) = wip[i * 512 + tid]; }
    }
    __syncthreads();
    const int j = tid & 63, tg = tid >> 6, chj = hb * 64 + j;
    {
        const float br = C.in[I_BR][l * 512 + chj], bi = C.in[I_BI][l * 512 + chj];
        const float lam = C.in[I_LAM][l * 512 + chj];
        const float sp = log1pf(expf(-lam));
        for (int k = 0; k < 16; ++k) {
            const int t = tg * 16 + k; float r = br, ig = bi;
            for (int i = 0; i < 64; ++i) { const float xv = xc[t * 64 + i]; r += xv * wr[i * 64 + j]; ig += xv * wi[i * 64 + j]; }
            r = sigmoid_f(r); ig = sigmoid_f(ig);
            const float loga = -8.f * r * sp; const float a = expf(loga); const float mult = sqrtf(-expm1f(2.f * loga));
            aa[t * 64 + j] = a; bb[t * 64 + j] = xc[t * 64 + j] * ig * mult;
        }
    }
    __syncthreads();
    if (tid < 64) {
        float hh = 0.f, P = 1.f;
        for (int t = 0; t < 128; ++t) { const float a = aa[t * 64 + tid]; hh = a * hh + bb[t * 64 + tid]; P *= a; aa[t * 64 + tid] = P; bb[t * 64 + tid] = hh; }
        C.carryA[(size_t)tile * 512 + hb * 64 + tid] = P; C.carryH[(size_t)tile * 512 + hb * 64 + tid] = hh;
    }
    __syncthreads();
    for (int k = 0; k < 16; ++k) {
        const int t = tg * 16 + k;
        const float G = bf2f(C.za[(size_t)(row0 + t) * NZA + 1536 + chj]);
        C.ly[(size_t)(row0 + t) * 512 + chj] = G * bb[t * 64 + j]; C.lp[(size_t)(row0 + t) * 512 + chj] = G * aa[t * 64 + j];
    }
    __syncthreads();
}

__device__ __forceinline__ int vperm_pos(int key) { const int w = key & 31; return (key & ~31) + ((w >> 2) & 3) * 8 + (w >> 4) * 4 + (w & 3); }
#define MFMA16(X, Y, ACC) __builtin_amdgcn_mfma_f32_16x16x32_bf16((X), (Y), (ACC), 0, 0, 0)
__device__ __forceinline__ bf16x8 pack_bf16x8(const float* f) { u32x4 w; w[0] = cvt_pk_bf16(f[0], f[1]); w[1] = cvt_pk_bf16(f[2], f[3]); w[2] = cvt_pk_bf16(f[4], f[5]); w[3] = cvt_pk_bf16(f[6], f[7]); return __builtin_bit_cast(bf16x8, w); }

__device__ __forceinline__ void kvprep_phase(const Ctx& C, int gw, int NGW, int lane) {
    for (int r = gw; r < 32 * 256; r += NGW) {
        const int combo = r >> 8, key = r & 255, l = combo >> 3, b = (combo >> 2) & 1, h = combo & 3;
        const unsigned w = *(const unsigned*)(C.memkv + ((size_t)(l * 512 + b * 256 + key)) * 1024 + h * 128 + 2 * lane);
        float f0 = __uint_as_float(w << 16), f1 = __uint_as_float(w & 0xffff0000u);
        const float ss = wave_sum(f0 * f0 + f1 * f1); const float rs = rsqrtf(ss * (1.f / 128.f) + EPS);
        const float* kg = C.in[I_XKG] + l * 128 + 2 * lane;
        *(unsigned*)(C.memK + (size_t)r * 128 + 2 * lane) = pk2(f0 * rs * kg[0], f1 * rs * kg[1]);
    }
    const int gt = gw * 64 + lane, NGT = NGW * 64;
    for (int t = gt; t < 32 * 32 * 128; t += NGT) {
        const int d = t & 127, pg = (t >> 7) & 31, combo = t >> 12, l = combo >> 3, b = (combo >> 2) & 1, h = combo & 3;
        const int kbase = (pg >> 2) * 32 + (pg & 3) * 4;
        const bf16_t* src = C.memkv + ((size_t)(l * 512 + b * 256)) * 1024 + 512 + h * 128 + d;
        unsigned short v[8];
#pragma unroll
        for (int e = 0; e < 4; ++e) { v[e] = src[(size_t)(kbase + e) * 1024]; v[4 + e] = src[(size_t)(kbase + 16 + e) * 1024]; }
        u32x4 o; o[0] = v[0] | ((unsigned)v[1] << 16); o[1] = v[2] | ((unsigned)v[3] << 16); o[2] = v[4] | ((unsigned)v[5] << 16); o[3] = v[6] | ((unsigned)v[7] << 16);
        *(u32x4*)(C.memVt + ((size_t)combo * 128 + d) * 256 + pg * 8) = o;
    }
}

__device__ __forceinline__ void xa_pair_mfma(LAS unsigned char* lds, const Ctx& C, int l, int pairidx) {
    const int tid = opaque_tid(), lane = tid & 63, w = __builtin_amdgcn_readfirstlane(tid >> 6), fr = lane & 15, fq = lane >> 4;
    LAS bf16_t* Ks = (LAS bf16_t*)lds;
    LAS bf16_t* Vt = Ks + 256 * 144;
    const int idx0 = pairidx * 2, bh = idx0 >> 6, b = bh >> 2, h = bh & 3, nb0 = idx0 & 63;
    u32x4 qr[2][4];
#pragma unroll
    for (int tt = 0; tt < 2; ++tt) { const bf16_t* qp = C.za + (size_t)((b * 64 + nb0 + tt) * 128 + w * 16 + fr) * NZA + 2816 + h * 128 + 8 * fq;
#pragma unroll
        for (int ks = 0; ks < 4; ++ks) qr[tt][ks] = *(const u32x4*)(qp + 32 * ks); }
    {
        const u32x4* ksrc = (const u32x4*)(C.memK + ((size_t)(l * 8 + bh)) * 256 * 128);
        const u32x4* vsrc = (const u32x4*)(C.memVt + ((size_t)(l * 8 + bh)) * 128 * 256);
#pragma unroll
        for (int i = 0; i < 8; ++i) { const int ch = i * 512 + tid;
            *(LAS u32x4*)(Ks + (ch >> 4) * 144 + (ch & 15) * 8) = ksrc[ch];
            *(LAS u32x4*)(Vt + (ch >> 5) * 272 + (ch & 31) * 8) = vsrc[ch]; }
    }
    __syncthreads();
    const float* qg = C.in[I_XQG] + l * 128;
#pragma unroll
    for (int tt = 0; tt < 2; ++tt) {
        const size_t row = (size_t)((b * 64 + nb0 + tt) * 128 + w * 16 + fr);
        bf16x8 qf[4];
        {
            float f[32];
#pragma unroll
            for (int ks = 0; ks < 4; ++ks) { const u32x4 wv = qr[tt][ks]; UNPACK8(wv, f, 8 * ks); }
            float ss = 0.f;
#pragma unroll
            for (int i = 0; i < 32; ++i) ss += f[i] * f[i];
            ss += __shfl_xor(ss, 16); ss += __shfl_xor(ss, 32);
            const float rs = rsqrtf(ss * (1.f / 128.f) + EPS) * (0.08838834764831845f * 1.4426950408889634f);
#pragma unroll
            for (int ks = 0; ks < 4; ++ks) {
#pragma unroll
                for (int i = 0; i < 8; ++i) f[8 * ks + i] *= rs * qg[32 * ks + 8 * fq + i];
                qf[ks] = pack_bf16x8(f + 8 * ks); }
        }
        f32x4 acc[16];
#pragma unroll
        for (int kb = 0; kb < 16; ++kb) { acc[kb] = (f32x4){0.f, 0.f, 0.f, 0.f};
#pragma unroll
            for (int ks = 0; ks < 4; ++ks) { const bf16x8 kf = *(const LAS bf16x8*)(Ks + (kb * 16 + fr) * 144 + 32 * ks + 8 * fq); acc[kb] = MFMA16(kf, qf[ks], acc[kb]); } }
        float mx = -3.0e38f;
#pragma unroll
        for (int kb = 0; kb < 16; ++kb) mx = fmaxf(fmaxf(fmaxf(acc[kb][0], acc[kb][1]), fmaxf(acc[kb][2], acc[kb][3])), mx);
        mx = fmaxf(mx, __shfl_xor(mx, 16)); mx = fmaxf(mx, __shfl_xor(mx, 32));
        float lsum = 0.f;
#pragma unroll
        for (int kb = 0; kb < 16; ++kb)
#pragma unroll
            for (int e = 0; e < 4; ++e) { const float pv = __builtin_amdgcn_exp2f(acc[kb][e] - mx); acc[kb][e] = pv; lsum += pv; }
        lsum += __shfl_xor(lsum, 16); lsum += __shfl_xor(lsum, 32);
        const float inv = 1.f / lsum;
        bf16x8 pf[8];
#pragma unroll
        for (int j = 0; j < 8; ++j) { u32x4 wv; wv[0] = cvt_pk_bf16(acc[2 * j][0], acc[2 * j][1]); wv[1] = cvt_pk_bf16(acc[2 * j][2], acc[2 * j][3]); wv[2] = cvt_pk_bf16(acc[2 * j + 1][0], acc[2 * j + 1][1]); wv[3] = cvt_pk_bf16(acc[2 * j + 1][2], acc[2 * j + 1][3]); pf[j] = __builtin_bit_cast(bf16x8, wv); }
        bf16_t* op = C.o + row * NO + 1536 + h * 128 + 4 * fq;
#pragma unroll
        for (int db = 0; db < 8; ++db) {
            f32x4 o = (f32x4){0.f, 0.f, 0.f, 0.f};
#pragma unroll
            for (int j = 0; j < 8; ++j) { const bf16x8 vf = *(const LAS bf16x8*)(Vt + (db * 16 + fr) * 272 + 32 * j + 8 * fq); o = MFMA16(vf, pf[j], o); }
            *(u32x2*)(op + db * 16) = (u32x2){cvt_pk_bf16(o[0] * inv, o[1] * inv), cvt_pk_bf16(o[2] * inv, o[3] * inv)};
        }
    }
    __syncthreads();
}

__device__ __forceinline__ void swa_item_mfma(LAS unsigned char* lds, const Ctx& C, int l, int tile, int kvh) {
    const int tid = opaque_tid(), lane = tid & 63, w = __builtin_amdgcn_readfirstlane(tid >> 6), fr = lane & 15, fq = lane >> 4;
    LAS bf16_t* Ks = (LAS bf16_t*)lds;
    LAS bf16_t* Vt = Ks + 256 * 80;
    const int nb = tile & 63, row0 = tile * 128;
    const bf16_t* qbase = C.za + (size_t)(row0 + 16 * w + fr) * NZA + 2048 + kvh * 256 + 8 * fq;
    u32x4 qn0 = *(const u32x4*)qbase, qn1 = *(const u32x4*)(qbase + 32);
    {
        const int key = tid >> 1, half = tid & 1;
        const bool ok = (nb > 0) || (key >= 128);
        const size_t grow = (size_t)(ok ? row0 - 128 + key : row0);
        const u32x4* kp = (const u32x4*)(C.za + grow * NZA + 2560 + kvh * 64 + half * 32);
        const u32x4* vp = (const u32x4*)(C.za + grow * NZA + 2688 + kvh * 64 + half * 32);
        float kf[32]; float ss = 0.f;
#pragma unroll
        for (int i = 0; i < 4; ++i) { const u32x4 wv = kp[i]; UNPACK8(wv, kf, 8 * i); }
#pragma unroll
        for (int i = 0; i < 32; ++i) ss += kf[i] * kf[i];
        ss += __shfl_xor(ss, 1);
        const float rs = rsqrtf(ss * (1.f / 64.f) + EPS);
        const float* kg = C.in[I_SKG] + l * 64 + half * 32;
#pragma unroll
        for (int i = 0; i < 32; ++i) kf[i] *= rs * kg[i];
        if (half == 0) { const int posi = ok ? nb * 128 - 128 + key : 0; ROPE16T(kf, C.rope + (size_t)posi * 16); }
#pragma unroll
        for (int i = 0; i < 4; ++i) *(LAS u32x4*)(Ks + key * 80 + half * 32 + 8 * i) = PACK8(kf, 8 * i);
        const int pp = vperm_pos(key);
#pragma unroll
        for (int i = 0; i < 4; ++i) { u32x4 wv = vp[i]; if (!ok) wv = (u32x4){0u, 0u, 0u, 0u};
#pragma unroll
            for (int e = 0; e < 4; ++e) { Vt[(half * 32 + 8 * i + 2 * e) * 272 + pp] = (bf16_t)(wv[e] & 0xffffu); Vt[(half * 32 + 8 * i + 2 * e + 1) * 272 + pp] = (bf16_t)(wv[e] >> 16); } }
    }
    __syncthreads();
    const int i0 = 16 * w, ws2 = w & ~1, qi = i0 + fr;
    float rc[8], rsn[8];
    { const f32x4* tp = (const f32x4*)(C.rope + (size_t)(nb * 128 + qi) * 16);
#pragma unroll
      for (int i = 0; i < 4; ++i) { const f32x4 cs = tp[i]; rc[2 * i] = cs[0]; rsn[2 * i] = cs[1]; rc[2 * i + 1] = cs[2]; rsn[2 * i + 1] = cs[3]; } }
    const size_t row = (size_t)(row0 + qi);
    float gq[16];
    { const float* qg = C.in[I_SQG] + l * 64 + 8 * fq;
#pragma unroll
      for (int i = 0; i < 8; ++i) { gq[i] = qg[i] * (0.125f * 1.4426950408889634f); gq[8 + i] = qg[32 + i] * (0.125f * 1.4426950408889634f); } }
    for (int hh = 0; hh < 4; ++hh) {
        const int h = kvh * 4 + hh;
        bf16x8 qf[2];
        {
            float f[16];
            { const u32x4 w0 = qn0, w1 = qn1; UNPACK8(w0, f, 0); UNPACK8(w1, f, 8); }
            if (hh < 3) { qn0 = *(const u32x4*)(qbase + 64 * (hh + 1)); qn1 = *(const u32x4*)(qbase + 64 * (hh + 1) + 32); }
            float ss = 0.f;
#pragma unroll
            for (int i = 0; i < 16; ++i) ss += f[i] * f[i];
            ss += __shfl_xor(ss, 16); ss += __shfl_xor(ss, 32);
            const float rs = rsqrtf(ss * (1.f / 64.f) + EPS);
#pragma unroll
            for (int i = 0; i < 16; ++i) f[i] *= rs * gq[i];
#pragma unroll
            for (int i = 0; i < 8; ++i) { const float other = __shfl_xor(f[i], 16);
                const float r0 = f[i] * rc[i] - other * rsn[i], r1 = f[i] * rc[i] + other * rsn[i];
                f[i] = (fq == 0) ? r0 : (fq == 1) ? r1 : f[i]; }
            qf[0] = pack_bf16x8(f); qf[1] = pack_bf16x8(f + 8);
        }
        f32x4 acc[10];
#pragma unroll
        for (int kk = 0; kk < 10; ++kk) { acc[kk] = (f32x4){0.f, 0.f, 0.f, 0.f};
#pragma unroll
            for (int ks = 0; ks < 2; ++ks) { const bf16x8 kf = *(const LAS bf16x8*)(Ks + ((ws2 + kk) * 16 + fr) * 80 + 32 * ks + 8 * fq); acc[kk] = MFMA16(kf, qf[ks], acc[kk]); } }
        const float sink = C.in[I_SINK][l * 8 + h] * 1.4426950408889634f;
        float mx = sink;
        const int sh = w & 1;
#pragma unroll
        for (int kk = 0; kk < 10; ++kk) {
            const int dlt = kk - sh;
            if (nb > 0 && dlt >= 1 && dlt <= 7) {
#pragma unroll
                for (int e = 0; e < 4; ++e) mx = fmaxf(mx, acc[kk][e]);
            } else {
#pragma unroll
                for (int e = 0; e < 4; ++e) { const int kj = (ws2 + kk) * 16 + 4 * fq + e, dd = kj - qi; const bool valid = (dd >= 1) && (dd <= 128) && ((nb > 0) || (kj >= 128));
                    const float sv = valid ? acc[kk][e] : -INFINITY; acc[kk][e] = sv; mx = fmaxf(mx, sv); }
            }
        }
        mx = fmaxf(mx, __shfl_xor(mx, 16)); mx = fmaxf(mx, __shfl_xor(mx, 32));
        float lsum = 0.f;
#pragma unroll
        for (int kk = 0; kk < 10; ++kk)
#pragma unroll
            for (int e = 0; e < 4; ++e) { const float pv = __builtin_amdgcn_exp2f(acc[kk][e] - mx); acc[kk][e] = pv; lsum += pv; }
        lsum += __shfl_xor(lsum, 16); lsum += __shfl_xor(lsum, 32);
        lsum += __builtin_amdgcn_exp2f(sink - mx);
        const float inv = 1.f / lsum;
        bf16x8 pf[5];
#pragma unroll
        for (int j = 0; j < 5; ++j) { u32x4 wv; wv[0] = cvt_pk_bf16(acc[2 * j][0], acc[2 * j][1]); wv[1] = cvt_pk_bf16(acc[2 * j][2], acc[2 * j][3]); wv[2] = cvt_pk_bf16(acc[2 * j + 1][0], acc[2 * j + 1][1]); wv[3] = cvt_pk_bf16(acc[2 * j + 1][2], acc[2 * j + 1][3]); pf[j] = __builtin_bit_cast(bf16x8, wv); }
        bf16_t* op = C.o + row * NO + 1024 + h * 64 + 4 * fq;
#pragma unroll
        for (int db = 0; db < 4; ++db) {
            f32x4 o = (f32x4){0.f, 0.f, 0.f, 0.f};
#pragma unroll
            for (int j = 0; j < 5; ++j) { const bf16x8 vf = *(const LAS bf16x8*)(Vt + (db * 16 + fr) * 272 + (ws2 + 2 * j) * 16 + 8 * fq); o = MFMA16(vf, pf[j], o); }
            *(u32x2*)(op + db * 16) = (u32x2){cvt_pk_bf16(o[0] * inv, o[1] * inv), cvt_pk_bf16(o[2] * inv, o[3] * inv)};
        }
    }
    __syncthreads();
}

__device__ __forceinline__ void gm_item_mfma(LAS unsigned char* lds, const Ctx& C, int l, int tile, int g) {
    const int tid = opaque_tid(), lane = tid & 63, w = __builtin_amdgcn_readfirstlane(tid >> 6), fr = lane & 15, fq = lane >> 4;
    LAS bf16_t* Wl = (LAS bf16_t*)lds;
    LAS bf16_t* vT = Wl + 128 * 144;
    LAS float* rsv = (LAS float*)(vT + 128 * 144);
    const int row0 = tile * 128;
    {
        if (tid < 128) { const f32x4* pp = (const f32x4*)(C.ssv + (size_t)(row0 + tid) * 8); const f32x4 a = pp[0], b2 = pp[1];
            rsv[tid] = rsqrtf((((a[0] + a[1]) + (a[2] + a[3])) + ((b2[0] + b2[1]) + (b2[2] + b2[3]))) * (1.f / 512.f) + EPS); }
        const int tok = tid >> 2, sub = tid & 3;
        const u32x4* gp = (const u32x4*)(C.za + (size_t)(row0 + tok) * NZA + 512 + g * 128 + sub * 32);
#pragma unroll
        for (int i = 0; i < 4; ++i) { const u32x4 wv = gp[i];
#pragma unroll
            for (int e = 0; e < 4; ++e) { vT[(sub * 32 + 8 * i + 2 * e) * 144 + (tok ^ (16 * sub))] = (bf16_t)(wv[e] & 0xffffu); vT[(sub * 32 + 8 * i + 2 * e + 1) * 144 + (tok ^ (16 * sub))] = (bf16_t)(wv[e] >> 16); } }
    }
    const int t_ = tid >> 2, s0 = (tid & 3) * 32;
    f32x4 wreg[8];
    { const f32x4* wp = (const f32x4*)(C.in[I_GMWS] + ((size_t)(l * 4 + g) * 128 + t_) * 128 + s0);
#pragma unroll
      for (int i = 0; i < 8; ++i) wreg[i] = wp[i]; }
    __syncthreads();
    {
#pragma unroll
        for (int i = 0; i < 4; ++i) { const f32x4 a = wreg[2 * i], b2 = wreg[2 * i + 1]; float f[8] = {a[0], a[1], a[2], a[3], b2[0], b2[1], b2[2], b2[3]};
#pragma unroll
            for (int e = 0; e < 8; ++e) { const int sidx = s0 + 8 * i + e; f[e] = (sidx <= t_) ? f[e] * rsv[sidx] : 0.f; }
            *(LAS u32x4*)(Wl + t_ * 144 + s0 + 8 * i) = PACK8(f, 0); }
    }
    __syncthreads();
    {
        const int nks = (w + 2) >> 1;
        f32x4 acc[8];
#pragma unroll
        for (int cb = 0; cb < 8; ++cb) acc[cb] = (f32x4){0.f, 0.f, 0.f, 0.f};
        for (int ks = 0; ks < nks; ++ks) {
            const bf16x8 wf = *(const LAS bf16x8*)(Wl + (16 * w + fr) * 144 + 32 * ks + 8 * fq);
#pragma unroll
            for (int cb = 0; cb < 8; ++cb) { const bf16x8 vf = *(const LAS bf16x8*)(vT + (cb * 16 + fr) * 144 + ((32 * ks + 8 * fq) ^ (16 * (cb >> 1)))); acc[cb] = MFMA16(vf, wf, acc[cb]); }
        }
        const int t = 16 * w + fr; const size_t r = (size_t)(row0 + t);
        const float bsv = C.in[I_GMBS][(size_t)(l * 4 + g) * 128 + t];
        const float* vg = C.in[I_GMVG] + l * 512 + g * 128 + 4 * fq;
        const bf16_t* up = C.za + r * NZA + g * 128 + 4 * fq; bf16_t* op = C.o + r * NO + g * 128 + 4 * fq;
#pragma unroll
        for (int cb = 0; cb < 8; ++cb) { const f32x4 gn = *(const f32x4*)(vg + cb * 16); const u32x2 uw = *(const u32x2*)(up + cb * 16);
            const float u0 = __uint_as_float(uw[0] << 16), u1 = __uint_as_float(uw[0] & 0xffff0000u), u2 = __uint_as_float(uw[1] << 16), u3 = __uint_as_float(uw[1] & 0xffff0000u);
            *(u32x2*)(op + cb * 16) = (u32x2){cvt_pk_bf16(u0 * (gn[0] * acc[cb][0] + bsv), u1 * (gn[1] * acc[cb][1] + bsv)), cvt_pk_bf16(u2 * (gn[2] * acc[cb][2] + bsv), u3 * (gn[3] * acc[cb][3] + bsv))}; }
    }
    __syncthreads();
}

__device__ __forceinline__ void lru_item_mfma(LAS unsigned char* lds, const Ctx& C, int l, int tile, int hb) {
    const int tid = opaque_tid(), lane = tid & 63, w = __builtin_amdgcn_readfirstlane(tid >> 6), fr = lane & 15, fq = lane >> 4;
    LAS bf16_t* xcb = (LAS bf16_t*)lds;
    LAS bf16_t* wrT = xcb + 128 * 80;
    LAS bf16_t* wiT = wrT + 64 * 80;
    LAS float* xcf = (LAS float*)(lds + 40960);
    LAS float* aa = xcf + 8192;
    LAS float* bb = aa + 8192;
    LAS float* segA = bb + 8192;
    LAS float* segH = segA + 512;
    const int nb = tile & 63, row0 = tile * 128;
    {
        const int t = tid >> 2, c0 = (tid & 3) * 16, ch = hb * 64 + c0;
        float acc[16];
#pragma unroll
        for (int i = 0; i < 16; ++i) acc[i] = C.in[I_CONVB][l * 512 + ch + i];
#pragma unroll
        for (int k = 0; k < 4; ++k) {
            const int tt = t - 3 + k;
            if (nb * 128 + tt >= 0) {
                const u32x4* xp = (const u32x4*)(C.za + (size_t)(row0 + tt) * NZA + 1024 + ch);
                float f[16]; const u32x4 w0 = xp[0], w1 = xp[1]; UNPACK8(w0, f, 0); UNPACK8(w1, f, 8);
                const float* cw = C.in[I_CONVW] + (size_t)(l * 4 + k) * 512 + ch;
#pragma unroll
                for (int i = 0; i < 16; ++i) acc[i] += cw[i] * f[i];
            }
        }
#pragma unroll
        for (int i = 0; i < 4; ++i) *(LAS f32x4*)(xcf + t * 64 + c0 + 4 * i) = (f32x4){acc[4 * i], acc[4 * i + 1], acc[4 * i + 2], acc[4 * i + 3]};
        *(LAS u32x4*)(xcb + t * 80 + c0) = PACK8(acc, 0); *(LAS u32x4*)(xcb + t * 80 + c0 + 8) = PACK8(acc, 8);
        const u32x4* wsrc = (const u32x4*)(C.wgT + (size_t)(l * 8 + hb) * 2 * 4096);
#pragma unroll
        for (int i = 0; i < 2; ++i) { const int c = i * 512 + tid; *(LAS u32x4*)(wrT + (c >> 3) * 80 + (c & 7) * 8) = wsrc[c]; }
    }
    __syncthreads();
    {
        bf16x8 xf[2];
#pragma unroll
        for (int ks = 0; ks < 2; ++ks) xf[ks] = *(const LAS bf16x8*)(xcb + (16 * w + fr) * 80 + 32 * ks + 8 * fq);
#pragma unroll
        for (int jb = 0; jb < 4; ++jb) {
            f32x4 ar = (f32x4){0.f, 0.f, 0.f, 0.f}, ai = (f32x4){0.f, 0.f, 0.f, 0.f};
#pragma unroll
            for (int ks = 0; ks < 2; ++ks) { const bf16x8 wf = *(const LAS bf16x8*)(wrT + (jb * 16 + fr) * 80 + 32 * ks + 8 * fq); ar = MFMA16(xf[ks], wf, ar);
                const bf16x8 wf2 = *(const LAS bf16x8*)(wiT + (jb * 16 + fr) * 80 + 32 * ks + 8 * fq); ai = MFMA16(xf[ks], wf2, ai); }
            const int j = jb * 16 + fr, chj = l * 512 + hb * 64 + j;
            const float br = C.in[I_BR][chj], bi = C.in[I_BI][chj], sp8 = (-8.f * 1.4426950408889634f) * C.spl[chj];
#pragma unroll
            for (int e = 0; e < 4; ++e) { const int t = 16 * w + 4 * fq + e;
                const float r = sigmoid_f(ar[e] + br), ig = sigmoid_f(ai[e] + bi);
                const float a = __builtin_amdgcn_exp2f(r * sp8); const float mult = __builtin_amdgcn_sqrtf(fmaxf(1.f - a * a, 0.f));
                aa[t * 64 + j] = a; bb[t * 64 + j] = xcf[t * 64 + j] * ig * mult; }
        }
    }
    __syncthreads();
    const int j = tid & 63, sg = tid >> 6;
    float av[16], bv[16], Gv[16];
    {
#pragma unroll
        for (int k = 0; k < 16; ++k) { av[k] = aa[(sg * 16 + k) * 64 + j]; bv[k] = bb[(sg * 16 + k) * 64 + j]; }
#pragma unroll
        for (int k = 0; k < 16; ++k) Gv[k] = bf2f(C.za[(size_t)(row0 + sg * 16 + k) * NZA + 1536 + hb * 64 + j]);
        float hh = 0.f, P = 1.f;
#pragma unroll
        for (int k = 0; k < 16; ++k) { hh = av[k] * hh + bv[k]; P *= av[k]; av[k] = P; bv[k] = hh; }
        segA[sg * 64 + j] = P; segH[sg * 64 + j] = hh;
    }
    __syncthreads();
    LAS float* cin = segH + 512;
    float Hc = 0.f, Pc = 1.f;
    for (int s2 = 0; s2 < sg; ++s2) { const float a = segA[s2 * 64 + j]; Hc = a * Hc + segH[s2 * 64 + j]; Pc *= a; }
    const int chj = hb * 64 + j, bt = tile >> 6;
    const size_t wbase = (size_t)l * 128 * 512 + chj;
    if (sg == 7) {
        const float At = Pc * segA[7 * 64 + j], Hl = segA[7 * 64 + j] * Hc + segH[7 * 64 + j];
        __hip_atomic_store(C.agg + wbase + (size_t)tile * 512, ((unsigned long long)__float_as_uint(Hl) << 32) | (unsigned long long)(__float_as_uint(At) | 1u), __ATOMIC_RELAXED, __HIP_MEMORY_SCOPE_AGENT);
    }
    if (sg == 0) {
        const int r0 = nb & ~15;
        unsigned long long wv[16]; unsigned spins = 0;
        for (;;) {
            bool ok = true;
#pragma unroll
            for (int i = 0; i < 16; ++i) {
                const int n = r0 - 1 + i; const bool need = (i == 0) ? (r0 > 0) : (n < nb);
                const unsigned long long* pw = (i == 0 ? C.inc : C.agg) + wbase + (size_t)(bt * 64 + (need ? n : 0)) * 512;
                wv[i] = need ? __hip_atomic_load(pw, __ATOMIC_RELAXED, __HIP_MEMORY_SCOPE_AGENT) : 1ull;
                ok = ok && (wv[i] != 0ull);
            }
            if (ok || ++spins > (1u << 20)) break;
            __builtin_amdgcn_s_sleep(2);
        }
        float Hin = (r0 > 0) ? __uint_as_float((unsigned)(wv[0] >> 32)) : 0.f;
#pragma unroll
        for (int i = 1; i < 16; ++i) if (r0 - 1 + i < nb) Hin = __uint_as_float((unsigned)wv[i]) * Hin + __uint_as_float((unsigned)(wv[i] >> 32));
        cin[j] = Hin;
    }
    __syncthreads();
    {
        const float Hs = Hc + Pc * cin[j];
        float hl = 0.f;
#pragma unroll
        for (int k = 0; k < 16; ++k) { const int t = sg * 16 + k; hl = bv[k] + av[k] * Hs;
            C.o[(size_t)(row0 + t) * NO + 512 + chj] = (bf16_t)(cvt_pk_bf16(Gv[k] * hl, 0.f) & 0xffffu); }
        if (sg == 7) __hip_atomic_store(C.inc + wbase + (size_t)tile * 512, ((unsigned long long)__float_as_uint(hl) << 32) | 1ull, __ATOMIC_RELAXED, __HIP_MEMORY_SCOPE_AGENT);
    }
    __syncthreads();
}

__device__ __forceinline__ void fix_item(const Ctx& C, int tile, int half) {
    const int c = opaque_tid(), b = tile >> 6, nb = tile & 63, row0 = tile * 128 + half * 64;
    float H = 0.f;
    for (int jn = 0; jn < nb; ++jn) { const size_t idx = (size_t)(b * 64 + jn) * 512 + c; H = C.carryA[idx] * H + C.carryH[idx]; }
    for (int t = 0; t < 64; ++t) { const size_t r = (size_t)(row0 + t); C.o[r * NO + 512 + c] = (bf16_t)f2bf(C.ly[r * 512 + c] + C.lp[r * 512 + c] * H); }
}

#ifndef PROBE_KIND
#define PROBE_KIND -1
#endif
#ifndef PROBE_MULT
#define PROBE_MULT 4
#endif
#if PROBE_KIND >= 0
#define BAR(kind) do { const unsigned long long _tb = __builtin_amdgcn_s_memrealtime(); xcd_barrier(bar); const unsigned long long _te = __builtin_amdgcn_s_memrealtime(); \
    if (PROBE_KIND == 7 || (PROBE_KIND == 15 && (kind) == 2)) tacc += _te - _tb; else if ((kind) == PROBE_KIND) tacc += _te - tprev; tprev = _te; } while (0)
#define TS(kind) do { if (PROBE_KIND >= 10) { const unsigned long long _te = __builtin_amdgcn_s_memrealtime(); if ((kind) == PROBE_KIND) tacc += _te - tprev; tprev = _te; } } while (0)
#else
#define BAR(kind) xcd_barrier(bar)
#define TS(kind) do { } while (0)
#endif
__global__ void __launch_bounds__(512, 2) fwd_megakernel(Args args) {
    extern __shared__ __attribute__((aligned(16))) unsigned char lds_raw[];
    LAS unsigned char* lds = (LAS unsigned char*)lds_raw;
    volatile LAS unsigned* MISC = (volatile LAS unsigned*)(lds + MISC_OFF);
    const int tid = threadIdx.x, lane = tid & 63, wave = __builtin_amdgcn_readfirstlane(tid >> 6);
    const int G = gridDim.x, bx = blockIdx.x;
    unsigned char* ws = args.ws;
    Ctx C;
    C.in = args.in; C.x = args.out;
    C.wt_in = (bf16_t*)(ws + WS_WIN); C.wt_br = (bf16_t*)(ws + WS_WBR); C.wt_out = (bf16_t*)(ws + WS_WOUT); C.wt_ff1 = (bf16_t*)(ws + WS_WFF1); C.wt_ff2 = (bf16_t*)(ws + WS_WFF2); C.wt_kv = (bf16_t*)(ws + WS_WKV);
    C.memn = (bf16_t*)(ws + WS_MEMN); C.memkv = (bf16_t*)(ws + WS_MEMKV); C.xb = (bf16_t*)(ws + WS_XB); C.za = (bf16_t*)(ws + WS_ZA); C.zg = (bf16_t*)(ws + WS_ZG); C.mb = (bf16_t*)(ws + WS_MB); C.o = (bf16_t*)(ws + WS_O);
    C.ssq = (float*)(ws + WS_SSQ); C.carryA = (float*)(ws + WS_CARRY); C.carryH = C.carryA + 128 * 512; C.S = (float*)(ws + WS_S); C.ly = (float*)(ws + WS_LY); C.lp = (float*)(ws + WS_LP); C.memK = (bf16_t*)(ws + WS_MEMK); C.memVt = (bf16_t*)(ws + WS_MEMVT); C.spl = (float*)(ws + WS_SPL); C.rope = (float*)(ws + WS_ROPE); C.ssv = (float*)(ws + WS_SSV); C.wgT = (bf16_t*)(ws + WS_WGT); C.agg = (unsigned long long*)(ws + WS_AGG); C.inc = (unsigned long long*)(ws + WS_INC);

    if (tid < 64) MISC[tid] = 0u;
    __syncthreads();
    XcdBarrier bar = xcd_barrier_post((unsigned*)(ws + WS_CTL), MISC + 8);
    const int gw = bx * 8 + wave, NGW = G * 8;
    LAS float* scr = (LAS float*)(lds + wave * 16384);
#if PROBE_KIND >= 0
    unsigned long long tacc = 0ull, tprev = __builtin_amdgcn_s_memrealtime();
#endif

    for (int it = gw; it < IT_WIN + 4 * IT_WKV; it += NGW) {
        if (it < IT_WIN) conv_w(C, 0, 0, it, scr, lane);
        else { const int r = it - IT_WIN; conv_w(C, 5, r / IT_WKV, r % IT_WKV, scr, lane); }
    }
    for (int m = gw; m < M + 512; m += NGW) {
        if (m < M) {
            const f32x4* xr = (const f32x4*)(C.in[I_X] + (size_t)m * D) + lane; f32x4 v[4]; float s = 0.f;
#pragma unroll
            for (int jj = 0; jj < 4; ++jj) { v[jj] = xr[64 * jj]; s += (v[jj].x * v[jj].x + v[jj].y * v[jj].y) + (v[jj].z * v[jj].z + v[jj].w * v[jj].w); }
            s = wave_sum(s);
            u32x2* bo = (u32x2*)(C.xb + (size_t)m * D) + lane;
#pragma unroll
            for (int jj = 0; jj < 4; ++jj) bo[64 * jj] = (u32x2){pk2(v[jj].x, v[jj].y), pk2(v[jj].z, v[jj].w)};
            if (lane < 16) C.ssq[(size_t)m * 16 + lane] = (lane == 0) ? s : 0.f;
        } else {
            const int r = m - M;
            const f32x4* xr = (const f32x4*)(C.in[I_MEM] + (size_t)r * D) + lane; f32x4 v[4]; float s = 0.f;
#pragma unroll
            for (int jj = 0; jj < 4; ++jj) { v[jj] = xr[64 * jj]; s += (v[jj].x * v[jj].x + v[jj].y * v[jj].y) + (v[jj].z * v[jj].z + v[jj].w * v[jj].w); }
            s = wave_sum(s); const float rs = rsqrtf(s * (1.f / 1024.f) + EPS);
            u32x2* bo = (u32x2*)(C.memn + (size_t)r * D) + lane;
#pragma unroll
            for (int jj = 0; jj < 4; ++jj) bo[64 * jj] = (u32x2){pk2(v[jj].x * rs, v[jj].y * rs), pk2(v[jj].z * rs, v[jj].w * rs)};
        }
    }
    { const int gt = bx * 512 + tid; if (gt < DEPTH * 512) C.spl[gt] = log1pf(expf(-C.in[I_LAM][gt])); }
    for (int c = bx * 512 + tid; c < DEPTH * 8 * 2 * 64 * 8; c += G * 512) {
        const int c8 = c & 7, jj = (c >> 3) & 63, gt2 = (c >> 9) & 1, lh = c >> 10;
        const float* src = C.in[gt2 ? I_WI : I_WR] + (size_t)lh * 4096 + (size_t)(c8 * 8) * 64 + jj;
        float f[8];
#pragma unroll
        for (int e = 0; e < 8; ++e) f[e] = src[e * 64];
        *(u32x4*)(C.wgT + (size_t)c * 8) = PACK8(f, 0);
    }
    for (int c = bx * 512 + tid; c < 8192 * 8; c += G * 512) {
        const int i = c & 7; const float inv = ROPE_INV(i); const float ang = (float)(c >> 3) * inv;
        C.rope[2 * c] = cosf(ang); C.rope[2 * c + 1] = sinf(ang);
    }
    { u32x4* zp = (u32x4*)(ws + WS_AGG); for (int i = bx * 512 + tid; i < (int)((WS_SSV - WS_AGG) / 16); i += G * 512) zp[i] = (u32x4){0u, 0u, 0u, 0u}; }
    __syncthreads();
    if (args.ws == nullptr) cg::this_grid().sync();
    BAR(0);

    for (int l = 0; l < DEPTH; ++l) {
        if (l == 0 && bx >= 64 && bx < 96) {
            pg8::Gemm g{C.memn, C.wt_kv}; pg8::SchedKV S{bx - 64}; pg8::EpiKV E{C.memkv};
            pg8::gemm_phase<pg8::EpiKV, pg8::SchedKV, true, D, D, D>(lds, g, S, E);
        }
        {
#ifndef SKIP_G1
            pg8::Gemm g{C.xb, C.wt_in}; pg8::SchedStd S; S.init(M, DIN, G, bx, D, D);
            pg8::EpiZ E{C.za, C.zg, C.ssq, C.in[I_BGATE] + (size_t)l * 4 * D, C.ssv};
            for (int rep = 0; rep < REP_G1; ++rep) pg8::gemm_phase<pg8::EpiZ, pg8::SchedStd, true, D, D, D>(lds, g, S, E);
#endif

        }
        const int cfirst = (l == 0) ? 96 : 64;
        if (G == 256 && bx >= cfirst) {
            const int lane_c = opaque_tid() & 63;
            const int cw = (bx - cfirst) * 8 + wave, NCW = (G - cfirst) * 8;
            for (int it = cw; it < IT_WBR + IT_WOUT + IT_WFF1 + IT_WFF2; it += NCW) {
                int r = it;
                if (r < IT_WBR) { conv_w(C, 1, l, r, scr, lane_c); continue; } r -= IT_WBR;
                if (r < IT_WOUT) { conv_w(C, 2, l, r, scr, lane_c); continue; } r -= IT_WOUT;
                if (r < IT_WFF1) { conv_w(C, 3, l, r, scr, lane_c); continue; } r -= IT_WFF1;
                conv_w(C, 4, l, r, scr, lane_c);
            }
        }
        BAR(1);
        TS(99);
        {
            if (l == 0) { kvprep_phase(C, gw, NGW, opaque_tid() & 63); BAR(2); }
            for (int rmix = 0; rmix < REP_MIX; ++rmix) {
#if USE_MFMA_SWA
            for (int rep = 0; rep < REP_SWA; ++rep) for (int it = bx; it < 256; it += G) swa_item_mfma(lds, C, l, it >> 1, it & 1);
#else
            for (int it = bx; it < 1024; it += G) swa_item(lds, C, l, it >> 3, it & 7);
#endif
            TS(10);
#if USE_MFMA_XA
            for (int rep = 0; rep < REP_XA; ++rep) for (int it = bx; it < 256; it += G) xa_pair_mfma(lds, C, l, it);
#else
            for (int it = bx; it < 512; it += G) xa_item(lds, C, l, it >> 2, it & 3);
#endif
            TS(11);
#if USE_MFMA_GM
            for (int rep = 0; rep < REP_GM; ++rep) for (int it = bx; it < 512; it += G) gm_item_mfma(lds, C, l, it >> 2, it & 3);
#else
            for (int it = bx; it < 512; it += G) gm_item(lds, C, l, it >> 2, it & 3);
#endif
            TS(12);
#if USE_MFMA_LRU
            for (int it = bx; it < 1024; it += G) lru_item_mfma(lds, C, l, ((it >> 3) & 1) * 64 + (it >> 4), it & 7);
#else
            for (int it = bx; it < 1024; it += G) lru_item(lds, C, l, it >> 3, it & 7);
#endif
            TS(13);
            }
            const int lane_c = opaque_tid() & 63;
            const int NC0 = (G == 256) ? 0 : IT_WBR + IT_WOUT + IT_WFF1 + IT_WFF2;
            const int NC = IT_WBR + IT_WOUT + IT_WFF1 + IT_WFF2 + (l + 1 < DEPTH ? IT_WIN : 0);
            for (int rep = 0; rep < REP_CONV; ++rep) for (int it = gw + (IT_WBR + IT_WOUT + IT_WFF1 + IT_WFF2 - NC0); it < NC; it += NGW) {
                int r = it;
                if (r < IT_WBR) { conv_w(C, 1, l, r, scr, lane_c); continue; } r -= IT_WBR;
                if (r < IT_WOUT) { conv_w(C, 2, l, r, scr, lane_c); continue; } r -= IT_WOUT;
                if (r < IT_WFF1) { conv_w(C, 3, l, r, scr, lane_c); continue; } r -= IT_WFF1;
                if (r < IT_WFF2) { conv_w(C, 4, l, r, scr, lane_c); continue; } r -= IT_WFF2;
                conv_w(C, 0, l + 1, r, scr, lane_c);
            }
            __syncthreads();
            TS(14);
        }
        BAR(2);
        {
#ifndef SKIP_G2
            pg8::Gemm g{C.o, C.wt_br}; pg8::SchedMerge S; S.t.init(M, D, G, bx, NO, NO);
            pg8::EpiMerge E{C.zg, C.mb};
            for (int rep = 0; rep < REP_G2; ++rep) pg8::gemm_phase<pg8::EpiMerge, pg8::SchedMerge, false, NO, NO, 512>(lds, g, S, E);
#endif

        }
        BAR(3);
        {
#ifndef SKIP_G3
            pg8::Gemm g{C.mb, C.wt_out}; pg8::SchedStd S; S.init(M, D, G, bx, D, D);
            pg8::EpiRes E{C.xb, C.xb, C.ssq, nullptr};
            pg8::gemm_phase<pg8::EpiRes, pg8::SchedStd, true, D, D, D>(lds, g, S, E);
#endif

        }
        BAR(4);
        {
#ifndef SKIP_G4
            pg8::Gemm g{C.xb, C.wt_ff1}; pg8::SchedStd S; S.init(M, FF, G, bx, D, D);
            pg8::EpiFF1 E{C.zg, C.ssq};
            for (int rep = 0; rep < REP_G4; ++rep) pg8::gemm_phase<pg8::EpiFF1, pg8::SchedStd, true, D, D, D>(lds, g, S, E);
#endif

        }
        BAR(5);
        {
#ifndef SKIP_G5
            pg8::Gemm g{C.zg, C.wt_ff2}; pg8::SchedStd S; S.init(M, D, G, bx, FF, FF);
            pg8::EpiRes E{C.xb, C.xb, C.ssq, (l + 1 == DEPTH) ? C.x : nullptr};
            pg8::gemm_phase<pg8::EpiRes, pg8::SchedStd, true, FF, FF, FF>(lds, g, S, E);
#endif

        }
        if (l + 1 < DEPTH) BAR(6);
    }
#if PROBE_KIND >= 0
    if (PROBE_KIND == 6) tacc += __builtin_amdgcn_s_memrealtime() - tprev;
    if (bx == 0 && tid == 0) { const unsigned long long target = tacc * PROBE_MULT, t0 = __builtin_amdgcn_s_memrealtime(); while (__builtin_amdgcn_s_memrealtime() - t0 < target) __builtin_amdgcn_s_sleep(8); }
#endif
}

extern "C" void kernel_launch(void* const* d_in, const int* in_sizes, int n_in, void* d_out, int out_size, void* d_ws, size_t ws_size, hipStream_t stream) {
    static int grid = 0;
    if (grid == 0) {
        if (n_in != 27 || out_size != M * D || ws_size < WS_END) { fprintf(stderr, "kernel_launch: unexpected shapes: n_in %d out %d ws %zu (need %zu)\n", n_in, out_size, ws_size, (size_t)WS_END); grid = -1; return; }
        int dev = 0, cus = 0, per_cu = 0;
        hipGetDevice(&dev); hipDeviceGetAttribute(&cus, hipDeviceAttributeMultiprocessorCount, dev);
        if (hipFuncSetAttribute((const void*)fwd_megakernel, hipFuncAttributeMaxDynamicSharedMemorySize, LDS_BYTES) != hipSuccess) { fprintf(stderr, "kernel_launch: hipFuncSetAttribute failed\n"); grid = -1; return; }
        if (hipOccupancyMaxActiveBlocksPerMultiprocessor(&per_cu, (const void*)fwd_megakernel, 512, LDS_BYTES) != hipSuccess || per_cu < 1) { fprintf(stderr, "kernel_launch: occupancy query says %d\n", per_cu); per_cu = 1; }
        (void)hipGetLastError();
        grid = cus;
        if (grid != 256) fprintf(stderr, "kernel_launch: note: %d CUs\n", grid);
    }
    if (grid < 0) return;
    hipMemsetAsync((char*)d_ws + WS_CTL, 0, CTL_ZERO_BYTES, stream);
    Args a{};
    for (int i = 0; i < 27; ++i) a.in[i] = (const float*)d_in[i];
    a.out = (float*)d_out; a.ws = (unsigned char*)d_ws;
    void* kargs[] = {&a};
    hipError_t e = hipLaunchCooperativeKernel((const void*)fwd_megakernel, dim3(grid), dim3(512), kargs, LDS_BYTES, stream);
    if (e != hipSuccess) fprintf(stderr, "kernel_launch: cooperative launch failed: %s\n", hipGetErrorString(e));
}
```

```cpp
#include <hip/hip_runtime.h>
#include <hip/hip_cooperative_groups.h>
#include <cstdio>
#include <cstdint>
namespace cg = cooperative_groups;

#define LAS __attribute__((address_space(3)))
#define GAS __attribute__((address_space(1)))
typedef unsigned short bf16_t;
typedef short bf16x8 __attribute__((ext_vector_type(8)));
typedef float f32x4 __attribute__((ext_vector_type(4)));
typedef unsigned u32x4 __attribute__((ext_vector_type(4)));
typedef unsigned u32x2 __attribute__((ext_vector_type(2)));

constexpr int M = 16384, D = 1024, DIN = 7424, NZA = 3328, NZG = 4096, FF = 4096, DEPTH = 4, NO = 2048;
constexpr float EPS = 1e-6f;
constexpr size_t MiB = 1u << 20;
constexpr size_t WS_CTL = 0, CTL_ZERO_BYTES = 64 * 1024;
constexpr size_t WS_WIN = 2 * MiB, WS_WBR = 17 * MiB, WS_WOUT = 21 * MiB, WS_WFF1 = 23 * MiB, WS_WFF2 = 31 * MiB, WS_WKV = 39 * MiB;
constexpr size_t WS_MEMN = 47 * MiB, WS_MEMKV = 48 * MiB, WS_SSQ = 52 * MiB, WS_CARRY = 53 * MiB, WS_XB = 54 * MiB;
constexpr size_t WS_ZA = 86 * MiB, WS_S = 86 * MiB, WS_MB = 150 * MiB, WS_ZG = 190 * MiB, WS_O = 318 * MiB, WS_LY = 382 * MiB, WS_LP = 414 * MiB, WS_MEMK = 446 * MiB, WS_MEMVT = 448 * MiB, WS_SPL = 450 * MiB, WS_AGG = 451 * MiB, WS_INC = 453 * MiB, WS_SSV = 455 * MiB, WS_WGT = 456 * MiB, WS_ROPE = 457 * MiB, WS_END = 458 * MiB;
static_assert(WS_ZA + (size_t)M * NZA * 2 <= WS_ZG && WS_MB + (size_t)M * D * 2 <= WS_ZG && WS_WIN + (size_t)DIN * D * 2 <= WS_WBR, "ws map");

constexpr int LDS_BYTES = 147456, MISC_OFF = LDS_BYTES - 256;

__device__ __forceinline__ float bf2f(bf16_t h) { return __uint_as_float((unsigned)h << 16); }
__device__ __forceinline__ unsigned f2bf(float f) { unsigned u = __float_as_uint(f); return (u + 0x7fffu + ((u >> 16) & 1u)) >> 16; }
__device__ __forceinline__ unsigned pk2(float lo, float hi) { return f2bf(lo) | (f2bf(hi) << 16); }
__device__ __forceinline__ unsigned cvt_pk_bf16(float lo, float hi) { unsigned r; asm volatile("v_cvt_pk_bf16_f32 %0, %1, %2" : "=v"(r) : "v"(lo), "v"(hi)); return r; }
#define UNPACK8(VV, f, o) do { (f)[(o) + 0] = __uint_as_float((VV)[0] << 16); (f)[(o) + 1] = __uint_as_float((VV)[0] & 0xffff0000u); (f)[(o) + 2] = __uint_as_float((VV)[1] << 16); (f)[(o) + 3] = __uint_as_float((VV)[1] & 0xffff0000u); \
    (f)[(o) + 4] = __uint_as_float((VV)[2] << 16); (f)[(o) + 5] = __uint_as_float((VV)[2] & 0xffff0000u); (f)[(o) + 6] = __uint_as_float((VV)[3] << 16); (f)[(o) + 7] = __uint_as_float((VV)[3] & 0xffff0000u); } while (0)
#define PACK8(f, o) ((u32x4){cvt_pk_bf16((f)[(o) + 0], (f)[(o) + 1]), cvt_pk_bf16((f)[(o) + 2], (f)[(o) + 3]), cvt_pk_bf16((f)[(o) + 4], (f)[(o) + 5]), cvt_pk_bf16((f)[(o) + 6], (f)[(o) + 7])})
__device__ __forceinline__ float gelu_t(float x) {
    const float c1 = -2.f * 0.7978845608028654f * 1.4426950408889634f, c2 = c1 * 0.044715f;
    return x * __builtin_amdgcn_rcpf(1.f + __builtin_amdgcn_exp2f(x * (c1 + c2 * (x * x)))); }
__device__ __forceinline__ float sigmoid_f(float x) { return __builtin_amdgcn_rcpf(1.f + __expf(-x)); }
__device__ __forceinline__ float row_rstd(const float* ssq, int row) {
    const f32x4* p = (const f32x4*)(ssq + (size_t)row * 16);
    const f32x4 a = p[0], b = p[1], c = p[2], d = p[3];
    const float s = (((a.x + a.y) + (a.z + a.w)) + ((b.x + b.y) + (b.z + b.w))) + (((c.x + c.y) + (c.z + c.w)) + ((d.x + d.y) + (d.z + d.w)));
    return rsqrtf(s * (1.f / 1024.f) + EPS);
}
__device__ __forceinline__ float row_rstd_coop(const float* ssq, int row, int fq) {
    const f32x4 a = *(const f32x4*)(ssq + (size_t)row * 16 + fq * 4);
    float s = (a.x + a.y) + (a.z + a.w);
    s += __shfl_xor(s, 16); s += __shfl_xor(s, 32);
    return rsqrtf(s * (1.f / 1024.f) + EPS);
}
#define LDS_WAIT() asm volatile("s_waitcnt lgkmcnt(0)" ::: "memory")
__device__ __forceinline__ int opaque_tid() { int t = threadIdx.x; asm volatile("" : "+v"(t)); return t; }

namespace pg8 {
constexpr int BM = 256, BK = 64, HALF = 128, HTB = HALF * BK * 2, STAGE_BYTES = 8 * HTB, NXCD = 8, WGM = 8;
__host__ __device__ __forceinline__ int lds_byte(int r, int c) { const int st = (r >> 4) * 2 + (c >> 5), rr = r & 15, cc = c & 31, ob = rr * 64 + cc * 2; return st * 1024 + (ob ^ (((ob >> 9) & 1) << 5)); }
__host__ __device__ __forceinline__ void stage_rc(int b, int& R, int& C) { const int st = b / 1024, sb = b % 1024, swz = sb ^ (((sb >> 9) & 1) << 5); R = (st >> 1) * 16 + swz / 64; C = (st & 1) * 32 + (swz % 64) / 2; }
__host__ __device__ __forceinline__ int perm32(int rho) { const int n = rho >> 4, i = rho & 15; return 8 * (i >> 2) + 4 * n + (i & 3); }

struct Unit { int pm, pn, b; };
struct Gemm { const bf16_t* A; const bf16_t* Bt; };

struct SchedStd {
    int nM, nN, nwg, G, c; size_t as, bs;
    __device__ void init(int M_, int N_, int G_, int c_, int lda, int ldb) { nM = M_ / BM; nN = N_ / BM; nwg = nM * nN; G = G_; c = c_; as = (size_t)BM * lda * 2; bs = (size_t)BM * ldb * 2; }
    __device__ bool tile(long L, Unit& u) const {
        if (L >= nwg) return false;
        int wgid = (int)L; { const int q = nwg / NXCD, r = nwg % NXCD, xcd = wgid % NXCD, off = wgid / NXCD; wgid = (xcd < r ? xcd * (q + 1) : r * (q + 1) + (xcd - r) * q) + off; }
        const int nig = WGM * nN, gid = wgid / nig, fm = gid * WGM, gsz = (nM - fm) < WGM ? (nM - fm) : WGM;
        u.pm = fm + ((wgid % nig) % gsz); u.pn = (wgid % nig) / gsz; u.b = 0; return true;
    }
    __device__ bool next(int i, Unit& u) const { return tile((long)i * G + c, u); }
    __device__ size_t aoff(const Unit& u) const { return (size_t)u.pm * as; }
    __device__ size_t boff(const Unit& u) const { return (size_t)u.pn * bs; }
};
struct SchedMerge {
    SchedStd t;
    __device__ bool next(int i, Unit& u) const { if (!t.tile((long)(i >> 2) * t.G + t.c, u)) return false; u.b = i & 3; return true; }
    __device__ size_t aoff(const Unit& u) const { return (size_t)u.pm * t.as + (size_t)u.b * 1024; }
    __device__ size_t boff(const Unit& u) const { return (size_t)u.pn * t.bs + (size_t)u.b * 1024; }
};
struct SchedKV {
    int c;
    __device__ bool next(int i, Unit& u) const { if (i > 0 || c >= 32) return false; u.b = c >> 3; u.pm = (c & 7) >> 2; u.pn = c & 3; return true; }
    __device__ size_t aoff(const Unit& u) const { return (size_t)u.pm * 256 * 1024 * 2; }
    __device__ size_t boff(const Unit& u) const { return ((size_t)u.b * 1024 + (size_t)u.pn * 256) * 1024 * 2; }
};

struct EpiZ {
    static constexpr bool PERM = true, KEEPS = false;
    bf16_t* za; bf16_t* zg; const float* ssq; const float* bgate; float* ssv;
    __device__ __forceinline__ void operator()(const f32x4 (&acc)[2][2][4][2], const Unit& u, int wr, int wc, int fr, int fq) const {
        const int row0 = u.pm * BM + wr * 64 + fr, pn = u.pn;
        bf16_t* base; int ldc, colt, mode;
        if (pn < 13) { base = za; ldc = NZA; colt = pn * 256; mode = (pn < 4 || pn == 6 || pn == 7) ? 1 : 0; }
        else { base = zg; ldc = NZG; colt = (pn - 13) * 256; mode = 2; }
        const int col0 = colt + wc * 32 + 8 * fq;
        const int d0 = 64 * (pn - 13) + 16 * wc + 4 * fq;
        f32x4 bv[2][2];
#pragma unroll
        for (int bj = 0; bj < 2; ++bj)
#pragma unroll
            for (int n = 0; n < 2; ++n) bv[bj][n] = (mode == 2) ? *(const f32x4*)(bgate + (2 * bj + n) * 1024 + d0) : (f32x4){0.f, 0.f, 0.f, 0.f};
        float rsa[2][4];
#pragma unroll
        for (int ai = 0; ai < 2; ++ai)
#pragma unroll
            for (int m = 0; m < 4; ++m) rsa[ai][m] = row_rstd_coop(ssq, row0 + ai * HALF + m * 16, fq);
        asm volatile("" ::: "memory");
#pragma unroll
        for (int ai = 0; ai < 2; ++ai) {
#pragma unroll
            for (int m = 0; m < 4; ++m) {
                const int row = row0 + ai * HALF + m * 16; const float rs = rsa[ai][m]; float vss = 0.f;
                bf16_t* rowp = base + (size_t)row * ldc + col0;
                if (mode == 2) {
                    f32x4 sden[4];
#pragma unroll
                    for (int b2 = 0; b2 < 4; ++b2) { const f32x4 zv = acc[ai][b2 >> 1][m][b2 & 1] * (rs * -1.4426950408889634f) + bv[b2 >> 1][b2 & 1] * -1.4426950408889634f;
#pragma unroll
                        for (int e = 0; e < 4; ++e) sden[b2][e] = 1.f + __builtin_amdgcn_exp2f(fminf(zv[e], 66.f)); }
#pragma unroll
                    for (int b2 = 0; b2 < 4; ++b2) { f32x4 rv;
#pragma unroll
                        for (int e = 0; e < 4; ++e) { const float ig = __builtin_amdgcn_rcpf(sden[b2][e]); rv[e] = (b2 < 3) ? sden[b2 + 1][e] * ig : ig; }
                        *(u32x2*)(zg + (size_t)row * NZG + b2 * 1024 + d0) = (u32x2){cvt_pk_bf16(rv[0], rv[1]), cvt_pk_bf16(rv[2], rv[3])}; }
                    continue;
                }
#pragma unroll
                for (int bj = 0; bj < 2; ++bj) {
                    f32x4 v0 = acc[ai][bj][m][0] * rs, v1 = acc[ai][bj][m][1] * rs;
                    if (mode == 1) {
#pragma unroll
                        for (int e = 0; e < 4; ++e) { v0[e] = gelu_t(v0[e]); v1[e] = gelu_t(v1[e]); }
                    } else if (mode == 2) {
                        v0 = v0 + bv[bj][0]; v1 = v1 + bv[bj][1];
#pragma unroll
                        for (int e = 0; e < 4; ++e) { v0[e] = sigmoid_f(v0[e]); v1[e] = sigmoid_f(v1[e]); }
                    }
                    u32x4 w; w.x = cvt_pk_bf16(v0[0], v0[1]); w.y = cvt_pk_bf16(v0[2], v0[3]); w.z = cvt_pk_bf16(v1[0], v1[1]); w.w = cvt_pk_bf16(v1[2], v1[3]);
                    *(u32x4*)(rowp + bj * HALF) = w;
                    if (pn == 2 || pn == 3) vss += (v0[0] * v0[0] + v0[1] * v0[1]) + (v0[2] * v0[2] + v0[3] * v0[3]) + (v1[0] * v1[0] + v1[1] * v1[1]) + (v1[2] * v1[2] + v1[3] * v1[3]);
                }
                if (pn == 2 || pn == 3) { vss += __shfl_xor(vss, 16); vss += __shfl_xor(vss, 32); if (fq == 0) ssv[(size_t)row * 8 + (pn - 2) * 4 + wc] = vss; }
            }
            asm volatile("" ::: "memory");
        }
    }
};
struct EpiFF1 {
    static constexpr bool PERM = true, KEEPS = false;
    bf16_t* f; const float* ssq;
    __device__ __forceinline__ void operator()(const f32x4 (&acc)[2][2][4][2], const Unit& u, int wr, int wc, int fr, int fq) const {
        const int row0 = u.pm * BM + wr * 64 + fr, col0 = u.pn * BM + wc * 32 + 8 * fq;
        float rsa[2][4];
#pragma unroll
        for (int ai = 0; ai < 2; ++ai)
#pragma unroll
            for (int m = 0; m < 4; ++m) rsa[ai][m] = row_rstd_coop(ssq, row0 + ai * HALF + m * 16, fq);
        asm volatile("" ::: "memory");
#pragma unroll
        for (int ai = 0; ai < 2; ++ai) {
#pragma unroll
            for (int m = 0; m < 4; ++m) {
                const int row = row0 + ai * HALF + m * 16; const float rs = rsa[ai][m];
                bf16_t* rowp = f + (size_t)row * FF + col0;
#pragma unroll
                for (int bj = 0; bj < 2; ++bj) {
                    f32x4 v0 = acc[ai][bj][m][0] * rs, v1 = acc[ai][bj][m][1] * rs;
#pragma unroll
                    for (int e = 0; e < 4; ++e) { const float a = fmaxf(v0[e], 0.f), b = fmaxf(v1[e], 0.f); v0[e] = a * a; v1[e] = b * b; }
                    u32x4 w; w.x = cvt_pk_bf16(v0[0], v0[1]); w.y = cvt_pk_bf16(v0[2], v0[3]); w.z = cvt_pk_bf16(v1[0], v1[1]); w.w = cvt_pk_bf16(v1[2], v1[3]);
                    *(u32x4*)(rowp + bj * HALF) = w;
                }
            }
            asm volatile("" ::: "memory");
        }
    }
};
struct EpiRes {
    static constexpr bool PERM = true, KEEPS = false;
    const bf16_t* xin; bf16_t* xb; float* ssq; float* xout;
    __device__ __forceinline__ void operator()(const f32x4 (&acc)[2][2][4][2], const Unit& u, int wr, int wc, int fr, int fq) const {
        const int row0 = u.pm * BM + wr * 64 + fr, col0 = u.pn * BM + wc * 32 + 8 * fq;
#pragma unroll
        for (int ai = 0; ai < 2; ++ai) {
            u32x4 xo[4][2];
#pragma unroll
            for (int m = 0; m < 4; ++m)
#pragma unroll
                for (int bj = 0; bj < 2; ++bj) xo[m][bj] = *(const u32x4*)(xin + (size_t)(row0 + ai * HALF + m * 16) * D + col0 + bj * HALF);
            asm volatile("" ::: "memory");
#pragma unroll
            for (int m = 0; m < 4; ++m) {
                const int row = row0 + ai * HALF + m * 16; float ss = 0.f;
#pragma unroll
                for (int bj = 0; bj < 2; ++bj) {
                    float xf[8]; UNPACK8(xo[m][bj], xf, 0);
                    const f32x4 v0 = (f32x4){xf[0], xf[1], xf[2], xf[3]} + acc[ai][bj][m][0], v1 = (f32x4){xf[4], xf[5], xf[6], xf[7]} + acc[ai][bj][m][1];
                    ss += (v0[0] * v0[0] + v0[1] * v0[1]) + (v0[2] * v0[2] + v0[3] * v0[3]) + (v1[0] * v1[0] + v1[1] * v1[1]) + (v1[2] * v1[2] + v1[3] * v1[3]);
                    u32x4 w; w.x = cvt_pk_bf16(v0[0], v0[1]); w.y = cvt_pk_bf16(v0[2], v0[3]); w.z = cvt_pk_bf16(v1[0], v1[1]); w.w = cvt_pk_bf16(v1[2], v1[3]);
                    *(u32x4*)(xb + (size_t)row * D + col0 + bj * HALF) = w;
                    if (xout) { float* xp = xout + (size_t)row * D + col0 + bj * HALF; *(f32x4*)xp = v0; *(f32x4*)(xp + 4) = v1; }
                }
                ss += __shfl_xor(ss, 16); ss += __shfl_xor(ss, 32);
                if (fq == 0) ssq[(size_t)row * 16 + u.pn * 4 + wc] = ss;
            }
            asm volatile("" ::: "memory");
        }
    }
};
struct EpiMerge {
    static constexpr bool PERM = true, KEEPS = true;
    const bf16_t* zg; bf16_t* mb;
    __device__ __forceinline__ bool merge(f32x4 (&acc)[2][2][4][2], const Unit& u, int wr, int wc, int fr, int fq) const {
        const int row0 = u.pm * BM + wr * 64 + fr, col0 = u.pn * BM + wc * 32 + 8 * fq, b = u.b;
        u32x4 ga[2][4][2];
#pragma unroll
        for (int ai = 0; ai < 2; ++ai)
#pragma unroll
            for (int m = 0; m < 4; ++m)
#pragma unroll
                for (int bj = 0; bj < 2; ++bj) ga[ai][m][bj] = *(const u32x4*)(zg + (size_t)(row0 + ai * HALF + m * 16) * NZG + b * 1024 + col0 + bj * HALF);
        asm volatile("" ::: "memory");
#pragma unroll
        for (int ai = 0; ai < 2; ++ai) {
#pragma unroll
            for (int m = 0; m < 4; ++m) {
                const int row = row0 + ai * HALF + m * 16;
#pragma unroll
                for (int bj = 0; bj < 2; ++bj) {
                    const int col = col0 + bj * HALF;
                    float g[8]; UNPACK8(ga[ai][m][bj], g, 0);
#pragma unroll
                    for (int e = 0; e < 4; ++e) { acc[ai][bj][m][0][e] *= g[e]; acc[ai][bj][m][1][e] *= g[4 + e]; }
                    if (b == 3) { const f32x4 v0 = acc[ai][bj][m][0], v1 = acc[ai][bj][m][1];
                        u32x4 w; w.x = cvt_pk_bf16(v0[0], v0[1]); w.y = cvt_pk_bf16(v0[2], v0[3]); w.z = cvt_pk_bf16(v1[0], v1[1]); w.w = cvt_pk_bf16(v1[2], v1[3]);
                        *(u32x4*)(mb + (size_t)row * D + col) = w; }
                }
            }
        }
        asm volatile("" ::: "memory");
        return b < 3;
    }
};
struct EpiKV {
    static constexpr bool PERM = true, KEEPS = false;
    bf16_t* out;
    __device__ __forceinline__ void operator()(const f32x4 (&acc)[2][2][4][2], const Unit& u, int wr, int wc, int fr, int fq) const {
        const int row0 = u.pm * BM + wr * 64 + fr, col0 = u.pn * BM + wc * 32 + 8 * fq;
        bf16_t* base = out + (size_t)u.b * 512 * 1024;
#pragma unroll
        for (int ai = 0; ai < 2; ++ai)
#pragma unroll
            for (int m = 0; m < 4; ++m) {
                const int row = row0 + ai * HALF + m * 16;
#pragma unroll
                for (int bj = 0; bj < 2; ++bj) {
                    const f32x4 v0 = acc[ai][bj][m][0], v1 = acc[ai][bj][m][1];
                    u32x4 w; w.x = cvt_pk_bf16(v0[0], v0[1]); w.y = cvt_pk_bf16(v0[2], v0[3]); w.z = cvt_pk_bf16(v1[0], v1[1]); w.w = cvt_pk_bf16(v1[2], v1[3]);
                    *(u32x4*)(base + (size_t)row * 1024 + col0 + bj * HALF) = w;
                }
            }
    }
};

template <class Epi, class Sched, bool ALIGN_EPI, int LDA, int LDB, int KK>
__device__ __forceinline__ void gemm_phase(LAS unsigned char* lds, const Gemm g, const Sched& S, const Epi& E) {
    const int tid = opaque_tid(), wid = __builtin_amdgcn_readfirstlane(tid >> 6), lane = tid & 63, wr = wid >> 2, wc = wid & 3, fr = lane & 15, fq = lane >> 4;
    constexpr int nt = KK / BK;
    unsigned voffA[2], voffB[2];
#pragma unroll
    for (int i = 0; i < 2; ++i) { int R, C; stage_rc(tid * 16 + i * 8192, R, C); const int Rb = Epi::PERM ? ((R & ~31) + perm32(R & 31)) : R;
        voffA[i] = (unsigned)(R * LDA + C) * 2u; voffB[i] = (unsigned)(Rb * LDB + C) * 2u; }
    constexpr size_t kstep = (size_t)(BK * 2);
    constexpr size_t hstepA = (size_t)HALF * LDA * 2, hstepB = (size_t)HALF * LDB * 2;
    const unsigned ldsw = (unsigned)wid * 1024u;
    const int aoff = lds_byte(wr * 64 + fr, fq * 8), boff = lds_byte(wc * 32 + fr, fq * 8);
#define PG8_SA(b, h) (((b) * 2 + (h)) * HTB)
#define PG8_SB(b, h) ((4 + (b) * 2 + (h)) * HTB)
#define PG8_STAGE(bufoff, gbase, voff) do { _Pragma("unroll") for (int _i = 0; _i < 2; ++_i) \
        __builtin_amdgcn_global_load_lds((const unsigned*)((const char*)(gbase) + (voff)[_i]), (LAS unsigned*)(lds + (bufoff) + ldsw + _i * 8192), 16, 0, 0); } while (0)
#define PG8_LDA(dst, b, h) do { _Pragma("unroll") for (int m = 0; m < 4; ++m) _Pragma("unroll") for (int k = 0; k < 2; ++k) dst[m][k] = *(const LAS bf16x8*)(lds + PG8_SA(b, h) + aoff + m * 2048 + k * 1024); } while (0)
#define PG8_LDB(dst, b, h) do { _Pragma("unroll") for (int n = 0; n < 2; ++n) _Pragma("unroll") for (int k = 0; k < 2; ++k) dst[n][k] = *(const LAS bf16x8*)(lds + PG8_SB(b, h) + boff + n * 2048 + k * 1024); } while (0)
#define PG8_MMA(ai, bj, At, Bt) do { __builtin_amdgcn_s_setprio(1); _Pragma("unroll") for (int m = 0; m < 4; ++m) _Pragma("unroll") for (int n = 0; n < 2; ++n) _Pragma("unroll") for (int k = 0; k < 2; ++k) \
        acc[ai][bj][m][n] = __builtin_amdgcn_mfma_f32_16x16x32_bf16(Bt[n][k], At[m][k], acc[ai][bj][m][n], 0, 0, 0); __builtin_amdgcn_s_setprio(0); } while (0)
#define PG8_WAIT_V(n) asm volatile("s_waitcnt vmcnt(" #n ")" ::: "memory")
#define PG8_WAIT_L(n) asm volatile("s_waitcnt lgkmcnt(" #n ")" ::: "memory")
#define PG8_BAR __builtin_amdgcn_s_barrier()
#define PG8_SCHED __builtin_amdgcn_sched_barrier(0)
    Unit cur, nxt; int ui = 0;
    if (!S.next(0, cur)) return;
    f32x4 acc[2][2][4][2];
#pragma unroll
    for (int a = 0; a < 2; ++a)
#pragma unroll
        for (int b = 0; b < 2; ++b)
#pragma unroll
            for (int m = 0; m < 4; ++m)
#pragma unroll
                for (int n = 0; n < 2; ++n) acc[a][b][m][n] = (f32x4){0.f, 0.f, 0.f, 0.f};
    bf16x8 At[4][2], B0[2][2], B1[2][2];
    const char* gA = (const char*)g.A; const char* gB = (const char*)g.Bt;
    asm volatile("" : "+s"(gA), "+s"(gB));
    const char* cA = gA + S.aoff(cur); const char* cB = gB + S.boff(cur);
    PG8_STAGE(PG8_SB(0, 0), cB, voffB); PG8_STAGE(PG8_SB(0, 1), cB + hstepB, voffB); PG8_STAGE(PG8_SA(0, 0), cA, voffA); PG8_STAGE(PG8_SA(0, 1), cA + hstepA, voffA);
    if (wr == 1) PG8_BAR;
    PG8_WAIT_V(2); PG8_BAR;
    PG8_STAGE(PG8_SB(1, 0), cB + kstep, voffB); PG8_STAGE(PG8_SA(1, 0), cA + kstep, voffA); PG8_STAGE(PG8_SB(1, 1), cB + hstepB + kstep, voffB);
    PG8_WAIT_V(6); PG8_BAR;
    for (;;) {
        const bool has_next = S.next(ui + 1, nxt);
        const char* nA = has_next ? gA + S.aoff(nxt) : cA; const char* nB = has_next ? gB + S.boff(nxt) : cB;
        for (int t = 0; t < nt; t += 2) {
            const bool last = (t == nt - 2);
            const char* a1 = cA + (size_t)(t + 1) * kstep;
            const char* a2 = last ? nA : cA + (size_t)(t + 2) * kstep; const char* b2 = last ? nB : cB + (size_t)(t + 2) * kstep;
            const char* a3 = a2 + kstep; const char* b3 = b2 + kstep;
            PG8_LDB(B0, 0, 0); PG8_LDB(B1, 0, 1); PG8_SCHED; PG8_LDA(At, 0, 0); PG8_STAGE(PG8_SA(1, 1), a1 + hstepA, voffA);
            PG8_WAIT_V(8); PG8_WAIT_L(0); PG8_BAR; PG8_MMA(0, 0, At, B0); PG8_MMA(0, 1, At, B1); PG8_BAR; PG8_SCHED;
            PG8_LDA(At, 0, 1); PG8_STAGE(PG8_SB(0, 0), b2, voffB); PG8_STAGE(PG8_SB(0, 1), b2 + hstepB, voffB); PG8_STAGE(PG8_SA(0, 0), a2, voffA);
            PG8_WAIT_V(8); PG8_WAIT_L(0); PG8_BAR; PG8_MMA(1, 0, At, B0); PG8_MMA(1, 1, At, B1); PG8_BAR; PG8_SCHED;
            PG8_LDB(B0, 1, 0); PG8_LDB(B1, 1, 1); PG8_SCHED; PG8_LDA(At, 1, 0); PG8_STAGE(PG8_SA(0, 1), a2 + hstepA, voffA);
            PG8_WAIT_V(8); PG8_WAIT_L(0); PG8_BAR; PG8_MMA(0, 0, At, B0); PG8_MMA(0, 1, At, B1); PG8_BAR; PG8_SCHED;
            PG8_LDA(At, 1, 1); PG8_STAGE(PG8_SB(1, 0), b3, voffB); PG8_STAGE(PG8_SB(1, 1), b3 + hstepB, voffB); PG8_STAGE(PG8_SA(1, 0), a3, voffA);
            PG8_WAIT_V(8); PG8_WAIT_L(0); PG8_BAR; PG8_MMA(1, 0, At, B0); PG8_MMA(1, 1, At, B1); PG8_BAR; PG8_SCHED;
        }
        if constexpr (ALIGN_EPI) { if (wr == 0) PG8_BAR; }
        bool keep = false;
        if constexpr (Epi::KEEPS) keep = E.merge(acc, cur, wr, wc, fr, fq); else E(acc, cur, wr, wc, fr, fq);
        if (!has_next) break;
        if (!keep)
#pragma unroll
        for (int a = 0; a < 2; ++a)
#pragma unroll
            for (int b = 0; b < 2; ++b)
#pragma unroll
                for (int m = 0; m < 4; ++m)
#pragma unroll
                    for (int n = 0; n < 2; ++n) acc[a][b][m][n] = (f32x4){0.f, 0.f, 0.f, 0.f};
        cur = nxt; cA = nA; cB = nB; ++ui;
        if constexpr (ALIGN_EPI) { if (wr == 1) PG8_BAR; }
    }
    PG8_WAIT_V(0);
    if constexpr (!ALIGN_EPI) { if (wr == 0) PG8_BAR; }
    PG8_BAR;
#undef PG8_SA
#undef PG8_SB
#undef PG8_STAGE
#undef PG8_LDA
#undef PG8_LDB
#undef PG8_MMA
#undef PG8_WAIT_V
#undef PG8_WAIT_L
#undef PG8_BAR
#undef PG8_SCHED
}
}

#define XB_TMO      128
#define XB_XCNT(j)  (256  + 64 * (j))
#define XB_XSUB(j)  (1280 + 64 * (j))
#define XB_XGEN(j)  (2304 + 64 * (j))
#define XB_TOP      3328
#define XB_TOPGEN   3392
#define XCD_BAR_WORDS 3456
#define XB_SPIN_CAP (1u << 23)
__device__ __forceinline__ unsigned xb_ld(unsigned* p)              { return __hip_atomic_load(p, __ATOMIC_RELAXED, __HIP_MEMORY_SCOPE_AGENT); }
__device__ __forceinline__ unsigned xb_add(unsigned* p, unsigned v) { return __hip_atomic_fetch_add(p, v, __ATOMIC_RELAXED, __HIP_MEMORY_SCOPE_AGENT); }
__device__ __forceinline__ unsigned xb_xcc_id() { return (unsigned)__builtin_amdgcn_s_getreg((3 << 11) | 20) & 0xFu; }
#define XB_SPIN(cond, bar) do { unsigned _sp = 0; while (cond) { __builtin_amdgcn_s_sleep(1); \
    if ((++_sp & 255u) == 0u) { if (xb_ld(&(bar)[XB_TMO])) break; if (_sp > XB_SPIN_CAP) { atomicAdd(&(bar)[XB_TMO], 1u); break; } } } } while (0)
struct XcdBarrier { unsigned* bar; unsigned x; volatile LAS unsigned* st; };
__device__ __forceinline__ XcdBarrier xcd_barrier_post(unsigned* bar, volatile LAS unsigned* st) {
    XcdBarrier b; b.bar = bar; b.x = xb_xcc_id(); b.st = st;
    if (threadIdx.x == 0) (void)xb_add(&bar[XB_XCNT(b.x)], 1u);
    return b;
}
__device__ __forceinline__ void xcd_barrier_complete(unsigned* bar, unsigned x, unsigned& nloc, unsigned& nx) {
    const unsigned G = gridDim.x * gridDim.y * gridDim.z;
    unsigned sum, cnt, mine, sp = 0u;
    for (;;) {
        sum = 0u; cnt = 0u; mine = 0u;
#pragma unroll
        for (unsigned j = 0; j < 16; ++j) { const unsigned c = xb_ld(&bar[XB_XCNT(j)]); sum += c; cnt += (c > 0u) ? 1u : 0u; mine = (j == x) ? c : mine; }
        if (sum == G) break;
        __builtin_amdgcn_s_sleep(1);
        if ((++sp & 255u) == 0u) { if (xb_ld(&bar[XB_TMO])) break; if (sp > XB_SPIN_CAP) { atomicAdd(&bar[XB_TMO], 1u); break; } }
    }
    nloc = mine > 0u ? mine : 1u; nx = cnt > 0u ? cnt : 1u;
}
__device__ __forceinline__ void xcd_barrier(const XcdBarrier& b) {
    asm volatile("s_waitcnt vmcnt(0)" ::: "memory");
    __syncthreads();
    if (threadIdx.x == 0) {
        unsigned* bar = b.bar;
        asm volatile("" : "+s"(bar));
        __builtin_amdgcn_s_waitcnt(0);
        unsigned nloc = b.st[0], nx = b.st[1];
        const unsigned bxcc = xb_xcc_id();
        if (nloc == 0u) { xcd_barrier_complete(bar, bxcc, nloc, nx); b.st[0] = nloc; b.st[1] = nx; }
        const unsigned old = xb_add(&bar[XB_XSUB(bxcc)], 1u);
        const unsigned gen = old / nloc;
        if (old + 1u == (gen + 1u) * nloc) {
            __builtin_amdgcn_fence(__ATOMIC_RELEASE, "agent");
            asm volatile("s_waitcnt vmcnt(0)" ::: "memory");
            const unsigned og = xb_add(&bar[XB_TOP], 1u);
            const unsigned tg = og / nx;
            if (og + 1u == (tg + 1u) * nx) xb_add(&bar[XB_TOPGEN], 1u);
            else XB_SPIN(xb_ld(&bar[XB_TOPGEN]) == tg, bar);
            __builtin_amdgcn_fence(__ATOMIC_ACQUIRE, "agent");
            xb_add(&bar[XB_XGEN(bxcc)], 1u);
            asm volatile("s_waitcnt vmcnt(0)" ::: "memory");
        } else {
            XB_SPIN(xb_ld(&bar[XB_XGEN(bxcc)]) == gen, bar);
            __builtin_amdgcn_fence(__ATOMIC_ACQUIRE, "agent");
            asm volatile("s_waitcnt vmcnt(0)" ::: "memory");
        }
    }
    __syncthreads();
}

struct Args { const float* in[27]; float* out; unsigned char* ws; };
enum { I_X = 0, I_MEM, I_NMIX, I_NMEM, I_NMLP, I_WIN, I_BGATE, I_GMVG, I_GMWS, I_GMBS, I_CONVW, I_CONVB, I_WR, I_BR, I_WI, I_BI, I_LAM, I_SQG, I_SKG, I_SINK, I_WKV, I_XQG, I_XKG, I_WBR, I_WOUT, I_WFF1, I_WFF2 };
struct Ctx {
    const float* const* in; float* x;
    bf16_t *wt_in, *wt_br, *wt_out, *wt_ff1, *wt_ff2, *wt_kv, *memn, *memkv, *xb, *za, *zg, *mb, *o;
    float *ssq, *carryA, *carryH, *S, *ly, *lp;
    bf16_t *memK, *memVt;
    float* spl;
    float* rope;
    float* ssv;
    bf16_t* wgT;
    unsigned long long *agg, *inc;
};

__device__ __forceinline__ int win_row(int n) {
    if (n < NZA) return n;
    const int ng = n - NZA, b = ng >> 10, d = ng & 1023, q = d >> 6, dc = d & 63;
    return NZA + q * 256 + 128 * (b >> 1) + 32 * (dc >> 4) + 8 * ((dc >> 2) & 3) + 4 * (b & 1) + (dc & 3);
}
template <bool GATEPERM>
__device__ __forceinline__ void transpose_item(const float* W, int N, bf16_t* WT, int ldk, int koff, const float* gain, LAS float* scr, int item, int lane) {
    const int nblk = N / 32, kb = item / nblk, nb = item % nblk, k0 = 64 * kb, n0 = 32 * nb;
    float v[32];
    const float* wp = W + (size_t)(k0 + (lane >> 5)) * N + n0 + (lane & 31);
#pragma unroll
    for (int i = 0; i < 32; ++i) v[i] = wp[(size_t)(2 * i) * N];
    if (gain) {
#pragma unroll
        for (int i = 0; i < 32; ++i) v[i] *= gain[k0 + 2 * i + (lane >> 5)];
    }
#pragma unroll
    for (int i = 0; i < 32; ++i) scr[(2 * i + (lane >> 5)) * 33 + (lane & 31)] = v[i];
    LDS_WAIT(); asm volatile("" ::: "memory");
    const int c = lane & 7;
#pragma unroll
    for (int j = 0; j < 4; ++j) { const int n = (lane >> 3) + 8 * j; const LAS float* s = scr + (8 * c) * 33 + n;
        u32x4 o; o.x = cvt_pk_bf16(s[0 * 33], s[1 * 33]); o.y = cvt_pk_bf16(s[2 * 33], s[3 * 33]); o.z = cvt_pk_bf16(s[4 * 33], s[5 * 33]); o.w = cvt_pk_bf16(s[6 * 33], s[7 * 33]);
        *(u32x4*)(WT + (size_t)(GATEPERM ? win_row(n0 + n) : n0 + n) * ldk + koff + k0 + 8 * c) = o; }
    LDS_WAIT(); asm volatile("" ::: "memory");
}
__device__ __forceinline__ float wave_sum(float v) {
#pragma unroll
    for (int o = 1; o < 64; o <<= 1) v += __shfl_xor(v, o);
    return v;
}
__device__ __forceinline__ void conv_w(const Ctx& C, int which, int l, int item, LAS float* scr, int lane) {
    if (which == 0) transpose_item<true>(C.in[I_WIN] + (size_t)l * D * DIN, DIN, C.wt_in, D, 0, C.in[I_NMIX] + l * D, scr, item, lane);
    else if (which == 1) { const int b = item >> 8; transpose_item<false>(C.in[I_WBR] + (size_t)(l * 4 + b) * 512 * D, D, C.wt_br, 2048, b * 512, nullptr, scr, item & 255, lane); }
    else if (which == 2) transpose_item<false>(C.in[I_WOUT] + (size_t)l * D * D, D, C.wt_out, D, 0, nullptr, scr, item, lane);
    else if (which == 3) transpose_item<false>(C.in[I_WFF1] + (size_t)l * D * FF, FF, C.wt_ff1, D, 0, C.in[I_NMLP] + l * D, scr, item, lane);
    else if (which == 4) transpose_item<false>(C.in[I_WFF2] + (size_t)l * FF * D, D, C.wt_ff2, FF, 0, nullptr, scr, item, lane);
    else transpose_item<false>(C.in[I_WKV] + (size_t)l * D * D, D, C.wt_kv + (size_t)l * D * D, D, 0, C.in[I_NMEM] + l * D, scr, item, lane);
}
constexpr int IT_WIN = 16 * 232, IT_WBR = 1024, IT_WOUT = 512, IT_WFF1 = 2048, IT_WFF2 = 2048, IT_WKV = 512;

#ifndef REP_SWA
#define REP_SWA 1
#endif
#ifndef REP_XA
#define REP_XA 1
#endif
#ifndef REP_GM
#define REP_GM 1
#endif
#ifndef REP_LRU
#define REP_LRU 1
#endif
#ifndef REP_CONV
#define REP_CONV 1
#endif
#ifndef REP_FIX
#define REP_FIX 1
#endif
#ifndef REP_G1
#define REP_G1 1
#endif
#ifndef REP_G2
#define REP_G2 1
#endif
#ifndef REP_G4
#define REP_G4 1
#endif
#ifndef REP_G3
#define REP_G3 1
#endif
#ifndef REP_G5
#define REP_G5 1
#endif
#ifndef REP_MIX
#define REP_MIX 1
#endif
#ifndef REP_BAR
#define REP_BAR 1
#endif
#ifndef USE_MFMA_SWA
#define USE_MFMA_SWA 1
#endif
#ifndef USE_MFMA_XA
#define USE_MFMA_XA 1
#endif
#ifndef USE_MFMA_GM
#define USE_MFMA_GM 1
#endif
#ifndef USE_MFMA_LRU
#define USE_MFMA_LRU 1
#endif
#define ROPE_INV(i) ((i) == 0 ? 1.0f : (i) == 1 ? 0.19392274474868576f : (i) == 2 ? 0.03760603093086393f : (i) == 3 ? 0.007292664737217109f : (i) == 4 ? 0.001414213562373095f : (i) == 5 ? 0.0002742481756762073f : (i) == 6 ? 5.318295896944988e-05f : 1.031338537721246e-05f)
#define ROPE16T(f, tab) do { _Pragma("unroll") for (int _i = 0; _i < 4; ++_i) { const f32x4 _cs = ((const f32x4*)(tab))[_i]; \
    { const float _x1 = (f)[2 * _i], _x2 = (f)[2 * _i + 8]; (f)[2 * _i] = _x1 * _cs[0] - _x2 * _cs[1]; (f)[2 * _i + 8] = _x2 * _cs[0] + _x1 * _cs[1]; } \
    { const float _x1 = (f)[2 * _i + 1], _x2 = (f)[2 * _i + 9]; (f)[2 * _i + 1] = _x1 * _cs[2] - _x2 * _cs[3]; (f)[2 * _i + 9] = _x2 * _cs[2] + _x1 * _cs[3]; } } } while (0)
#define ROPE16(f, pos) do { _Pragma("unroll") for (int _i = 0; _i < 8; ++_i) { float _s, _c; sincosf((pos) * ROPE_INV(_i), &_s, &_c); const float _x1 = (f)[_i], _x2 = (f)[_i + 8]; (f)[_i] = _x1 * _c - _x2 * _s; (f)[_i + 8] = _x2 * _c + _x1 * _s; } } while (0)

__device__ __forceinline__ void swa_item(LAS unsigned char* lds, const Ctx& C, int l, int tile, int h) {
    const int tid = opaque_tid();
    LAS bf16_t* Ks = (LAS bf16_t*)lds;
    LAS bf16_t* Vs = Ks + 256 * 72;
    const int kvh = h >> 2, nb = tile & 63, row0 = tile * 128;
    {
        const int key = tid >> 1, half = tid & 1;
        const bool ok = (nb > 0) || (key >= 128);
        const size_t grow = (size_t)(ok ? row0 - 128 + key : row0);
        const u32x4* kp = (const u32x4*)(C.za + grow * NZA + 2560 + kvh * 64 + half * 32);
        const u32x4* vp = (const u32x4*)(C.za + grow * NZA + 2688 + kvh * 64 + half * 32);
        float kf[32]; float ss = 0.f;
#pragma unroll
        for (int i = 0; i < 4; ++i) { const u32x4 w = kp[i]; UNPACK8(w, kf, 8 * i); }
#pragma unroll
        for (int i = 0; i < 32; ++i) ss += kf[i] * kf[i];
        ss += __shfl_xor(ss, 1);
        const float rs = rsqrtf(ss * (1.f / 64.f) + EPS);
        const float* kg = C.in[I_SKG] + l * 64 + half * 32;
#pragma unroll
        for (int i = 0; i < 32; ++i) kf[i] *= rs * kg[i];
        if (half == 0) { const float pos = (float)(nb * 128 - 128 + key); ROPE16(kf, pos); }
#pragma unroll
        for (int i = 0; i < 4; ++i) { *(LAS u32x4*)(Ks + key * 72 + half * 32 + 8 * i) = PACK8(kf, 8 * i); *(LAS u32x4*)(Vs + key * 72 + half * 32 + 8 * i) = vp[i]; }
    }
    const int q = tid >> 2, sub = tid & 3;
    float qf[16];
    {
        const u32x4* qp = (const u32x4*)(C.za + (size_t)(row0 + q) * NZA + 2048 + h * 64 + sub * 16);
        const u32x4 w0 = qp[0], w1 = qp[1]; UNPACK8(w0, qf, 0); UNPACK8(w1, qf, 8);
        float ss = 0.f;
#pragma unroll
        for (int i = 0; i < 16; ++i) ss += qf[i] * qf[i];
        ss += __shfl_xor(ss, 1); ss += __shfl_xor(ss, 2);
        const float rs = rsqrtf(ss * (1.f / 64.f) + EPS);
        const float* qg = C.in[I_SQG] + l * 64 + sub * 16;
#pragma unroll
        for (int i = 0; i < 16; ++i) qf[i] *= rs * qg[i];
        if (sub == 0) { const float pos = (float)(nb * 128 + q); ROPE16(qf, pos); }
#pragma unroll
        for (int i = 0; i < 16; ++i) qf[i] *= 0.125f;
    }
    __syncthreads();
    const float sink = C.in[I_SINK][l * 8 + h];
    float mx = sink;
    for (int j = 0; j < 128; ++j) {
        const int kj = q + 1 + j; const bool valid = (nb > 0) || (kj >= 128);
        const LAS u32x4* kr = (const LAS u32x4*)(Ks + kj * 72 + sub * 16);
        float kf[16]; const u32x4 w0 = kr[0], w1 = kr[1]; UNPACK8(w0, kf, 0); UNPACK8(w1, kf, 8);
        float s = 0.f;
#pragma unroll
        for (int i = 0; i < 16; ++i) s += qf[i] * kf[i];
        s += __shfl_xor(s, 1); s += __shfl_xor(s, 2);
        if (valid) mx = fmaxf(mx, s);
    }
    float lsum = __expf(sink - mx); float o[16];
#pragma unroll
    for (int i = 0; i < 16; ++i) o[i] = 0.f;
    for (int j = 0; j < 128; ++j) {
        const int kj = q + 1 + j; const bool valid = (nb > 0) || (kj >= 128);
        const LAS u32x4* kr = (const LAS u32x4*)(Ks + kj * 72 + sub * 16);
        float kf[16]; { const u32x4 w0 = kr[0], w1 = kr[1]; UNPACK8(w0, kf, 0); UNPACK8(w1, kf, 8); }
        float s = 0.f;
#pragma unroll
        for (int i = 0; i < 16; ++i) s += qf[i] * kf[i];
        s += __shfl_xor(s, 1); s += __shfl_xor(s, 2);
        const float p = valid ? __expf(s - mx) : 0.f;
        lsum += p;
        const LAS u32x4* vr = (const LAS u32x4*)(Vs + kj * 72 + sub * 16);
        float vf[16]; { const u32x4 w0 = vr[0], w1 = vr[1]; UNPACK8(w0, vf, 0); UNPACK8(w1, vf, 8); }
#pragma unroll
        for (int i = 0; i < 16; ++i) o[i] += p * vf[i];
    }
    const float inv = 1.f / lsum;
#pragma unroll
    for (int i = 0; i < 16; ++i) o[i] *= inv;
    u32x4* op = (u32x4*)(C.o + (size_t)(row0 + q) * NO + 1024 + h * 64 + sub * 16);
    op[0] = PACK8(o, 0); op[1] = PACK8(o, 8);
    __syncthreads();
}

__device__ __forceinline__ void xa_item(LAS unsigned char* lds, const Ctx& C, int l, int tile, int h) {
    const int tid = opaque_tid();
    LAS bf16_t* Ks = (LAS bf16_t*)lds;
    LAS bf16_t* Vs = Ks + 256 * 136;
    const int b = tile >> 6, row0 = tile * 128;
    {
        const int key = tid >> 1, half = tid & 1;
        const bf16_t* src = C.memkv + ((size_t)(l * 512 + b * 256 + key)) * 1024 + h * 128 + half * 64;
        const u32x4* kp = (const u32x4*)src; const u32x4* vp = (const u32x4*)(src + 512);
        float kf[64]; float ss = 0.f;
#pragma unroll
        for (int i = 0; i < 8; ++i) { const u32x4 w = kp[i]; UNPACK8(w, kf, 8 * i); }
#pragma unroll
        for (int i = 0; i < 64; ++i) ss += kf[i] * kf[i];
        ss += __shfl_xor(ss, 1);
        const float rs = rsqrtf(ss * (1.f / 128.f) + EPS);
        const float* kg = C.in[I_XKG] + l * 128 + half * 64;
#pragma unroll
        for (int i = 0; i < 64; ++i) kf[i] *= rs * kg[i];
#pragma unroll
        for (int i = 0; i < 8; ++i) { *(LAS u32x4*)(Ks + key * 136 + half * 64 + 8 * i) = PACK8(kf, 8 * i); *(LAS u32x4*)(Vs + key * 136 + half * 64 + 8 * i) = vp[i]; }
    }
    const int q = tid >> 2, sub = tid & 3;
    float qf[32];
    {
        const u32x4* qp = (const u32x4*)(C.za + (size_t)(row0 + q) * NZA + 2816 + h * 128 + sub * 32);
#pragma unroll
        for (int i = 0; i < 4; ++i) { const u32x4 w = qp[i]; UNPACK8(w, qf, 8 * i); }
        float ss = 0.f;
#pragma unroll
        for (int i = 0; i < 32; ++i) ss += qf[i] * qf[i];
        ss += __shfl_xor(ss, 1); ss += __shfl_xor(ss, 2);
        const float rs = rsqrtf(ss * (1.f / 128.f) + EPS) * 0.08838834764831845f;
        const float* qg = C.in[I_XQG] + l * 128 + sub * 32;
#pragma unroll
        for (int i = 0; i < 32; ++i) qf[i] *= rs * qg[i];
    }
    __syncthreads();
    float mx = -3.0e38f;
    for (int key = 0; key < 256; ++key) {
        const LAS u32x4* kr = (const LAS u32x4*)(Ks + key * 136 + sub * 32);
        float s = 0.f;
#pragma unroll
        for (int c = 0; c < 4; ++c) { float kf[8]; const u32x4 w = kr[c]; UNPACK8(w, kf, 0);
#pragma unroll
            for (int i = 0; i < 8; ++i) s += qf[8 * c + i] * kf[i]; }
        s += __shfl_xor(s, 1); s += __shfl_xor(s, 2);
        mx = fmaxf(mx, s);
    }
    float lsum = 0.f; float o[32];
#pragma unroll
    for (int i = 0; i < 32; ++i) o[i] = 0.f;
    for (int key = 0; key < 256; ++key) {
        const LAS u32x4* kr = (const LAS u32x4*)(Ks + key * 136 + sub * 32);
        float s = 0.f;
#pragma unroll
        for (int c = 0; c < 4; ++c) { float kf[8]; const u32x4 w = kr[c]; UNPACK8(w, kf, 0);
#pragma unroll
            for (int i = 0; i < 8; ++i) s += qf[8 * c + i] * kf[i]; }
        s += __shfl_xor(s, 1); s += __shfl_xor(s, 2);
        const float p = __expf(s - mx);
        lsum += p;
        const LAS u32x4* vr = (const LAS u32x4*)(Vs + key * 136 + sub * 32);
#pragma unroll
        for (int c = 0; c < 4; ++c) { float vf[8]; const u32x4 w = vr[c]; UNPACK8(w, vf, 0);
#pragma unroll
            for (int i = 0; i < 8; ++i) o[8 * c + i] += p * vf[i]; }
    }
    const float inv = 1.f / lsum;
#pragma unroll
    for (int i = 0; i < 32; ++i) o[i] *= inv;
    u32x4* op = (u32x4*)(C.o + (size_t)(row0 + q) * NO + 1536 + h * 128 + sub * 32);
#pragma unroll
    for (int c = 0; c < 4; ++c) op[c] = PACK8(o, 8 * c);
    __syncthreads();
}

__device__ __forceinline__ void gm_item(LAS unsigned char* lds, const Ctx& C, int l, int tile, int g) {
    const int tid = opaque_tid();
    LAS float* vn = (LAS float*)lds;
    LAS float* Wl = vn + 128 * 128;
    LAS float* rsv = Wl + 128 * 128;
    const int row0 = tile * 128;
    {
        const int tok = tid >> 2, sub = tid & 3;
        const u32x4* vp = (const u32x4*)(C.za + (size_t)(row0 + tok) * NZA + 512 + sub * 128);
        float ss = 0.f;
#pragma unroll
        for (int i = 0; i < 16; ++i) { float f[8]; const u32x4 w = vp[i]; UNPACK8(w, f, 0);
#pragma unroll
            for (int e = 0; e < 8; ++e) ss += f[e] * f[e]; }
        ss += __shfl_xor(ss, 1); ss += __shfl_xor(ss, 2);
        if (sub == 0) rsv[tok] = rsqrtf(ss * (1.f / 512.f) + EPS);
        const f32x4* wp = (const f32x4*)(C.in[I_GMWS] + (size_t)(l * 4 + g) * 128 * 128);
#pragma unroll
        for (int i = 0; i < 8; ++i) *(LAS f32x4*)(Wl + (i * 512 + tid) * 4) = wp[i * 512 + tid];
    }
    __syncthreads();
    {
        const int s = tid >> 2, c0 = (tid & 3) * 32;
        const u32x4* vp = (const u32x4*)(C.za + (size_t)(row0 + s) * NZA + 512 + g * 128 + c0);
        const float rs = rsv[s]; const float* vg = C.in[I_GMVG] + l * 512 + g * 128 + c0;
#pragma unroll
        for (int i = 0; i < 4; ++i) { float f[8]; const u32x4 w = vp[i]; UNPACK8(w, f, 0);
#pragma unroll
            for (int e = 0; e < 8; ++e) f[e] *= rs * vg[8 * i + e];
            *(LAS f32x4*)(vn + s * 128 + c0 + 8 * i) = (f32x4){f[0], f[1], f[2], f[3]}; *(LAS f32x4*)(vn + s * 128 + c0 + 8 * i + 4) = (f32x4){f[4], f[5], f[6], f[7]}; }
    }
    __syncthreads();
    {
        const int c = tid & 127, tq = tid >> 7;
        const float* bs = C.in[I_GMBS] + (size_t)(l * 4 + g) * 128;
        for (int k = 0; k < 32; ++k) {
            const int t = tq * 32 + k; float acc = 0.f;
            for (int s = 0; s <= t; ++s) acc += Wl[t * 128 + s] * vn[s * 128 + c];
            const float sval = acc + bs[t];
            const float u = bf2f(C.za[(size_t)(row0 + t) * NZA + g * 128 + c]);
            C.o[(size_t)(row0 + t) * NO + g * 128 + c] = (bf16_t)f2bf(u * sval);
        }
    }
    __syncthreads();
}

__device__ __forceinline__ void lru_item(LAS unsigned char* lds, const Ctx& C, int l, int tile, int hb) {
    const int tid = opaque_tid();
    LAS float* xc = (LAS float*)lds;
    LAS float* wr = xc + 8192;
    LAS float* wi = wr + 4096;
    LAS float* aa = wi + 4096;
    LAS float* bb = aa + 8192;
    const int nb = tile & 63, row0 = tile * 128;
    {
        const int t = tid >> 2, c0 = (tid & 3) * 16, ch = hb * 64 + c0;
        float acc[16];
#pragma unroll
        for (int i = 0; i < 16; ++i) acc[i] = C.in[I_CONVB][l * 512 + ch + i];
#pragma unroll
        for (int k = 0; k < 4; ++k) {
            const int tt = t - 3 + k;
            if (nb * 128 + tt >= 0) {
                const u32x4* xp = (const u32x4*)(C.za + (size_t)(row0 + tt) * NZA + 1024 + ch);
                float f[16]; const u32x4 w0 = xp[0], w1 = xp[1]; UNPACK8(w0, f, 0); UNPACK8(w1, f, 8);
                const float* cw = C.in[I_CONVW] + (size_t)(l * 4 + k) * 512 + ch;
#pragma unroll
                for (int i = 0; i < 16; ++i) acc[i] += cw[i] * f[i];
            }
        }
#pragma unroll
        for (int i = 0; i < 4; ++i) *(LAS f32x4*)(xc + t * 64 + c0 + 4 * i) = (f32x4){acc[4 * i], acc[4 * i + 1], acc[4 * i + 2], acc[4 * i + 3]};
        const f32x4* wrp = (const f32x4*)(C.in[I_WR] + (size_t)(l * 8 + hb) * 4096); const f32x4* wip = (const f32x4*)(C.in[I_WI] + (size_t)(l * 8 + hb) * 4096);
#pragma unroll
        for (int i = 0; i < 2; ++i) { *(LAS f32x4*)(wr + (i * 512 + tid) * 4) = wrp[i * 512 + tid]; *(LAS f32x4*)(wi + (i * 512 + tid) * 4) = wip[i * 512 + tid]; }
    }
    __syncthreads();
    const int j = tid & 63, tg = tid >> 6, chj = hb * 64 + j;
    {
        const float br = C.in[I_BR][l * 512 + chj], bi = C.in[I_BI][l * 512 + chj];
        const float lam = C.in[I_LAM][l * 512 + chj];
        const float sp = log1pf(expf(-lam));
        for (int k = 0; k < 16; ++k) {
            const int t = tg * 16 + k; float r = br, ig = bi;
            for (int i = 0; i < 64; ++i) { const float xv = xc[t * 64 + i]; r += xv * wr[i * 64 + j]; ig += xv * wi[i * 64 + j]; }
            r = sigmoid_f(r); ig = sigmoid_f(ig);
            const float loga = -8.f * r * sp; const float a = expf(loga); const float mult = sqrtf(-expm1f(2.f * loga));
            aa[t * 64 + j] = a; bb[t * 64 + j] = xc[t * 64 + j] * ig * mult;
        }
    }
    __syncthreads();
    if (tid < 64) {
        float hh = 0.f, P = 1.f;
        for (int t = 0; t < 128; ++t) { const float a = aa[t * 64 + tid]; hh = a * hh + bb[t * 64 + tid]; P *= a; aa[t * 64 + tid] = P; bb[t * 64 + tid] = hh; }
        C.carryA[(size_t)tile * 512 + hb * 64 + tid] = P; C.carryH[(size_t)tile * 512 + hb * 64 + tid] = hh;
    }
    __syncthreads();
    for (int k = 0; k < 16; ++k) {
        const int t = tg * 16 + k;
        const float G = bf2f(C.za[(size_t)(row0 + t) * NZA + 1536 + chj]);
        C.ly[(size_t)(row0 + t) * 512 + chj] = G * bb[t * 64 + j]; C.lp[(size_t)(row0 + t) * 512 + chj] = G * aa[t * 64 + j];
    }
    __syncthreads();
}

__device__ __forceinline__ int vperm_pos(int key) { const int w = key & 31; return (key & ~31) + ((w >> 2) & 3) * 8 + (w >> 4) * 4 + (w & 3); }
#define MFMA16(X, Y, ACC) __builtin_amdgcn_mfma_f32_16x16x32_bf16((X), (Y), (ACC), 0, 0, 0)
__device__ __forceinline__ bf16x8 pack_bf16x8(const float* f) { u32x4 w; w[0] = cvt_pk_bf16(f[0], f[1]); w[1] = cvt_pk_bf16(f[2], f[3]); w[2] = cvt_pk_bf16(f[4], f[5]); w[3] = cvt_pk_bf16(f[6], f[7]); return __builtin_bit_cast(bf16x8, w); }

__device__ __forceinline__ void kvprep_phase(const Ctx& C, int gw, int NGW, int lane) {
    for (int r = gw; r < 32 * 256; r += NGW) {
        const int combo = r >> 8, key = r & 255, l = combo >> 3, b = (combo >> 2) & 1, h = combo & 3;
        const unsigned w = *(const unsigned*)(C.memkv + ((size_t)(l * 512 + b * 256 + key)) * 1024 + h * 128 + 2 * lane);
        float f0 = __uint_as_float(w << 16), f1 = __uint_as_float(w & 0xffff0000u);
        const float ss = wave_sum(f0 * f0 + f1 * f1); const float rs = rsqrtf(ss * (1.f / 128.f) + EPS);
        const float* kg = C.in[I_XKG] + l * 128 + 2 * lane;
        *(unsigned*)(C.memK + (size_t)r * 128 + 2 * lane) = pk2(f0 * rs * kg[0], f1 * rs * kg[1]);
    }
    const int gt = gw * 64 + lane, NGT = NGW * 64;
    for (int t = gt; t < 32 * 32 * 128; t += NGT) {
        const int d = t & 127, pg = (t >> 7) & 31, combo = t >> 12, l = combo >> 3, b = (combo >> 2) & 1, h = combo & 3;
        const int kbase = (pg >> 2) * 32 + (pg & 3) * 4;
        const bf16_t* src = C.memkv + ((size_t)(l * 512 + b * 256)) * 1024 + 512 + h * 128 + d;
        unsigned short v[8];
#pragma unroll
        for (int e = 0; e < 4; ++e) { v[e] = src[(size_t)(kbase + e) * 1024]; v[4 + e] = src[(size_t)(kbase + 16 + e) * 1024]; }
        u32x4 o; o[0] = v[0] | ((unsigned)v[1] << 16); o[1] = v[2] | ((unsigned)v[3] << 16); o[2] = v[4] | ((unsigned)v[5] << 16); o[3] = v[6] | ((unsigned)v[7] << 16);
        *(u32x4*)(C.memVt + ((size_t)combo * 128 + d) * 256 + pg * 8) = o;
    }
}

__device__ __forceinline__ void xa_pair_mfma(LAS unsigned char* lds, const Ctx& C, int l, int pairidx) {
    const int tid = opaque_tid(), lane = tid & 63, w = __builtin_amdgcn_readfirstlane(tid >> 6), fr = lane & 15, fq = lane >> 4;
    LAS bf16_t* Ks = (LAS bf16_t*)lds;
    LAS bf16_t* Vt = Ks + 256 * 144;
    const int idx0 = pairidx * 2, bh = idx0 >> 6, b = bh >> 2, h = bh & 3, nb0 = idx0 & 63;
    u32x4 qr[2][4];
#pragma unroll
    for (int tt = 0; tt < 2; ++tt) { const bf16_t* qp = C.za + (size_t)((b * 64 + nb0 + tt) * 128 + w * 16 + fr) * NZA + 2816 + h * 128 + 8 * fq;
#pragma unroll
        for (int ks = 0; ks < 4; ++ks) qr[tt][ks] = *(const u32x4*)(qp + 32 * ks); }
    {
        const u32x4* ksrc = (const u32x4*)(C.memK + ((size_t)(l * 8 + bh)) * 256 * 128);
        const u32x4* vsrc = (const u32x4*)(C.memVt + ((size_t)(l * 8 + bh)) * 128 * 256);
#pragma unroll
        for (int i = 0; i < 8; ++i) { const int ch = i * 512 + tid;
            *(LAS u32x4*)(Ks + (ch >> 4) * 144 + (ch & 15) * 8) = ksrc[ch];
            *(LAS u32x4*)(Vt + (ch >> 5) * 272 + (ch & 31) * 8) = vsrc[ch]; }
    }
    __syncthreads();
    const float* qg = C.in[I_XQG] + l * 128;
#pragma unroll
    for (int tt = 0; tt < 2; ++tt) {
        const size_t row = (size_t)((b * 64 + nb0 + tt) * 128 + w * 16 + fr);
        bf16x8 qf[4];
        {
            float f[32];
#pragma unroll
            for (int ks = 0; ks < 4; ++ks) { const u32x4 wv = qr[tt][ks]; UNPACK8(wv, f, 8 * ks); }
            float ss = 0.f;
#pragma unroll
            for (int i = 0; i < 32; ++i) ss += f[i] * f[i];
            ss += __shfl_xor(ss, 16); ss += __shfl_xor(ss, 32);
            const float rs = rsqrtf(ss * (1.f / 128.f) + EPS) * (0.08838834764831845f * 1.4426950408889634f);
#pragma unroll
            for (int ks = 0; ks < 4; ++ks) {
#pragma unroll
                for (int i = 0; i < 8; ++i) f[8 * ks + i] *= rs * qg[32 * ks + 8 * fq + i];
                qf[ks] = pack_bf16x8(f + 8 * ks); }
        }
        f32x4 acc[16];
#pragma unroll
        for (int kb = 0; kb < 16; ++kb) { acc[kb] = (f32x4){0.f, 0.f, 0.f, 0.f};
#pragma unroll
            for (int ks = 0; ks < 4; ++ks) { const bf16x8 kf = *(const LAS bf16x8*)(Ks + (kb * 16 + fr) * 144 + 32 * ks + 8 * fq); acc[kb] = MFMA16(kf, qf[ks], acc[kb]); } }
        float mx = -3.0e38f;
#pragma unroll
        for (int kb = 0; kb < 16; ++kb) mx = fmaxf(fmaxf(fmaxf(acc[kb][0], acc[kb][1]), fmaxf(acc[kb][2], acc[kb][3])), mx);
        mx = fmaxf(mx, __shfl_xor(mx, 16)); mx = fmaxf(mx, __shfl_xor(mx, 32));
        float lsum = 0.f;
#pragma unroll
        for (int kb = 0; kb < 16; ++kb)
#pragma unroll
            for (int e = 0; e < 4; ++e) { const float pv = __builtin_amdgcn_exp2f(acc[kb][e] - mx); acc[kb][e] = pv; lsum += pv; }
        lsum += __shfl_xor(lsum, 16); lsum += __shfl_xor(lsum, 32);
        const float inv = 1.f / lsum;
        bf16x8 pf[8];
#pragma unroll
        for (int j = 0; j < 8; ++j) { u32x4 wv; wv[0] = cvt_pk_bf16(acc[2 * j][0], acc[2 * j][1]); wv[1] = cvt_pk_bf16(acc[2 * j][2], acc[2 * j][3]); wv[2] = cvt_pk_bf16(acc[2 * j + 1][0], acc[2 * j + 1][1]); wv[3] = cvt_pk_bf16(acc[2 * j + 1][2], acc[2 * j + 1][3]); pf[j] = __builtin_bit_cast(bf16x8, wv); }
        bf16_t* op = C.o + row * NO + 1536 + h * 128 + 4 * fq;
#pragma unroll
        for (int db = 0; db < 8; ++db) {
            f32x4 o = (f32x4){0.f, 0.f, 0.f, 0.f};
#pragma unroll
            for (int j = 0; j < 8; ++j) { const bf16x8 vf = *(const LAS bf16x8*)(Vt + (db * 16 + fr) * 272 + 32 * j + 8 * fq); o = MFMA16(vf, pf[j], o); }
            *(u32x2*)(op + db * 16) = (u32x2){cvt_pk_bf16(o[0] * inv, o[1] * inv), cvt_pk_bf16(o[2] * inv, o[3] * inv)};
        }
    }
    __syncthreads();
}

__device__ __forceinline__ void swa_item_mfma(LAS unsigned char* lds, const Ctx& C, int l, int tile, int kvh) {
    const int tid = opaque_tid(), lane = tid & 63, w = __builtin_amdgcn_readfirstlane(tid >> 6), fr = lane & 15, fq = lane >> 4;
    LAS bf16_t* Ks = (LAS bf16_t*)lds;
    LAS bf16_t* Vt = Ks + 256 * 80;
    const int nb = tile & 63, row0 = tile * 128;
    const bf16_t* qbase = C.za + (size_t)(row0 + 16 * w + fr) * NZA + 2048 + kvh * 256 + 8 * fq;
    u32x4 qn0 = *(const u32x4*)qbase, qn1 = *(const u32x4*)(qbase + 32);
    {
        const int key = tid >> 1, half = tid & 1;
        const bool ok = (nb > 0) || (key >= 128);
        const size_t grow = (size_t)(ok ? row0 - 128 + key : row0);
        const u32x4* kp = (const u32x4*)(C.za + grow * NZA + 2560 + kvh * 64 + half * 32);
        const u32x4* vp = (const u32x4*)(C.za + grow * NZA + 2688 + kvh * 64 + half * 32);
        float kf[32]; float ss = 0.f;
#pragma unroll
        for (int i = 0; i < 4; ++i) { const u32x4 wv = kp[i]; UNPACK8(wv, kf, 8 * i); }
#pragma unroll
        for (int i = 0; i < 32; ++i) ss += kf[i] * kf[i];
        ss += __shfl_xor(ss, 1);
        const float rs = rsqrtf(ss * (1.f / 64.f) + EPS);
        const float* kg = C.in[I_SKG] + l * 64 + half * 32;
#pragma unroll
        for (int i = 0; i < 32; ++i) kf[i] *= rs * kg[i];
        if (half == 0) { const int posi = ok ? nb * 128 - 128 + key : 0; ROPE16T(kf, C.rope + (size_t)posi * 16); }
#pragma unroll
        for (int i = 0; i < 4; ++i) *(LAS u32x4*)(Ks + key * 80 + half * 32 + 8 * i) = PACK8(kf, 8 * i);
        const int pp = vperm_pos(key);
#pragma unroll
        for (int i = 0; i < 4; ++i) { u32x4 wv = vp[i]; if (!ok) wv = (u32x4){0u, 0u, 0u, 0u};
#pragma unroll
            for (int e = 0; e < 4; ++e) { Vt[(half * 32 + 8 * i + 2 * e) * 272 + pp] = (bf16_t)(wv[e] & 0xffffu); Vt[(half * 32 + 8 * i + 2 * e + 1) * 272 + pp] = (bf16_t)(wv[e] >> 16); } }
    }
    __syncthreads();
    const int i0 = 16 * w, ws2 = w & ~1, qi = i0 + fr;
    float rc[8], rsn[8];
    { const f32x4* tp = (const f32x4*)(C.rope + (size_t)(nb * 128 + qi) * 16);
#pragma unroll
      for (int i = 0; i < 4; ++i) { const f32x4 cs = tp[i]; rc[2 * i] = cs[0]; rsn[2 * i] = cs[1]; rc[2 * i + 1] = cs[2]; rsn[2 * i + 1] = cs[3]; } }
    const size_t row = (size_t)(row0 + qi);
    float gq[16];
    { const float* qg = C.in[I_SQG] + l * 64 + 8 * fq;
#pragma unroll
      for (int i = 0; i < 8; ++i) { gq[i] = qg[i] * (0.125f * 1.4426950408889634f); gq[8 + i] = qg[32 + i] * (0.125f * 1.4426950408889634f); } }
    for (int hh = 0; hh < 4; ++hh) {
        const int h = kvh * 4 + hh;
        bf16x8 qf[2];
        {
            float f[16];
            { const u32x4 w0 = qn0, w1 = qn1; UNPACK8(w0, f, 0); UNPACK8(w1, f, 8); }
            if (hh < 3) { qn0 = *(const u32x4*)(qbase + 64 * (hh + 1)); qn1 = *(const u32x4*)(qbase + 64 * (hh + 1) + 32); }
            float ss = 0.f;
#pragma unroll
            for (int i = 0; i < 16; ++i) ss += f[i] * f[i];
            ss += __shfl_xor(ss, 16); ss += __shfl_xor(ss, 32);
            const float rs = rsqrtf(ss * (1.f / 64.f) + EPS);
#pragma unroll
            for (int i = 0; i < 16; ++i) f[i] *= rs * gq[i];
#pragma unroll
            for (int i = 0; i < 8; ++i) { const float other = __shfl_xor(f[i], 16);
                const float r0 = f[i] * rc[i] - other * rsn[i], r1 = f[i] * rc[i] + other * rsn[i];
                f[i] = (fq == 0) ? r0 : (fq == 1) ? r1 : f[i]; }
            qf[0] = pack_bf16x8(f); qf[1] = pack_bf16x8(f + 8);
        }
        f32x4 acc[10];
#pragma unroll
        for (int kk = 0; kk < 10; ++kk) { acc[kk] = (f32x4){0.f, 0.f, 0.f, 0.f};
#pragma unroll
            for (int ks = 0; ks < 2; ++ks) { const bf16x8 kf = *(const LAS bf16x8*)(Ks + ((ws2 + kk) * 16 + fr) * 80 + 32 * ks + 8 * fq); acc[kk] = MFMA16(kf, qf[ks], acc[kk]); } }
        const float sink = C.in[I_SINK][l * 8 + h] * 1.4426950408889634f;
        float mx = sink;
        const int sh = w & 1;
#pragma unroll
        for (int kk = 0; kk < 10; ++kk) {
            const int dlt = kk - sh;
            if (nb > 0 && dlt >= 1 && dlt <= 7) {
#pragma unroll
                for (int e = 0; e < 4; ++e) mx = fmaxf(mx, acc[kk][e]);
            } else {
#pragma unroll
                for (int e = 0; e < 4; ++e) { const int kj = (ws2 + kk) * 16 + 4 * fq + e, dd = kj - qi; const bool valid = (dd >= 1) && (dd <= 128) && ((nb > 0) || (kj >= 128));
                    const float sv = valid ? acc[kk][e] : -INFINITY; acc[kk][e] = sv; mx = fmaxf(mx, sv); }
            }
        }
        mx = fmaxf(mx, __shfl_xor(mx, 16)); mx = fmaxf(mx, __shfl_xor(mx, 32));
        float lsum = 0.f;
#pragma unroll
        for (int kk = 0; kk < 10; ++kk)
#pragma unroll
            for (int e = 0; e < 4; ++e) { const float pv = __builtin_amdgcn_exp2f(acc[kk][e] - mx); acc[kk][e] = pv; lsum += pv; }
        lsum += __shfl_xor(lsum, 16); lsum += __shfl_xor(lsum, 32);
        lsum += __builtin_amdgcn_exp2f(sink - mx);
        const float inv = 1.f / lsum;
        bf16x8 pf[5];
#pragma unroll
        for (int j = 0; j < 5; ++j) { u32x4 wv; wv[0] = cvt_pk_bf16(acc[2 * j][0], acc[2 * j][1]); wv[1] = cvt_pk_bf16(acc[2 * j][2], acc[2 * j][3]); wv[2] = cvt_pk_bf16(acc[2 * j + 1][0], acc[2 * j + 1][1]); wv[3] = cvt_pk_bf16(acc[2 * j + 1][2], acc[2 * j + 1][3]); pf[j] = __builtin_bit_cast(bf16x8, wv); }
        bf16_t* op = C.o + row * NO + 1024 + h * 64 + 4 * fq;
#pragma unroll
        for (int db = 0; db < 4; ++db) {
            f32x4 o = (f32x4){0.f, 0.f, 0.f, 0.f};
#pragma unroll
            for (int j = 0; j < 5; ++j) { const bf16x8 vf = *(const LAS bf16x8*)(Vt + (db * 16 + fr) * 272 + (ws2 + 2 * j) * 16 + 8 * fq); o = MFMA16(vf, pf[j], o); }
            *(u32x2*)(op + db * 16) = (u32x2){cvt_pk_bf16(o[0] * inv, o[1] * inv), cvt_pk_bf16(o[2] * inv, o[3] * inv)};
        }
    }
    __syncthreads();
}

__device__ __forceinline__ void gm_item_mfma(LAS unsigned char* lds, const Ctx& C, int l, int tile, int g) {
    const int tid = opaque_tid(), lane = tid & 63, w = __builtin_amdgcn_readfirstlane(tid >> 6), fr = lane & 15, fq = lane >> 4;
    LAS bf16_t* Wl = (LAS bf16_t*)lds;
    LAS bf16_t* vT = Wl + 128 * 144;
    LAS float* rsv = (LAS float*)(vT + 128 * 144);
    const int row0 = tile * 128;
    {
        if (tid < 128) { const f32x4* pp = (const f32x4*)(C.ssv + (size_t)(row0 + tid) * 8); const f32x4 a = pp[0], b2 = pp[1];
            rsv[tid] = rsqrtf((((a[0] + a[1]) + (a[2] + a[3])) + ((b2[0] + b2[1]) + (b2[2] + b2[3]))) * (1.f / 512.f) + EPS); }
        const int tok = tid >> 2, sub = tid & 3;
        const u32x4* gp = (const u32x4*)(C.za + (size_t)(row0 + tok) * NZA + 512 + g * 128 + sub * 32);
#pragma unroll
        for (int i = 0; i < 4; ++i) { const u32x4 wv = gp[i];
#pragma unroll
            for (int e = 0; e < 4; ++e) { vT[(sub * 32 + 8 * i + 2 * e) * 144 + tok] = (bf16_t)(wv[e] & 0xffffu); vT[(sub * 32 + 8 * i + 2 * e + 1) * 144 + tok] = (bf16_t)(wv[e] >> 16); } }
    }
    const int t_ = tid >> 2, s0 = (tid & 3) * 32;
    f32x4 wreg[8];
    { const f32x4* wp = (const f32x4*)(C.in[I_GMWS] + ((size_t)(l * 4 + g) * 128 + t_) * 128 + s0);
#pragma unroll
      for (int i = 0; i < 8; ++i) wreg[i] = wp[i]; }
    __syncthreads();
    {
#pragma unroll
        for (int i = 0; i < 4; ++i) { const f32x4 a = wreg[2 * i], b2 = wreg[2 * i + 1]; float f[8] = {a[0], a[1], a[2], a[3], b2[0], b2[1], b2[2], b2[3]};
#pragma unroll
            for (int e = 0; e < 8; ++e) { const int sidx = s0 + 8 * i + e; f[e] = (sidx <= t_) ? f[e] * rsv[sidx] : 0.f; }
            *(LAS u32x4*)(Wl + t_ * 144 + s0 + 8 * i) = PACK8(f, 0); }
    }
    __syncthreads();
    {
        const int nks = (w + 2) >> 1;
        f32x4 acc[8];
#pragma unroll
        for (int cb = 0; cb < 8; ++cb) acc[cb] = (f32x4){0.f, 0.f, 0.f, 0.f};
        for (int ks = 0; ks < nks; ++ks) {
            const bf16x8 wf = *(const LAS bf16x8*)(Wl + (16 * w + fr) * 144 + 32 * ks + 8 * fq);
#pragma unroll
            for (int cb = 0; cb < 8; ++cb) { const bf16x8 vf = *(const LAS bf16x8*)(vT + (cb * 16 + fr) * 144 + 32 * ks + 8 * fq); acc[cb] = MFMA16(vf, wf, acc[cb]); }
        }
        const int t = 16 * w + fr; const size_t r = (size_t)(row0 + t);
        const float bsv = C.in[I_GMBS][(size_t)(l * 4 + g) * 128 + t];
        const float* vg = C.in[I_GMVG] + l * 512 + g * 128 + 4 * fq;
        const bf16_t* up = C.za + r * NZA + g * 128 + 4 * fq; bf16_t* op = C.o + r * NO + g * 128 + 4 * fq;
#pragma unroll
        for (int cb = 0; cb < 8; ++cb) { const f32x4 gn = *(const f32x4*)(vg + cb * 16); const u32x2 uw = *(const u32x2*)(up + cb * 16);
            const float u0 = __uint_as_float(uw[0] << 16), u1 = __uint_as_float(uw[0] & 0xffff0000u), u2 = __uint_as_float(uw[1] << 16), u3 = __uint_as_float(uw[1] & 0xffff0000u);
            *(u32x2*)(op + cb * 16) = (u32x2){cvt_pk_bf16(u0 * (gn[0] * acc[cb][0] + bsv), u1 * (gn[1] * acc[cb][1] + bsv)), cvt_pk_bf16(u2 * (gn[2] * acc[cb][2] + bsv), u3 * (gn[3] * acc[cb][3] + bsv))}; }
    }
    __syncthreads();
}

__device__ __forceinline__ void lru_item_mfma(LAS unsigned char* lds, const Ctx& C, int l, int tile, int hb) {
    const int tid = opaque_tid(), lane = tid & 63, w = __builtin_amdgcn_readfirstlane(tid >> 6), fr = lane & 15, fq = lane >> 4;
    LAS bf16_t* xcb = (LAS bf16_t*)lds;
    LAS bf16_t* wrT = xcb + 128 * 80;
    LAS bf16_t* wiT = wrT + 64 * 80;
    LAS float* xcf = (LAS float*)(lds + 40960);
    LAS float* aa = xcf + 8192;
    LAS float* bb = aa + 8192;
    LAS float* segA = bb + 8192;
    LAS float* segH = segA + 512;
    const int nb = tile & 63, row0 = tile * 128;
    {
        const int t = tid >> 2, c0 = (tid & 3) * 16, ch = hb * 64 + c0;
        float acc[16];
#pragma unroll
        for (int i = 0; i < 16; ++i) acc[i] = C.in[I_CONVB][l * 512 + ch + i];
#pragma unroll
        for (int k = 0; k < 4; ++k) {
            const int tt = t - 3 + k;
            if (nb * 128 + tt >= 0) {
                const u32x4* xp = (const u32x4*)(C.za + (size_t)(row0 + tt) * NZA + 1024 + ch);
                float f[16]; const u32x4 w0 = xp[0], w1 = xp[1]; UNPACK8(w0, f, 0); UNPACK8(w1, f, 8);
                const float* cw = C.in[I_CONVW] + (size_t)(l * 4 + k) * 512 + ch;
#pragma unroll
                for (int i = 0; i < 16; ++i) acc[i] += cw[i] * f[i];
            }
        }
#pragma unroll
        for (int i = 0; i < 4; ++i) *(LAS f32x4*)(xcf + t * 64 + c0 + 4 * i) = (f32x4){acc[4 * i], acc[4 * i + 1], acc[4 * i + 2], acc[4 * i + 3]};
        *(LAS u32x4*)(xcb + t * 80 + c0) = PACK8(acc, 0); *(LAS u32x4*)(xcb + t * 80 + c0 + 8) = PACK8(acc, 8);
        const u32x4* wsrc = (const u32x4*)(C.wgT + (size_t)(l * 8 + hb) * 2 * 4096);
#pragma unroll
        for (int i = 0; i < 2; ++i) { const int c = i * 512 + tid; *(LAS u32x4*)(wrT + (c >> 3) * 80 + (c & 7) * 8) = wsrc[c]; }
    }
    __syncthreads();
    {
        bf16x8 xf[2];
#pragma unroll
        for (int ks = 0; ks < 2; ++ks) xf[ks] = *(const LAS bf16x8*)(xcb + (16 * w + fr) * 80 + 32 * ks + 8 * fq);
#pragma unroll
        for (int jb = 0; jb < 4; ++jb) {
            f32x4 ar = (f32x4){0.f, 0.f, 0.f, 0.f}, ai = (f32x4){0.f, 0.f, 0.f, 0.f};
#pragma unroll
            for (int ks = 0; ks < 2; ++ks) { const bf16x8 wf = *(const LAS bf16x8*)(wrT + (jb * 16 + fr) * 80 + 32 * ks + 8 * fq); ar = MFMA16(xf[ks], wf, ar);
                const bf16x8 wf2 = *(const LAS bf16x8*)(wiT + (jb * 16 + fr) * 80 + 32 * ks + 8 * fq); ai = MFMA16(xf[ks], wf2, ai); }
            const int j = jb * 16 + fr, chj = l * 512 + hb * 64 + j;
            const float br = C.in[I_BR][chj], bi = C.in[I_BI][chj], sp8 = (-8.f * 1.4426950408889634f) * C.spl[chj];
#pragma unroll
            for (int e = 0; e < 4; ++e) { const int t = 16 * w + 4 * fq + e;
                const float r = sigmoid_f(ar[e] + br), ig = sigmoid_f(ai[e] + bi);
                const float a = __builtin_amdgcn_exp2f(r * sp8); const float mult = __builtin_amdgcn_sqrtf(fmaxf(1.f - a * a, 0.f));
                aa[t * 64 + j] = a; bb[t * 64 + j] = xcf[t * 64 + j] * ig * mult; }
        }
    }
    __syncthreads();
    const int j = tid & 63, sg = tid >> 6;
    float av[16], bv[16], Gv[16];
    {
#pragma unroll
        for (int k = 0; k < 16; ++k) { av[k] = aa[(sg * 16 + k) * 64 + j]; bv[k] = bb[(sg * 16 + k) * 64 + j]; }
#pragma unroll
        for (int k = 0; k < 16; ++k) Gv[k] = bf2f(C.za[(size_t)(row0 + sg * 16 + k) * NZA + 1536 + hb * 64 + j]);
        float hh = 0.f, P = 1.f;
#pragma unroll
        for (int k = 0; k < 16; ++k) { hh = av[k] * hh + bv[k]; P *= av[k]; av[k] = P; bv[k] = hh; }
        segA[sg * 64 + j] = P; segH[sg * 64 + j] = hh;
    }
    __syncthreads();
    LAS float* cin = segH + 512;
    float Hc = 0.f, Pc = 1.f;
    for (int s2 = 0; s2 < sg; ++s2) { const float a = segA[s2 * 64 + j]; Hc = a * Hc + segH[s2 * 64 + j]; Pc *= a; }
    const int chj = hb * 64 + j, bt = tile >> 6;
    const size_t wbase = (size_t)l * 128 * 512 + chj;
    if (sg == 7) {
        const float At = Pc * segA[7 * 64 + j], Hl = segA[7 * 64 + j] * Hc + segH[7 * 64 + j];
        __hip_atomic_store(C.agg + wbase + (size_t)tile * 512, ((unsigned long long)__float_as_uint(Hl) << 32) | (unsigned long long)(__float_as_uint(At) | 1u), __ATOMIC_RELAXED, __HIP_MEMORY_SCOPE_AGENT);
    }
    if (sg == 0) {
        const int r0 = nb & ~15;
        unsigned long long wv[16]; unsigned spins = 0;
        for (;;) {
            bool ok = true;
#pragma unroll
            for (int i = 0; i < 16; ++i) {
                const int n = r0 - 1 + i; const bool need = (i == 0) ? (r0 > 0) : (n < nb);
                const unsigned long long* pw = (i == 0 ? C.inc : C.agg) + wbase + (size_t)(bt * 64 + (need ? n : 0)) * 512;
                wv[i] = need ? __hip_atomic_load(pw, __ATOMIC_RELAXED, __HIP_MEMORY_SCOPE_AGENT) : 1ull;
                ok = ok && (wv[i] != 0ull);
            }
            if (ok || ++spins > (1u << 20)) break;
            __builtin_amdgcn_s_sleep(2);
        }
        float Hin = (r0 > 0) ? __uint_as_float((unsigned)(wv[0] >> 32)) : 0.f;
#pragma unroll
        for (int i = 1; i < 16; ++i) if (r0 - 1 + i < nb) Hin = __uint_as_float((unsigned)wv[i]) * Hin + __uint_as_float((unsigned)(wv[i] >> 32));
        cin[j] = Hin;
    }
    __syncthreads();
    {
        const float Hs = Hc + Pc * cin[j];
        float hl = 0.f;
#pragma unroll
        for (int k = 0; k < 16; ++k) { const int t = sg * 16 + k; hl = bv[k] + av[k] * Hs;
            C.o[(size_t)(row0 + t) * NO + 512 + chj] = (bf16_t)(cvt_pk_bf16(Gv[k] * hl, 0.f) & 0xffffu); }
        if (sg == 7) __hip_atomic_store(C.inc + wbase + (size_t)tile * 512, ((unsigned long long)__float_as_uint(hl) << 32) | 1ull, __ATOMIC_RELAXED, __HIP_MEMORY_SCOPE_AGENT);
    }
    __syncthreads();
}

__device__ __forceinline__ void fix_item(const Ctx& C, int tile, int half) {
    const int c = opaque_tid(), b = tile >> 6, nb = tile & 63, row0 = tile * 128 + half * 64;
    float H = 0.f;
    for (int jn = 0; jn < nb; ++jn) { const size_t idx = (size_t)(b * 64 + jn) * 512 + c; H = C.carryA[idx] * H + C.carryH[idx]; }
    for (int t = 0; t < 64; ++t) { const size_t r = (size_t)(row0 + t); C.o[r * NO + 512 + c] = (bf16_t)f2bf(C.ly[r * 512 + c] + C.lp[r * 512 + c] * H); }
}

#ifndef PROBE_KIND
#define PROBE_KIND -1
#endif
#ifndef PROBE_MULT
#define PROBE_MULT 4
#endif
#if PROBE_KIND >= 0
#define BAR(kind) do { const unsigned long long _tb = __builtin_amdgcn_s_memrealtime(); xcd_barrier(bar); const unsigned long long _te = __builtin_amdgcn_s_memrealtime(); \
    if (PROBE_KIND == 7 || (PROBE_KIND == 15 && (kind) == 2)) tacc += _te - _tb; else if ((kind) == PROBE_KIND) tacc += _te - tprev; tprev = _te; } while (0)
#define TS(kind) do { if (PROBE_KIND >= 10) { const unsigned long long _te = __builtin_amdgcn_s_memrealtime(); if ((kind) == PROBE_KIND) tacc += _te - tprev; tprev = _te; } } while (0)
#else
#define BAR(kind) xcd_barrier(bar)
#define TS(kind) do { } while (0)
#endif
__global__ void __launch_bounds__(512, 2) fwd_megakernel(Args args) {
    extern __shared__ __attribute__((aligned(16))) unsigned char lds_raw[];
    LAS unsigned char* lds = (LAS unsigned char*)lds_raw;
    volatile LAS unsigned* MISC = (volatile LAS unsigned*)(lds + MISC_OFF);
    const int tid = threadIdx.x, lane = tid & 63, wave = __builtin_amdgcn_readfirstlane(tid >> 6);
    const int G = gridDim.x, bx = blockIdx.x;
    unsigned char* ws = args.ws;
    Ctx C;
    C.in = args.in; C.x = args.out;
    C.wt_in = (bf16_t*)(ws + WS_WIN); C.wt_br = (bf16_t*)(ws + WS_WBR); C.wt_out = (bf16_t*)(ws + WS_WOUT); C.wt_ff1 = (bf16_t*)(ws + WS_WFF1); C.wt_ff2 = (bf16_t*)(ws + WS_WFF2); C.wt_kv = (bf16_t*)(ws + WS_WKV);
    C.memn = (bf16_t*)(ws + WS_MEMN); C.memkv = (bf16_t*)(ws + WS_MEMKV); C.xb = (bf16_t*)(ws + WS_XB); C.za = (bf16_t*)(ws + WS_ZA); C.zg = (bf16_t*)(ws + WS_ZG); C.mb = (bf16_t*)(ws + WS_MB); C.o = (bf16_t*)(ws + WS_O);
    C.ssq = (float*)(ws + WS_SSQ); C.carryA = (float*)(ws + WS_CARRY); C.carryH = C.carryA + 128 * 512; C.S = (float*)(ws + WS_S); C.ly = (float*)(ws + WS_LY); C.lp = (float*)(ws + WS_LP); C.memK = (bf16_t*)(ws + WS_MEMK); C.memVt = (bf16_t*)(ws + WS_MEMVT); C.spl = (float*)(ws + WS_SPL); C.rope = (float*)(ws + WS_ROPE); C.ssv = (float*)(ws + WS_SSV); C.wgT = (bf16_t*)(ws + WS_WGT); C.agg = (unsigned long long*)(ws + WS_AGG); C.inc = (unsigned long long*)(ws + WS_INC);

    if (tid < 64) MISC[tid] = 0u;
    __syncthreads();
    XcdBarrier bar = xcd_barrier_post((unsigned*)(ws + WS_CTL), MISC + 8);
    const int gw = bx * 8 + wave, NGW = G * 8;
    LAS float* scr = (LAS float*)(lds + wave * 16384);
#if PROBE_KIND >= 0
    unsigned long long tacc = 0ull, tprev = __builtin_amdgcn_s_memrealtime();
#endif

    for (int it = gw; it < IT_WIN + 4 * IT_WKV; it += NGW) {
        if (it < IT_WIN) conv_w(C, 0, 0, it, scr, lane);
        else { const int r = it - IT_WIN; conv_w(C, 5, r / IT_WKV, r % IT_WKV, scr, lane); }
    }
    for (int m = gw; m < M + 512; m += NGW) {
        if (m < M) {
            const f32x4* xr = (const f32x4*)(C.in[I_X] + (size_t)m * D) + lane; f32x4 v[4]; float s = 0.f;
#pragma unroll
            for (int jj = 0; jj < 4; ++jj) { v[jj] = xr[64 * jj]; s += (v[jj].x * v[jj].x + v[jj].y * v[jj].y) + (v[jj].z * v[jj].z + v[jj].w * v[jj].w); }
            s = wave_sum(s);
            u32x2* bo = (u32x2*)(C.xb + (size_t)m * D) + lane;
#pragma unroll
            for (int jj = 0; jj < 4; ++jj) bo[64 * jj] = (u32x2){pk2(v[jj].x, v[jj].y), pk2(v[jj].z, v[jj].w)};
            if (lane < 16) C.ssq[(size_t)m * 16 + lane] = (lane == 0) ? s : 0.f;
        } else {
            const int r = m - M;
            const f32x4* xr = (const f32x4*)(C.in[I_MEM] + (size_t)r * D) + lane; f32x4 v[4]; float s = 0.f;
#pragma unroll
            for (int jj = 0; jj < 4; ++jj) { v[jj] = xr[64 * jj]; s += (v[jj].x * v[jj].x + v[jj].y * v[jj].y) + (v[jj].z * v[jj].z + v[jj].w * v[jj].w); }
            s = wave_sum(s); const float rs = rsqrtf(s * (1.f / 1024.f) + EPS);
            u32x2* bo = (u32x2*)(C.memn + (size_t)r * D) + lane;
#pragma unroll
            for (int jj = 0; jj < 4; ++jj) bo[64 * jj] = (u32x2){pk2(v[jj].x * rs, v[jj].y * rs), pk2(v[jj].z * rs, v[jj].w * rs)};
        }
    }
    { const int gt = bx * 512 + tid; if (gt < DEPTH * 512) C.spl[gt] = log1pf(expf(-C.in[I_LAM][gt])); }
    for (int c = bx * 512 + tid; c < DEPTH * 8 * 2 * 64 * 8; c += G * 512) {
        const int c8 = c & 7, jj = (c >> 3) & 63, gt2 = (c >> 9) & 1, lh = c >> 10;
        const float* src = C.in[gt2 ? I_WI : I_WR] + (size_t)lh * 4096 + (size_t)(c8 * 8) * 64 + jj;
        float f[8];
#pragma unroll
        for (int e = 0; e < 8; ++e) f[e] = src[e * 64];
        *(u32x4*)(C.wgT + (size_t)c * 8) = PACK8(f, 0);
    }
    for (int c = bx * 512 + tid; c < 8192 * 8; c += G * 512) {
        const int i = c & 7; const float inv = ROPE_INV(i); const float ang = (float)(c >> 3) * inv;
        C.rope[2 * c] = cosf(ang); C.rope[2 * c + 1] = sinf(ang);
    }
    { u32x4* zp = (u32x4*)(ws + WS_AGG); for (int i = bx * 512 + tid; i < (int)((WS_SSV - WS_AGG) / 16); i += G * 512) zp[i] = (u32x4){0u, 0u, 0u, 0u}; }
    __syncthreads();
    if (args.ws == nullptr) cg::this_grid().sync();
    BAR(0);

    for (int l = 0; l < DEPTH; ++l) {
        if (l == 0 && bx >= 64 && bx < 96) {
            pg8::Gemm g{C.memn, C.wt_kv}; pg8::SchedKV S{bx - 64}; pg8::EpiKV E{C.memkv};
            pg8::gemm_phase<pg8::EpiKV, pg8::SchedKV, true, D, D, D>(lds, g, S, E);
        }
        {
#ifndef SKIP_G1
            pg8::Gemm g{C.xb, C.wt_in}; pg8::SchedStd S; S.init(M, DIN, G, bx, D, D);
            pg8::EpiZ E{C.za, C.zg, C.ssq, C.in[I_BGATE] + (size_t)l * 4 * D, C.ssv};
            for (int rep = 0; rep < REP_G1; ++rep) pg8::gemm_phase<pg8::EpiZ, pg8::SchedStd, true, D, D, D>(lds, g, S, E);
#endif

        }
        const int cfirst = (l == 0) ? 96 : 64;
        if (G == 256 && bx >= cfirst) {
            const int lane_c = opaque_tid() & 63;
            const int cw = (bx - cfirst) * 8 + wave, NCW = (G - cfirst) * 8;
            for (int it = cw; it < IT_WBR + IT_WOUT + IT_WFF1 + IT_WFF2; it += NCW) {
                int r = it;
                if (r < IT_WBR) { conv_w(C, 1, l, r, scr, lane_c); continue; } r -= IT_WBR;
                if (r < IT_WOUT) { conv_w(C, 2, l, r, scr, lane_c); continue; } r -= IT_WOUT;
                if (r < IT_WFF1) { conv_w(C, 3, l, r, scr, lane_c); continue; } r -= IT_WFF1;
                conv_w(C, 4, l, r, scr, lane_c);
            }
        }
        BAR(1);
        TS(99);
        {
            if (l == 0) { kvprep_phase(C, gw, NGW, opaque_tid() & 63); BAR(2); }
            for (int rmix = 0; rmix < REP_MIX; ++rmix) {
#if USE_MFMA_SWA
            for (int rep = 0; rep < REP_SWA; ++rep) for (int it = bx; it < 256; it += G) swa_item_mfma(lds, C, l, it >> 1, it & 1);
#else
            for (int it = bx; it < 1024; it += G) swa_item(lds, C, l, it >> 3, it & 7);
#endif
            TS(10);
#if USE_MFMA_XA
            for (int rep = 0; rep < REP_XA; ++rep) for (int it = bx; it < 256; it += G) xa_pair_mfma(lds, C, l, it);
#else
            for (int it = bx; it < 512; it += G) xa_item(lds, C, l, it >> 2, it & 3);
#endif
            TS(11);
#if USE_MFMA_GM
            for (int rep = 0; rep < REP_GM; ++rep) for (int it = bx; it < 512; it += G) gm_item_mfma(lds, C, l, it >> 2, it & 3);
#else
            for (int it = bx; it < 512; it += G) gm_item(lds, C, l, it >> 2, it & 3);
#endif
            TS(12);
#if USE_MFMA_LRU
            for (int it = bx; it < 1024; it += G) lru_item_mfma(lds, C, l, ((it >> 3) & 1) * 64 + (it >> 4), it & 7);
#else
            for (int it = bx; it < 1024; it += G) lru_item(lds, C, l, it >> 3, it & 7);
#endif
            TS(13);
            }
            const int lane_c = opaque_tid() & 63;
            const int NC0 = (G == 256) ? 0 : IT_WBR + IT_WOUT + IT_WFF1 + IT_WFF2;
            const int NC = IT_WBR + IT_WOUT + IT_WFF1 + IT_WFF2 + (l + 1 < DEPTH ? IT_WIN : 0);
            for (int rep = 0; rep < REP_CONV; ++rep) for (int it = gw + (IT_WBR + IT_WOUT + IT_WFF1 + IT_WFF2 - NC0); it < NC; it += NGW) {
                int r = it;
                if (r < IT_WBR) { conv_w(C, 1, l, r, scr, lane_c); continue; } r -= IT_WBR;
                if (r < IT_WOUT) { conv_w(C, 2, l, r, scr, lane_c); continue; } r -= IT_WOUT;
                if (r < IT_WFF1) { conv_w(C, 3, l, r, scr, lane_c); continue; } r -= IT_WFF1;
                if (r < IT_WFF2) { conv_w(C, 4, l, r, scr, lane_c); continue; } r -= IT_WFF2;
                conv_w(C, 0, l + 1, r, scr, lane_c);
            }
            __syncthreads();
            TS(14);
        }
        BAR(2);
        {
#ifndef SKIP_G2
            pg8::Gemm g{C.o, C.wt_br}; pg8::SchedMerge S; S.t.init(M, D, G, bx, NO, NO);
            pg8::EpiMerge E{C.zg, C.mb};
            for (int rep = 0; rep < REP_G2; ++rep) pg8::gemm_phase<pg8::EpiMerge, pg8::SchedMerge, false, NO, NO, 512>(lds, g, S, E);
#endif

        }
        BAR(3);
        {
#ifndef SKIP_G3
            pg8::Gemm g{C.mb, C.wt_out}; pg8::SchedStd S; S.init(M, D, G, bx, D, D);
            pg8::EpiRes E{C.xb, C.xb, C.ssq, nullptr};
            pg8::gemm_phase<pg8::EpiRes, pg8::SchedStd, true, D, D, D>(lds, g, S, E);
#endif

        }
        BAR(4);
        {
#ifndef SKIP_G4
            pg8::Gemm g{C.xb, C.wt_ff1}; pg8::SchedStd S; S.init(M, FF, G, bx, D, D);
            pg8::EpiFF1 E{C.zg, C.ssq};
            for (int rep = 0; rep < REP_G4; ++rep) pg8::gemm_phase<pg8::EpiFF1, pg8::SchedStd, true, D, D, D>(lds, g, S, E);
#endif

        }
        BAR(5);
        {
#ifndef SKIP_G5
            pg8::Gemm g{C.zg, C.wt_ff2}; pg8::SchedStd S; S.init(M, D, G, bx, FF, FF);
            pg8::EpiRes E{C.xb, C.xb, C.ssq, (l + 1 == DEPTH) ? C.x : nullptr};
            pg8::gemm_phase<pg8::EpiRes, pg8::SchedStd, true, FF, FF, FF>(lds, g, S, E);
#endif

        }
        if (l + 1 < DEPTH) BAR(6);
    }
#if PROBE_KIND >= 0
    if (PROBE_KIND == 6) tacc += __builtin_amdgcn_s_memrealtime() - tprev;
    if (bx == 0 && tid == 0) { const unsigned long long target = tacc * PROBE_MULT, t0 = __builtin_amdgcn_s_memrealtime(); while (__builtin_amdgcn_s_memrealtime() - t0 < target) __builtin_amdgcn_s_sleep(8); }
#endif
}

extern "C" void kernel_launch(void* const* d_in, const int* in_sizes, int n_in, void* d_out, int out_size, void* d_ws, size_t ws_size, hipStream_t stream) {
    static int grid = 0;
    if (grid == 0) {
        if (n_in != 27 || out_size != M * D || ws_size < WS_END) { fprintf(stderr, "kernel_launch: unexpected shapes: n_in %d out %d ws %zu (need %zu)\n", n_in, out_size, ws_size, (size_t)WS_END); grid = -1; return; }
        int dev = 0, cus = 0, per_cu = 0;
        hipGetDevice(&dev); hipDeviceGetAttribute(&cus, hipDeviceAttributeMultiprocessorCount, dev);
        if (hipFuncSetAttribute((const void*)fwd_megakernel, hipFuncAttributeMaxDynamicSharedMemorySize, LDS_BYTES) != hipSuccess) { fprintf(stderr, "kernel_launch: hipFuncSetAttribute failed\n"); grid = -1; return; }
        if (hipOccupancyMaxActiveBlocksPerMultiprocessor(&per_cu, (const void*)fwd_megakernel, 512, LDS_BYTES) != hipSuccess || per_cu < 1) { fprintf(stderr, "kernel_launch: occupancy query says %d\n", per_cu); per_cu = 1; }
        (void)hipGetLastError();
        grid = cus;
        if (grid != 256) fprintf(stderr, "kernel_launch: note: %d CUs\n", grid);
    }
    if (grid < 0) return;
    hipMemsetAsync((char*)d_ws + WS_CTL, 0, CTL_ZERO_BYTES, stream);
    Args a{};
    for (int i = 0; i < 27; ++i) a.in[i] = (const float*)d_in[i];
    a.out = (float*)d_out; a.ws = (unsigned char*)d_ws;
    void* kargs[] = {&a};
    hipError_t e = hipLaunchCooperativeKernel((const void*)fwd_megakernel, dim3(grid), dim3(512), kargs, LDS_BYTES, stream);
    if (e != hipSuccess) fprintf(stderr, "kernel_launch: cooperative launch failed: %s\n", hipGetErrorString(e));
}
```

```cpp
#include <hip/hip_runtime.h>
#include <hip/hip_cooperative_groups.h>
#include <cstdio>
#include <cstdint>
namespace cg = cooperative_groups;

#define LAS __attribute__((address_space(3)))
#define GAS __attribute__((address_space(1)))
typedef unsigned short bf16_t;
typedef short bf16x8 __attribute__((ext_vector_type(8)));
typedef float f32x4 __attribute__((ext_vector_type(4)));
typedef unsigned u32x4 __attribute__((ext_vector_type(4)));
typedef unsigned u32x2 __attribute__((ext_vector_type(2)));

constexpr int M = 16384, D = 1024, DIN = 7424, NZA = 3328, NZG = 4096, FF = 4096, DEPTH = 4, NO = 2048;
constexpr float EPS = 1e-6f;
constexpr size_t MiB = 1u << 20;
constexpr size_t WS_CTL = 0, CTL_ZERO_BYTES = 64 * 1024;
constexpr size_t WS_WIN = 2 * MiB, WS_WBR = 17 * MiB, WS_WOUT = 21 * MiB, WS_WFF1 = 23 * MiB, WS_WFF2 = 31 * MiB, WS_WKV = 39 * MiB;
constexpr size_t WS_MEMN = 47 * MiB, WS_MEMKV = 48 * MiB, WS_SSQ = 52 * MiB, WS_CARRY = 53 * MiB, WS_XB = 54 * MiB;
constexpr size_t WS_ZA = 86 * MiB, WS_S = 86 * MiB, WS_MB = 150 * MiB, WS_ZG = 190 * MiB, WS_O = 318 * MiB, WS_LY = 382 * MiB, WS_LP = 414 * MiB, WS_MEMK = 446 * MiB, WS_MEMVT = 448 * MiB, WS_SPL = 450 * MiB, WS_AGG = 451 * MiB, WS_INC = 453 * MiB, WS_SSV = 455 * MiB, WS_WGT = 456 * MiB, WS_ROPE = 457 * MiB, WS_END = 458 * MiB;
static_assert(WS_ZA + (size_t)M * NZA * 2 <= WS_ZG && WS_MB + (size_t)M * D * 2 <= WS_ZG && WS_WIN + (size_t)DIN * D * 2 <= WS_WBR, "ws map");

constexpr int LDS_BYTES = 147456, MISC_OFF = LDS_BYTES - 256;

__device__ __forceinline__ float bf2f(bf16_t h) { return __uint_as_float((unsigned)h << 16); }
__device__ __forceinline__ unsigned f2bf(float f) { unsigned u = __float_as_uint(f); return (u + 0x7fffu + ((u >> 16) & 1u)) >> 16; }
__device__ __forceinline__ unsigned pk2(float lo, float hi) { return f2bf(lo) | (f2bf(hi) << 16); }
__device__ __forceinline__ unsigned cvt_pk_bf16(float lo, float hi) { unsigned r; asm volatile("v_cvt_pk_bf16_f32 %0, %1, %2" : "=v"(r) : "v"(lo), "v"(hi)); return r; }
#define UNPACK8(VV, f, o) do { (f)[(o) + 0] = __uint_as_float((VV)[0] << 16); (f)[(o) + 1] = __uint_as_float((VV)[0] & 0xffff0000u); (f)[(o) + 2] = __uint_as_float((VV)[1] << 16); (f)[(o) + 3] = __uint_as_float((VV)[1] & 0xffff0000u); \
    (f)[(o) + 4] = __uint_as_float((VV)[2] << 16); (f)[(o) + 5] = __uint_as_float((VV)[2] & 0xffff0000u); (f)[(o) + 6] = __uint_as_float((VV)[3] << 16); (f)[(o) + 7] = __uint_as_float((VV)[3] & 0xffff0000u); } while (0)
#define PACK8(f, o) ((u32x4){cvt_pk_bf16((f)[(o) + 0], (f)[(o) + 1]), cvt_pk_bf16((f)[(o) + 2], (f)[(o) + 3]), cvt_pk_bf16((f)[(o) + 4], (f)[(o) + 5]), cvt_pk_bf16((f)[(o) + 6], (f)[(o) + 7])})
__device__ __forceinline__ float gelu_t(float x) {
    const float c1 = -2.f * 0.7978845608028654f * 1.4426950408889634f, c2 = c1 * 0.044715f;
    return x * __builtin_amdgcn_rcpf(1.f + __builtin_amdgcn_exp2f(x * (c1 + c2 * (x * x)))); }
__device__ __forceinline__ float sigmoid_f(float x) { return __builtin_amdgcn_rcpf(1.f + __expf(-x)); }
__device__ __forceinline__ float row_rstd(const float* ssq, int row) {
    const f32x4* p = (const f32x4*)(ssq + (size_t)row * 16);
    const f32x4 a = p[0], b = p[1], c = p[2], d = p[3];
    const float s = (((a.x + a.y) + (a.z + a.w)) + ((b.x + b.y) + (b.z + b.w))) + (((c.x + c.y) + (c.z + c.w)) + ((d.x + d.y) + (d.z + d.w)));
    return rsqrtf(s * (1.f / 1024.f) + EPS);
}
__device__ __forceinline__ float row_rstd_coop(const float* ssq, int row, int fq) {
    const f32x4 a = *(const f32x4*)(ssq + (size_t)row * 16 + fq * 4);
    float s = (a.x + a.y) + (a.z + a.w);
    s += __shfl_xor(s, 16); s += __shfl_xor(s, 32);
    return rsqrtf(s * (1.f / 1024.f) + EPS);
}
#define LDS_WAIT() asm volatile("s_waitcnt lgkmcnt(0)" ::: "memory")
__device__ __forceinline__ int opaque_tid() { int t = threadIdx.x; asm volatile("" : "+v"(t)); return t; }

namespace pg8 {
constexpr int BM = 256, BK = 64, HALF = 128, HTB = HALF * BK * 2, STAGE_BYTES = 8 * HTB, NXCD = 8, WGM = 8;
__host__ __device__ __forceinline__ int lds_byte(int r, int c) { const int st = (r >> 4) * 2 + (c >> 5), rr = r & 15, cc = c & 31, ob = rr * 64 + cc * 2; return st * 1024 + (ob ^ (((ob >> 9) & 1) << 5)); }
__host__ __device__ __forceinline__ void stage_rc(int b, int& R, int& C) { const int st = b / 1024, sb = b % 1024, swz = sb ^ (((sb >> 9) & 1) << 5); R = (st >> 1) * 16 + swz / 64; C = (st & 1) * 32 + (swz % 64) / 2; }
__host__ __device__ __forceinline__ int perm32(int rho) { const int n = rho >> 4, i = rho & 15; return 8 * (i >> 2) + 4 * n + (i & 3); }

struct Unit { int pm, pn, b; };
struct Gemm { const bf16_t* A; const bf16_t* Bt; };

struct SchedStd {
    int nM, nN, nwg, G, c; size_t as, bs;
    __device__ void init(int M_, int N_, int G_, int c_, int lda, int ldb) { nM = M_ / BM; nN = N_ / BM; nwg = nM * nN; G = G_; c = c_; as = (size_t)BM * lda * 2; bs = (size_t)BM * ldb * 2; }
    __device__ bool tile(long L, Unit& u) const {
        if (L >= nwg) return false;
        int wgid = (int)L; { const int q = nwg / NXCD, r = nwg % NXCD, xcd = wgid % NXCD, off = wgid / NXCD; wgid = (xcd < r ? xcd * (q + 1) : r * (q + 1) + (xcd - r) * q) + off; }
        const int nig = WGM * nN, gid = wgid / nig, fm = gid * WGM, gsz = (nM - fm) < WGM ? (nM - fm) : WGM;
        u.pm = fm + ((wgid % nig) % gsz); u.pn = (wgid % nig) / gsz; u.b = 0; return true;
    }
    __device__ bool next(int i, Unit& u) const { return tile((long)i * G + c, u); }
    __device__ size_t aoff(const Unit& u) const { return (size_t)u.pm * as; }
    __device__ size_t boff(const Unit& u) const { return (size_t)u.pn * bs; }
};
struct SchedMerge {
    SchedStd t;
    __device__ bool next(int i, Unit& u) const { if (!t.tile((long)(i >> 2) * t.G + t.c, u)) return false; u.b = i & 3; return true; }
    __device__ size_t aoff(const Unit& u) const { return (size_t)u.pm * t.as + (size_t)u.b * 1024; }
    __device__ size_t boff(const Unit& u) const { return (size_t)u.pn * t.bs + (size_t)u.b * 1024; }
};
struct SchedKV {
    int c;
    __device__ bool next(int i, Unit& u) const { if (i > 0 || c >= 32) return false; u.b = c >> 3; u.pm = (c & 7) >> 2; u.pn = c & 3; return true; }
    __device__ size_t aoff(const Unit& u) const { return (size_t)u.pm * 256 * 1024 * 2; }
    __device__ size_t boff(const Unit& u) const { return ((size_t)u.b * 1024 + (size_t)u.pn * 256) * 1024 * 2; }
};

struct EpiZ {
    static constexpr bool PERM = true, KEEPS = false;
    bf16_t* za; bf16_t* zg; const float* ssq; const float* bgate; float* ssv;
    __device__ __forceinline__ void operator()(const f32x4 (&acc)[2][2][4][2], const Unit& u, int wr, int wc, int fr, int fq) const {
        const int row0 = u.pm * BM + wr * 64 + fr, pn = u.pn;
        bf16_t* base; int ldc, colt, mode;
        if (pn < 13) { base = za; ldc = NZA; colt = pn * 256; mode = (pn < 4 || pn == 6 || pn == 7) ? 1 : 0; }
        else { base = zg; ldc = NZG; colt = (pn - 13) * 256; mode = 2; }
        const int col0 = colt + wc * 32 + 8 * fq;
        const int d0 = 64 * (pn - 13) + 16 * wc + 4 * fq;
        f32x4 bv[2][2];
#pragma unroll
        for (int bj = 0; bj < 2; ++bj)
#pragma unroll
            for (int n = 0; n < 2; ++n) bv[bj][n] = (mode == 2) ? *(const f32x4*)(bgate + (2 * bj + n) * 1024 + d0) : (f32x4){0.f, 0.f, 0.f, 0.f};
        float rsa[2][4];
#pragma unroll
        for (int ai = 0; ai < 2; ++ai)
#pragma unroll
            for (int m = 0; m < 4; ++m) rsa[ai][m] = row_rstd_coop(ssq, row0 + ai * HALF + m * 16, fq);
        asm volatile("" ::: "memory");
#pragma unroll
        for (int ai = 0; ai < 2; ++ai) {
#pragma unroll
            for (int m = 0; m < 4; ++m) {
                const int row = row0 + ai * HALF + m * 16; const float rs = rsa[ai][m]; float vss = 0.f;
                bf16_t* rowp = base + (size_t)row * ldc + col0;
                if (mode == 2) {
                    f32x4 sden[4];
#pragma unroll
                    for (int b2 = 0; b2 < 4; ++b2) { const f32x4 zv = acc[ai][b2 >> 1][m][b2 & 1] * (rs * -1.4426950408889634f) + bv[b2 >> 1][b2 & 1] * -1.4426950408889634f;
#pragma unroll
                        for (int e = 0; e < 4; ++e) sden[b2][e] = 1.f + __builtin_amdgcn_exp2f(fminf(zv[e], 66.f)); }
#pragma unroll
                    for (int b2 = 0; b2 < 4; ++b2) { f32x4 rv;
#pragma unroll
                        for (int e = 0; e < 4; ++e) { const float ig = __builtin_amdgcn_rcpf(sden[b2][e]); rv[e] = (b2 < 3) ? sden[b2 + 1][e] * ig : ig; }
                        *(u32x2*)(zg + (size_t)row * NZG + b2 * 1024 + d0) = (u32x2){cvt_pk_bf16(rv[0], rv[1]), cvt_pk_bf16(rv[2], rv[3])}; }
                    continue;
                }
#pragma unroll
                for (int bj = 0; bj < 2; ++bj) {
                    f32x4 v0 = acc[ai][bj][m][0] * rs, v1 = acc[ai][bj][m][1] * rs;
                    if (mode == 1) {
#pragma unroll
                        for (int e = 0; e < 4; ++e) { v0[e] = gelu_t(v0[e]); v1[e] = gelu_t(v1[e]); }
                    } else if (mode == 2) {
                        v0 = v0 + bv[bj][0]; v1 = v1 + bv[bj][1];
#pragma unroll
                        for (int e = 0; e < 4; ++e) { v0[e] = sigmoid_f(v0[e]); v1[e] = sigmoid_f(v1[e]); }
                    }
                    u32x4 w; w.x = cvt_pk_bf16(v0[0], v0[1]); w.y = cvt_pk_bf16(v0[2], v0[3]); w.z = cvt_pk_bf16(v1[0], v1[1]); w.w = cvt_pk_bf16(v1[2], v1[3]);
                    *(u32x4*)(rowp + bj * HALF) = w;
                    if (pn == 2 || pn == 3) vss += (v0[0] * v0[0] + v0[1] * v0[1]) + (v0[2] * v0[2] + v0[3] * v0[3]) + (v1[0] * v1[0] + v1[1] * v1[1]) + (v1[2] * v1[2] + v1[3] * v1[3]);
                }
                if (pn == 2 || pn == 3) { vss += __shfl_xor(vss, 16); vss += __shfl_xor(vss, 32); if (fq == 0) ssv[(size_t)row * 8 + (pn - 2) * 4 + wc] = vss; }
            }
            asm volatile("" ::: "memory");
        }
    }
};
struct EpiFF1 {
    static constexpr bool PERM = true, KEEPS = false;
    bf16_t* f; const float* ssq;
    __device__ __forceinline__ void operator()(const f32x4 (&acc)[2][2][4][2], const Unit& u, int wr, int wc, int fr, int fq) const {
        const int row0 = u.pm * BM + wr * 64 + fr, col0 = u.pn * BM + wc * 32 + 8 * fq;
        float rsa[2][4];
#pragma unroll
        for (int ai = 0; ai < 2; ++ai)
#pragma unroll
            for (int m = 0; m < 4; ++m) rsa[ai][m] = row_rstd_coop(ssq, row0 + ai * HALF + m * 16, fq);
        asm volatile("" ::: "memory");
#pragma unroll
        for (int ai = 0; ai < 2; ++ai) {
#pragma unroll
            for (int m = 0; m < 4; ++m) {
                const int row = row0 + ai * HALF + m * 16; const float rs = rsa[ai][m];
                bf16_t* rowp = f + (size_t)row * FF + col0;
#pragma unroll
                for (int bj = 0; bj < 2; ++bj) {
                    f32x4 v0 = acc[ai][bj][m][0] * rs, v1 = acc[ai][bj][m][1] * rs;
#pragma unroll
                    for (int e = 0; e < 4; ++e) { const float a = fmaxf(v0[e], 0.f), b = fmaxf(v1[e], 0.f); v0[e] = a * a; v1[e] = b * b; }
                    u32x4 w; w.x = cvt_pk_bf16(v0[0], v0[1]); w.y = cvt_pk_bf16(v0[2], v0[3]); w.z = cvt_pk_bf16(v1[0], v1[1]); w.w = cvt_pk_bf16(v1[2], v1[3]);
                    *(u32x4*)(rowp + bj * HALF) = w;
                }
            }
            asm volatile("" ::: "memory");
        }
    }
};
struct EpiRes {
    static constexpr bool PERM = true, KEEPS = false;
    const bf16_t* xin; bf16_t* xb; float* ssq; float* xout;
    __device__ __forceinline__ void operator()(const f32x4 (&acc)[2][2][4][2], const Unit& u, int wr, int wc, int fr, int fq) const {
        const int row0 = u.pm * BM + wr * 64 + fr, col0 = u.pn * BM + wc * 32 + 8 * fq;
#pragma unroll
        for (int ai = 0; ai < 2; ++ai) {
            u32x4 xo[4][2];
#pragma unroll
            for (int m = 0; m < 4; ++m)
#pragma unroll
                for (int bj = 0; bj < 2; ++bj) xo[m][bj] = *(const u32x4*)(xin + (size_t)(row0 + ai * HALF + m * 16) * D + col0 + bj * HALF);
            asm volatile("" ::: "memory");
#pragma unroll
            for (int m = 0; m < 4; ++m) {
                const int row = row0 + ai * HALF + m * 16; float ss = 0.f;
#pragma unroll
                for (int bj = 0; bj < 2; ++bj) {
                    float xf[8]; UNPACK8(xo[m][bj], xf, 0);
                    const f32x4 v0 = (f32x4){xf[0], xf[1], xf[2], xf[3]} + acc[ai][bj][m][0], v1 = (f32x4){xf[4], xf[5], xf[6], xf[7]} + acc[ai][bj][m][1];
                    ss += (v0[0] * v0[0] + v0[1] * v0[1]) + (v0[2] * v0[2] + v0[3] * v0[3]) + (v1[0] * v1[0] + v1[1] * v1[1]) + (v1[2] * v1[2] + v1[3] * v1[3]);
                    u32x4 w; w.x = cvt_pk_bf16(v0[0], v0[1]); w.y = cvt_pk_bf16(v0[2], v0[3]); w.z = cvt_pk_bf16(v1[0], v1[1]); w.w = cvt_pk_bf16(v1[2], v1[3]);
                    *(u32x4*)(xb + (size_t)row * D + col0 + bj * HALF) = w;
                    if (xout) { float* xp = xout + (size_t)row * D + col0 + bj * HALF; *(f32x4*)xp = v0; *(f32x4*)(xp + 4) = v1; }
                }
                ss += __shfl_xor(ss, 16); ss += __shfl_xor(ss, 32);
                if (fq == 0) ssq[(size_t)row * 16 + u.pn * 4 + wc] = ss;
            }
            asm volatile("" ::: "memory");
        }
    }
};
struct EpiMerge {
    static constexpr bool PERM = true, KEEPS = true;
    const bf16_t* zg; bf16_t* mb;
    __device__ __forceinline__ bool merge(f32x4 (&acc)[2][2][4][2], const Unit& u, int wr, int wc, int fr, int fq) const {
        const int row0 = u.pm * BM + wr * 64 + fr, col0 = u.pn * BM + wc * 32 + 8 * fq, b = u.b;
        u32x4 ga[2][4][2];
#pragma unroll
        for (int ai = 0; ai < 2; ++ai)
#pragma unroll
            for (int m = 0; m < 4; ++m)
#pragma unroll
                for (int bj = 0; bj < 2; ++bj) ga[ai][m][bj] = *(const u32x4*)(zg + (size_t)(row0 + ai * HALF + m * 16) * NZG + b * 1024 + col0 + bj * HALF);
        asm volatile("" ::: "memory");
#pragma unroll
        for (int ai = 0; ai < 2; ++ai) {
#pragma unroll
            for (int m = 0; m < 4; ++m) {
                const int row = row0 + ai * HALF + m * 16;
#pragma unroll
                for (int bj = 0; bj < 2; ++bj) {
                    const int col = col0 + bj * HALF;
                    float g[8]; UNPACK8(ga[ai][m][bj], g, 0);
#pragma unroll
                    for (int e = 0; e < 4; ++e) { acc[ai][bj][m][0][e] *= g[e]; acc[ai][bj][m][1][e] *= g[4 + e]; }
                    if (b == 3) { const f32x4 v0 = acc[ai][bj][m][0], v1 = acc[ai][bj][m][1];
                        u32x4 w; w.x = cvt_pk_bf16(v0[0], v0[1]); w.y = cvt_pk_bf16(v0[2], v0[3]); w.z = cvt_pk_bf16(v1[0], v1[1]); w.w = cvt_pk_bf16(v1[2], v1[3]);
                        *(u32x4*)(mb + (size_t)row * D + col) = w; }
                }
            }
        }
        asm volatile("" ::: "memory");
        return b < 3;
    }
};
struct EpiKV {
    static constexpr bool PERM = true, KEEPS = false;
    bf16_t* out;
    __device__ __forceinline__ void operator()(const f32x4 (&acc)[2][2][4][2], const Unit& u, int wr, int wc, int fr, int fq) const {
        const int row0 = u.pm * BM + wr * 64 + fr, col0 = u.pn * BM + wc * 32 + 8 * fq;
        bf16_t* base = out + (size_t)u.b * 512 * 1024;
#pragma unroll
        for (int ai = 0; ai < 2; ++ai)
#pragma unroll
            for (int m = 0; m < 4; ++m) {
                const int row = row0 + ai * HALF + m * 16;
#pragma unroll
                for (int bj = 0; bj < 2; ++bj) {
                    const f32x4 v0 = acc[ai][bj][m][0], v1 = acc[ai][bj][m][1];
                    u32x4 w; w.x = cvt_pk_bf16(v0[0], v0[1]); w.y = cvt_pk_bf16(v0[2], v0[3]); w.z = cvt_pk_bf16(v1[0], v1[1]); w.w = cvt_pk_bf16(v1[2], v1[3]);
                    *(u32x4*)(base + (size_t)row * 1024 + col0 + bj * HALF) = w;
                }
            }
    }
};

template <class Epi, class Sched, bool ALIGN_EPI, int LDA, int LDB, int KK>
__device__ __forceinline__ void gemm_phase(LAS unsigned char* lds, const Gemm g, const Sched& S, const Epi& E) {
    const int tid = opaque_tid(), wid = __builtin_amdgcn_readfirstlane(tid >> 6), lane = tid & 63, wr = wid >> 2, wc = wid & 3, fr = lane & 15, fq = lane >> 4;
    constexpr int nt = KK / BK;
    unsigned voffA[2], voffB[2];
#pragma unroll
    for (int i = 0; i < 2; ++i) { int R, C; stage_rc(tid * 16 + i * 8192, R, C); const int Rb = Epi::PERM ? ((R & ~31) + perm32(R & 31)) : R;
        voffA[i] = (unsigned)(R * LDA + C) * 2u; voffB[i] = (unsigned)(Rb * LDB + C) * 2u; }
    constexpr size_t kstep = (size_t)(BK * 2);
    constexpr size_t hstepA = (size_t)HALF * LDA * 2, hstepB = (size_t)HALF * LDB * 2;
    const unsigned ldsw = (unsigned)wid * 1024u;
    const int aoff = lds_byte(wr * 64 + fr, fq * 8), boff = lds_byte(wc * 32 + fr, fq * 8);
#define PG8_SA(b, h) (((b) * 2 + (h)) * HTB)
#define PG8_SB(b, h) ((4 + (b) * 2 + (h)) * HTB)
#define PG8_STAGE(bufoff, gbase, voff) do { _Pragma("unroll") for (int _i = 0; _i < 2; ++_i) \
        __builtin_amdgcn_global_load_lds((const unsigned*)((const char*)(gbase) + (voff)[_i]), (LAS unsigned*)(lds + (bufoff) + ldsw + _i * 8192), 16, 0, 0); } while (0)
#define PG8_LDA(dst, b, h) do { _Pragma("unroll") for (int m = 0; m < 4; ++m) _Pragma("unroll") for (int k = 0; k < 2; ++k) dst[m][k] = *(const LAS bf16x8*)(lds + PG8_SA(b, h) + aoff + m * 2048 + k * 1024); } while (0)
#define PG8_LDB(dst, b, h) do { _Pragma("unroll") for (int n = 0; n < 2; ++n) _Pragma("unroll") for (int k = 0; k < 2; ++k) dst[n][k] = *(const LAS bf16x8*)(lds + PG8_SB(b, h) + boff + n * 2048 + k * 1024); } while (0)
#define PG8_MMA(ai, bj, At, Bt) do { __builtin_amdgcn_s_setprio(1); _Pragma("unroll") for (int m = 0; m < 4; ++m) _Pragma("unroll") for (int n = 0; n < 2; ++n) _Pragma("unroll") for (int k = 0; k < 2; ++k) \
        acc[ai][bj][m][n] = __builtin_amdgcn_mfma_f32_16x16x32_bf16(Bt[n][k], At[m][k], acc[ai][bj][m][n], 0, 0, 0); __builtin_amdgcn_s_setprio(0); } while (0)
#define PG8_WAIT_V(n) asm volatile("s_waitcnt vmcnt(" #n ")" ::: "memory")
#define PG8_WAIT_L(n) asm volatile("s_waitcnt lgkmcnt(" #n ")" ::: "memory")
#define PG8_BAR __builtin_amdgcn_s_barrier()
#define PG8_SCHED __builtin_amdgcn_sched_barrier(0)
    Unit cur, nxt; int ui = 0;
    if (!S.next(0, cur)) return;
    f32x4 acc[2][2][4][2];
#pragma unroll
    for (int a = 0; a < 2; ++a)
#pragma unroll
        for (int b = 0; b < 2; ++b)
#pragma unroll
            for (int m = 0; m < 4; ++m)
#pragma unroll
                for (int n = 0; n < 2; ++n) acc[a][b][m][n] = (f32x4){0.f, 0.f, 0.f, 0.f};
    bf16x8 At[4][2], B0[2][2], B1[2][2];
    const char* gA = (const char*)g.A; const char* gB = (const char*)g.Bt;
    asm volatile("" : "+s"(gA), "+s"(gB));
    const char* cA = gA + S.aoff(cur); const char* cB = gB + S.boff(cur);
    PG8_STAGE(PG8_SB(0, 0), cB, voffB); PG8_STAGE(PG8_SB(0, 1), cB + hstepB, voffB); PG8_STAGE(PG8_SA(0, 0), cA, voffA); PG8_STAGE(PG8_SA(0, 1), cA + hstepA, voffA);
    if (wr == 1) PG8_BAR;
    PG8_WAIT_V(2); PG8_BAR;
    PG8_STAGE(PG8_SB(1, 0), cB + kstep, voffB); PG8_STAGE(PG8_SA(1, 0), cA + kstep, voffA); PG8_STAGE(PG8_SB(1, 1), cB + hstepB + kstep, voffB);
    PG8_WAIT_V(6); PG8_BAR;
    for (;;) {
        const bool has_next = S.next(ui + 1, nxt);
        const char* nA = has_next ? gA + S.aoff(nxt) : cA; const char* nB = has_next ? gB + S.boff(nxt) : cB;
        for (int t = 0; t < nt; t += 2) {
            const bool last = (t == nt - 2);
            const char* a1 = cA + (size_t)(t + 1) * kstep;
            const char* a2 = last ? nA : cA + (size_t)(t + 2) * kstep; const char* b2 = last ? nB : cB + (size_t)(t + 2) * kstep;
            const char* a3 = a2 + kstep; const char* b3 = b2 + kstep;
            PG8_LDB(B0, 0, 0); PG8_LDB(B1, 0, 1); PG8_SCHED; PG8_LDA(At, 0, 0); PG8_STAGE(PG8_SA(1, 1), a1 + hstepA, voffA);
            PG8_WAIT_V(8); PG8_WAIT_L(0); PG8_BAR; PG8_MMA(0, 0, At, B0); PG8_MMA(0, 1, At, B1); PG8_BAR; PG8_SCHED;
            PG8_LDA(At, 0, 1); PG8_STAGE(PG8_SB(0, 0), b2, voffB); PG8_STAGE(PG8_SB(0, 1), b2 + hstepB, voffB); PG8_STAGE(PG8_SA(0, 0), a2, voffA);
            PG8_WAIT_V(8); PG8_WAIT_L(0); PG8_BAR; PG8_MMA(1, 0, At, B0); PG8_MMA(1, 1, At, B1); PG8_BAR; PG8_SCHED;
            PG8_LDB(B0, 1, 0); PG8_LDB(B1, 1, 1); PG8_SCHED; PG8_LDA(At, 1, 0); PG8_STAGE(PG8_SA(0, 1), a2 + hstepA, voffA);
            PG8_WAIT_V(8); PG8_WAIT_L(0); PG8_BAR; PG8_MMA(0, 0, At, B0); PG8_MMA(0, 1, At, B1); PG8_BAR; PG8_SCHED;
            PG8_LDA(At, 1, 1); PG8_STAGE(PG8_SB(1, 0), b3, voffB); PG8_STAGE(PG8_SB(1, 1), b3 + hstepB, voffB); PG8_STAGE(PG8_SA(1, 0), a3, voffA);
            PG8_WAIT_V(8); PG8_WAIT_L(0); PG8_BAR; PG8_MMA(1, 0, At, B0); PG8_MMA(1, 1, At, B1); PG8_BAR; PG8_SCHED;
        }
        if constexpr (ALIGN_EPI) { if (wr == 0) PG8_BAR; }
        bool keep = false;
        if constexpr (Epi::KEEPS) keep = E.merge(acc, cur, wr, wc, fr, fq); else E(acc, cur, wr, wc, fr, fq);
        if (!has_next) break;
        if (!keep)
#pragma unroll
        for (int a = 0; a < 2; ++a)
#pragma unroll
            for (int b = 0; b < 2; ++b)
#pragma unroll
                for (int m = 0; m < 4; ++m)
#pragma unroll
                    for (int n = 0; n < 2; ++n) acc[a][b][m][n] = (f32x4){0.f, 0.f, 0.f, 0.f};
        cur = nxt; cA = nA; cB = nB; ++ui;
        if constexpr (ALIGN_EPI) { if (wr == 1) PG8_BAR; }
    }
    PG8_WAIT_V(0);
    if constexpr (!ALIGN_EPI) { if (wr == 0) PG8_BAR; }
    PG8_BAR;
#undef PG8_SA
#undef PG8_SB
#undef PG8_STAGE
#undef PG8_LDA
#undef PG8_LDB
#undef PG8_MMA
#undef PG8_WAIT_V
#undef PG8_WAIT_L
#undef PG8_BAR
#undef PG8_SCHED
}
}

#define XB_TMO      128
#define XB_XCNT(j)  (256  + 64 * (j))
#define XB_XSUB(j)  (1280 + 64 * (j))
#define XB_XGEN(j)  (2304 + 64 * (j))
#define XB_TOP      3328
#define XB_TOPGEN   3392
#define XCD_BAR_WORDS 3456
#define XB_SPIN_CAP (1u << 23)
__device__ __forceinline__ unsigned xb_ld(unsigned* p)              { return __hip_atomic_load(p, __ATOMIC_RELAXED, __HIP_MEMORY_SCOPE_AGENT); }
__device__ __forceinline__ unsigned xb_add(unsigned* p, unsigned v) { return __hip_atomic_fetch_add(p, v, __ATOMIC_RELAXED, __HIP_MEMORY_SCOPE_AGENT); }
__device__ __forceinline__ unsigned xb_xcc_id() { return (unsigned)__builtin_amdgcn_s_getreg((3 << 11) | 20) & 0xFu; }
#define XB_SPIN(cond, bar) do { unsigned _sp = 0; while (cond) { __builtin_amdgcn_s_sleep(1); \
    if ((++_sp & 255u) == 0u) { if (xb_ld(&(bar)[XB_TMO])) break; if (_sp > XB_SPIN_CAP) { atomicAdd(&(bar)[XB_TMO], 1u); break; } } } } while (0)
struct XcdBarrier { unsigned* bar; unsigned x; volatile LAS unsigned* st; };
__device__ __forceinline__ XcdBarrier xcd_barrier_post(unsigned* bar, volatile LAS unsigned* st) {
    XcdBarrier b; b.bar = bar; b.x = xb_xcc_id(); b.st = st;
    if (threadIdx.x == 0) (void)xb_add(&bar[XB_XCNT(b.x)], 1u);
    return b;
}
__device__ __forceinline__ void xcd_barrier_complete(unsigned* bar, unsigned x, unsigned& nloc, unsigned& nx) {
    const unsigned G = gridDim.x * gridDim.y * gridDim.z;
    unsigned sum, cnt, mine, sp = 0u;
    for (;;) {
        sum = 0u; cnt = 0u; mine = 0u;
#pragma unroll
        for (unsigned j = 0; j < 16; ++j) { const unsigned c = xb_ld(&bar[XB_XCNT(j)]); sum += c; cnt += (c > 0u) ? 1u : 0u; mine = (j == x) ? c : mine; }
        if (sum == G) break;
        __builtin_amdgcn_s_sleep(1);
        if ((++sp & 255u) == 0u) { if (xb_ld(&bar[XB_TMO])) break; if (sp > XB_SPIN_CAP) { atomicAdd(&bar[XB_TMO], 1u); break; } }
    }
    nloc = mine > 0u ? mine : 1u; nx = cnt > 0u ? cnt : 1u;
}
__device__ __forceinline__ void xcd_barrier(const XcdBarrier& b) {
    asm volatile("s_waitcnt vmcnt(0)" ::: "memory");
    __syncthreads();
    if (threadIdx.x == 0) {
        unsigned* bar = b.bar;
        asm volatile("" : "+s"(bar));
        __builtin_amdgcn_s_waitcnt(0);
        unsigned nloc = b.st[0], nx = b.st[1];
        const unsigned bxcc = xb_xcc_id();
        if (nloc == 0u) { xcd_barrier_complete(bar, bxcc, nloc, nx); b.st[0] = nloc; b.st[1] = nx; }
        const unsigned old = xb_add(&bar[XB_XSUB(bxcc)], 1u);
        const unsigned gen = old / nloc;
        if (old + 1u == (gen + 1u) * nloc) {
            __builtin_amdgcn_fence(__ATOMIC_RELEASE, "agent");
            asm volatile("s_waitcnt vmcnt(0)" ::: "memory");
            const unsigned og = xb_add(&bar[XB_TOP], 1u);
            const unsigned tg = og / nx;
            if (og + 1u == (tg + 1u) * nx) xb_add(&bar[XB_TOPGEN], 1u);
            else XB_SPIN(xb_ld(&bar[XB_TOPGEN]) == tg, bar);
            __builtin_amdgcn_fence(__ATOMIC_ACQUIRE, "agent");
            xb_add(&bar[XB_XGEN(bxcc)], 1u);
            asm volatile("s_waitcnt vmcnt(0)" ::: "memory");
        } else {
            XB_SPIN(xb_ld(&bar[XB_XGEN(bxcc)]) == gen, bar);
            __builtin_amdgcn_fence(__ATOMIC_ACQUIRE, "agent");
            asm volatile("s_waitcnt vmcnt(0)" ::: "memory");
        }
    }
    __syncthreads();
}

struct Args { const float* in[27]; float* out; unsigned char* ws; };
enum { I_X = 0, I_MEM, I_NMIX, I_NMEM, I_NMLP, I_WIN, I_BGATE, I_GMVG, I_GMWS, I_GMBS, I_CONVW, I_CONVB, I_WR, I_BR, I_WI, I_BI, I_LAM, I_SQG, I_SKG, I_SINK, I_WKV, I_XQG, I_XKG, I_WBR, I_WOUT, I_WFF1, I_WFF2 };
struct Ctx {
    const float* const* in; float* x;
    bf16_t *wt_in, *wt_br, *wt_out, *wt_ff1, *wt_ff2, *wt_kv, *memn, *memkv, *xb, *za, *zg, *mb, *o;
    float *ssq, *carryA, *carryH, *S, *ly, *lp;
    bf16_t *memK, *memVt;
    float* spl;
    float* rope;
    float* ssv;
    bf16_t* wgT;
    unsigned long long *agg, *inc;
};

__device__ __forceinline__ int win_row(int n) {
    if (n < NZA) return n;
    const int ng = n - NZA, b = ng >> 10, d = ng & 1023, q = d >> 6, dc = d & 63;
    return NZA + q * 256 + 128 * (b >> 1) + 32 * (dc >> 4) + 8 * ((dc >> 2) & 3) + 4 * (b & 1) + (dc & 3);
}
template <bool GATEPERM>
__device__ __forceinline__ void transpose_item(const float* W, int N, bf16_t* WT, int ldk, int koff, const float* gain, LAS float* scr, int item, int lane) {
    const int nblk = N / 32, kb = item / nblk, nb = item % nblk, k0 = 64 * kb, n0 = 32 * nb;
    float v[32];
    const float* wp = W + (size_t)(k0 + (lane >> 5)) * N + n0 + (lane & 31);
#pragma unroll
    for (int i = 0; i < 32; ++i) v[i] = wp[(size_t)(2 * i) * N];
    if (gain) {
#pragma unroll
        for (int i = 0; i < 32; ++i) v[i] *= gain[k0 + 2 * i + (lane >> 5)];
    }
#pragma unroll
    for (int i = 0; i < 32; ++i) scr[(2 * i + (lane >> 5)) * 33 + (lane & 31)] = v[i];
    LDS_WAIT(); asm volatile("" ::: "memory");
    const int c = lane & 7;
#pragma unroll
    for (int j = 0; j < 4; ++j) { const int n = (lane >> 3) + 8 * j; const LAS float* s = scr + (8 * c) * 33 + n;
        u32x4 o; o.x = cvt_pk_bf16(s[0 * 33], s[1 * 33]); o.y = cvt_pk_bf16(s[2 * 33], s[3 * 33]); o.z = cvt_pk_bf16(s[4 * 33], s[5 * 33]); o.w = cvt_pk_bf16(s[6 * 33], s[7 * 33]);
        *(u32x4*)(WT + (size_t)(GATEPERM ? win_row(n0 + n) : n0 + n) * ldk + koff + k0 + 8 * c) = o; }
    LDS_WAIT(); asm volatile("" ::: "memory");
}
__device__ __forceinline__ float wave_sum(float v) {
#pragma unroll
    for (int o = 1; o < 64; o <<= 1) v += __shfl_xor(v, o);
    return v;
}
__device__ __forceinline__ void conv_w(const Ctx& C, int which, int l, int item, LAS float* scr, int lane) {
    if (which == 0) transpose_item<true>(C.in[I_WIN] + (size_t)l * D * DIN, DIN, C.wt_in, D, 0, C.in[I_NMIX] + l * D, scr, item, lane);
    else if (which == 1) { const int b = item >> 8; transpose_item<false>(C.in[I_WBR] + (size_t)(l * 4 + b) * 512 * D, D, C.wt_br, 2048, b * 512, nullptr, scr, item & 255, lane); }
    else if (which == 2) transpose_item<false>(C.in[I_WOUT] + (size_t)l * D * D, D, C.wt_out, D, 0, nullptr, scr, item, lane);
    else if (which == 3) transpose_item<false>(C.in[I_WFF1] + (size_t)l * D * FF, FF, C.wt_ff1, D, 0, C.in[I_NMLP] + l * D, scr, item, lane);
    else if (which == 4) transpose_item<false>(C.in[I_WFF2] + (size_t)l * FF * D, D, C.wt_ff2, FF, 0, nullptr, scr, item, lane);
    else transpose_item<false>(C.in[I_WKV] + (size_t)l * D * D, D, C.wt_kv + (size_t)l * D * D, D, 0, C.in[I_NMEM] + l * D, scr, item, lane);
}
constexpr int IT_WIN = 16 * 232, IT_WBR = 1024, IT_WOUT = 512, IT_WFF1 = 2048, IT_WFF2 = 2048, IT_WKV = 512;

#ifndef REP_SWA
#define REP_SWA 1
#endif
#ifndef REP_XA
#define REP_XA 1
#endif
#ifndef REP_GM
#define REP_GM 1
#endif
#ifndef REP_LRU
#define REP_LRU 1
#endif
#ifndef REP_CONV
#define REP_CONV 1
#endif
#ifndef REP_FIX
#define REP_FIX 1
#endif
#ifndef REP_G1
#define REP_G1 1
#endif
#ifndef REP_G2
#define REP_G2 1
#endif
#ifndef REP_G4
#define REP_G4 1
#endif
#ifndef REP_G3
#define REP_G3 1
#endif
#ifndef REP_G5
#define REP_G5 1
#endif
#ifndef REP_MIX
#define REP_MIX 1
#endif
#ifndef REP_BAR
#define REP_BAR 1
#endif
#ifndef USE_MFMA_SWA
#define USE_MFMA_SWA 1
#endif
#ifndef USE_MFMA_XA
#define USE_MFMA_XA 1
#endif
#ifndef USE_MFMA_GM
#define USE_MFMA_GM 1
#endif
#ifndef USE_MFMA_LRU
#define USE_MFMA_LRU 1
#endif
#define ROPE_INV(i) ((i) == 0 ? 1.0f : (i) == 1 ? 0.19392274474868576f : (i) == 2 ? 0.03760603093086393f : (i) == 3 ? 0.007292664737217109f : (i) == 4 ? 0.001414213562373095f : (i) == 5 ? 0.0002742481756762073f : (i) == 6 ? 5.318295896944988e-05f : 1.031338537721246e-05f)
#define ROPE16T(f, tab) do { _Pragma("unroll") for (int _i = 0; _i < 4; ++_i) { const f32x4 _cs = ((const f32x4*)(tab))[_i]; \
    { const float _x1 = (f)[2 * _i], _x2 = (f)[2 * _i + 8]; (f)[2 * _i] = _x1 * _cs[0] - _x2 * _cs[1]; (f)[2 * _i + 8] = _x2 * _cs[0] + _x1 * _cs[1]; } \
    { const float _x1 = (f)[2 * _i + 1], _x2 = (f)[2 * _i + 9]; (f)[2 * _i + 1] = _x1 * _cs[2] - _x2 * _cs[3]; (f)[2 * _i + 9] = _x2 * _cs[2] + _x1 * _cs[3]; } } } while (0)
#define ROPE16(f, pos) do { _Pragma("unroll") for (int _i = 0; _i < 8; ++_i) { float _s, _c; sincosf((pos) * ROPE_INV(_i), &_s, &_c); const float _x1 = (f)[_i], _x2 = (f)[_i + 8]; (f)[_i] = _x1 * _c - _x2 * _s; (f)[_i + 8] = _x2 * _c + _x1 * _s; } } while (0)

__device__ __forceinline__ void swa_item(LAS unsigned char* lds, const Ctx& C, int l, int tile, int h) {
    const int tid = opaque_tid();
    LAS bf16_t* Ks = (LAS bf16_t*)lds;
    LAS bf16_t* Vs = Ks + 256 * 72;
    const int kvh = h >> 2, nb = tile & 63, row0 = tile * 128;
    {
        const int key = tid >> 1, half = tid & 1;
        const bool ok = (nb > 0) || (key >= 128);
        const size_t grow = (size_t)(ok ? row0 - 128 + key : row0);
        const u32x4* kp = (const u32x4*)(C.za + grow * NZA + 2560 + kvh * 64 + half * 32);
        const u32x4* vp = (const u32x4*)(C.za + grow * NZA + 2688 + kvh * 64 + half * 32);
        float kf[32]; float ss = 0.f;
#pragma unroll
        for (int i = 0; i < 4; ++i) { const u32x4 w = kp[i]; UNPACK8(w, kf, 8 * i); }
#pragma unroll
        for (int i = 0; i < 32; ++i) ss += kf[i] * kf[i];
        ss += __shfl_xor(ss, 1);
        const float rs = rsqrtf(ss * (1.f / 64.f) + EPS);
        const float* kg = C.in[I_SKG] + l * 64 + half * 32;
#pragma unroll
        for (int i = 0; i < 32; ++i) kf[i] *= rs * kg[i];
        if (half == 0) { const float pos = (float)(nb * 128 - 128 + key); ROPE16(kf, pos); }
#pragma unroll
        for (int i = 0; i < 4; ++i) { *(LAS u32x4*)(Ks + key * 72 + half * 32 + 8 * i) = PACK8(kf, 8 * i); *(LAS u32x4*)(Vs + key * 72 + half * 32 + 8 * i) = vp[i]; }
    }
    const int q = tid >> 2, sub = tid & 3;
    float qf[16];
    {
        const u32x4* qp = (const u32x4*)(C.za + (size_t)(row0 + q) * NZA + 2048 + h * 64 + sub * 16);
        const u32x4 w0 = qp[0], w1 = qp[1]; UNPACK8(w0, qf, 0); UNPACK8(w1, qf, 8);
        float ss = 0.f;
#pragma unroll
        for (int i = 0; i < 16; ++i) ss += qf[i] * qf[i];
        ss += __shfl_xor(ss, 1); ss += __shfl_xor(ss, 2);
        const float rs = rsqrtf(ss * (1.f / 64.f) + EPS);
        const float* qg = C.in[I_SQG] + l * 64 + sub * 16;
#pragma unroll
        for (int i = 0; i < 16; ++i) qf[i] *= rs * qg[i];
        if (sub == 0) { const float pos = (float)(nb * 128 + q); ROPE16(qf, pos); }
#pragma unroll
        for (int i = 0; i < 16; ++i) qf[i] *= 0.125f;
    }
    __syncthreads();
    const float sink = C.in[I_SINK][l * 8 + h];
    float mx = sink;
    for (int j = 0; j < 128; ++j) {
        const int kj = q + 1 + j; const bool valid = (nb > 0) || (kj >= 128);
        const LAS u32x4* kr = (const LAS u32x4*)(Ks + kj * 72 + sub * 16);
        float kf[16]; const u32x4 w0 = kr[0], w1 = kr[1]; UNPACK8(w0, kf, 0); UNPACK8(w1, kf, 8);
        float s = 0.f;
#pragma unroll
        for (int i = 0; i < 16; ++i) s += qf[i] * kf[i];
        s += __shfl_xor(s, 1); s += __shfl_xor(s, 2);
        if (valid) mx = fmaxf(mx, s);
    }
    float lsum = __expf(sink - mx); float o[16];
#pragma unroll
    for (int i = 0; i < 16; ++i) o[i] = 0.f;
    for (int j = 0; j < 128; ++j) {
        const int kj = q + 1 + j; const bool valid = (nb > 0) || (kj >= 128);
        const LAS u32x4* kr = (const LAS u32x4*)(Ks + kj * 72 + sub * 16);
        float kf[16]; { const u32x4 w0 = kr[0], w1 = kr[1]; UNPACK8(w0, kf, 0); UNPACK8(w1, kf, 8); }
        float s = 0.f;
#pragma unroll
        for (int i = 0; i < 16; ++i) s += qf[i] * kf[i];
        s += __shfl_xor(s, 1); s += __shfl_xor(s, 2);
        const float p = valid ? __expf(s - mx) : 0.f;
        lsum += p;
        const LAS u32x4* vr = (const LAS u32x4*)(Vs + kj * 72 + sub * 16);
        float vf[16]; { const u32x4 w0 = vr[0], w1 = vr[1]; UNPACK8(w0, vf, 0); UNPACK8(w1, vf, 8); }
#pragma unroll
        for (int i = 0; i < 16; ++i) o[i] += p * vf[i];
    }
    const float inv = 1.f / lsum;
#pragma unroll
    for (int i = 0; i < 16; ++i) o[i] *= inv;
    u32x4* op = (u32x4*)(C.o + (size_t)(row0 + q) * NO + 1024 + h * 64 + sub * 16);
    op[0] = PACK8(o, 0); op[1] = PACK8(o, 8);
    __syncthreads();
}

__device__ __forceinline__ void xa_item(LAS unsigned char* lds, const Ctx& C, int l, int tile, int h) {
    const int tid = opaque_tid();
    LAS bf16_t* Ks = (LAS bf16_t*)lds;
    LAS bf16_t* Vs = Ks + 256 * 136;
    const int b = tile >> 6, row0 = tile * 128;
    {
        const int key = tid >> 1, half = tid & 1;
        const bf16_t* src = C.memkv + ((size_t)(l * 512 + b * 256 + key)) * 1024 + h * 128 + half * 64;
        const u32x4* kp = (const u32x4*)src; const u32x4* vp = (const u32x4*)(src + 512);
        float kf[64]; float ss = 0.f;
#pragma unroll
        for (int i = 0; i < 8; ++i) { const u32x4 w = kp[i]; UNPACK8(w, kf, 8 * i); }
#pragma unroll
        for (int i = 0; i < 64; ++i) ss += kf[i] * kf[i];
        ss += __shfl_xor(ss, 1);
        const float rs = rsqrtf(ss * (1.f / 128.f) + EPS);
        const float* kg = C.in[I_XKG] + l * 128 + half * 64;
#pragma unroll
        for (int i = 0; i < 64; ++i) kf[i] *= rs * kg[i];
#pragma unroll
        for (int i = 0; i < 8; ++i) { *(LAS u32x4*)(Ks + key * 136 + half * 64 + 8 * i) = PACK8(kf, 8 * i); *(LAS u32x4*)(Vs + key * 136 + half * 64 + 8 * i) = vp[i]; }
    }
    const int q = tid >> 2, sub = tid & 3;
    float qf[32];
    {
        const u32x4* qp = (const u32x4*)(C.za + (size_t)(row0 + q) * NZA + 2816 + h * 128 + sub * 32);
#pragma unroll
        for (int i = 0; i < 4; ++i) { const u32x4 w = qp[i]; UNPACK8(w, qf, 8 * i); }
        float ss = 0.f;
#pragma unroll
        for (int i = 0; i < 32; ++i) ss += qf[i] * qf[i];
        ss += __shfl_xor(ss, 1); ss += __shfl_xor(ss, 2);
        const float rs = rsqrtf(ss * (1.f / 128.f) + EPS) * 0.08838834764831845f;
        const float* qg = C.in[I_XQG] + l * 128 + sub * 32;
#pragma unroll
        for (int i = 0; i < 32; ++i) qf[i] *= rs * qg[i];
    }
    __syncthreads();
    float mx = -3.0e38f;
    for (int key = 0; key < 256; ++key) {
        const LAS u32x4* kr = (const LAS u32x4*)(Ks + key * 136 + sub * 32);
        float s = 0.f;
#pragma unroll
        for (int c = 0; c < 4; ++c) { float kf[8]; const u32x4 w = kr[c]; UNPACK8(w, kf, 0);
#pragma unroll
            for (int i = 0; i < 8; ++i) s += qf[8 * c + i] * kf[i]; }
        s += __shfl_xor(s, 1); s += __shfl_xor(s, 2);
        mx = fmaxf(mx, s);
    }
    float lsum = 0.f; float o[32];
#pragma unroll
    for (int i = 0; i < 32; ++i) o[i] = 0.f;
    for (int key = 0; key < 256; ++key) {
        const LAS u32x4* kr = (const LAS u32x4*)(Ks + key * 136 + sub * 32);
        float s = 0.f;
#pragma unroll
        for (int c = 0; c < 4; ++c) { float kf[8]; const u32x4 w = kr[c]; UNPACK8(w, kf, 0);
#pragma unroll
            for (int i = 0; i < 8; ++i) s += qf[8 * c + i] * kf[i]; }
        s += __shfl_xor(s, 1); s += __shfl_xor(s, 2);
        const float p = __expf(s - mx);
        lsum += p;
        const LAS u32x4* vr = (const LAS u32x4*)(Vs + key * 136 + sub * 32);
#pragma unroll
        for (int c = 0; c < 4; ++c) { float vf[8]; const u32x4 w = vr[c]; UNPACK8(w, vf, 0);
#pragma unroll
            for (int i = 0; i < 8; ++i) o[8 * c + i] += p * vf[i]; }
    }
    const float inv = 1.f / lsum;
#pragma unroll
    for (int i = 0; i < 32; ++i) o[i] *= inv;
    u32x4* op = (u32x4*)(C.o + (size_t)(row0 + q) * NO + 1536 + h * 128 + sub * 32);
#pragma unroll
    for (int c = 0; c < 4; ++c) op[c] = PACK8(o, 8 * c);
    __syncthreads();
}

__device__ __forceinline__ void gm_item(LAS unsigned char* lds, const Ctx& C, int l, int tile, int g) {
    const int tid = opaque_tid();
    LAS float* vn = (LAS float*)lds;
    LAS float* Wl = vn + 128 * 128;
    LAS float* rsv = Wl + 128 * 128;
    const int row0 = tile * 128;
    {
        const int tok = tid >> 2, sub = tid & 3;
        const u32x4* vp = (const u32x4*)(C.za + (size_t)(row0 + tok) * NZA + 512 + sub * 128);
        float ss = 0.f;
#pragma unroll
        for (int i = 0; i < 16; ++i) { float f[8]; const u32x4 w = vp[i]; UNPACK8(w, f, 0);
#pragma unroll
            for (int e = 0; e < 8; ++e) ss += f[e] * f[e]; }
        ss += __shfl_xor(ss, 1); ss += __shfl_xor(ss, 2);
        if (sub == 0) rsv[tok] = rsqrtf(ss * (1.f / 512.f) + EPS);
        const f32x4* wp = (const f32x4*)(C.in[I_GMWS] + (size_t)(l * 4 + g) * 128 * 128);
#pragma unroll
        for (int i = 0; i < 8; ++i) *(LAS f32x4*)(Wl + (i * 512 + tid) * 4) = wp[i * 512 + tid];
    }
    __syncthreads();
    {
        const int s = tid >> 2, c0 = (tid & 3) * 32;
        const u32x4* vp = (const u32x4*)(C.za + (size_t)(row0 + s) * NZA + 512 + g * 128 + c0);
        const float rs = rsv[s]; const float* vg = C.in[I_GMVG] + l * 512 + g * 128 + c0;
#pragma unroll
        for (int i = 0; i < 4; ++i) { float f[8]; const u32x4 w = vp[i]; UNPACK8(w, f, 0);
#pragma unroll
            for (int e = 0; e < 8; ++e) f[e] *= rs * vg[8 * i + e];
            *(LAS f32x4*)(vn + s * 128 + c0 + 8 * i) = (f32x4){f[0], f[1], f[2], f[3]}; *(LAS f32x4*)(vn + s * 128 + c0 + 8 * i + 4) = (f32x4){f[4], f[5], f[6], f[7]}; }
    }
    __syncthreads();
    {
        const int c = tid & 127, tq = tid >> 7;
        const float* bs = C.in[I_GMBS] + (size_t)(l * 4 + g) * 128;
        for (int k = 0; k < 32; ++k) {
            const int t = tq * 32 + k; float acc = 0.f;
            for (int s = 0; s <= t; ++s) acc += Wl[t * 128 + s] * vn[s * 128 + c];
            const float sval = acc + bs[t];
            const float u = bf2f(C.za[(size_t)(row0 + t) * NZA + g * 128 + c]);
            C.o[(size_t)(row0 + t) * NO + g * 128 + c] = (bf16_t)f2bf(u * sval);
        }
    }
    __syncthreads();
}

__device__ __forceinline__ void lru_item(LAS unsigned char* lds, const Ctx& C, int l, int tile, int hb) {
    const int tid = opaque_tid();
    LAS float* xc = (LAS float*)lds;
    LAS float* wr = xc + 8192;
    LAS float* wi = wr + 4096;
    LAS float* aa = wi + 4096;
    LAS float* bb = aa + 8192;
    const int nb = tile & 63, row0 = tile * 128;
    {
        const int t = tid >> 2, c0 = (tid & 3) * 16, ch = hb * 64 + c0;
        float acc[16];
#pragma unroll
        for (int i = 0; i < 16; ++i) acc[i] = C.in[I_CONVB][l * 512 + ch + i];
#pragma unroll
        for (int k = 0; k < 4; ++k) {
            const int tt = t - 3 + k;
            if (nb * 128 + tt >= 0) {
                const u32x4* xp = (const u32x4*)(C.za + (size_t)(row0 + tt) * NZA + 1024 + ch);
                float f[16]; const u32x4 w0 = xp[0], w1 = xp[1]; UNPACK8(w0, f, 0); UNPACK8(w1, f, 8);
                const float* cw = C.in[I_CONVW] + (size_t)(l * 4 + k) * 512 + ch;
#pragma unroll
                for (int i = 0; i < 16; ++i) acc[i] += cw[i] * f[i];
            }
        }
#pragma unroll
        for (int i = 0; i < 4; ++i) *(LAS f32x4*)(xc + t * 64 + c0 + 4 * i) = (f32x4){acc[4 * i], acc[4 * i + 1], acc[4 * i + 2], acc[4 * i + 3]};
        const f32x4* wrp = (const f32x4*)(C.in[I_WR] + (size_t)(l * 8 + hb) * 4096); const f32x4* wip = (const f32x4*)(C.in[I_WI] + (size_t)(l * 8 + hb) * 4096);
#pragma unroll
        for (int i = 0; i < 2; ++i) { *(LAS f32x4*)(wr + (i * 512 + tid) * 4) = wrp[i * 512 + tid]; *(LAS f32x4*)(wi + (i * 512 + tid) * 4) = wip[i * 512 + tid]; }
    }
    __syncthreads();
    const int j = tid & 63, tg = tid >> 6, chj = hb * 64 + j;
    {
        const float br = C.in[I_BR][l * 512 + chj], bi = C.in[I_BI][l * 512 + chj];
        const float lam = C.in[I_LAM][l * 512 + chj];
        const float sp = log1pf(expf(-lam));
        for (int k = 0; k < 16; ++k) {
            const int t = tg * 16 + k; float r = br, ig = bi;
            for (int i = 0; i < 64; ++i) { const float xv = xc[t * 64 + i]; r += xv * wr[i * 64 + j]; ig += xv * wi[i * 64 + j]; }
            r = sigmoid_f(r); ig = sigmoid_f(ig);
            const float loga = -8.f * r * sp; const float a = expf(loga); const float mult = sqrtf(-expm1f(2.f * loga));
            aa[t * 64 + j] = a; bb[t * 64 + j] = xc[t * 64 + j] * ig * mult;
        }
    }
    __syncthreads();
    if (tid < 64) {
        float hh = 0.f, P = 1.f;
        for (int t = 0; t < 128; ++t) { const float a = aa[t * 64 + tid]; hh = a * hh + bb[t * 64 + tid]; P *= a; aa[t * 64 + tid] = P; bb[t * 64 + tid] = hh; }
        C.carryA[(size_t)tile * 512 + hb * 64 + tid] = P; C.carryH[(size_t)tile * 512 + hb * 64 + tid] = hh;
    }
    __syncthreads();
    for (int k = 0; k < 16; ++k) {
        const int t = tg * 16 + k;
        const float G = bf2f(C.za[(size_t)(row0 + t) * NZA + 1536 + chj]);
        C.ly[(size_t)(row0 + t) * 512 + chj] = G * bb[t * 64 + j]; C.lp[(size_t)(row0 + t) * 512 + chj] = G * aa[t * 64 + j];
    }
    __syncthreads();
}

__device__ __forceinline__ int vperm_pos(int key) { const int w = key & 31; return (key & ~31) + ((w >> 2) & 3) * 8 + (w >> 4) * 4 + (w & 3); }
#define MFMA16(X, Y, ACC) __builtin_amdgcn_mfma_f32_16x16x32_bf16((X), (Y), (ACC), 0, 0, 0)
__device__ __forceinline__ bf16x8 pack_bf16x8(const float* f) { u32x4 w; w[0] = cvt_pk_bf16(f[0], f[1]); w[1] = cvt_pk_bf16(f[2], f[3]); w[2] = cvt_pk_bf16(f[4], f[5]); w[3] = cvt_pk_bf16(f[6], f[7]); return __builtin_bit_cast(bf16x8, w); }

__device__ __forceinline__ void kvprep_phase(const Ctx& C, int gw, int NGW, int lane) {
    for (int r = gw; r < 32 * 256; r += NGW) {
        const int combo = r >> 8, key = r & 255, l = combo >> 3, b = (combo >> 2) & 1, h = combo & 3;
        const unsigned w = *(const unsigned*)(C.memkv + ((size_t)(l * 512 + b * 256 + key)) * 1024 + h * 128 + 2 * lane);
        float f0 = __uint_as_float(w << 16), f1 = __uint_as_float(w & 0xffff0000u);
        const float ss = wave_sum(f0 * f0 + f1 * f1); const float rs = rsqrtf(ss * (1.f / 128.f) + EPS);
        const float* kg = C.in[I_XKG] + l * 128 + 2 * lane;
        *(unsigned*)(C.memK + (size_t)r * 128 + 2 * lane) = pk2(f0 * rs * kg[0], f1 * rs * kg[1]);
    }
    const int gt = gw * 64 + lane, NGT = NGW * 64;
    for (int t = gt; t < 32 * 32 * 128; t += NGT) {
        const int d = t & 127, pg = (t >> 7) & 31, combo = t >> 12, l = combo >> 3, b = (combo >> 2) & 1, h = combo & 3;
        const int kbase = (pg >> 2) * 32 + (pg & 3) * 4;
        const bf16_t* src = C.memkv + ((size_t)(l * 512 + b * 256)) * 1024 + 512 + h * 128 + d;
        unsigned short v[8];
#pragma unroll
        for (int e = 0; e < 4; ++e) { v[e] = src[(size_t)(kbase + e) * 1024]; v[4 + e] = src[(size_t)(kbase + 16 + e) * 1024]; }
        u32x4 o; o[0] = v[0] | ((unsigned)v[1] << 16); o[1] = v[2] | ((unsigned)v[3] << 16); o[2] = v[4] | ((unsigned)v[5] << 16); o[3] = v[6] | ((unsigned)v[7] << 16);
        *(u32x4*)(C.memVt + ((size_t)combo * 128 + d) * 256 + pg * 8) = o;
    }
}

__device__ __forceinline__ void xa_pair_mfma(LAS unsigned char* lds, const Ctx& C, int l, int pairidx) {
    const int tid = opaque_tid(), lane = tid & 63, w = __builtin_amdgcn_readfirstlane(tid >> 6), fr = lane & 15, fq = lane >> 4;
    LAS bf16_t* Ks = (LAS bf16_t*)lds;
    LAS bf16_t* Vt = Ks + 256 * 144;
    const int idx0 = pairidx * 2, bh = idx0 >> 6, b = bh >> 2, h = bh & 3, nb0 = idx0 & 63;
    u32x4 qr[2][4];
#pragma unroll
    for (int tt = 0; tt < 2; ++tt) { const bf16_t* qp = C.za + (size_t)((b * 64 + nb0 + tt) * 128 + w * 16 + fr) * NZA + 2816 + h * 128 + 8 * fq;
#pragma unroll
        for (int ks = 0; ks < 4; ++ks) qr[tt][ks] = *(const u32x4*)(qp + 32 * ks); }
    {
        const u32x4* ksrc = (const u32x4*)(C.memK + ((size_t)(l * 8 + bh)) * 256 * 128);
        const u32x4* vsrc = (const u32x4*)(C.memVt + ((size_t)(l * 8 + bh)) * 128 * 256);
#pragma unroll
        for (int i = 0; i < 8; ++i) { const int ch = i * 512 + tid;
            *(LAS u32x4*)(Ks + (ch >> 4) * 144 + (ch & 15) * 8) = ksrc[ch];
            *(LAS u32x4*)(Vt + (ch >> 5) * 272 + (ch & 31) * 8) = vsrc[ch]; }
    }
    __syncthreads();
    float gqx[32];
    { const float* qg = C.in[I_XQG] + l * 128 + 8 * fq;
#pragma unroll
      for (int ks = 0; ks < 4; ++ks)
#pragma unroll
          for (int i = 0; i < 8; ++i) gqx[8 * ks + i] = qg[32 * ks + i] * (0.08838834764831845f * 1.4426950408889634f); }
#pragma unroll
    for (int tt = 0; tt < 2; ++tt) {
        const size_t row = (size_t)((b * 64 + nb0 + tt) * 128 + w * 16 + fr);
        bf16x8 qf[4];
        {
            float f[32];
#pragma unroll
            for (int ks = 0; ks < 4; ++ks) { const u32x4 wv = qr[tt][ks]; UNPACK8(wv, f, 8 * ks); }
            float ss = 0.f;
#pragma unroll
            for (int i = 0; i < 32; ++i) ss += f[i] * f[i];
            ss += __shfl_xor(ss, 16); ss += __shfl_xor(ss, 32);
            const float rs = rsqrtf(ss * (1.f / 128.f) + EPS);
#pragma unroll
            for (int ks = 0; ks < 4; ++ks) {
#pragma unroll
                for (int i = 0; i < 8; ++i) f[8 * ks + i] *= rs * gqx[8 * ks + i];
                qf[ks] = pack_bf16x8(f + 8 * ks); }
        }
        f32x4 acc[16];
#pragma unroll
        for (int kb = 0; kb < 16; ++kb) { acc[kb] = (f32x4){0.f, 0.f, 0.f, 0.f};
#pragma unroll
            for (int ks = 0; ks < 4; ++ks) { const bf16x8 kf = *(const LAS bf16x8*)(Ks + (kb * 16 + fr) * 144 + 32 * ks + 8 * fq); acc[kb] = MFMA16(kf, qf[ks], acc[kb]); } }
        float mx = -3.0e38f;
#pragma unroll
        for (int kb = 0; kb < 16; ++kb) mx = fmaxf(fmaxf(fmaxf(acc[kb][0], acc[kb][1]), fmaxf(acc[kb][2], acc[kb][3])), mx);
        mx = fmaxf(mx, __shfl_xor(mx, 16)); mx = fmaxf(mx, __shfl_xor(mx, 32));
        float lsum = 0.f;
#pragma unroll
        for (int kb = 0; kb < 16; ++kb)
#pragma unroll
            for (int e = 0; e < 4; ++e) { const float pv = __builtin_amdgcn_exp2f(acc[kb][e] - mx); acc[kb][e] = pv; lsum += pv; }
        lsum += __shfl_xor(lsum, 16); lsum += __shfl_xor(lsum, 32);
        const float inv = 1.f / lsum;
        bf16x8 pf[8];
#pragma unroll
        for (int j = 0; j < 8; ++j) { u32x4 wv; wv[0] = cvt_pk_bf16(acc[2 * j][0], acc[2 * j][1]); wv[1] = cvt_pk_bf16(acc[2 * j][2], acc[2 * j][3]); wv[2] = cvt_pk_bf16(acc[2 * j + 1][0], acc[2 * j + 1][1]); wv[3] = cvt_pk_bf16(acc[2 * j + 1][2], acc[2 * j + 1][3]); pf[j] = __builtin_bit_cast(bf16x8, wv); }
        bf16_t* op = C.o + row * NO + 1536 + h * 128 + 4 * fq;
#pragma unroll
        for (int db = 0; db < 8; ++db) {
            f32x4 o = (f32x4){0.f, 0.f, 0.f, 0.f};
#pragma unroll
            for (int j = 0; j < 8; ++j) { const bf16x8 vf = *(const LAS bf16x8*)(Vt + (db * 16 + fr) * 272 + 32 * j + 8 * fq); o = MFMA16(vf, pf[j], o); }
            *(u32x2*)(op + db * 16) = (u32x2){cvt_pk_bf16(o[0] * inv, o[1] * inv), cvt_pk_bf16(o[2] * inv, o[3] * inv)};
        }
    }
    __syncthreads();
}

__device__ __forceinline__ void swa_item_mfma(LAS unsigned char* lds, const Ctx& C, int l, int tile, int kvh) {
    const int tid = opaque_tid(), lane = tid & 63, w = __builtin_amdgcn_readfirstlane(tid >> 6), fr = lane & 15, fq = lane >> 4;
    LAS bf16_t* Ks = (LAS bf16_t*)lds;
    LAS bf16_t* Vt = Ks + 256 * 80;
    const int nb = tile & 63, row0 = tile * 128;
    const bf16_t* qbase = C.za + (size_t)(row0 + 16 * w + fr) * NZA + 2048 + kvh * 256 + 8 * fq;
    u32x4 qn0 = *(const u32x4*)qbase, qn1 = *(const u32x4*)(qbase + 32);
    {
        const int key = tid >> 1, half = tid & 1;
        const bool ok = (nb > 0) || (key >= 128);
        const size_t grow = (size_t)(ok ? row0 - 128 + key : row0);
        const u32x4* kp = (const u32x4*)(C.za + grow * NZA + 2560 + kvh * 64 + half * 32);
        const u32x4* vp = (const u32x4*)(C.za + grow * NZA + 2688 + kvh * 64 + half * 32);
        float kf[32]; float ss = 0.f;
#pragma unroll
        for (int i = 0; i < 4; ++i) { const u32x4 wv = kp[i]; UNPACK8(wv, kf, 8 * i); }
#pragma unroll
        for (int i = 0; i < 32; ++i) ss += kf[i] * kf[i];
        ss += __shfl_xor(ss, 1);
        const float rs = rsqrtf(ss * (1.f / 64.f) + EPS);
        const float* kg = C.in[I_SKG] + l * 64 + half * 32;
#pragma unroll
        for (int i = 0; i < 32; ++i) kf[i] *= rs * kg[i];
        if (half == 0) { const int posi = ok ? nb * 128 - 128 + key : 0; ROPE16T(kf, C.rope + (size_t)posi * 16); }
#pragma unroll
        for (int i = 0; i < 4; ++i) *(LAS u32x4*)(Ks + key * 80 + half * 32 + 8 * i) = PACK8(kf, 8 * i);
        const int pp = vperm_pos(key);
#pragma unroll
        for (int i = 0; i < 4; ++i) { u32x4 wv = vp[i]; if (!ok) wv = (u32x4){0u, 0u, 0u, 0u};
#pragma unroll
            for (int e = 0; e < 4; ++e) { Vt[(half * 32 + 8 * i + 2 * e) * 272 + pp] = (bf16_t)(wv[e] & 0xffffu); Vt[(half * 32 + 8 * i + 2 * e + 1) * 272 + pp] = (bf16_t)(wv[e] >> 16); } }
    }
    __syncthreads();
    const int i0 = 16 * w, ws2 = w & ~1, qi = i0 + fr;
    float rc[8], rsn[8];
    { const f32x4* tp = (const f32x4*)(C.rope + (size_t)(nb * 128 + qi) * 16);
#pragma unroll
      for (int i = 0; i < 4; ++i) { const f32x4 cs = tp[i]; rc[2 * i] = cs[0]; rsn[2 * i] = cs[1]; rc[2 * i + 1] = cs[2]; rsn[2 * i + 1] = cs[3]; } }
    const size_t row = (size_t)(row0 + qi);
    float gq[16];
    { const float* qg = C.in[I_SQG] + l * 64 + 8 * fq;
#pragma unroll
      for (int i = 0; i < 8; ++i) { gq[i] = qg[i] * (0.125f * 1.4426950408889634f); gq[8 + i] = qg[32 + i] * (0.125f * 1.4426950408889634f); } }
    for (int hh = 0; hh < 4; ++hh) {
        const int h = kvh * 4 + hh;
        bf16x8 qf[2];
        {
            float f[16];
            { const u32x4 w0 = qn0, w1 = qn1; UNPACK8(w0, f, 0); UNPACK8(w1, f, 8); }
            if (hh < 3) { qn0 = *(const u32x4*)(qbase + 64 * (hh + 1)); qn1 = *(const u32x4*)(qbase + 64 * (hh + 1) + 32); }
            float ss = 0.f;
#pragma unroll
            for (int i = 0; i < 16; ++i) ss += f[i] * f[i];
            ss += __shfl_xor(ss, 16); ss += __shfl_xor(ss, 32);
            const float rs = rsqrtf(ss * (1.f / 64.f) + EPS);
#pragma unroll
            for (int i = 0; i < 16; ++i) f[i] *= rs * gq[i];
#pragma unroll
            for (int i = 0; i < 8; ++i) { const float other = __shfl_xor(f[i], 16);
                const float r0 = f[i] * rc[i] - other * rsn[i], r1 = f[i] * rc[i] + other * rsn[i];
                f[i] = (fq == 0) ? r0 : (fq == 1) ? r1 : f[i]; }
            qf[0] = pack_bf16x8(f); qf[1] = pack_bf16x8(f + 8);
        }
        f32x4 acc[10];
#pragma unroll
        for (int kk = 0; kk < 10; ++kk) { acc[kk] = (f32x4){0.f, 0.f, 0.f, 0.f};
            if ((kk == 0 && (w & 1)) || (kk == 9 && !(w & 1))) continue;
#pragma unroll
            for (int ks = 0; ks < 2; ++ks) { const bf16x8 kf = *(const LAS bf16x8*)(Ks + ((ws2 + kk) * 16 + fr) * 80 + 32 * ks + 8 * fq); acc[kk] = MFMA16(kf, qf[ks], acc[kk]); } }
        const float sink = C.in[I_SINK][l * 8 + h] * 1.4426950408889634f;
        float mx = sink;
        const int sh = w & 1;
#pragma unroll
        for (int kk = 0; kk < 10; ++kk) {
            const int dlt = kk - sh;
            if (nb > 0 && dlt >= 1 && dlt <= 7) {
#pragma unroll
                for (int e = 0; e < 4; ++e) mx = fmaxf(mx, acc[kk][e]);
            } else {
#pragma unroll
                for (int e = 0; e < 4; ++e) { const int kj = (ws2 + kk) * 16 + 4 * fq + e, dd = kj - qi; const bool valid = (dd >= 1) && (dd <= 128) && ((nb > 0) || (kj >= 128));
                    const float sv = valid ? acc[kk][e] : -INFINITY; acc[kk][e] = sv; mx = fmaxf(mx, sv); }
            }
        }
        mx = fmaxf(mx, __shfl_xor(mx, 16)); mx = fmaxf(mx, __shfl_xor(mx, 32));
        float lsum = 0.f;
#pragma unroll
        for (int kk = 0; kk < 10; ++kk)
#pragma unroll
            for (int e = 0; e < 4; ++e) { const float pv = __builtin_amdgcn_exp2f(acc[kk][e] - mx); acc[kk][e] = pv; lsum += pv; }
        lsum += __shfl_xor(lsum, 16); lsum += __shfl_xor(lsum, 32);
        lsum += __builtin_amdgcn_exp2f(sink - mx);
        const float inv = 1.f / lsum;
        bf16x8 pf[5];
#pragma unroll
        for (int j = 0; j < 5; ++j) { u32x4 wv; wv[0] = cvt_pk_bf16(acc[2 * j][0], acc[2 * j][1]); wv[1] = cvt_pk_bf16(acc[2 * j][2], acc[2 * j][3]); wv[2] = cvt_pk_bf16(acc[2 * j + 1][0], acc[2 * j + 1][1]); wv[3] = cvt_pk_bf16(acc[2 * j + 1][2], acc[2 * j + 1][3]); pf[j] = __builtin_bit_cast(bf16x8, wv); }
        bf16_t* op = C.o + row * NO + 1024 + h * 64 + 4 * fq;
#pragma unroll
        for (int db = 0; db < 4; ++db) {
            f32x4 o = (f32x4){0.f, 0.f, 0.f, 0.f};
#pragma unroll
            for (int j = 0; j < 5; ++j) { const bf16x8 vf = *(const LAS bf16x8*)(Vt + (db * 16 + fr) * 272 + (ws2 + 2 * j) * 16 + 8 * fq); o = MFMA16(vf, pf[j], o); }
            *(u32x2*)(op + db * 16) = (u32x2){cvt_pk_bf16(o[0] * inv, o[1] * inv), cvt_pk_bf16(o[2] * inv, o[3] * inv)};
        }
    }
    __syncthreads();
}

__device__ __forceinline__ void gm_item_mfma(LAS unsigned char* lds, const Ctx& C, int l, int tile, int g) {
    const int tid = opaque_tid(), lane = tid & 63, w = __builtin_amdgcn_readfirstlane(tid >> 6), fr = lane & 15, fq = lane >> 4;
    LAS bf16_t* Wl = (LAS bf16_t*)lds;
    LAS bf16_t* vT = Wl + 128 * 144;
    LAS float* rsv = (LAS float*)(vT + 128 * 144);
    const int row0 = tile * 128;
    {
        if (tid < 128) { const f32x4* pp = (const f32x4*)(C.ssv + (size_t)(row0 + tid) * 8); const f32x4 a = pp[0], b2 = pp[1];
            rsv[tid] = rsqrtf((((a[0] + a[1]) + (a[2] + a[3])) + ((b2[0] + b2[1]) + (b2[2] + b2[3]))) * (1.f / 512.f) + EPS); }
        const int tok = tid >> 2, sub = tid & 3;
        const u32x4* gp = (const u32x4*)(C.za + (size_t)(row0 + tok) * NZA + 512 + g * 128 + sub * 32);
#pragma unroll
        for (int i = 0; i < 4; ++i) { const u32x4 wv = gp[i];
#pragma unroll
            for (int e = 0; e < 4; ++e) { vT[(sub * 32 + 8 * i + 2 * e) * 144 + tok] = (bf16_t)(wv[e] & 0xffffu); vT[(sub * 32 + 8 * i + 2 * e + 1) * 144 + tok] = (bf16_t)(wv[e] >> 16); } }
    }
    const int t_ = tid >> 2, s0 = (tid & 3) * 32;
    f32x4 wreg[8];
    { const f32x4* wp = (const f32x4*)(C.in[I_GMWS] + ((size_t)(l * 4 + g) * 128 + t_) * 128 + s0);
#pragma unroll
      for (int i = 0; i < 8; ++i) wreg[i] = wp[i]; }
    __syncthreads();
    {
#pragma unroll
        for (int i = 0; i < 4; ++i) { const f32x4 a = wreg[2 * i], b2 = wreg[2 * i + 1]; float f[8] = {a[0], a[1], a[2], a[3], b2[0], b2[1], b2[2], b2[3]};
#pragma unroll
            for (int e = 0; e < 8; ++e) { const int sidx = s0 + 8 * i + e; f[e] = (sidx <= t_) ? f[e] * rsv[sidx] : 0.f; }
            *(LAS u32x4*)(Wl + t_ * 144 + s0 + 8 * i) = PACK8(f, 0); }
    }
    __syncthreads();
    {
        const int nks = (w + 2) >> 1;
        f32x4 acc[8];
#pragma unroll
        for (int cb = 0; cb < 8; ++cb) acc[cb] = (f32x4){0.f, 0.f, 0.f, 0.f};
        for (int ks = 0; ks < nks; ++ks) {
            const bf16x8 wf = *(const LAS bf16x8*)(Wl + (16 * w + fr) * 144 + 32 * ks + 8 * fq);
#pragma unroll
            for (int cb = 0; cb < 8; ++cb) { const bf16x8 vf = *(const LAS bf16x8*)(vT + (cb * 16 + fr) * 144 + 32 * ks + 8 * fq); acc[cb] = MFMA16(vf, wf, acc[cb]); }
        }
        const int t = 16 * w + fr; const size_t r = (size_t)(row0 + t);
        const float bsv = C.in[I_GMBS][(size_t)(l * 4 + g) * 128 + t];
        const float* vg = C.in[I_GMVG] + l * 512 + g * 128 + 4 * fq;
        const bf16_t* up = C.za + r * NZA + g * 128 + 4 * fq; bf16_t* op = C.o + r * NO + g * 128 + 4 * fq;
#pragma unroll
        for (int cb = 0; cb < 8; ++cb) { const f32x4 gn = *(const f32x4*)(vg + cb * 16); const u32x2 uw = *(const u32x2*)(up + cb * 16);
            const float u0 = __uint_as_float(uw[0] << 16), u1 = __uint_as_float(uw[0] & 0xffff0000u), u2 = __uint_as_float(uw[1] << 16), u3 = __uint_as_float(uw[1] & 0xffff0000u);
            *(u32x2*)(op + cb * 16) = (u32x2){cvt_pk_bf16(u0 * (gn[0] * acc[cb][0] + bsv), u1 * (gn[1] * acc[cb][1] + bsv)), cvt_pk_bf16(u2 * (gn[2] * acc[cb][2] + bsv), u3 * (gn[3] * acc[cb][3] + bsv))}; }
    }
    __syncthreads();
}

__device__ __forceinline__ void lru_item_mfma(LAS unsigned char* lds, const Ctx& C, int l, int tile, int hb) {
    const int tid = opaque_tid(), lane = tid & 63, w = __builtin_amdgcn_readfirstlane(tid >> 6), fr = lane & 15, fq = lane >> 4;
    LAS bf16_t* xcb = (LAS bf16_t*)lds;
    LAS bf16_t* wrT = xcb + 128 * 80;
    LAS bf16_t* wiT = wrT + 64 * 80;
    LAS float* xcf = (LAS float*)(lds + 40960);
    LAS float* aa = xcf + 8192;
    LAS float* bb = aa + 8192;
    LAS float* segA = bb + 8192;
    LAS float* segH = segA + 512;
    const int nb = tile & 63, row0 = tile * 128;
    {
        const int t = tid >> 2, c0 = (tid & 3) * 16, ch = hb * 64 + c0;
        float acc[16];
#pragma unroll
        for (int i = 0; i < 16; ++i) acc[i] = C.in[I_CONVB][l * 512 + ch + i];
#pragma unroll
        for (int k = 0; k < 4; ++k) {
            const int tt = t - 3 + k;
            if (nb * 128 + tt >= 0) {
                const u32x4* xp = (const u32x4*)(C.za + (size_t)(row0 + tt) * NZA + 1024 + ch);
                float f[16]; const u32x4 w0 = xp[0], w1 = xp[1]; UNPACK8(w0, f, 0); UNPACK8(w1, f, 8);
                const float* cw = C.in[I_CONVW] + (size_t)(l * 4 + k) * 512 + ch;
#pragma unroll
                for (int i = 0; i < 16; ++i) acc[i] += cw[i] * f[i];
            }
        }
#pragma unroll
        for (int i = 0; i < 4; ++i) *(LAS f32x4*)(xcf + t * 64 + c0 + 4 * i) = (f32x4){acc[4 * i], acc[4 * i + 1], acc[4 * i + 2], acc[4 * i + 3]};
        *(LAS u32x4*)(xcb + t * 80 + c0) = PACK8(acc, 0); *(LAS u32x4*)(xcb + t * 80 + c0 + 8) = PACK8(acc, 8);
        const u32x4* wsrc = (const u32x4*)(C.wgT + (size_t)(l * 8 + hb) * 2 * 4096);
#pragma unroll
        for (int i = 0; i < 2; ++i) { const int c = i * 512 + tid; *(LAS u32x4*)(wrT + (c >> 3) * 80 + (c & 7) * 8) = wsrc[c]; }
    }
    __syncthreads();
    {
        bf16x8 xf[2];
#pragma unroll
        for (int ks = 0; ks < 2; ++ks) xf[ks] = *(const LAS bf16x8*)(xcb + (16 * w + fr) * 80 + 32 * ks + 8 * fq);
#pragma unroll
        for (int jb = 0; jb < 4; ++jb) {
            f32x4 ar = (f32x4){0.f, 0.f, 0.f, 0.f}, ai = (f32x4){0.f, 0.f, 0.f, 0.f};
#pragma unroll
            for (int ks = 0; ks < 2; ++ks) { const bf16x8 wf = *(const LAS bf16x8*)(wrT + (jb * 16 + fr) * 80 + 32 * ks + 8 * fq); ar = MFMA16(xf[ks], wf, ar);
                const bf16x8 wf2 = *(const LAS bf16x8*)(wiT + (jb * 16 + fr) * 80 + 32 * ks + 8 * fq); ai = MFMA16(xf[ks], wf2, ai); }
            const int j = jb * 16 + fr, chj = l * 512 + hb * 64 + j;
            const float br = C.in[I_BR][chj], bi = C.in[I_BI][chj], sp8 = (-8.f * 1.4426950408889634f) * C.spl[chj];
#pragma unroll
            for (int e = 0; e < 4; ++e) { const int t = 16 * w + 4 * fq + e;
                const float r = sigmoid_f(ar[e] + br), ig = sigmoid_f(ai[e] + bi);
                const float a = __builtin_amdgcn_exp2f(r * sp8); const float mult = __builtin_amdgcn_sqrtf(fmaxf(1.f - a * a, 0.f));
                aa[t * 64 + j] = a; bb[t * 64 + j] = xcf[t * 64 + j] * ig * mult; }
        }
    }
    __syncthreads();
    const int j = tid & 63, sg = tid >> 6;
    float av[16], bv[16], Gv[16];
    {
#pragma unroll
        for (int k = 0; k < 16; ++k) { av[k] = aa[(sg * 16 + k) * 64 + j]; bv[k] = bb[(sg * 16 + k) * 64 + j]; }
#pragma unroll
        for (int k = 0; k < 16; ++k) Gv[k] = bf2f(C.za[(size_t)(row0 + sg * 16 + k) * NZA + 1536 + hb * 64 + j]);
        float hh = 0.f, P = 1.f;
#pragma unroll
        for (int k = 0; k < 16; ++k) { hh = av[k] * hh + bv[k]; P *= av[k]; av[k] = P; bv[k] = hh; }
        segA[sg * 64 + j] = P; segH[sg * 64 + j] = hh;
    }
    __syncthreads();
    LAS float* cin = segH + 512;
    float Hc = 0.f, Pc = 1.f;
    for (int s2 = 0; s2 < sg; ++s2) { const float a = segA[s2 * 64 + j]; Hc = a * Hc + segH[s2 * 64 + j]; Pc *= a; }
    const int chj = hb * 64 + j, bt = tile >> 6;
    const size_t wbase = (size_t)l * 128 * 512 + chj;
    if (sg == 7) {
        const float At = Pc * segA[7 * 64 + j], Hl = segA[7 * 64 + j] * Hc + segH[7 * 64 + j];
        __hip_atomic_store(C.agg + wbase + (size_t)tile * 512, ((unsigned long long)__float_as_uint(Hl) << 32) | (unsigned long long)(__float_as_uint(At) | 1u), __ATOMIC_RELAXED, __HIP_MEMORY_SCOPE_AGENT);
    }
    if (sg == 0) {
        const int r0 = nb & ~15;
        unsigned long long wv[16]; unsigned spins = 0;
        for (;;) {
            bool ok = true;
#pragma unroll
            for (int i = 0; i < 16; ++i) {
                const int n = r0 - 1 + i; const bool need = (i == 0) ? (r0 > 0) : (n < nb);
                const unsigned long long* pw = (i == 0 ? C.inc : C.agg) + wbase + (size_t)(bt * 64 + (need ? n : 0)) * 512;
                wv[i] = need ? __hip_atomic_load(pw, __ATOMIC_RELAXED, __HIP_MEMORY_SCOPE_AGENT) : 1ull;
                ok = ok && (wv[i] != 0ull);
            }
            if (ok || ++spins > (1u << 20)) break;
            __builtin_amdgcn_s_sleep(2);
        }
        float Hin = (r0 > 0) ? __uint_as_float((unsigned)(wv[0] >> 32)) : 0.f;
#pragma unroll
        for (int i = 1; i < 16; ++i) if (r0 - 1 + i < nb) Hin = __uint_as_float((unsigned)wv[i]) * Hin + __uint_as_float((unsigned)(wv[i] >> 32));
        cin[j] = Hin;
    }
    __syncthreads();
    {
        const float Hs = Hc + Pc * cin[j];
        float hl = 0.f;
#pragma unroll
        for (int k = 0; k < 16; ++k) { const int t = sg * 16 + k; hl = bv[k] + av[k] * Hs;
            C.o[(size_t)(row0 + t) * NO + 512 + chj] = (bf16_t)(cvt_pk_bf16(Gv[k] * hl, 0.f) & 0xffffu); }
        if (sg == 7) __hip_atomic_store(C.inc + wbase + (size_t)tile * 512, ((unsigned long long)__float_as_uint(hl) << 32) | 1ull, __ATOMIC_RELAXED, __HIP_MEMORY_SCOPE_AGENT);
    }
    __syncthreads();
}

__device__ __forceinline__ void fix_item(const Ctx& C, int tile, int half) {
    const int c = opaque_tid(), b = tile >> 6, nb = tile & 63, row0 = tile * 128 + half * 64;
    float H = 0.f;
    for (int jn = 0; jn < nb; ++jn) { const size_t idx = (size_t)(b * 64 + jn) * 512 + c; H = C.carryA[idx] * H + C.carryH[idx]; }
    for (int t = 0; t < 64; ++t) { const size_t r = (size_t)(row0 + t); C.o[r * NO + 512 + c] = (bf16_t)f2bf(C.ly[r * 512 + c] + C.lp[r * 512 + c] * H); }
}

#ifndef PROBE_KIND
#define PROBE_KIND -1
#endif
#ifndef PROBE_MULT
#define PROBE_MULT 4
#endif
#if PROBE_KIND >= 0
#define BAR(kind) do { const unsigned long long _tb = __builtin_amdgcn_s_memrealtime(); xcd_barrier(bar); const unsigned long long _te = __builtin_amdgcn_s_memrealtime(); \
    if (PROBE_KIND == 7 || (PROBE_KIND == 15 && (kind) == 2)) tacc += _te - _tb; else if ((kind) == PROBE_KIND) tacc += _te - tprev; tprev = _te; } while (0)
#define TS(kind) do { if (PROBE_KIND >= 10) { const unsigned long long _te = __builtin_amdgcn_s_memrealtime(); if ((kind) == PROBE_KIND) tacc += _te - tprev; tprev = _te; } } while (0)
#else
#define BAR(kind) xcd_barrier(bar)
#define TS(kind) do { } while (0)
#endif
__global__ void __launch_bounds__(512, 2) fwd_megakernel(Args args) {
    extern __shared__ __attribute__((aligned(16))) unsigned char lds_raw[];
    LAS unsigned char* lds = (LAS unsigned char*)lds_raw;
    volatile LAS unsigned* MISC = (volatile LAS unsigned*)(lds + MISC_OFF);
    const int tid = threadIdx.x, lane = tid & 63, wave = __builtin_amdgcn_readfirstlane(tid >> 6);
    const int G = gridDim.x, bx = blockIdx.x;
    unsigned char* ws = args.ws;
    Ctx C;
    C.in = args.in; C.x = args.out;
    C.wt_in = (bf16_t*)(ws + WS_WIN); C.wt_br = (bf16_t*)(ws + WS_WBR); C.wt_out = (bf16_t*)(ws + WS_WOUT); C.wt_ff1 = (bf16_t*)(ws + WS_WFF1); C.wt_ff2 = (bf16_t*)(ws + WS_WFF2); C.wt_kv = (bf16_t*)(ws + WS_WKV);
    C.memn = (bf16_t*)(ws + WS_MEMN); C.memkv = (bf16_t*)(ws + WS_MEMKV); C.xb = (bf16_t*)(ws + WS_XB); C.za = (bf16_t*)(ws + WS_ZA); C.zg = (bf16_t*)(ws + WS_ZG); C.mb = (bf16_t*)(ws + WS_MB); C.o = (bf16_t*)(ws + WS_O);
    C.ssq = (float*)(ws + WS_SSQ); C.carryA = (float*)(ws + WS_CARRY); C.carryH = C.carryA + 128 * 512; C.S = (float*)(ws + WS_S); C.ly = (float*)(ws + WS_LY); C.lp = (float*)(ws + WS_LP); C.memK = (bf16_t*)(ws + WS_MEMK); C.memVt = (bf16_t*)(ws + WS_MEMVT); C.spl = (float*)(ws + WS_SPL); C.rope = (float*)(ws + WS_ROPE); C.ssv = (float*)(ws + WS_SSV); C.wgT = (bf16_t*)(ws + WS_WGT); C.agg = (unsigned long long*)(ws + WS_AGG); C.inc = (unsigned long long*)(ws + WS_INC);

    if (tid < 64) MISC[tid] = 0u;
    __syncthreads();
    XcdBarrier bar = xcd_barrier_post((unsigned*)(ws + WS_CTL), MISC + 8);
    const int gw = bx * 8 + wave, NGW = G * 8;
    LAS float* scr = (LAS float*)(lds + wave * 16384);
#if PROBE_KIND >= 0
    unsigned long long tacc = 0ull, tprev = __builtin_amdgcn_s_memrealtime();
#endif

    for (int it = gw; it < IT_WIN + 4 * IT_WKV; it += NGW) {
        if (it < IT_WIN) conv_w(C, 0, 0, it, scr, lane);
        else { const int r = it - IT_WIN; conv_w(C, 5, r / IT_WKV, r % IT_WKV, scr, lane); }
    }
    for (int m = gw; m < M + 512; m += NGW) {
        if (m < M) {
            const f32x4* xr = (const f32x4*)(C.in[I_X] + (size_t)m * D) + lane; f32x4 v[4]; float s = 0.f;
#pragma unroll
            for (int jj = 0; jj < 4; ++jj) { v[jj] = xr[64 * jj]; s += (v[jj].x * v[jj].x + v[jj].y * v[jj].y) + (v[jj].z * v[jj].z + v[jj].w * v[jj].w); }
            s = wave_sum(s);
            u32x2* bo = (u32x2*)(C.xb + (size_t)m * D) + lane;
#pragma unroll
            for (int jj = 0; jj < 4; ++jj) bo[64 * jj] = (u32x2){pk2(v[jj].x, v[jj].y), pk2(v[jj].z, v[jj].w)};
            if (lane < 16) C.ssq[(size_t)m * 16 + lane] = (lane == 0) ? s : 0.f;
        } else {
            const int r = m - M;
            const f32x4* xr = (const f32x4*)(C.in[I_MEM] + (size_t)r * D) + lane; f32x4 v[4]; float s = 0.f;
#pragma unroll
            for (int jj = 0; jj < 4; ++jj) { v[jj] = xr[64 * jj]; s += (v[jj].x * v[jj].x + v[jj].y * v[jj].y) + (v[jj].z * v[jj].z + v[jj].w * v[jj].w); }
            s = wave_sum(s); const float rs = rsqrtf(s * (1.f / 1024.f) + EPS);
            u32x2* bo = (u32x2*)(C.memn + (size_t)r * D) + lane;
#pragma unroll
            for (int jj = 0; jj < 4; ++jj) bo[64 * jj] = (u32x2){pk2(v[jj].x * rs, v[jj].y * rs), pk2(v[jj].z * rs, v[jj].w * rs)};
        }
    }
    { const int gt = bx * 512 + tid; if (gt < DEPTH * 512) C.spl[gt] = log1pf(expf(-C.in[I_LAM][gt])); }
    for (int c = bx * 512 + tid; c < DEPTH * 8 * 2 * 64 * 8; c += G * 512) {
        const int c8 = c & 7, jj = (c >> 3) & 63, gt2 = (c >> 9) & 1, lh = c >> 10;
        const float* src = C.in[gt2 ? I_WI : I_WR] + (size_t)lh * 4096 + (size_t)(c8 * 8) * 64 + jj;
        float f[8];
#pragma unroll
        for (int e = 0; e < 8; ++e) f[e] = src[e * 64];
        *(u32x4*)(C.wgT + (size_t)c * 8) = PACK8(f, 0);
    }
    for (int c = bx * 512 + tid; c < 8192 * 8; c += G * 512) {
        const int i = c & 7; const float inv = ROPE_INV(i); const float ang = (float)(c >> 3) * inv;
        C.rope[2 * c] = cosf(ang); C.rope[2 * c + 1] = sinf(ang);
    }
    { u32x4* zp = (u32x4*)(ws + WS_AGG); for (int i = bx * 512 + tid; i < (int)((WS_SSV - WS_AGG) / 16); i += G * 512) zp[i] = (u32x4){0u, 0u, 0u, 0u}; }
    __syncthreads();
    if (args.ws == nullptr) cg::this_grid().sync();
    BAR(0);

    for (int l = 0; l < DEPTH; ++l) {
        if (l == 0 && bx >= 64 && bx < 96) {
            pg8::Gemm g{C.memn, C.wt_kv}; pg8::SchedKV S{bx - 64}; pg8::EpiKV E{C.memkv};
            pg8::gemm_phase<pg8::EpiKV, pg8::SchedKV, true, D, D, D>(lds, g, S, E);
        }
        {
#ifndef SKIP_G1
            pg8::Gemm g{C.xb, C.wt_in}; pg8::SchedStd S; S.init(M, DIN, G, bx, D, D);
            pg8::EpiZ E{C.za, C.zg, C.ssq, C.in[I_BGATE] + (size_t)l * 4 * D, C.ssv};
            for (int rep = 0; rep < REP_G1; ++rep) pg8::gemm_phase<pg8::EpiZ, pg8::SchedStd, true, D, D, D>(lds, g, S, E);
#endif

        }
        const int cfirst = (l == 0) ? 96 : 64;
        if (G == 256 && bx >= cfirst) {
            const int lane_c = opaque_tid() & 63;
            const int cw = (bx - cfirst) * 8 + wave, NCW = (G - cfirst) * 8;
            for (int it = cw; it < IT_WBR + IT_WOUT + IT_WFF1 + IT_WFF2; it += NCW) {
                int r = it;
                if (r < IT_WBR) { conv_w(C, 1, l, r, scr, lane_c); continue; } r -= IT_WBR;
                if (r < IT_WOUT) { conv_w(C, 2, l, r, scr, lane_c); continue; } r -= IT_WOUT;
                if (r < IT_WFF1) { conv_w(C, 3, l, r, scr, lane_c); continue; } r -= IT_WFF1;
                conv_w(C, 4, l, r, scr, lane_c);
            }
        }
        BAR(1);
        TS(99);
        {
            if (l == 0) { kvprep_phase(C, gw, NGW, opaque_tid() & 63); BAR(2); }
            for (int rmix = 0; rmix < REP_MIX; ++rmix) {
#if USE_MFMA_SWA
            for (int rep = 0; rep < REP_SWA; ++rep) for (int it = bx; it < 256; it += G) swa_item_mfma(lds, C, l, it >> 1, it & 1);
#else
            for (int it = bx; it < 1024; it += G) swa_item(lds, C, l, it >> 3, it & 7);
#endif
            TS(10);
#if USE_MFMA_XA
            for (int rep = 0; rep < REP_XA; ++rep) for (int it = bx; it < 256; it += G) xa_pair_mfma(lds, C, l, it);
#else
            for (int it = bx; it < 512; it += G) xa_item(lds, C, l, it >> 2, it & 3);
#endif
            TS(11);
#if USE_MFMA_GM
            for (int rep = 0; rep < REP_GM; ++rep) for (int it = bx; it < 512; it += G) gm_item_mfma(lds, C, l, it >> 2, it & 3);
#else
            for (int it = bx; it < 512; it += G) gm_item(lds, C, l, it >> 2, it & 3);
#endif
            TS(12);
#if USE_MFMA_LRU
            for (int it = bx; it < 1024; it += G) lru_item_mfma(lds, C, l, ((it >> 3) & 1) * 64 + (it >> 4), it & 7);
#else
            for (int it = bx; it < 1024; it += G) lru_item(lds, C, l, it >> 3, it & 7);
#endif
            TS(13);
            }
            const int lane_c = opaque_tid() & 63;
            const int NC0 = (G == 256) ? 0 : IT_WBR + IT_WOUT + IT_WFF1 + IT_WFF2;
            const int NC = IT_WBR + IT_WOUT + IT_WFF1 + IT_WFF2 + (l + 1 < DEPTH ? IT_WIN : 0);
            for (int rep = 0; rep < REP_CONV; ++rep) for (int it = gw + (IT_WBR + IT_WOUT + IT_WFF1 + IT_WFF2 - NC0); it < NC; it += NGW) {
                int r = it;
                if (r < IT_WBR) { conv_w(C, 1, l, r, scr, lane_c); continue; } r -= IT_WBR;
                if (r < IT_WOUT) { conv_w(C, 2, l, r, scr, lane_c); continue; } r -= IT_WOUT;
                if (r < IT_WFF1) { conv_w(C, 3, l, r, scr, lane_c); continue; } r -= IT_WFF1;
                if (r < IT_WFF2) { conv_w(C, 4, l, r, scr, lane_c); continue; } r -= IT_WFF2;
                conv_w(C, 0, l + 1, r, scr, lane_c);
            }
            __syncthreads();
            TS(14);
        }
        BAR(2);
        {
#ifndef SKIP_G2
            pg8::Gemm g{C.o, C.wt_br}; pg8::SchedMerge S; S.t.init(M, D, G, bx, NO, NO);
            pg8::EpiMerge E{C.zg, C.mb};
            for (int rep = 0; rep < REP_G2; ++rep) pg8::gemm_phase<pg8::EpiMerge, pg8::SchedMerge, false, NO, NO, 512>(lds, g, S, E);
#endif

        }
        BAR(3);
        {
#ifndef SKIP_G3
            pg8::Gemm g{C.mb, C.wt_out}; pg8::SchedStd S; S.init(M, D, G, bx, D, D);
            pg8::EpiRes E{C.xb, C.xb, C.ssq, nullptr};
            pg8::gemm_phase<pg8::EpiRes, pg8::SchedStd, true, D, D, D>(lds, g, S, E);
#endif

        }
        BAR(4);
        {
#ifndef SKIP_G4
            pg8::Gemm g{C.xb, C.wt_ff1}; pg8::SchedStd S; S.init(M, FF, G, bx, D, D);
            pg8::EpiFF1 E{C.zg, C.ssq};
            for (int rep = 0; rep < REP_G4; ++rep) pg8::gemm_phase<pg8::EpiFF1, pg8::SchedStd, true, D, D, D>(lds, g, S, E);
#endif

        }
        BAR(5);
        {
#ifndef SKIP_G5
            pg8::Gemm g{C.zg, C.wt_ff2}; pg8::SchedStd S; S.init(M, D, G, bx, FF, FF);
            pg8::EpiRes E{C.xb, C.xb, C.ssq, (l + 1 == DEPTH) ? C.x : nullptr};
            pg8::gemm_phase<pg8::EpiRes, pg8::SchedStd, true, FF, FF, FF>(lds, g, S, E);
#endif

        }
        if (l + 1 < DEPTH) BAR(6);
    }
#if PROBE_KIND >= 0
    if (PROBE_KIND == 6) tacc += __builtin_amdgcn_s_memrealtime() - tprev;
    if (bx == 0 && tid == 0) { const unsigned long long target = tacc * PROBE_MULT, t0 = __builtin_amdgcn_s_memrealtime(); while (__builtin_amdgcn_s_memrealtime() - t0 < target) __builtin_amdgcn_s_sleep(8); }
#endif
}

extern "C" void kernel_launch(void* const* d_in, const int* in_sizes, int n_in, void* d_out, int out_size, void* d_ws, size_t ws_size, hipStream_t stream) {
    static int grid = 0;
    if (grid == 0) {
        if (n_in != 27 || out_size != M * D || ws_size < WS_END) { fprintf(stderr, "kernel_launch: unexpected shapes: n_in %d out %d ws %zu (need %zu)\n", n_in, out_size, ws_size, (size_t)WS_END); grid = -1; return; }
        int dev = 0, cus = 0, per_cu = 0;
        hipGetDevice(&dev); hipDeviceGetAttribute(&cus, hipDeviceAttributeMultiprocessorCount, dev);
        if (hipFuncSetAttribute((const void*)fwd_megakernel, hipFuncAttributeMaxDynamicSharedMemorySize, LDS_BYTES) != hipSuccess) { fprintf(stderr, "kernel_launch: hipFuncSetAttribute failed\n"); grid = -1; return; }
        if (hipOccupancyMaxActiveBlocksPerMultiprocessor(&per_cu, (const void*)fwd_megakernel, 512, LDS_BYTES) != hipSuccess || per_cu < 1) { fprintf(stderr, "kernel_launch: occupancy query says %d\n", per_cu); per_cu = 1; }
        (void)hipGetLastError();
        grid = cus;
        if (grid != 256) fprintf(stderr, "kernel_launch: note: %d CUs\n", grid);
    }
    if (grid < 0) return;
    hipMemsetAsync((char*)d_ws + WS_CTL, 0, CTL_ZERO_BYTES, stream);
    Args a{};
    for (int i = 0; i < 27; ++i) a.in[i] = (const float*)d_in[i];
    a.out = (float*)d_out; a.ws = (unsigned char*)d_ws;
    void* kargs[] = {&a};
    hipError_t e = hipLaunchCooperativeKernel((const void*)fwd_megakernel, dim3(grid), dim3(512), kargs, LDS_BYTES, stream);
    if (e != hipSuccess) fprintf(stderr, "kernel_launch: cooperative launch failed: %s\n", hipGetErrorString(e));
}
```

```cpp
#include <hip/hip_runtime.h>
#include <hip/hip_cooperative_groups.h>
#include <cstdio>
#include <cstdint>
namespace cg = cooperative_groups;

#define LAS __attribute__((address_space(3)))
#define GAS __attribute__((address_space(1)))
typedef unsigned short bf16_t;
typedef short bf16x8 __attribute__((ext_vector_type(8)));
typedef float f32x4 __attribute__((ext_vector_type(4)));
typedef unsigned u32x4 __attribute__((ext_vector_type(4)));
typedef unsigned u32x2 __attribute__((ext_vector_type(2)));

constexpr int M = 16384, D = 1024, DIN = 7424, NZA = 3328, NZG = 4096, FF = 4096, DEPTH = 4, NO = 2048;
constexpr float EPS = 1e-6f;
constexpr size_t MiB = 1u << 20;
constexpr size_t WS_CTL = 0, CTL_ZERO_BYTES = 64 * 1024;
constexpr size_t WS_WIN = 2 * MiB, WS_WBR = 17 * MiB, WS_WOUT = 21 * MiB, WS_WFF1 = 23 * MiB, WS_WFF2 = 31 * MiB, WS_WKV = 39 * MiB;
constexpr size_t WS_MEMN = 47 * MiB, WS_MEMKV = 48 * MiB, WS_SSQ = 52 * MiB, WS_CARRY = 53 * MiB, WS_XB = 54 * MiB;
constexpr size_t WS_ZA = 86 * MiB, WS_S = 86 * MiB, WS_MB = 150 * MiB, WS_ZG = 190 * MiB, WS_O = 318 * MiB, WS_LY = 382 * MiB, WS_LP = 414 * MiB, WS_MEMK = 446 * MiB, WS_MEMVT = 448 * MiB, WS_SPL = 450 * MiB, WS_AGG = 451 * MiB, WS_INC = 453 * MiB, WS_SSV = 455 * MiB, WS_WGT = 456 * MiB, WS_ROPE = 457 * MiB, WS_END = 458 * MiB;
static_assert(WS_ZA + (size_t)M * NZA * 2 <= WS_ZG && WS_MB + (size_t)M * D * 2 <= WS_ZG && WS_WIN + (size_t)DIN * D * 2 <= WS_WBR, "ws map");

constexpr int LDS_BYTES = 147456, MISC_OFF = LDS_BYTES - 256;

__device__ __forceinline__ float bf2f(bf16_t h) { return __uint_as_float((unsigned)h << 16); }
__device__ __forceinline__ unsigned f2bf(float f) { unsigned u = __float_as_uint(f); return (u + 0x7fffu + ((u >> 16) & 1u)) >> 16; }
__device__ __forceinline__ unsigned pk2(float lo, float hi) { return f2bf(lo) | (f2bf(hi) << 16); }
__device__ __forceinline__ unsigned cvt_pk_bf16(float lo, float hi) { unsigned r; asm volatile("v_cvt_pk_bf16_f32 %0, %1, %2" : "=v"(r) : "v"(lo), "v"(hi)); return r; }
#define UNPACK8(VV, f, o) do { (f)[(o) + 0] = __uint_as_float((VV)[0] << 16); (f)[(o) + 1] = __uint_as_float((VV)[0] & 0xffff0000u); (f)[(o) + 2] = __uint_as_float((VV)[1] << 16); (f)[(o) + 3] = __uint_as_float((VV)[1] & 0xffff0000u); \
    (f)[(o) + 4] = __uint_as_float((VV)[2] << 16); (f)[(o) + 5] = __uint_as_float((VV)[2] & 0xffff0000u); (f)[(o) + 6] = __uint_as_float((VV)[3] << 16); (f)[(o) + 7] = __uint_as_float((VV)[3] & 0xffff0000u); } while (0)
#define PACK8(f, o) ((u32x4){cvt_pk_bf16((f)[(o) + 0], (f)[(o) + 1]), cvt_pk_bf16((f)[(o) + 2], (f)[(o) + 3]), cvt_pk_bf16((f)[(o) + 4], (f)[(o) + 5]), cvt_pk_bf16((f)[(o) + 6], (f)[(o) + 7])})
__device__ __forceinline__ float gelu_t(float x) {
    const float c1 = -2.f * 0.7978845608028654f * 1.4426950408889634f, c2 = c1 * 0.044715f;
    return x * __builtin_amdgcn_rcpf(1.f + __builtin_amdgcn_exp2f(x * (c1 + c2 * (x * x)))); }
__device__ __forceinline__ float sigmoid_f(float x) { return __builtin_amdgcn_rcpf(1.f + __expf(-x)); }
__device__ __forceinline__ float row_rstd(const float* ssq, int row) {
    const f32x4* p = (const f32x4*)(ssq + (size_t)row * 16);
    const f32x4 a = p[0], b = p[1], c = p[2], d = p[3];
    const float s = (((a.x + a.y) + (a.z + a.w)) + ((b.x + b.y) + (b.z + b.w))) + (((c.x + c.y) + (c.z + c.w)) + ((d.x + d.y) + (d.z + d.w)));
    return rsqrtf(s * (1.f / 1024.f) + EPS);
}
__device__ __forceinline__ float row_rstd_coop(const float* ssq, int row, int fq) {
    const f32x4 a = *(const f32x4*)(ssq + (size_t)row * 16 + fq * 4);
    float s = (a.x + a.y) + (a.z + a.w);
    s += __shfl_xor(s, 16); s += __shfl_xor(s, 32);
    return rsqrtf(s * (1.f / 1024.f) + EPS);
}
#define LDS_WAIT() asm volatile("s_waitcnt lgkmcnt(0)" ::: "memory")
__device__ __forceinline__ int opaque_tid() { int t = threadIdx.x; asm volatile("" : "+v"(t)); return t; }

namespace pg8 {
constexpr int BM = 256, BK = 64, HALF = 128, HTB = HALF * BK * 2, STAGE_BYTES = 8 * HTB, NXCD = 8, WGM = 8;
__host__ __device__ __forceinline__ int lds_byte(int r, int c) { const int st = (r >> 4) * 2 + (c >> 5), rr = r & 15, cc = c & 31, ob = rr * 64 + cc * 2; return st * 1024 + (ob ^ (((ob >> 9) & 1) << 5)); }
__host__ __device__ __forceinline__ void stage_rc(int b, int& R, int& C) { const int st = b / 1024, sb = b % 1024, swz = sb ^ (((sb >> 9) & 1) << 5); R = (st >> 1) * 16 + swz / 64; C = (st & 1) * 32 + (swz % 64) / 2; }
__host__ __device__ __forceinline__ int perm32(int rho) { const int n = rho >> 4, i = rho & 15; return 8 * (i >> 2) + 4 * n + (i & 3); }

struct Unit { int pm, pn, b; };
struct Gemm { const bf16_t* A; const bf16_t* Bt; };

struct SchedStd {
    int nM, nN, nwg, G, c; size_t as, bs;
    __device__ void init(int M_, int N_, int G_, int c_, int lda, int ldb) { nM = M_ / BM; nN = N_ / BM; nwg = nM * nN; G = G_; c = c_; as = (size_t)BM * lda * 2; bs = (size_t)BM * ldb * 2; }
    __device__ bool tile(long L, Unit& u) const {
        if (L >= nwg) return false;
        int wgid = (int)L; { const int q = nwg / NXCD, r = nwg % NXCD, xcd = wgid % NXCD, off = wgid / NXCD; wgid = (xcd < r ? xcd * (q + 1) : r * (q + 1) + (xcd - r) * q) + off; }
        const int nig = WGM * nN, gid = wgid / nig, fm = gid * WGM, gsz = (nM - fm) < WGM ? (nM - fm) : WGM;
        u.pm = fm + ((wgid % nig) % gsz); u.pn = (wgid % nig) / gsz; u.b = 0; return true;
    }
    __device__ bool next(int i, Unit& u) const { return tile((long)i * G + c, u); }
    __device__ size_t aoff(const Unit& u) const { return (size_t)u.pm * as; }
    __device__ size_t boff(const Unit& u) const { return (size_t)u.pn * bs; }
};
struct SchedMerge {
    SchedStd t;
    __device__ bool next(int i, Unit& u) const { if (!t.tile((long)(i >> 2) * t.G + t.c, u)) return false; u.b = i & 3; return true; }
    __device__ size_t aoff(const Unit& u) const { return (size_t)u.pm * t.as + (size_t)u.b * 1024; }
    __device__ size_t boff(const Unit& u) const { return (size_t)u.pn * t.bs + (size_t)u.b * 1024; }
};
struct SchedKV {
    int c;
    __device__ bool next(int i, Unit& u) const { if (i > 0 || c >= 32) return false; u.b = c >> 3; u.pm = (c & 7) >> 2; u.pn = c & 3; return true; }
    __device__ size_t aoff(const Unit& u) const { return (size_t)u.pm * 256 * 1024 * 2; }
    __device__ size_t boff(const Unit& u) const { return ((size_t)u.b * 1024 + (size_t)u.pn * 256) * 1024 * 2; }
};

struct EpiZ {
    static constexpr bool PERM = true, KEEPS = false;
    bf16_t* za; bf16_t* zg; const float* ssq; const float* bgate; float* ssv;
    __device__ __forceinline__ void operator()(const f32x4 (&acc)[2][2][4][2], const Unit& u, int wr, int wc, int fr, int fq) const {
        const int row0 = u.pm * BM + wr * 64 + fr, pn = u.pn;
        bf16_t* base; int ldc, colt, mode;
        if (pn < 13) { base = za; ldc = NZA; colt = pn * 256; mode = (pn < 4 || pn == 6 || pn == 7) ? 1 : 0; }
        else { base = zg; ldc = NZG; colt = (pn - 13) * 256; mode = 2; }
        const int col0 = colt + wc * 32 + 8 * fq;
        const int d0 = 64 * (pn - 13) + 16 * wc + 4 * fq;
        f32x4 bv[2][2];
#pragma unroll
        for (int bj = 0; bj < 2; ++bj)
#pragma unroll
            for (int n = 0; n < 2; ++n) bv[bj][n] = (mode == 2) ? *(const f32x4*)(bgate + (2 * bj + n) * 1024 + d0) : (f32x4){0.f, 0.f, 0.f, 0.f};
        float rsa[2][4];
#pragma unroll
        for (int ai = 0; ai < 2; ++ai)
#pragma unroll
            for (int m = 0; m < 4; ++m) rsa[ai][m] = row_rstd_coop(ssq, row0 + ai * HALF + m * 16, fq);
        asm volatile("" ::: "memory");
#pragma unroll
        for (int ai = 0; ai < 2; ++ai) {
#pragma unroll
            for (int m = 0; m < 4; ++m) {
                const int row = row0 + ai * HALF + m * 16; const float rs = rsa[ai][m]; float vss = 0.f;
                bf16_t* rowp = base + (size_t)row * ldc + col0;
                if (mode == 2) {
                    f32x4 sden[4];
#pragma unroll
                    for (int b2 = 0; b2 < 4; ++b2) { const f32x4 zv = acc[ai][b2 >> 1][m][b2 & 1] * (rs * -1.4426950408889634f) + bv[b2 >> 1][b2 & 1] * -1.4426950408889634f;
#pragma unroll
                        for (int e = 0; e < 4; ++e) sden[b2][e] = 1.f + __builtin_amdgcn_exp2f(fminf(zv[e], 66.f)); }
#pragma unroll
                    for (int b2 = 0; b2 < 4; ++b2) { f32x4 rv;
#pragma unroll
                        for (int e = 0; e < 4; ++e) { const float ig = __builtin_amdgcn_rcpf(sden[b2][e]); rv[e] = (b2 < 3) ? sden[b2 + 1][e] * ig : ig; }
                        *(u32x2*)(zg + (size_t)row * NZG + b2 * 1024 + d0) = (u32x2){cvt_pk_bf16(rv[0], rv[1]), cvt_pk_bf16(rv[2], rv[3])}; }
                    continue;
                }
#pragma unroll
                for (int bj = 0; bj < 2; ++bj) {
                    f32x4 v0 = acc[ai][bj][m][0] * rs, v1 = acc[ai][bj][m][1] * rs;
                    if (mode == 1) {
#pragma unroll
                        for (int e = 0; e < 4; ++e) { v0[e] = gelu_t(v0[e]); v1[e] = gelu_t(v1[e]); }
                    } else if (mode == 2) {
                        v0 = v0 + bv[bj][0]; v1 = v1 + bv[bj][1];
#pragma unroll
                        for (int e = 0; e < 4; ++e) { v0[e] = sigmoid_f(v0[e]); v1[e] = sigmoid_f(v1[e]); }
                    }
                    u32x4 w; w.x = cvt_pk_bf16(v0[0], v0[1]); w.y = cvt_pk_bf16(v0[2], v0[3]); w.z = cvt_pk_bf16(v1[0], v1[1]); w.w = cvt_pk_bf16(v1[2], v1[3]);
                    *(u32x4*)(rowp + bj * HALF) = w;
                    if (pn == 2 || pn == 3) vss += (v0[0] * v0[0] + v0[1] * v0[1]) + (v0[2] * v0[2] + v0[3] * v0[3]) + (v1[0] * v1[0] + v1[1] * v1[1]) + (v1[2] * v1[2] + v1[3] * v1[3]);
                }
                if (pn == 2 || pn == 3) { vss += __shfl_xor(vss, 16); vss += __shfl_xor(vss, 32); if (fq == 0) ssv[(size_t)row * 8 + (pn - 2) * 4 + wc] = vss; }
            }
            asm volatile("" ::: "memory");
        }
    }
};
struct EpiFF1 {
    static constexpr bool PERM = true, KEEPS = false;
    bf16_t* f; const float* ssq;
    __device__ __forceinline__ void operator()(const f32x4 (&acc)[2][2][4][2], const Unit& u, int wr, int wc, int fr, int fq) const {
        const int row0 = u.pm * BM + wr * 64 + fr, col0 = u.pn * BM + wc * 32 + 8 * fq;
        float rsa[2][4];
#pragma unroll
        for (int ai = 0; ai < 2; ++ai)
#pragma unroll
            for (int m = 0; m < 4; ++m) rsa[ai][m] = row_rstd_coop(ssq, row0 + ai * HALF + m * 16, fq);
        asm volatile("" ::: "memory");
#pragma unroll
        for (int ai = 0; ai < 2; ++ai) {
#pragma unroll
            for (int m = 0; m < 4; ++m) {
                const int row = row0 + ai * HALF + m * 16; const float rs = rsa[ai][m];
                bf16_t* rowp = f + (size_t)row * FF + col0;
#pragma unroll
                for (int bj = 0; bj < 2; ++bj) {
                    f32x4 v0 = acc[ai][bj][m][0] * rs, v1 = acc[ai][bj][m][1] * rs;
#pragma unroll
                    for (int e = 0; e < 4; ++e) { const float a = fmaxf(v0[e], 0.f), b = fmaxf(v1[e], 0.f); v0[e] = a * a; v1[e] = b * b; }
                    u32x4 w; w.x = cvt_pk_bf16(v0[0], v0[1]); w.y = cvt_pk_bf16(v0[2], v0[3]); w.z = cvt_pk_bf16(v1[0], v1[1]); w.w = cvt_pk_bf16(v1[2], v1[3]);
                    *(u32x4*)(rowp + bj * HALF) = w;
                }
            }
            asm volatile("" ::: "memory");
        }
    }
};
struct EpiRes {
    static constexpr bool PERM = true, KEEPS = false;
    const bf16_t* xin; bf16_t* xb; float* ssq; float* xout;
    __device__ __forceinline__ void operator()(const f32x4 (&acc)[2][2][4][2], const Unit& u, int wr, int wc, int fr, int fq) const {
        const int row0 = u.pm * BM + wr * 64 + fr, col0 = u.pn * BM + wc * 32 + 8 * fq;
#pragma unroll
        for (int ai = 0; ai < 2; ++ai) {
            u32x4 xo[4][2];
#pragma unroll
            for (int m = 0; m < 4; ++m)
#pragma unroll
                for (int bj = 0; bj < 2; ++bj) xo[m][bj] = *(const u32x4*)(xin + (size_t)(row0 + ai * HALF + m * 16) * D + col0 + bj * HALF);
            asm volatile("" ::: "memory");
#pragma unroll
            for (int m = 0; m < 4; ++m) {
                const int row = row0 + ai * HALF + m * 16; float ss = 0.f;
#pragma unroll
                for (int bj = 0; bj < 2; ++bj) {
                    float xf[8]; UNPACK8(xo[m][bj], xf, 0);
                    const f32x4 v0 = (f32x4){xf[0], xf[1], xf[2], xf[3]} + acc[ai][bj][m][0], v1 = (f32x4){xf[4], xf[5], xf[6], xf[7]} + acc[ai][bj][m][1];
                    ss += (v0[0] * v0[0] + v0[1] * v0[1]) + (v0[2] * v0[2] + v0[3] * v0[3]) + (v1[0] * v1[0] + v1[1] * v1[1]) + (v1[2] * v1[2] + v1[3] * v1[3]);
                    u32x4 w; w.x = cvt_pk_bf16(v0[0], v0[1]); w.y = cvt_pk_bf16(v0[2], v0[3]); w.z = cvt_pk_bf16(v1[0], v1[1]); w.w = cvt_pk_bf16(v1[2], v1[3]);
                    *(u32x4*)(xb + (size_t)row * D + col0 + bj * HALF) = w;
                    if (xout) { float* xp = xout + (size_t)row * D + col0 + bj * HALF; *(f32x4*)xp = v0; *(f32x4*)(xp + 4) = v1; }
                }
                ss += __shfl_xor(ss, 16); ss += __shfl_xor(ss, 32);
                if (fq == 0) ssq[(size_t)row * 16 + u.pn * 4 + wc] = ss;
            }
            asm volatile("" ::: "memory");
        }
    }
};
struct EpiMerge {
    static constexpr bool PERM = true, KEEPS = true;
    const bf16_t* zg; bf16_t* mb;
    __device__ __forceinline__ bool merge(f32x4 (&acc)[2][2][4][2], const Unit& u, int wr, int wc, int fr, int fq) const {
        const int row0 = u.pm * BM + wr * 64 + fr, col0 = u.pn * BM + wc * 32 + 8 * fq, b = u.b;
        u32x4 ga[2][4][2];
#pragma unroll
        for (int ai = 0; ai < 2; ++ai)
#pragma unroll
            for (int m = 0; m < 4; ++m)
#pragma unroll
                for (int bj = 0; bj < 2; ++bj) ga[ai][m][bj] = *(const u32x4*)(zg + (size_t)(row0 + ai * HALF + m * 16) * NZG + b * 1024 + col0 + bj * HALF);
        asm volatile("" ::: "memory");
#pragma unroll
        for (int ai = 0; ai < 2; ++ai) {
#pragma unroll
            for (int m = 0; m < 4; ++m) {
                const int row = row0 + ai * HALF + m * 16;
#pragma unroll
                for (int bj = 0; bj < 2; ++bj) {
                    const int col = col0 + bj * HALF;
                    float g[8]; UNPACK8(ga[ai][m][bj], g, 0);
#pragma unroll
                    for (int e = 0; e < 4; ++e) { acc[ai][bj][m][0][e] *= g[e]; acc[ai][bj][m][1][e] *= g[4 + e]; }
                    if (b == 3) { const f32x4 v0 = acc[ai][bj][m][0], v1 = acc[ai][bj][m][1];
                        u32x4 w; w.x = cvt_pk_bf16(v0[0], v0[1]); w.y = cvt_pk_bf16(v0[2], v0[3]); w.z = cvt_pk_bf16(v1[0], v1[1]); w.w = cvt_pk_bf16(v1[2], v1[3]);
                        *(u32x4*)(mb + (size_t)row * D + col) = w; }
                }
            }
        }
        asm volatile("" ::: "memory");
        return b < 3;
    }
};
struct EpiKV {
    static constexpr bool PERM = true, KEEPS = false;
    bf16_t* out;
    __device__ __forceinline__ void operator()(const f32x4 (&acc)[2][2][4][2], const Unit& u, int wr, int wc, int fr, int fq) const {
        const int row0 = u.pm * BM + wr * 64 + fr, col0 = u.pn * BM + wc * 32 + 8 * fq;
        bf16_t* base = out + (size_t)u.b * 512 * 1024;
#pragma unroll
        for (int ai = 0; ai < 2; ++ai)
#pragma unroll
            for (int m = 0; m < 4; ++m) {
                const int row = row0 + ai * HALF + m * 16;
#pragma unroll
                for (int bj = 0; bj < 2; ++bj) {
                    const f32x4 v0 = acc[ai][bj][m][0], v1 = acc[ai][bj][m][1];
                    u32x4 w; w.x = cvt_pk_bf16(v0[0], v0[1]); w.y = cvt_pk_bf16(v0[2], v0[3]); w.z = cvt_pk_bf16(v1[0], v1[1]); w.w = cvt_pk_bf16(v1[2], v1[3]);
                    *(u32x4*)(base + (size_t)row * 1024 + col0 + bj * HALF) = w;
                }
            }
    }
};

template <class Epi, class Sched, bool ALIGN_EPI, int LDA, int LDB, int KK>
__device__ __forceinline__ void gemm_phase(LAS unsigned char* lds, const Gemm g, const Sched& S, const Epi& E) {
    const int tid = opaque_tid(), wid = __builtin_amdgcn_readfirstlane(tid >> 6), lane = tid & 63, wr = wid >> 2, wc = wid & 3, fr = lane & 15, fq = lane >> 4;
    constexpr int nt = KK / BK;
    unsigned voffA[2], voffB[2];
#pragma unroll
    for (int i = 0; i < 2; ++i) { int R, C; stage_rc(tid * 16 + i * 8192, R, C); const int Rb = Epi::PERM ? ((R & ~31) + perm32(R & 31)) : R;
        voffA[i] = (unsigned)(R * LDA + C) * 2u; voffB[i] = (unsigned)(Rb * LDB + C) * 2u; }
    constexpr size_t kstep = (size_t)(BK * 2);
    constexpr size_t hstepA = (size_t)HALF * LDA * 2, hstepB = (size_t)HALF * LDB * 2;
    const unsigned ldsw = (unsigned)wid * 1024u;
    const int aoff = lds_byte(wr * 64 + fr, fq * 8), boff = lds_byte(wc * 32 + fr, fq * 8);
#define PG8_SA(b, h) (((b) * 2 + (h)) * HTB)
#define PG8_SB(b, h) ((4 + (b) * 2 + (h)) * HTB)
#define PG8_STAGE(bufoff, gbase, voff) do { _Pragma("unroll") for (int _i = 0; _i < 2; ++_i) \
        __builtin_amdgcn_global_load_lds((const unsigned*)((const char*)(gbase) + (voff)[_i]), (LAS unsigned*)(lds + (bufoff) + ldsw + _i * 8192), 16, 0, 0); } while (0)
#define PG8_LDA(dst, b, h) do { _Pragma("unroll") for (int m = 0; m < 4; ++m) _Pragma("unroll") for (int k = 0; k < 2; ++k) dst[m][k] = *(const LAS bf16x8*)(lds + PG8_SA(b, h) + aoff + m * 2048 + k * 1024); } while (0)
#define PG8_LDB(dst, b, h) do { _Pragma("unroll") for (int n = 0; n < 2; ++n) _Pragma("unroll") for (int k = 0; k < 2; ++k) dst[n][k] = *(const LAS bf16x8*)(lds + PG8_SB(b, h) + boff + n * 2048 + k * 1024); } while (0)
#define PG8_MMA(ai, bj, At, Bt) do { __builtin_amdgcn_s_setprio(1); _Pragma("unroll") for (int m = 0; m < 4; ++m) _Pragma("unroll") for (int n = 0; n < 2; ++n) _Pragma("unroll") for (int k = 0; k < 2; ++k) \
        acc[ai][bj][m][n] = __builtin_amdgcn_mfma_f32_16x16x32_bf16(Bt[n][k], At[m][k], acc[ai][bj][m][n], 0, 0, 0); __builtin_amdgcn_s_setprio(0); } while (0)
#define PG8_WAIT_V(n) asm volatile("s_waitcnt vmcnt(" #n ")" ::: "memory")
#define PG8_WAIT_L(n) asm volatile("s_waitcnt lgkmcnt(" #n ")" ::: "memory")
#define PG8_BAR __builtin_amdgcn_s_barrier()
#define PG8_SCHED __builtin_amdgcn_sched_barrier(0)
    Unit cur, nxt; int ui = 0;
    if (!S.next(0, cur)) return;
    f32x4 acc[2][2][4][2];
#pragma unroll
    for (int a = 0; a < 2; ++a)
#pragma unroll
        for (int b = 0; b < 2; ++b)
#pragma unroll
            for (int m = 0; m < 4; ++m)
#pragma unroll
                for (int n = 0; n < 2; ++n) acc[a][b][m][n] = (f32x4){0.f, 0.f, 0.f, 0.f};
    bf16x8 At[4][2], B0[2][2], B1[2][2];
    const char* gA = (const char*)g.A; const char* gB = (const char*)g.Bt;
    asm volatile("" : "+s"(gA), "+s"(gB));
    const char* cA = gA + S.aoff(cur); const char* cB = gB + S.boff(cur);
    PG8_STAGE(PG8_SB(0, 0), cB, voffB); PG8_STAGE(PG8_SB(0, 1), cB + hstepB, voffB); PG8_STAGE(PG8_SA(0, 0), cA, voffA); PG8_STAGE(PG8_SA(0, 1), cA + hstepA, voffA);
    if (wr == 1) PG8_BAR;
    PG8_WAIT_V(2); PG8_BAR;
    PG8_STAGE(PG8_SB(1, 0), cB + kstep, voffB); PG8_STAGE(PG8_SA(1, 0), cA + kstep, voffA); PG8_STAGE(PG8_SB(1, 1), cB + hstepB + kstep, voffB);
    PG8_WAIT_V(6); PG8_BAR;
    for (;;) {
        const bool has_next = S.next(ui + 1, nxt);
        const char* nA = has_next ? gA + S.aoff(nxt) : cA; const char* nB = has_next ? gB + S.boff(nxt) : cB;
        for (int t = 0; t < nt; t += 2) {
            const bool last = (t == nt - 2);
            const char* a1 = cA + (size_t)(t + 1) * kstep;
            const char* a2 = last ? nA : cA + (size_t)(t + 2) * kstep; const char* b2 = last ? nB : cB + (size_t)(t + 2) * kstep;
            const char* a3 = a2 + kstep; const char* b3 = b2 + kstep;
            PG8_LDB(B0, 0, 0); PG8_LDB(B1, 0, 1); PG8_SCHED; PG8_LDA(At, 0, 0); PG8_STAGE(PG8_SA(1, 1), a1 + hstepA, voffA);
            PG8_WAIT_V(8); PG8_WAIT_L(0); PG8_BAR; PG8_MMA(0, 0, At, B0); PG8_MMA(0, 1, At, B1); PG8_BAR; PG8_SCHED;
            PG8_LDA(At, 0, 1); PG8_STAGE(PG8_SB(0, 0), b2, voffB); PG8_STAGE(PG8_SB(0, 1), b2 + hstepB, voffB); PG8_STAGE(PG8_SA(0, 0), a2, voffA);
            PG8_WAIT_V(8); PG8_WAIT_L(0); PG8_BAR; PG8_MMA(1, 0, At, B0); PG8_MMA(1, 1, At, B1); PG8_BAR; PG8_SCHED;
            PG8_LDB(B0, 1, 0); PG8_LDB(B1, 1, 1); PG8_SCHED; PG8_LDA(At, 1, 0); PG8_STAGE(PG8_SA(0, 1), a2 + hstepA, voffA);
            PG8_WAIT_V(8); PG8_WAIT_L(0); PG8_BAR; PG8_MMA(0, 0, At, B0); PG8_MMA(0, 1, At, B1); PG8_BAR; PG8_SCHED;
            PG8_LDA(At, 1, 1); PG8_STAGE(PG8_SB(1, 0), b3, voffB); PG8_STAGE(PG8_SB(1, 1), b3 + hstepB, voffB); PG8_STAGE(PG8_SA(1, 0), a3, voffA);
            PG8_WAIT_V(8); PG8_WAIT_L(0); PG8_BAR; PG8_MMA(1, 0, At, B0); PG8_MMA(1, 1, At, B1); PG8_BAR; PG8_SCHED;
        }
        if constexpr (ALIGN_EPI) { if (wr == 0) PG8_BAR; }
        bool keep = false;
        if constexpr (Epi::KEEPS) keep = E.merge(acc, cur, wr, wc, fr, fq); else E(acc, cur, wr, wc, fr, fq);
        if (!has_next) break;
        if (!keep)
#pragma unroll
        for (int a = 0; a < 2; ++a)
#pragma unroll
            for (int b = 0; b < 2; ++b)
#pragma unroll
                for (int m = 0; m < 4; ++m)
#pragma unroll
                    for (int n = 0; n < 2; ++n) acc[a][b][m][n] = (f32x4){0.f, 0.f, 0.f, 0.f};
        cur = nxt; cA = nA; cB = nB; ++ui;
        if constexpr (ALIGN_EPI) { if (wr == 1) PG8_BAR; }
    }
    PG8_WAIT_V(0);
    if constexpr (!ALIGN_EPI) { if (wr == 0) PG8_BAR; }
    PG8_BAR;
#undef PG8_SA
#undef PG8_SB
#undef PG8_STAGE
#undef PG8_LDA
#undef PG8_LDB
#undef PG8_MMA
#undef PG8_WAIT_V
#undef PG8_WAIT_L
#undef PG8_BAR
#undef PG8_SCHED
}
}

#define XB_TMO      128
#define XB_XCNT(j)  (256  + 64 * (j))
#define XB_XSUB(j)  (1280 + 64 * (j))
#define XB_XGEN(j)  (2304 + 64 * (j))
#define XB_TOP      3328
#define XB_TOPGEN   3392
#define XCD_BAR_WORDS 3456
#define XB_SPIN_CAP (1u << 23)
__device__ __forceinline__ unsigned xb_ld(unsigned* p)              { return __hip_atomic_load(p, __ATOMIC_RELAXED, __HIP_MEMORY_SCOPE_AGENT); }
__device__ __forceinline__ unsigned xb_add(unsigned* p, unsigned v) { return __hip_atomic_fetch_add(p, v, __ATOMIC_RELAXED, __HIP_MEMORY_SCOPE_AGENT); }
__device__ __forceinline__ unsigned xb_xcc_id() { return (unsigned)__builtin_amdgcn_s_getreg((3 << 11) | 20) & 0xFu; }
#define XB_SPIN(cond, bar) do { unsigned _sp = 0; while (cond) { __builtin_amdgcn_s_sleep(1); \
    if ((++_sp & 255u) == 0u) { if (xb_ld(&(bar)[XB_TMO])) break; if (_sp > XB_SPIN_CAP) { atomicAdd(&(bar)[XB_TMO], 1u); break; } } } } while (0)
struct XcdBarrier { unsigned* bar; unsigned x; volatile LAS unsigned* st; };
__device__ __forceinline__ XcdBarrier xcd_barrier_post(unsigned* bar, volatile LAS unsigned* st) {
    XcdBarrier b; b.bar = bar; b.x = xb_xcc_id(); b.st = st;
    if (threadIdx.x == 0) (void)xb_add(&bar[XB_XCNT(b.x)], 1u);
    return b;
}
__device__ __forceinline__ void xcd_barrier_complete(unsigned* bar, unsigned x, unsigned& nloc, unsigned& nx) {
    const unsigned G = gridDim.x * gridDim.y * gridDim.z;
    unsigned sum, cnt, mine, sp = 0u;
    for (;;) {
        sum = 0u; cnt = 0u; mine = 0u;
#pragma unroll
        for (unsigned j = 0; j < 16; ++j) { const unsigned c = xb_ld(&bar[XB_XCNT(j)]); sum += c; cnt += (c > 0u) ? 1u : 0u; mine = (j == x) ? c : mine; }
        if (sum == G) break;
        __builtin_amdgcn_s_sleep(1);
        if ((++sp & 255u) == 0u) { if (xb_ld(&bar[XB_TMO])) break; if (sp > XB_SPIN_CAP) { atomicAdd(&bar[XB_TMO], 1u); break; } }
    }
    nloc = mine > 0u ? mine : 1u; nx = cnt > 0u ? cnt : 1u;
}
__device__ __forceinline__ void xcd_barrier(const XcdBarrier& b) {
    asm volatile("s_waitcnt vmcnt(0)" ::: "memory");
    __syncthreads();
    if (threadIdx.x == 0) {
        unsigned* bar = b.bar;
        asm volatile("" : "+s"(bar));
        __builtin_amdgcn_s_waitcnt(0);
        unsigned nloc = b.st[0], nx = b.st[1];
        const unsigned bxcc = xb_xcc_id();
        if (nloc == 0u) { xcd_barrier_complete(bar, bxcc, nloc, nx); b.st[0] = nloc; b.st[1] = nx; }
        const unsigned old = xb_add(&bar[XB_XSUB(bxcc)], 1u);
        const unsigned gen = old / nloc;
        if (old + 1u == (gen + 1u) * nloc) {
            __builtin_amdgcn_fence(__ATOMIC_RELEASE, "agent");
            asm volatile("s_waitcnt vmcnt(0)" ::: "memory");
            const unsigned og = xb_add(&bar[XB_TOP], 1u);
            const unsigned tg = og / nx;
            if (og + 1u == (tg + 1u) * nx) xb_add(&bar[XB_TOPGEN], 1u);
            else XB_SPIN(xb_ld(&bar[XB_TOPGEN]) == tg, bar);
            __builtin_amdgcn_fence(__ATOMIC_ACQUIRE, "agent");
            xb_add(&bar[XB_XGEN(bxcc)], 1u);
            asm volatile("s_waitcnt vmcnt(0)" ::: "memory");
        } else {
            XB_SPIN(xb_ld(&bar[XB_XGEN(bxcc)]) == gen, bar);
            __builtin_amdgcn_fence(__ATOMIC_ACQUIRE, "agent");
            asm volatile("s_waitcnt vmcnt(0)" ::: "memory");
        }
    }
    __syncthreads();
}

struct Args { const float* in[27]; float* out; unsigned char* ws; };
enum { I_X = 0, I_MEM, I_NMIX, I_NMEM, I_NMLP, I_WIN, I_BGATE, I_GMVG, I_GMWS, I_GMBS, I_CONVW, I_CONVB, I_WR, I_BR, I_WI, I_BI, I_LAM, I_SQG, I_SKG, I_SINK, I_WKV, I_XQG, I_XKG, I_WBR, I_WOUT, I_WFF1, I_WFF2 };
struct Ctx {
    const float* const* in; float* x;
    bf16_t *wt_in, *wt_br, *wt_out, *wt_ff1, *wt_ff2, *wt_kv, *memn, *memkv, *xb, *za, *zg, *mb, *o;
    float *ssq, *carryA, *carryH, *S, *ly, *lp;
    bf16_t *memK, *memVt;
    float* spl;
    float* rope;
    float* ssv;
    bf16_t* wgT;
    unsigned long long *agg, *inc;
};

__device__ __forceinline__ int win_row(int n) {
    if (n < NZA) return n;
    const int ng = n - NZA, b = ng >> 10, d = ng & 1023, q = d >> 6, dc = d & 63;
    return NZA + q * 256 + 128 * (b >> 1) + 32 * (dc >> 4) + 8 * ((dc >> 2) & 3) + 4 * (b & 1) + (dc & 3);
}
template <bool GATEPERM>
__device__ __forceinline__ void transpose_item(const float* W, int N, bf16_t* WT, int ldk, int koff, const float* gain, LAS float* scr, int item, int lane) {
    const int nblk = N / 32, kb = item / nblk, nb = item % nblk, k0 = 64 * kb, n0 = 32 * nb;
    float v[32];
    const float* wp = W + (size_t)(k0 + (lane >> 5)) * N + n0 + (lane & 31);
#pragma unroll
    for (int i = 0; i < 32; ++i) v[i] = wp[(size_t)(2 * i) * N];
    if (gain) {
#pragma unroll
        for (int i = 0; i < 32; ++i) v[i] *= gain[k0 + 2 * i + (lane >> 5)];
    }
#pragma unroll
    for (int i = 0; i < 32; ++i) scr[(2 * i + (lane >> 5)) * 33 + (lane & 31)] = v[i];
    LDS_WAIT(); asm volatile("" ::: "memory");
    const int c = lane & 7;
#pragma unroll
    for (int j = 0; j < 4; ++j) { const int n = (lane >> 3) + 8 * j; const LAS float* s = scr + (8 * c) * 33 + n;
        u32x4 o; o.x = cvt_pk_bf16(s[0 * 33], s[1 * 33]); o.y = cvt_pk_bf16(s[2 * 33], s[3 * 33]); o.z = cvt_pk_bf16(s[4 * 33], s[5 * 33]); o.w = cvt_pk_bf16(s[6 * 33], s[7 * 33]);
        *(u32x4*)(WT + (size_t)(GATEPERM ? win_row(n0 + n) : n0 + n) * ldk + koff + k0 + 8 * c) = o; }
    LDS_WAIT(); asm volatile("" ::: "memory");
}
__device__ __forceinline__ float wave_sum(float v) {
#pragma unroll
    for (int o = 1; o < 64; o <<= 1) v += __shfl_xor(v, o);
    return v;
}
__device__ __forceinline__ void conv_w(const Ctx& C, int which, int l, int item, LAS float* scr, int lane) {
    if (which == 0) transpose_item<true>(C.in[I_WIN] + (size_t)l * D * DIN, DIN, C.wt_in, D, 0, C.in[I_NMIX] + l * D, scr, item, lane);
    else if (which == 1) { const int b = item >> 8; transpose_item<false>(C.in[I_WBR] + (size_t)(l * 4 + b) * 512 * D, D, C.wt_br, 2048, b * 512, nullptr, scr, item & 255, lane); }
    else if (which == 2) transpose_item<false>(C.in[I_WOUT] + (size_t)l * D * D, D, C.wt_out, D, 0, nullptr, scr, item, lane);
    else if (which == 3) transpose_item<false>(C.in[I_WFF1] + (size_t)l * D * FF, FF, C.wt_ff1, D, 0, C.in[I_NMLP] + l * D, scr, item, lane);
    else if (which == 4) transpose_item<false>(C.in[I_WFF2] + (size_t)l * FF * D, D, C.wt_ff2, FF, 0, nullptr, scr, item, lane);
    else transpose_item<false>(C.in[I_WKV] + (size_t)l * D * D, D, C.wt_kv + (size_t)l * D * D, D, 0, C.in[I_NMEM] + l * D, scr, item, lane);
}
constexpr int IT_WIN = 16 * 232, IT_WBR = 1024, IT_WOUT = 512, IT_WFF1 = 2048, IT_WFF2 = 2048, IT_WKV = 512;

#ifndef REP_SWA
#define REP_SWA 1
#endif
#ifndef REP_XA
#define REP_XA 1
#endif
#ifndef REP_GM
#define REP_GM 1
#endif
#ifndef REP_LRU
#define REP_LRU 1
#endif
#ifndef REP_CONV
#define REP_CONV 1
#endif
#ifndef REP_FIX
#define REP_FIX 1
#endif
#ifndef REP_G1
#define REP_G1 1
#endif
#ifndef REP_G2
#define REP_G2 1
#endif
#ifndef REP_G4
#define REP_G4 1
#endif
#ifndef REP_G3
#define REP_G3 1
#endif
#ifndef REP_G5
#define REP_G5 1
#endif
#ifndef REP_MIX
#define REP_MIX 1
#endif
#ifndef REP_BAR
#define REP_BAR 1
#endif
#ifndef USE_MFMA_SWA
#define USE_MFMA_SWA 1
#endif
#ifndef USE_MFMA_XA
#define USE_MFMA_XA 1
#endif
#ifndef USE_MFMA_GM
#define USE_MFMA_GM 1
#endif
#ifndef USE_MFMA_LRU
#define USE_MFMA_LRU 1
#endif
#define ROPE_INV(i) ((i) == 0 ? 1.0f : (i) == 1 ? 0.19392274474868576f : (i) == 2 ? 0.03760603093086393f : (i) == 3 ? 0.007292664737217109f : (i) == 4 ? 0.001414213562373095f : (i) == 5 ? 0.0002742481756762073f : (i) == 6 ? 5.318295896944988e-05f : 1.031338537721246e-05f)
#define ROPE16T(f, tab) do { _Pragma("unroll") for (int _i = 0; _i < 4; ++_i) { const f32x4 _cs = ((const f32x4*)(tab))[_i]; \
    { const float _x1 = (f)[2 * _i], _x2 = (f)[2 * _i + 8]; (f)[2 * _i] = _x1 * _cs[0] - _x2 * _cs[1]; (f)[2 * _i + 8] = _x2 * _cs[0] + _x1 * _cs[1]; } \
    { const float _x1 = (f)[2 * _i + 1], _x2 = (f)[2 * _i + 9]; (f)[2 * _i + 1] = _x1 * _cs[2] - _x2 * _cs[3]; (f)[2 * _i + 9] = _x2 * _cs[2] + _x1 * _cs[3]; } } } while (0)
#define ROPE16(f, pos) do { _Pragma("unroll") for (int _i = 0; _i < 8; ++_i) { float _s, _c; sincosf((pos) * ROPE_INV(_i), &_s, &_c); const float _x1 = (f)[_i], _x2 = (f)[_i + 8]; (f)[_i] = _x1 * _c - _x2 * _s; (f)[_i + 8] = _x2 * _c + _x1 * _s; } } while (0)

__device__ __forceinline__ void swa_item(LAS unsigned char* lds, const Ctx& C, int l, int tile, int h) {
    const int tid = opaque_tid();
    LAS bf16_t* Ks = (LAS bf16_t*)lds;
    LAS bf16_t* Vs = Ks + 256 * 72;
    const int kvh = h >> 2, nb = tile & 63, row0 = tile * 128;
    {
        const int key = tid >> 1, half = tid & 1;
        const bool ok = (nb > 0) || (key >= 128);
        const size_t grow = (size_t)(ok ? row0 - 128 + key : row0);
        const u32x4* kp = (const u32x4*)(C.za + grow * NZA + 2560 + kvh * 64 + half * 32);
        const u32x4* vp = (const u32x4*)(C.za + grow * NZA + 2688 + kvh * 64 + half * 32);
        float kf[32]; float ss = 0.f;
#pragma unroll
        for (int i = 0; i < 4; ++i) { const u32x4 w = kp[i]; UNPACK8(w, kf, 8 * i); }
#pragma unroll
        for (int i = 0; i < 32; ++i) ss += kf[i] * kf[i];
        ss += __shfl_xor(ss, 1);
        const float rs = rsqrtf(ss * (1.f / 64.f) + EPS);
        const float* kg = C.in[I_SKG] + l * 64 + half * 32;
#pragma unroll
        for (int i = 0; i < 32; ++i) kf[i] *= rs * kg[i];
        if (half == 0) { const float pos = (float)(nb * 128 - 128 + key); ROPE16(kf, pos); }
#pragma unroll
        for (int i = 0; i < 4; ++i) { *(LAS u32x4*)(Ks + key * 72 + half * 32 + 8 * i) = PACK8(kf, 8 * i); *(LAS u32x4*)(Vs + key * 72 + half * 32 + 8 * i) = vp[i]; }
    }
    const int q = tid >> 2, sub = tid & 3;
    float qf[16];
    {
        const u32x4* qp = (const u32x4*)(C.za + (size_t)(row0 + q) * NZA + 2048 + h * 64 + sub * 16);
        const u32x4 w0 = qp[0], w1 = qp[1]; UNPACK8(w0, qf, 0); UNPACK8(w1, qf, 8);
        float ss = 0.f;
#pragma unroll
        for (int i = 0; i < 16; ++i) ss += qf[i] * qf[i];
        ss += __shfl_xor(ss, 1); ss += __shfl_xor(ss, 2);
        const float rs = rsqrtf(ss * (1.f / 64.f) + EPS);
        const float* qg = C.in[I_SQG] + l * 64 + sub * 16;
#pragma unroll
        for (int i = 0; i < 16; ++i) qf[i] *= rs * qg[i];
        if (sub == 0) { const float pos = (float)(nb * 128 + q); ROPE16(qf, pos); }
#pragma unroll
        for (int i = 0; i < 16; ++i) qf[i] *= 0.125f;
    }
    __syncthreads();
    const float sink = C.in[I_SINK][l * 8 + h];
    float mx = sink;
    for (int j = 0; j < 128; ++j) {
        const int kj = q + 1 + j; const bool valid = (nb > 0) || (kj >= 128);
        const LAS u32x4* kr = (const LAS u32x4*)(Ks + kj * 72 + sub * 16);
        float kf[16]; const u32x4 w0 = kr[0], w1 = kr[1]; UNPACK8(w0, kf, 0); UNPACK8(w1, kf, 8);
        float s = 0.f;
#pragma unroll
        for (int i = 0; i < 16; ++i) s += qf[i] * kf[i];
        s += __shfl_xor(s, 1); s += __shfl_xor(s, 2);
        if (valid) mx = fmaxf(mx, s);
    }
    float lsum = __expf(sink - mx); float o[16];
#pragma unroll
    for (int i = 0; i < 16; ++i) o[i] = 0.f;
    for (int j = 0; j < 128; ++j) {
        const int kj = q + 1 + j; const bool valid = (nb > 0) || (kj >= 128);
        const LAS u32x4* kr = (const LAS u32x4*)(Ks + kj * 72 + sub * 16);
        float kf[16]; { const u32x4 w0 = kr[0], w1 = kr[1]; UNPACK8(w0, kf, 0); UNPACK8(w1, kf, 8); }
        float s = 0.f;
#pragma unroll
        for (int i = 0; i < 16; ++i) s += qf[i] * kf[i];
        s += __shfl_xor(s, 1); s += __shfl_xor(s, 2);
        const float p = valid ? __expf(s - mx) : 0.f;
        lsum += p;
        const LAS u32x4* vr = (const LAS u32x4*)(Vs + kj * 72 + sub * 16);
        float vf[16]; { const u32x4 w0 = vr[0], w1 = vr[1]; UNPACK8(w0, vf, 0); UNPACK8(w1, vf, 8); }
#pragma unroll
        for (int i = 0; i < 16; ++i) o[i] += p * vf[i];
    }
    const float inv = 1.f / lsum;
#pragma unroll
    for (int i = 0; i < 16; ++i) o[i] *= inv;
    u32x4* op = (u32x4*)(C.o + (size_t)(row0 + q) * NO + 1024 + h * 64 + sub * 16);
    op[0] = PACK8(o, 0); op[1] = PACK8(o, 8);
    __syncthreads();
}

__device__ __forceinline__ void xa_item(LAS unsigned char* lds, const Ctx& C, int l, int tile, int h) {
    const int tid = opaque_tid();
    LAS bf16_t* Ks = (LAS bf16_t*)lds;
    LAS bf16_t* Vs = Ks + 256 * 136;
    const int b = tile >> 6, row0 = tile * 128;
    {
        const int key = tid >> 1, half = tid & 1;
        const bf16_t* src = C.memkv + ((size_t)(l * 512 + b * 256 + key)) * 1024 + h * 128 + half * 64;
        const u32x4* kp = (const u32x4*)src; const u32x4* vp = (const u32x4*)(src + 512);
        float kf[64]; float ss = 0.f;
#pragma unroll
        for (int i = 0; i < 8; ++i) { const u32x4 w = kp[i]; UNPACK8(w, kf, 8 * i); }
#pragma unroll
        for (int i = 0; i < 64; ++i) ss += kf[i] * kf[i];
        ss += __shfl_xor(ss, 1);
        const float rs = rsqrtf(ss * (1.f / 128.f) + EPS);
        const float* kg = C.in[I_XKG] + l * 128 + half * 64;
#pragma unroll
        for (int i = 0; i < 64; ++i) kf[i] *= rs * kg[i];
#pragma unroll
        for (int i = 0; i < 8; ++i) { *(LAS u32x4*)(Ks + key * 136 + half * 64 + 8 * i) = PACK8(kf, 8 * i); *(LAS u32x4*)(Vs + key * 136 + half * 64 + 8 * i) = vp[i]; }
    }
    const int q = tid >> 2, sub = tid & 3;
    float qf[32];
    {
        const u32x4* qp = (const u32x4*)(C.za + (size_t)(row0 + q) * NZA + 2816 + h * 128 + sub * 32);
#pragma unroll
        for (int i = 0; i < 4; ++i) { const u32x4 w = qp[i]; UNPACK8(w, qf, 8 * i); }
        float ss = 0.f;
#pragma unroll
        for (int i = 0; i < 32; ++i) ss += qf[i] * qf[i];
        ss += __shfl_xor(ss, 1); ss += __shfl_xor(ss, 2);
        const float rs = rsqrtf(ss * (1.f / 128.f) + EPS) * 0.08838834764831845f;
        const float* qg = C.in[I_XQG] + l * 128 + sub * 32;
#pragma unroll
        for (int i = 0; i < 32; ++i) qf[i] *= rs * qg[i];
    }
    __syncthreads();
    float mx = -3.0e38f;
    for (int key = 0; key < 256; ++key) {
        const LAS u32x4* kr = (const LAS u32x4*)(Ks + key * 136 + sub * 32);
        float s = 0.f;
#pragma unroll
        for (int c = 0; c < 4; ++c) { float kf[8]; const u32x4 w = kr[c]; UNPACK8(w, kf, 0);
#pragma unroll
            for (int i = 0; i < 8; ++i) s += qf[8 * c + i] * kf[i]; }
        s += __shfl_xor(s, 1); s += __shfl_xor(s, 2);
        mx = fmaxf(mx, s);
    }
    float lsum = 0.f; float o[32];
#pragma unroll
    for (int i = 0; i < 32; ++i) o[i] = 0.f;
    for (int key = 0; key < 256; ++key) {
        const LAS u32x4* kr = (const LAS u32x4*)(Ks + key * 136 + sub * 32);
        float s = 0.f;
#pragma unroll
        for (int c = 0; c < 4; ++c) { float kf[8]; const u32x4 w = kr[c]; UNPACK8(w, kf, 0);
#pragma unroll
            for (int i = 0; i < 8; ++i) s += qf[8 * c + i] * kf[i]; }
        s += __shfl_xor(s, 1); s += __shfl_xor(s, 2);
        const float p = __expf(s - mx);
        lsum += p;
        const LAS u32x4* vr = (const LAS u32x4*)(Vs + key * 136 + sub * 32);
#pragma unroll
        for (int c = 0; c < 4; ++c) { float vf[8]; const u32x4 w = vr[c]; UNPACK8(w, vf, 0);
#pragma unroll
            for (int i = 0; i < 8; ++i) o[8 * c + i] += p * vf[i]; }
    }
    const float inv = 1.f / lsum;
#pragma unroll
    for (int i = 0; i < 32; ++i) o[i] *= inv;
    u32x4* op = (u32x4*)(C.o + (size_t)(row0 + q) * NO + 1536 + h * 128 + sub * 32);
#pragma unroll
    for (int c = 0; c < 4; ++c) op[c] = PACK8(o, 8 * c);
    __syncthreads();
}

__device__ __forceinline__ void gm_item(LAS unsigned char* lds, const Ctx& C, int l, int tile, int g) {
    const int tid = opaque_tid();
    LAS float* vn = (LAS float*)lds;
    LAS float* Wl = vn + 128 * 128;
    LAS float* rsv = Wl + 128 * 128;
    const int row0 = tile * 128;
    {
        const int tok = tid >> 2, sub = tid & 3;
        const u32x4* vp = (const u32x4*)(C.za + (size_t)(row0 + tok) * NZA + 512 + sub * 128);
        float ss = 0.f;
#pragma unroll
        for (int i = 0; i < 16; ++i) { float f[8]; const u32x4 w = vp[i]; UNPACK8(w, f, 0);
#pragma unroll
            for (int e = 0; e < 8; ++e) ss += f[e] * f[e]; }
        ss += __shfl_xor(ss, 1); ss += __shfl_xor(ss, 2);
        if (sub == 0) rsv[tok] = rsqrtf(ss * (1.f / 512.f) + EPS);
        const f32x4* wp = (const f32x4*)(C.in[I_GMWS] + (size_t)(l * 4 + g) * 128 * 128);
#pragma unroll
        for (int i = 0; i < 8; ++i) *(LAS f32x4*)(Wl + (i * 512 + tid) * 4) = wp[i * 512 + tid];
    }
    __syncthreads();
    {
        const int s = tid >> 2, c0 = (tid & 3) * 32;
        const u32x4* vp = (const u32x4*)(C.za + (size_t)(row0 + s) * NZA + 512 + g * 128 + c0);
        const float rs = rsv[s]; const float* vg = C.in[I_GMVG] + l * 512 + g * 128 + c0;
#pragma unroll
        for (int i = 0; i < 4; ++i) { float f[8]; const u32x4 w = vp[i]; UNPACK8(w, f, 0);
#pragma unroll
            for (int e = 0; e < 8; ++e) f[e] *= rs * vg[8 * i + e];
            *(LAS f32x4*)(vn + s * 128 + c0 + 8 * i) = (f32x4){f[0], f[1], f[2], f[3]}; *(LAS f32x4*)(vn + s * 128 + c0 + 8 * i + 4) = (f32x4){f[4], f[5], f[6], f[7]}; }
    }
    __syncthreads();
    {
        const int c = tid & 127, tq = tid >> 7;
        const float* bs = C.in[I_GMBS] + (size_t)(l * 4 + g) * 128;
        for (int k = 0; k < 32; ++k) {
            const int t = tq * 32 + k; float acc = 0.f;
            for (int s = 0; s <= t; ++s) acc += Wl[t * 128 + s] * vn[s * 128 + c];
            const float sval = acc + bs[t];
            const float u = bf2f(C.za[(size_t)(row0 + t) * NZA + g * 128 + c]);
            C.o[(size_t)(row0 + t) * NO + g * 128 + c] = (bf16_t)f2bf(u * sval);
        }
    }
    __syncthreads();
}

__device__ __forceinline__ void lru_item(LAS unsigned char* lds, const Ctx& C, int l, int tile, int hb) {
    const int tid = opaque_tid();
    LAS float* xc = (LAS float*)lds;
    LAS float* wr = xc + 8192;
    LAS float* wi = wr + 4096;
    LAS float* aa = wi + 4096;
    LAS float* bb = aa + 8192;
    const int nb = tile & 63, row0 = tile * 128;
    {
        const int t = tid >> 2, c0 = (tid & 3) * 16, ch = hb * 64 + c0;
        float acc[16];
#pragma unroll
        for (int i = 0; i < 16; ++i) acc[i] = C.in[I_CONVB][l * 512 + ch + i];
#pragma unroll
        for (int k = 0; k < 4; ++k) {
            const int tt = t - 3 + k;
            if (nb * 128 + tt >= 0) {
                const u32x4* xp = (const u32x4*)(C.za + (size_t)(row0 + tt) * NZA + 1024 + ch);
                float f[16]; const u32x4 w0 = xp[0], w1 = xp[1]; UNPACK8(w0, f, 0); UNPACK8(w1, f, 8);
                const float* cw = C.in[I_CONVW] + (size_t)(l * 4 + k) * 512 + ch;
#pragma unroll
                for (int i = 0; i < 16; ++i) acc[i] += cw[i] * f[i];
            }
        }
#pragma unroll
        for (int i = 0; i < 4; ++i) *(LAS f32x4*)(xc + t * 64 + c0 + 4 * i) = (f32x4){acc[4 * i], acc[4 * i + 1], acc[4 * i + 2], acc[4 * i + 3]};
        const f32x4* wrp = (const f32x4*)(C.in[I_WR] + (size_t)(l * 8 + hb) * 4096); const f32x4* wip = (const f32x4*)(C.in[I_WI] + (size_t)(l * 8 + hb) * 4096);
#pragma unroll
        for (int i = 0; i < 2; ++i) { *(LAS f32x4*)(wr + (i * 512 + tid) * 4) = wrp[i * 512 + tid]; *(LAS f32x4*)(wi + (i * 512 + tid) * 4) = wip[i * 512 + tid]; }
    }
    __syncthreads();
    const int j = tid & 63, tg = tid >> 6, chj = hb * 64 + j;
    {
        const float br = C.in[I_BR][l * 512 + chj], bi = C.in[I_BI][l * 512 + chj];
        const float lam = C.in[I_LAM][l * 512 + chj];
        const float sp = log1pf(expf(-lam));
        for (int k = 0; k < 16; ++k) {
            const int t = tg * 16 + k; float r = br, ig = bi;
            for (int i = 0; i < 64; ++i) { const float xv = xc[t * 64 + i]; r += xv * wr[i * 64 + j]; ig += xv * wi[i * 64 + j]; }
            r = sigmoid_f(r); ig = sigmoid_f(ig);
            const float loga = -8.f * r * sp; const float a = expf(loga); const float mult = sqrtf(-expm1f(2.f * loga));
            aa[t * 64 + j] = a; bb[t * 64 + j] = xc[t * 64 + j] * ig * mult;
        }
    }
    __syncthreads();
    if (tid < 64) {
        float hh = 0.f, P = 1.f;
        for (int t = 0; t < 128; ++t) { const float a = aa[t * 64 + tid]; hh = a * hh + bb[t * 64 + tid]; P *= a; aa[t * 64 + tid] = P; bb[t * 64 + tid] = hh; }
        C.carryA[(size_t)tile * 512 + hb * 64 + tid] = P; C.carryH[(size_t)tile * 512 + hb * 64 + tid] = hh;
    }
    __syncthreads();
    for (int k = 0; k < 16; ++k) {
        const int t = tg * 16 + k;
        const float G = bf2f(C.za[(size_t)(row0 + t) * NZA + 1536 + chj]);
        C.ly[(size_t)(row0 + t) * 512 + chj] = G * bb[t * 64 + j]; C.lp[(size_t)(row0 + t) * 512 + chj] = G * aa[t * 64 + j];
    }
    __syncthreads();
}

__device__ __forceinline__ int vperm_pos(int key) { const int w = key & 31; return (key & ~31) + ((w >> 2) & 3) * 8 + (w >> 4) * 4 + (w & 3); }
#define MFMA16(X, Y, ACC) __builtin_amdgcn_mfma_f32_16x16x32_bf16((X), (Y), (ACC), 0, 0, 0)
__device__ __forceinline__ bf16x8 pack_bf16x8(const float* f) { u32x4 w; w[0] = cvt_pk_bf16(f[0], f[1]); w[1] = cvt_pk_bf16(f[2], f[3]); w[2] = cvt_pk_bf16(f[4], f[5]); w[3] = cvt_pk_bf16(f[6], f[7]); return __builtin_bit_cast(bf16x8, w); }

__device__ __forceinline__ void kvprep_phase(const Ctx& C, int gw, int NGW, int lane) {
    for (int r = gw; r < 32 * 256; r += NGW) {
        const int combo = r >> 8, key = r & 255, l = combo >> 3, b = (combo >> 2) & 1, h = combo & 3;
        const unsigned w = *(const unsigned*)(C.memkv + ((size_t)(l * 512 + b * 256 + key)) * 1024 + h * 128 + 2 * lane);
        float f0 = __uint_as_float(w << 16), f1 = __uint_as_float(w & 0xffff0000u);
        const float ss = wave_sum(f0 * f0 + f1 * f1); const float rs = rsqrtf(ss * (1.f / 128.f) + EPS);
        const float* kg = C.in[I_XKG] + l * 128 + 2 * lane;
        *(unsigned*)(C.memK + (size_t)r * 128 + 2 * lane) = pk2(f0 * rs * kg[0], f1 * rs * kg[1]);
    }
    const int gt = gw * 64 + lane, NGT = NGW * 64;
    for (int t = gt; t < 32 * 32 * 128; t += NGT) {
        const int d = t & 127, pg = (t >> 7) & 31, combo = t >> 12, l = combo >> 3, b = (combo >> 2) & 1, h = combo & 3;
        const int kbase = (pg >> 2) * 32 + (pg & 3) * 4;
        const bf16_t* src = C.memkv + ((size_t)(l * 512 + b * 256)) * 1024 + 512 + h * 128 + d;
        unsigned short v[8];
#pragma unroll
        for (int e = 0; e < 4; ++e) { v[e] = src[(size_t)(kbase + e) * 1024]; v[4 + e] = src[(size_t)(kbase + 16 + e) * 1024]; }
        u32x4 o; o[0] = v[0] | ((unsigned)v[1] << 16); o[1] = v[2] | ((unsigned)v[3] << 16); o[2] = v[4] | ((unsigned)v[5] << 16); o[3] = v[6] | ((unsigned)v[7] << 16);
        *(u32x4*)(C.memVt + ((size_t)combo * 128 + d) * 256 + pg * 8) = o;
    }
}

__device__ __forceinline__ void xa_pair_mfma(LAS unsigned char* lds, const Ctx& C, int l, int pairidx) {
    const int tid = opaque_tid(), lane = tid & 63, w = __builtin_amdgcn_readfirstlane(tid >> 6), fr = lane & 15, fq = lane >> 4;
    LAS bf16_t* Ks = (LAS bf16_t*)lds;
    LAS bf16_t* Vt = Ks + 256 * 144;
    const int idx0 = pairidx * 2, bh = idx0 >> 6, b = bh >> 2, h = bh & 3, nb0 = idx0 & 63;
    u32x4 qr[2][4];
#pragma unroll
    for (int tt = 0; tt < 2; ++tt) { const bf16_t* qp = C.za + (size_t)((b * 64 + nb0 + tt) * 128 + w * 16 + fr) * NZA + 2816 + h * 128 + 8 * fq;
#pragma unroll
        for (int ks = 0; ks < 4; ++ks) qr[tt][ks] = *(const u32x4*)(qp + 32 * ks); }
    {
        const u32x4* ksrc = (const u32x4*)(C.memK + ((size_t)(l * 8 + bh)) * 256 * 128);
        const u32x4* vsrc = (const u32x4*)(C.memVt + ((size_t)(l * 8 + bh)) * 128 * 256);
#pragma unroll
        for (int i = 0; i < 8; ++i) { const int ch = i * 512 + tid;
            *(LAS u32x4*)(Ks + (ch >> 4) * 144 + (ch & 15) * 8) = ksrc[ch];
            *(LAS u32x4*)(Vt + (ch >> 5) * 272 + (ch & 31) * 8) = vsrc[ch]; }
    }
    __syncthreads();
    float gqx[32];
    { const float* qg = C.in[I_XQG] + l * 128 + 8 * fq;
#pragma unroll
      for (int ks = 0; ks < 4; ++ks)
#pragma unroll
          for (int i = 0; i < 8; ++i) gqx[8 * ks + i] = qg[32 * ks + i] * (0.08838834764831845f * 1.4426950408889634f); }
#pragma unroll
    for (int tt = 0; tt < 2; ++tt) {
        const size_t row = (size_t)((b * 64 + nb0 + tt) * 128 + w * 16 + fr);
        bf16x8 qf[4];
        {
            float f[32];
#pragma unroll
            for (int ks = 0; ks < 4; ++ks) { const u32x4 wv = qr[tt][ks]; UNPACK8(wv, f, 8 * ks); }
            float ss = 0.f;
#pragma unroll
            for (int i = 0; i < 32; ++i) ss += f[i] * f[i];
            ss += __shfl_xor(ss, 16); ss += __shfl_xor(ss, 32);
            const float rs = rsqrtf(ss * (1.f / 128.f) + EPS);
#pragma unroll
            for (int ks = 0; ks < 4; ++ks) {
#pragma unroll
                for (int i = 0; i < 8; ++i) f[8 * ks + i] *= rs * gqx[8 * ks + i];
                qf[ks] = pack_bf16x8(f + 8 * ks); }
        }
        f32x4 acc[16];
#pragma unroll
        for (int kb = 0; kb < 16; ++kb) { acc[kb] = (f32x4){0.f, 0.f, 0.f, 0.f};
#pragma unroll
            for (int ks = 0; ks < 4; ++ks) { const bf16x8 kf = *(const LAS bf16x8*)(Ks + (kb * 16 + fr) * 144 + 32 * ks + 8 * fq); acc[kb] = MFMA16(kf, qf[ks], acc[kb]); } }
        float mx = -3.0e38f;
#pragma unroll
        for (int kb = 0; kb < 16; ++kb) mx = fmaxf(fmaxf(fmaxf(acc[kb][0], acc[kb][1]), fmaxf(acc[kb][2], acc[kb][3])), mx);
        mx = fmaxf(mx, __shfl_xor(mx, 16)); mx = fmaxf(mx, __shfl_xor(mx, 32));
        float lsum = 0.f;
#pragma unroll
        for (int kb = 0; kb < 16; ++kb)
#pragma unroll
            for (int e = 0; e < 4; ++e) { const float pv = __builtin_amdgcn_exp2f(acc[kb][e] - mx); acc[kb][e] = pv; lsum += pv; }
        lsum += __shfl_xor(lsum, 16); lsum += __shfl_xor(lsum, 32);
        const float inv = 1.f / lsum;
        bf16x8 pf[8];
#pragma unroll
        for (int j = 0; j < 8; ++j) { u32x4 wv; wv[0] = cvt_pk_bf16(acc[2 * j][0], acc[2 * j][1]); wv[1] = cvt_pk_bf16(acc[2 * j][2], acc[2 * j][3]); wv[2] = cvt_pk_bf16(acc[2 * j + 1][0], acc[2 * j + 1][1]); wv[3] = cvt_pk_bf16(acc[2 * j + 1][2], acc[2 * j + 1][3]); pf[j] = __builtin_bit_cast(bf16x8, wv); }
        bf16_t* op = C.o + row * NO + 1536 + h * 128 + 4 * fq;
#pragma unroll
        for (int db = 0; db < 8; ++db) {
            f32x4 o = (f32x4){0.f, 0.f, 0.f, 0.f};
#pragma unroll
            for (int j = 0; j < 8; ++j) { const bf16x8 vf = *(const LAS bf16x8*)(Vt + (db * 16 + fr) * 272 + 32 * j + 8 * fq); o = MFMA16(vf, pf[j], o); }
            *(u32x2*)(op + db * 16) = (u32x2){cvt_pk_bf16(o[0] * inv, o[1] * inv), cvt_pk_bf16(o[2] * inv, o[3] * inv)};
        }
    }
    __syncthreads();
}

__device__ __forceinline__ void swa_item_mfma(LAS unsigned char* lds, const Ctx& C, int l, int tile, int kvh) {
    const int tid = opaque_tid(), lane = tid & 63, w = __builtin_amdgcn_readfirstlane(tid >> 6), fr = lane & 15, fq = lane >> 4;
    LAS bf16_t* Ks = (LAS bf16_t*)lds;
    LAS bf16_t* Vt = Ks + 256 * 80;
    const int nb = tile & 63, row0 = tile * 128;
    const bf16_t* qbase = C.za + (size_t)(row0 + 16 * w + fr) * NZA + 2048 + kvh * 256 + 8 * fq;
    u32x4 qn0 = *(const u32x4*)qbase, qn1 = *(const u32x4*)(qbase + 32);
    {
        const int key = tid >> 1, half = tid & 1;
        const bool ok = (nb > 0) || (key >= 128);
        const size_t grow = (size_t)(ok ? row0 - 128 + key : row0);
        const u32x4* kp = (const u32x4*)(C.za + grow * NZA + 2560 + kvh * 64 + half * 32);
        const u32x4* vp = (const u32x4*)(C.za + grow * NZA + 2688 + kvh * 64 + half * 32);
        float kf[32]; float ss = 0.f;
#pragma unroll
        for (int i = 0; i < 4; ++i) { const u32x4 wv = kp[i]; UNPACK8(wv, kf, 8 * i); }
#pragma unroll
        for (int i = 0; i < 32; ++i) ss += kf[i] * kf[i];
        ss += __shfl_xor(ss, 1);
        const float rs = rsqrtf(ss * (1.f / 64.f) + EPS);
        const float* kg = C.in[I_SKG] + l * 64 + half * 32;
#pragma unroll
        for (int i = 0; i < 32; ++i) kf[i] *= rs * kg[i];
        if (half == 0) { const int posi = ok ? nb * 128 - 128 + key : 0; ROPE16T(kf, C.rope + (size_t)posi * 16); }
#pragma unroll
        for (int i = 0; i < 4; ++i) *(LAS u32x4*)(Ks + key * 80 + half * 32 + 8 * i) = PACK8(kf, 8 * i);
        const int pp = vperm_pos(key);
#pragma unroll
        for (int i = 0; i < 4; ++i) { u32x4 wv = vp[i]; if (!ok) wv = (u32x4){0u, 0u, 0u, 0u};
#pragma unroll
            for (int e = 0; e < 4; ++e) { Vt[(half * 32 + 8 * i + 2 * e) * 272 + pp] = (bf16_t)(wv[e] & 0xffffu); Vt[(half * 32 + 8 * i + 2 * e + 1) * 272 + pp] = (bf16_t)(wv[e] >> 16); } }
    }
    __syncthreads();
    const int i0 = 16 * w, ws2 = w & ~1, qi = i0 + fr;
    float rc[8], rsn[8];
    { const f32x4* tp = (const f32x4*)(C.rope + (size_t)(nb * 128 + qi) * 16);
#pragma unroll
      for (int i = 0; i < 4; ++i) { const f32x4 cs = tp[i]; rc[2 * i] = cs[0]; rsn[2 * i] = cs[1]; rc[2 * i + 1] = cs[2]; rsn[2 * i + 1] = cs[3]; } }
    const size_t row = (size_t)(row0 + qi);
    float gq[16];
    { const float* qg = C.in[I_SQG] + l * 64 + 8 * fq;
#pragma unroll
      for (int i = 0; i < 8; ++i) { gq[i] = qg[i] * (0.125f * 1.4426950408889634f); gq[8 + i] = qg[32 + i] * (0.125f * 1.4426950408889634f); } }
    for (int hh = 0; hh < 4; ++hh) {
        const int h = kvh * 4 + hh;
        bf16x8 qf[2];
        {
            float f[16];
            { const u32x4 w0 = qn0, w1 = qn1; UNPACK8(w0, f, 0); UNPACK8(w1, f, 8); }
            if (hh < 3) { qn0 = *(const u32x4*)(qbase + 64 * (hh + 1)); qn1 = *(const u32x4*)(qbase + 64 * (hh + 1) + 32); }
            float ss = 0.f;
#pragma unroll
            for (int i = 0; i < 16; ++i) ss += f[i] * f[i];
            ss += __shfl_xor(ss, 16); ss += __shfl_xor(ss, 32);
            const float rs = rsqrtf(ss * (1.f / 64.f) + EPS);
#pragma unroll
            for (int i = 0; i < 16; ++i) f[i] *= rs * gq[i];
#pragma unroll
            for (int i = 0; i < 8; ++i) { const float other = __shfl_xor(f[i], 16);
                const float r0 = f[i] * rc[i] - other * rsn[i], r1 = f[i] * rc[i] + other * rsn[i];
                f[i] = (fq == 0) ? r0 : (fq == 1) ? r1 : f[i]; }
            qf[0] = pack_bf16x8(f); qf[1] = pack_bf16x8(f + 8);
        }
        f32x4 acc[10];
#pragma unroll
        for (int kk = 0; kk < 10; ++kk) { acc[kk] = (f32x4){0.f, 0.f, 0.f, 0.f};
            if ((kk == 0 && (w & 1)) || (kk == 9 && !(w & 1))) continue;
#pragma unroll
            for (int ks = 0; ks < 2; ++ks) { const bf16x8 kf = *(const LAS bf16x8*)(Ks + ((ws2 + kk) * 16 + fr) * 80 + 32 * ks + 8 * fq); acc[kk] = MFMA16(kf, qf[ks], acc[kk]); } }
        const float sink = C.in[I_SINK][l * 8 + h] * 1.4426950408889634f;
        float mx = sink;
        const int sh = w & 1;
#pragma unroll
        for (int kk = 0; kk < 10; ++kk) {
            const int dlt = kk - sh;
            if (nb > 0 && dlt >= 1 && dlt <= 7) {
#pragma unroll
                for (int e = 0; e < 4; ++e) mx = fmaxf(mx, acc[kk][e]);
            } else {
#pragma unroll
                for (int e = 0; e < 4; ++e) { const int kj = (ws2 + kk) * 16 + 4 * fq + e, dd = kj - qi; const bool valid = (dd >= 1) && (dd <= 128) && ((nb > 0) || (kj >= 128));
                    const float sv = valid ? acc[kk][e] : -INFINITY; acc[kk][e] = sv; mx = fmaxf(mx, sv); }
            }
        }
        mx = fmaxf(mx, __shfl_xor(mx, 16)); mx = fmaxf(mx, __shfl_xor(mx, 32));
        float lsum = 0.f;
#pragma unroll
        for (int kk = 0; kk < 10; ++kk)
#pragma unroll
            for (int e = 0; e < 4; ++e) { const float pv = __builtin_amdgcn_exp2f(acc[kk][e] - mx); acc[kk][e] = pv; lsum += pv; }
        lsum += __shfl_xor(lsum, 16); lsum += __shfl_xor(lsum, 32);
        lsum += __builtin_amdgcn_exp2f(sink - mx);
        const float inv = 1.f / lsum;
        bf16x8 pf[5];
#pragma unroll
        for (int j = 0; j < 5; ++j) { u32x4 wv; wv[0] = cvt_pk_bf16(acc[2 * j][0], acc[2 * j][1]); wv[1] = cvt_pk_bf16(acc[2 * j][2], acc[2 * j][3]); wv[2] = cvt_pk_bf16(acc[2 * j + 1][0], acc[2 * j + 1][1]); wv[3] = cvt_pk_bf16(acc[2 * j + 1][2], acc[2 * j + 1][3]); pf[j] = __builtin_bit_cast(bf16x8, wv); }
        bf16_t* op = C.o + row * NO + 1024 + h * 64 + 4 * fq;
#pragma unroll
        for (int db = 0; db < 4; ++db) {
            f32x4 o = (f32x4){0.f, 0.f, 0.f, 0.f};
#pragma unroll
            for (int j = 0; j < 5; ++j) { const bf16x8 vf = *(const LAS bf16x8*)(Vt + (db * 16 + fr) * 272 + (ws2 + 2 * j) * 16 + 8 * fq); o = MFMA16(vf, pf[j], o); }
            *(u32x2*)(op + db * 16) = (u32x2){cvt_pk_bf16(o[0] * inv, o[1] * inv), cvt_pk_bf16(o[2] * inv, o[3] * inv)};
        }
    }
    __syncthreads();
}

__device__ __forceinline__ void gm_item_mfma(LAS unsigned char* lds, const Ctx& C, int l, int tile, int g) {
    const int tid = opaque_tid(), lane = tid & 63, w = __builtin_amdgcn_readfirstlane(tid >> 6), fr = lane & 15, fq = lane >> 4;
    LAS bf16_t* Wl = (LAS bf16_t*)lds;
    LAS bf16_t* vT = Wl + 128 * 144;
    LAS float* rsv = (LAS float*)(vT + 128 * 144);
    const int row0 = tile * 128;
    {
        if (tid < 128) { const f32x4* pp = (const f32x4*)(C.ssv + (size_t)(row0 + tid) * 8); const f32x4 a = pp[0], b2 = pp[1];
            rsv[tid] = rsqrtf((((a[0] + a[1]) + (a[2] + a[3])) + ((b2[0] + b2[1]) + (b2[2] + b2[3]))) * (1.f / 512.f) + EPS); }
        const int tok = tid >> 2, sub = tid & 3;
        const u32x4* gp = (const u32x4*)(C.za + (size_t)(row0 + tok) * NZA + 512 + g * 128 + sub * 32);
#pragma unroll
        for (int i = 0; i < 4; ++i) { const u32x4 wv = gp[i];
#pragma unroll
            for (int e = 0; e < 4; ++e) { vT[(sub * 32 + 8 * i + 2 * e) * 144 + tok] = (bf16_t)(wv[e] & 0xffffu); vT[(sub * 32 + 8 * i + 2 * e + 1) * 144 + tok] = (bf16_t)(wv[e] >> 16); } }
    }
    const int t_ = tid >> 2, s0 = (tid & 3) * 32;
    f32x4 wreg[8];
    { const f32x4* wp = (const f32x4*)(C.in[I_GMWS] + ((size_t)(l * 4 + g) * 128 + t_) * 128 + s0);
#pragma unroll
      for (int i = 0; i < 8; ++i) wreg[i] = wp[i]; }
    __syncthreads();
    {
#pragma unroll
        for (int i = 0; i < 4; ++i) { const f32x4 a = wreg[2 * i], b2 = wreg[2 * i + 1]; float f[8] = {a[0], a[1], a[2], a[3], b2[0], b2[1], b2[2], b2[3]};
#pragma unroll
            for (int e = 0; e < 8; ++e) { const int sidx = s0 + 8 * i + e; f[e] = (sidx <= t_) ? f[e] * rsv[sidx] : 0.f; }
            *(LAS u32x4*)(Wl + t_ * 144 + s0 + 8 * i) = PACK8(f, 0); }
    }
    __syncthreads();
    {
        const int nks = (w + 2) >> 1;
        f32x4 acc[8];
#pragma unroll
        for (int cb = 0; cb < 8; ++cb) acc[cb] = (f32x4){0.f, 0.f, 0.f, 0.f};
        for (int ks = 0; ks < nks; ++ks) {
            const bf16x8 wf = *(const LAS bf16x8*)(Wl + (16 * w + fr) * 144 + 32 * ks + 8 * fq);
#pragma unroll
            for (int cb = 0; cb < 8; ++cb) { const bf16x8 vf = *(const LAS bf16x8*)(vT + (cb * 16 + fr) * 144 + 32 * ks + 8 * fq); acc[cb] = MFMA16(vf, wf, acc[cb]); }
        }
        const int t = 16 * w + fr; const size_t r = (size_t)(row0 + t);
        const float bsv = C.in[I_GMBS][(size_t)(l * 4 + g) * 128 + t];
        const float* vg = C.in[I_GMVG] + l * 512 + g * 128 + 4 * fq;
        const bf16_t* up = C.za + r * NZA + g * 128 + 4 * fq; bf16_t* op = C.o + r * NO + g * 128 + 4 * fq;
#pragma unroll
        for (int cb = 0; cb < 8; ++cb) { const f32x4 gn = *(const f32x4*)(vg + cb * 16); const u32x2 uw = *(const u32x2*)(up + cb * 16);
            const float u0 = __uint_as_float(uw[0] << 16), u1 = __uint_as_float(uw[0] & 0xffff0000u), u2 = __uint_as_float(uw[1] << 16), u3 = __uint_as_float(uw[1] & 0xffff0000u);
            *(u32x2*)(op + cb * 16) = (u32x2){cvt_pk_bf16(u0 * (gn[0] * acc[cb][0] + bsv), u1 * (gn[1] * acc[cb][1] + bsv)), cvt_pk_bf16(u2 * (gn[2] * acc[cb][2] + bsv), u3 * (gn[3] * acc[cb][3] + bsv))}; }
    }
    __syncthreads();
}

__device__ __forceinline__ void lru_item_mfma(LAS unsigned char* lds, const Ctx& C, int l, int tile, int hb) {
    const int tid = opaque_tid(), lane = tid & 63, w = __builtin_amdgcn_readfirstlane(tid >> 6), fr = lane & 15, fq = lane >> 4;
    LAS bf16_t* xcb = (LAS bf16_t*)lds;
    LAS bf16_t* wrT = xcb + 128 * 80;
    LAS bf16_t* wiT = wrT + 64 * 80;
    LAS float* xcf = (LAS float*)(lds + 40960);
    LAS float* aa = xcf + 8192;
    LAS float* bb = aa + 8192;
    LAS float* segA = bb + 8192;
    LAS float* segH = segA + 512;
    const int nb = tile & 63, row0 = tile * 128;
    {
        const int t = tid >> 2, c0 = (tid & 3) * 16, ch = hb * 64 + c0;
        float acc[16];
#pragma unroll
        for (int i = 0; i < 16; ++i) acc[i] = C.in[I_CONVB][l * 512 + ch + i];
#pragma unroll
        for (int k = 0; k < 4; ++k) {
            const int tt = t - 3 + k;
            if (nb * 128 + tt >= 0) {
                const u32x4* xp = (const u32x4*)(C.za + (size_t)(row0 + tt) * NZA + 1024 + ch);
                float f[16]; const u32x4 w0 = xp[0], w1 = xp[1]; UNPACK8(w0, f, 0); UNPACK8(w1, f, 8);
                const float* cw = C.in[I_CONVW] + (size_t)(l * 4 + k) * 512 + ch;
#pragma unroll
                for (int i = 0; i < 16; ++i) acc[i] += cw[i] * f[i];
            }
        }
#pragma unroll
        for (int i = 0; i < 4; ++i) *(LAS f32x4*)(xcf + t * 64 + c0 + 4 * i) = (f32x4){acc[4 * i], acc[4 * i + 1], acc[4 * i + 2], acc[4 * i + 3]};
        *(LAS u32x4*)(xcb + t * 80 + c0) = PACK8(acc, 0); *(LAS u32x4*)(xcb + t * 80 + c0 + 8) = PACK8(acc, 8);
        const u32x4* wsrc = (const u32x4*)(C.wgT + (size_t)(l * 8 + hb) * 2 * 4096);
#pragma unroll
        for (int i = 0; i < 2; ++i) { const int c = i * 512 + tid; *(LAS u32x4*)(wrT + (c >> 3) * 80 + (c & 7) * 8) = wsrc[c]; }
    }
    __syncthreads();
    {
        bf16x8 xf[2];
#pragma unroll
        for (int ks = 0; ks < 2; ++ks) xf[ks] = *(const LAS bf16x8*)(xcb + (16 * w + fr) * 80 + 32 * ks + 8 * fq);
#pragma unroll
        for (int jb = 0; jb < 4; ++jb) {
            f32x4 ar = (f32x4){0.f, 0.f, 0.f, 0.f}, ai = (f32x4){0.f, 0.f, 0.f, 0.f};
#pragma unroll
            for (int ks = 0; ks < 2; ++ks) { const bf16x8 wf = *(const LAS bf16x8*)(wrT + (jb * 16 + fr) * 80 + 32 * ks + 8 * fq); ar = MFMA16(xf[ks], wf, ar);
                const bf16x8 wf2 = *(const LAS bf16x8*)(wiT + (jb * 16 + fr) * 80 + 32 * ks + 8 * fq); ai = MFMA16(xf[ks], wf2, ai); }
            const int j = jb * 16 + fr, chj = l * 512 + hb * 64 + j;
            const float br = -1.4426950408889634f * C.in[I_BR][chj], bi = -1.4426950408889634f * C.in[I_BI][chj], sp8 = (-8.f * 1.4426950408889634f) * C.spl[chj];
#pragma unroll
            for (int e = 0; e < 4; ++e) { const int t = 16 * w + 4 * fq + e;
                const float r = __builtin_amdgcn_rcpf(1.f + __builtin_amdgcn_exp2f(fmaf(ar[e], -1.4426950408889634f, br))), ig = __builtin_amdgcn_rcpf(1.f + __builtin_amdgcn_exp2f(fmaf(ai[e], -1.4426950408889634f, bi)));
                const float a = __builtin_amdgcn_exp2f(r * sp8); const float mult = __builtin_amdgcn_sqrtf(fmaxf(1.f - a * a, 0.f));
                aa[t * 64 + j] = a; bb[t * 64 + j] = xcf[t * 64 + j] * ig * mult; }
        }
    }
    __syncthreads();
    const int j = tid & 63, sg = tid >> 6;
    float av[16], bv[16], Gv[16];
    {
#pragma unroll
        for (int k = 0; k < 16; ++k) { av[k] = aa[(sg * 16 + k) * 64 + j]; bv[k] = bb[(sg * 16 + k) * 64 + j]; }
#pragma unroll
        for (int k = 0; k < 16; ++k) Gv[k] = bf2f(C.za[(size_t)(row0 + sg * 16 + k) * NZA + 1536 + hb * 64 + j]);
        float hh = 0.f, P = 1.f;
#pragma unroll
        for (int k = 0; k < 16; ++k) { hh = av[k] * hh + bv[k]; P *= av[k]; av[k] = P; bv[k] = hh; }
        segA[sg * 64 + j] = P; segH[sg * 64 + j] = hh;
    }
    __syncthreads();
    LAS float* cin = segH + 512;
    float Hc = 0.f, Pc = 1.f;
    for (int s2 = 0; s2 < sg; ++s2) { const float a = segA[s2 * 64 + j]; Hc = a * Hc + segH[s2 * 64 + j]; Pc *= a; }
    const int chj = hb * 64 + j, bt = tile >> 6;
    const size_t wbase = (size_t)l * 128 * 512 + chj;
    if (sg == 7) {
        const float At = Pc * segA[7 * 64 + j], Hl = segA[7 * 64 + j] * Hc + segH[7 * 64 + j];
        __hip_atomic_store(C.agg + wbase + (size_t)tile * 512, ((unsigned long long)__float_as_uint(Hl) << 32) | (unsigned long long)(__float_as_uint(At) | 1u), __ATOMIC_RELAXED, __HIP_MEMORY_SCOPE_AGENT);
    }
    if (sg == 0) {
        const int r0 = nb & ~15;
        unsigned long long wv[16]; unsigned spins = 0;
        for (;;) {
            bool ok = true;
#pragma unroll
            for (int i = 0; i < 16; ++i) {
                const int n = r0 - 1 + i; const bool need = (i == 0) ? (r0 > 0) : (n < nb);
                const unsigned long long* pw = (i == 0 ? C.inc : C.agg) + wbase + (size_t)(bt * 64 + (need ? n : 0)) * 512;
                wv[i] = need ? __hip_atomic_load(pw, __ATOMIC_RELAXED, __HIP_MEMORY_SCOPE_AGENT) : 1ull;
                ok = ok && (wv[i] != 0ull);
            }
            if (ok || ++spins > (1u << 20)) break;
            __builtin_amdgcn_s_sleep(2);
        }
        float Hin = (r0 > 0) ? __uint_as_float((unsigned)(wv[0] >> 32)) : 0.f;
#pragma unroll
        for (int i = 1; i < 16; ++i) if (r0 - 1 + i < nb) Hin = __uint_as_float((unsigned)wv[i]) * Hin + __uint_as_float((unsigned)(wv[i] >> 32));
        cin[j] = Hin;
    }
    __syncthreads();
    {
        const float Hs = Hc + Pc * cin[j];
        float hl = 0.f;
#pragma unroll
        for (int k = 0; k < 16; ++k) { const int t = sg * 16 + k; hl = bv[k] + av[k] * Hs;
            C.o[(size_t)(row0 + t) * NO + 512 + chj] = (bf16_t)(cvt_pk_bf16(Gv[k] * hl, 0.f) & 0xffffu); }
        if (sg == 7) __hip_atomic_store(C.inc + wbase + (size_t)tile * 512, ((unsigned long long)__float_as_uint(hl) << 32) | 1ull, __ATOMIC_RELAXED, __HIP_MEMORY_SCOPE_AGENT);
    }
    __syncthreads();
}

__device__ __forceinline__ void fix_item(const Ctx& C, int tile, int half) {
    const int c = opaque_tid(), b = tile >> 6, nb = tile & 63, row0 = tile * 128 + half * 64;
    float H = 0.f;
    for (int jn = 0; jn < nb; ++jn) { const size_t idx = (size_t)(b * 64 + jn) * 512 + c; H = C.carryA[idx] * H + C.carryH[idx]; }
    for (int t = 0; t < 64; ++t) { const size_t r = (size_t)(row0 + t); C.o[r * NO + 512 + c] = (bf16_t)f2bf(C.ly[r * 512 + c] + C.lp[r * 512 + c] * H); }
}

#ifndef PROBE_KIND
#define PROBE_KIND -1
#endif
#ifndef PROBE_MULT
#define PROBE_MULT 4
#endif
#if PROBE_KIND >= 0
#define BAR(kind) do { const unsigned long long _tb = __builtin_amdgcn_s_memrealtime(); xcd_barrier(bar); const unsigned long long _te = __builtin_amdgcn_s_memrealtime(); \
    if (PROBE_KIND == 7 || (PROBE_KIND == 15 && (kind) == 2)) tacc += _te - _tb; else if ((kind) == PROBE_KIND) tacc += _te - tprev; tprev = _te; } while (0)
#define TS(kind) do { if (PROBE_KIND >= 10) { const unsigned long long _te = __builtin_amdgcn_s_memrealtime(); if ((kind) == PROBE_KIND) tacc += _te - tprev; tprev = _te; } } while (0)
#else
#define BAR(kind) xcd_barrier(bar)
#define TS(kind) do { } while (0)
#endif
__global__ void __launch_bounds__(512, 2) fwd_megakernel(Args args) {
    extern __shared__ __attribute__((aligned(16))) unsigned char lds_raw[];
    LAS unsigned char* lds = (LAS unsigned char*)lds_raw;
    volatile LAS unsigned* MISC = (volatile LAS unsigned*)(lds + MISC_OFF);
    const int tid = threadIdx.x, lane = tid & 63, wave = __builtin_amdgcn_readfirstlane(tid >> 6);
    const int G = gridDim.x, bx = blockIdx.x;
    unsigned char* ws = args.ws;
    Ctx C;
    C.in = args.in; C.x = args.out;
    C.wt_in = (bf16_t*)(ws + WS_WIN); C.wt_br = (bf16_t*)(ws + WS_WBR); C.wt_out = (bf16_t*)(ws + WS_WOUT); C.wt_ff1 = (bf16_t*)(ws + WS_WFF1); C.wt_ff2 = (bf16_t*)(ws + WS_WFF2); C.wt_kv = (bf16_t*)(ws + WS_WKV);
    C.memn = (bf16_t*)(ws + WS_MEMN); C.memkv = (bf16_t*)(ws + WS_MEMKV); C.xb = (bf16_t*)(ws + WS_XB); C.za = (bf16_t*)(ws + WS_ZA); C.zg = (bf16_t*)(ws + WS_ZG); C.mb = (bf16_t*)(ws + WS_MB); C.o = (bf16_t*)(ws + WS_O);
    C.ssq = (float*)(ws + WS_SSQ); C.carryA = (float*)(ws + WS_CARRY); C.carryH = C.carryA + 128 * 512; C.S = (float*)(ws + WS_S); C.ly = (float*)(ws + WS_LY); C.lp = (float*)(ws + WS_LP); C.memK = (bf16_t*)(ws + WS_MEMK); C.memVt = (bf16_t*)(ws + WS_MEMVT); C.spl = (float*)(ws + WS_SPL); C.rope = (float*)(ws + WS_ROPE); C.ssv = (float*)(ws + WS_SSV); C.wgT = (bf16_t*)(ws + WS_WGT); C.agg = (unsigned long long*)(ws + WS_AGG); C.inc = (unsigned long long*)(ws + WS_INC);

    if (tid < 64) MISC[tid] = 0u;
    __syncthreads();
    XcdBarrier bar = xcd_barrier_post((unsigned*)(ws + WS_CTL), MISC + 8);
    const int gw = bx * 8 + wave, NGW = G * 8;
    LAS float* scr = (LAS float*)(lds + wave * 16384);
#if PROBE_KIND >= 0
    unsigned long long tacc = 0ull, tprev = __builtin_amdgcn_s_memrealtime();
#endif

    for (int it = gw; it < IT_WIN + 4 * IT_WKV; it += NGW) {
        if (it < IT_WIN) conv_w(C, 0, 0, it, scr, lane);
        else { const int r = it - IT_WIN; conv_w(C, 5, r / IT_WKV, r % IT_WKV, scr, lane); }
    }
    for (int m0 = gw; m0 < M; m0 += 4 * NGW) {
        f32x4 v[4][4];
#pragma unroll
        for (int q = 0; q < 4; ++q) { const int m = m0 + q * NGW; const f32x4* xr = (const f32x4*)(C.in[I_X] + (size_t)(m < M ? m : m0) * D) + lane;
#pragma unroll
            for (int jj = 0; jj < 4; ++jj) v[q][jj] = xr[64 * jj]; }
#pragma unroll
        for (int q = 0; q < 4; ++q) { const int m = m0 + q * NGW; if (m >= M) continue;
            float sq = 0.f;
#pragma unroll
            for (int jj = 0; jj < 4; ++jj) sq += (v[q][jj].x * v[q][jj].x + v[q][jj].y * v[q][jj].y) + (v[q][jj].z * v[q][jj].z + v[q][jj].w * v[q][jj].w);
            sq = wave_sum(sq);
            u32x2* bo = (u32x2*)(C.xb + (size_t)m * D) + lane;
#pragma unroll
            for (int jj = 0; jj < 4; ++jj) bo[64 * jj] = (u32x2){cvt_pk_bf16(v[q][jj].x, v[q][jj].y), cvt_pk_bf16(v[q][jj].z, v[q][jj].w)};
            if (lane < 16) C.ssq[(size_t)m * 16 + lane] = (lane == 0) ? sq : 0.f; }
    }
    for (int r = gw; r < 512; r += NGW) {
        const f32x4* xr = (const f32x4*)(C.in[I_MEM] + (size_t)r * D) + lane; f32x4 v[4]; float sq = 0.f;
#pragma unroll
        for (int jj = 0; jj < 4; ++jj) { v[jj] = xr[64 * jj]; sq += (v[jj].x * v[jj].x + v[jj].y * v[jj].y) + (v[jj].z * v[jj].z + v[jj].w * v[jj].w); }
        sq = wave_sum(sq); const float rs = rsqrtf(sq * (1.f / 1024.f) + EPS);
        u32x2* bo = (u32x2*)(C.memn + (size_t)r * D) + lane;
#pragma unroll
        for (int jj = 0; jj < 4; ++jj) bo[64 * jj] = (u32x2){cvt_pk_bf16(v[jj].x * rs, v[jj].y * rs), cvt_pk_bf16(v[jj].z * rs, v[jj].w * rs)};
    }
    { const int gt = bx * 512 + tid; if (gt < DEPTH * 512) C.spl[gt] = log1pf(expf(-C.in[I_LAM][gt])); }
    for (int c = bx * 512 + tid; c < DEPTH * 8 * 2 * 64 * 8; c += G * 512) {
        const int c8 = c & 7, jj = (c >> 3) & 63, gt2 = (c >> 9) & 1, lh = c >> 10;
        const float* src = C.in[gt2 ? I_WI : I_WR] + (size_t)lh * 4096 + (size_t)(c8 * 8) * 64 + jj;
        float f[8];
#pragma unroll
        for (int e = 0; e < 8; ++e) f[e] = src[e * 64];
        *(u32x4*)(C.wgT + (size_t)c * 8) = PACK8(f, 0);
    }
    for (int c = bx * 512 + tid; c < 8192 * 8; c += G * 512) {
        const int i = c & 7; const float inv = ROPE_INV(i); const float ang = (float)(c >> 3) * inv;
        C.rope[2 * c] = cosf(ang); C.rope[2 * c + 1] = sinf(ang);
    }
    { u32x4* zp = (u32x4*)(ws + WS_AGG); for (int i = bx * 512 + tid; i < (int)((WS_SSV - WS_AGG) / 16); i += G * 512) zp[i] = (u32x4){0u, 0u, 0u, 0u}; }
    __syncthreads();
    if (args.ws == nullptr) cg::this_grid().sync();
    BAR(0);

    for (int l = 0; l < DEPTH; ++l) {
        if (l == 0 && bx >= 64 && bx < 96) {
            pg8::Gemm g{C.memn, C.wt_kv}; pg8::SchedKV S{bx - 64}; pg8::EpiKV E{C.memkv};
            pg8::gemm_phase<pg8::EpiKV, pg8::SchedKV, true, D, D, D>(lds, g, S, E);
        }
        {
#ifndef SKIP_G1
            pg8::Gemm g{C.xb, C.wt_in}; pg8::SchedStd S; S.init(M, DIN, G, bx, D, D);
            pg8::EpiZ E{C.za, C.zg, C.ssq, C.in[I_BGATE] + (size_t)l * 4 * D, C.ssv};
            for (int rep = 0; rep < REP_G1; ++rep) pg8::gemm_phase<pg8::EpiZ, pg8::SchedStd, true, D, D, D>(lds, g, S, E);
#endif

        }
        const int cfirst = (l == 0) ? 96 : 64;
        if (G == 256 && bx >= cfirst) {
            const int lane_c = opaque_tid() & 63;
            const int cw = (bx - cfirst) * 8 + wave, NCW = (G - cfirst) * 8;
            for (int it = cw; it < IT_WBR + IT_WOUT + IT_WFF1 + IT_WFF2; it += NCW) {
                int r = it;
                if (r < IT_WBR) { conv_w(C, 1, l, r, scr, lane_c); continue; } r -= IT_WBR;
                if (r < IT_WOUT) { conv_w(C, 2, l, r, scr, lane_c); continue; } r -= IT_WOUT;
                if (r < IT_WFF1) { conv_w(C, 3, l, r, scr, lane_c); continue; } r -= IT_WFF1;
                conv_w(C, 4, l, r, scr, lane_c);
            }
        }
        BAR(1);
        TS(99);
        {
            if (l == 0) { kvprep_phase(C, gw, NGW, opaque_tid() & 63); BAR(2); }
            for (int rmix = 0; rmix < REP_MIX; ++rmix) {
#if USE_MFMA_SWA
            for (int rep = 0; rep < REP_SWA; ++rep) for (int it = bx; it < 256; it += G) swa_item_mfma(lds, C, l, it >> 1, it & 1);
#else
            for (int it = bx; it < 1024; it += G) swa_item(lds, C, l, it >> 3, it & 7);
#endif
            TS(10);
#if USE_MFMA_XA
            for (int rep = 0; rep < REP_XA; ++rep) for (int it = bx; it < 256; it += G) xa_pair_mfma(lds, C, l, it);
#else
            for (int it = bx; it < 512; it += G) xa_item(lds, C, l, it >> 2, it & 3);
#endif
            TS(11);
#if USE_MFMA_GM
            for (int rep = 0; rep < REP_GM; ++rep) for (int it = bx; it < 512; it += G) gm_item_mfma(lds, C, l, it >> 2, it & 3);
#else
            for (int it = bx; it < 512; it += G) gm_item(lds, C, l, it >> 2, it & 3);
#endif
            TS(12);
#if USE_MFMA_LRU
            for (int it = bx; it < 1024; it += G) lru_item_mfma(lds, C, l, ((it >> 3) & 1) * 64 + (it >> 4), it & 7);
#else
            for (int it = bx; it < 1024; it += G) lru_item(lds, C, l, it >> 3, it & 7);
#endif
            TS(13);
            }
            const int lane_c = opaque_tid() & 63;
            const int NC0 = (G == 256) ? 0 : IT_WBR + IT_WOUT + IT_WFF1 + IT_WFF2;
            const int NC = IT_WBR + IT_WOUT + IT_WFF1 + IT_WFF2 + (l + 1 < DEPTH ? IT_WIN : 0);
            for (int rep = 0; rep < REP_CONV; ++rep) for (int it = gw + (IT_WBR + IT_WOUT + IT_WFF1 + IT_WFF2 - NC0); it < NC; it += NGW) {
                int r = it;
                if (r < IT_WBR) { conv_w(C, 1, l, r, scr, lane_c); continue; } r -= IT_WBR;
                if (r < IT_WOUT) { conv_w(C, 2, l, r, scr, lane_c); continue; } r -= IT_WOUT;
                if (r < IT_WFF1) { conv_w(C, 3, l, r, scr, lane_c); continue; } r -= IT_WFF1;
                if (r < IT_WFF2) { conv_w(C, 4, l, r, scr, lane_c); continue; } r -= IT_WFF2;
                conv_w(C, 0, l + 1, r, scr, lane_c);
            }
            __syncthreads();
            TS(14);
        }
        BAR(2);
        {
#ifndef SKIP_G2
            pg8::Gemm g{C.o, C.wt_br}; pg8::SchedMerge S; S.t.init(M, D, G, bx, NO, NO);
            pg8::EpiMerge E{C.zg, C.mb};
            for (int rep = 0; rep < REP_G2; ++rep) pg8::gemm_phase<pg8::EpiMerge, pg8::SchedMerge, false, NO, NO, 512>(lds, g, S, E);
#endif

        }
        BAR(3);
        {
#ifndef SKIP_G3
            pg8::Gemm g{C.mb, C.wt_out}; pg8::SchedStd S; S.init(M, D, G, bx, D, D);
            pg8::EpiRes E{C.xb, C.xb, C.ssq, nullptr};
            pg8::gemm_phase<pg8::EpiRes, pg8::SchedStd, true, D, D, D>(lds, g, S, E);
#endif

        }
        BAR(4);
        {
#ifndef SKIP_G4
            pg8::Gemm g{C.xb, C.wt_ff1}; pg8::SchedStd S; S.init(M, FF, G, bx, D, D);
            pg8::EpiFF1 E{C.zg, C.ssq};
            for (int rep = 0; rep < REP_G4; ++rep) pg8::gemm_phase<pg8::EpiFF1, pg8::SchedStd, true, D, D, D>(lds, g, S, E);
#endif

        }
        BAR(5);
        {
#ifndef SKIP_G5
            pg8::Gemm g{C.zg, C.wt_ff2}; pg8::SchedStd S; S.init(M, D, G, bx, FF, FF);
            pg8::EpiRes E{C.xb, C.xb, C.ssq, (l + 1 == DEPTH) ? C.x : nullptr};
            pg8::gemm_phase<pg8::EpiRes, pg8::SchedStd, true, FF, FF, FF>(lds, g, S, E);
#endif

        }
        if (l + 1 < DEPTH) BAR(6);
    }
#if PROBE_KIND >= 0
    if (PROBE_KIND == 6) tacc += __builtin_amdgcn_s_memrealtime() - tprev;
    if (bx == 0 && tid == 0) { const unsigned long long target = tacc * PROBE_MULT, t0 = __builtin_amdgcn_s_memrealtime(); while (__builtin_amdgcn_s_memrealtime() - t0 < target) __builtin_amdgcn_s_sleep(8); }
#endif
}

extern "C" void kernel_launch(void* const* d_in, const int* in_sizes, int n_in, void* d_out, int out_size, void* d_ws, size_t ws_size, hipStream_t stream) {
    static int grid = 0;
    if (grid == 0) {
        if (n_in != 27 || out_size != M * D || ws_size < WS_END) { fprintf(stderr, "kernel_launch: unexpected shapes: n_in %d out %d ws %zu (need %zu)\n", n_in, out_size, ws_size, (size_t)WS_END); grid = -1; return; }
        int dev = 0, cus = 0, per_cu = 0;
        hipGetDevice(&dev); hipDeviceGetAttribute(&cus, hipDeviceAttributeMultiprocessorCount, dev);
        if (hipFuncSetAttribute((const void*)fwd_megakernel, hipFuncAttributeMaxDynamicSharedMemorySize, LDS_BYTES) != hipSuccess) { fprintf(stderr, "kernel_launch: hipFuncSetAttribute failed\n"); grid = -1; return; }
        if (hipOccupancyMaxActiveBlocksPerMultiprocessor(&per_cu, (const void*)fwd_megakernel, 512, LDS_BYTES) != hipSuccess || per_cu < 1) { fprintf(stderr, "kernel_launch: occupancy query says %d\n", per_cu); per_cu = 1; }
        (void)hipGetLastError();
        grid = cus;
        if (grid != 256) fprintf(stderr, "kernel_launch: note: %d CUs\n", grid);
    }
    if (grid < 0) return;
    hipMemsetAsync((char*)d_ws + WS_CTL, 0, CTL_ZERO_BYTES, stream);
    Args a{};
    for (int i = 0; i < 27; ++i) a.in[i] = (const float*)d_in[i];
    a.out = (float*)d_out; a.ws = (unsigned char*)d_ws;
    void* kargs[] = {&a};
    hipError_t e = hipLaunchCooperativeKernel((const void*)fwd_megakernel, dim3(grid), dim3(512), kargs, LDS_BYTES, stream);
    if (e != hipSuccess) fprintf(stderr, "kernel_launch: cooperative launch failed: %s\n", hipGetErrorString(e));
}
```
